# Optimizing an MI355X kernel written in HIP

```python
import jax
import jax.numpy as jnp
from jax import lax
import numpy as np


D_MODEL = 2048
BATCH = 1
SEQ = 16384
DEPTH = 2

GRID_W = 64
CTX_LEN = 256
N_MIXERS = 2
EPS = 1e-6
ROPE_THETA = 10000.0
Q_BLOCK = 128

MLA_HEADS = 16
Q_LORA = 512
KV_LORA = 512
QK_NOPE = 128
QK_ROPE = 64
QK_HEAD = QK_NOPE + QK_ROPE
V_DIM = 128

NA_HEADS = 16
NA_HEAD_DIM = D_MODEL // NA_HEADS
NA_KH = 8
NA_KW = 16

N_EXPERTS = 16
EXPERT_FF = 1408
EC_FACTOR = 2

kernel_name = 'hybrid_mla_natten_ecmoe_dit'


def rmsnorm(x, g):
    xf = x.astype(jnp.float32)
    y = xf * lax.rsqrt(jnp.mean(xf * xf, axis=-1, keepdims=True) + EPS)
    return (y * g.astype(jnp.float32)).astype(x.dtype)


def modulate(h, shift, scale):
    return h * (1.0 + scale) + shift


def axial_angles(n_tokens, rot_dim):
    half = rot_dim // 2
    inv = ROPE_THETA ** (-jnp.arange(0, half, 2, dtype=jnp.float32) / half)
    t = jnp.arange(n_tokens)
    row = (t // GRID_W).astype(jnp.float32)
    col = (t % GRID_W).astype(jnp.float32)
    return row[:, None] * inv[None, :], col[:, None] * inv[None, :]


def rotate(x, ang):
    m = ang.shape[-1]
    cos = jnp.cos(ang)[:, None, :].astype(x.dtype)
    sin = jnp.sin(ang)[:, None, :].astype(x.dtype)
    x1, x2 = x[..., :m], x[..., m:]
    return jnp.concatenate([x1 * cos - x2 * sin, x2 * cos + x1 * sin], axis=-1)


def apply_axial_rope(x, ang_r, ang_c):
    half = x.shape[-1] // 2
    return jnp.concatenate([rotate(x[..., :half], ang_r), rotate(x[..., half:], ang_c)], axis=-1)


def softmax_attend(q, k, v, scale):
    s = jnp.einsum('bqhd,bkhd->bhqk', q, k).astype(jnp.float32) * scale
    p = jax.nn.softmax(s, axis=-1).astype(v.dtype)
    return jnp.einsum('bhqk,bkhd->bqhd', p, v)


def mla_mixer(h_lat, h_ctx, w_in, q_a_gain, kv_a_gain, w_qb, w_kvb, q_gain, k_gain, w_o,
              ang_r, ang_c, with_ctx):
    def project(h, use_rope):
        B, T, _ = h.shape
        a = h @ w_in
        q_c = a[..., :Q_LORA]
        kv_c = a[..., Q_LORA:Q_LORA + KV_LORA]
        k_pe = a[..., Q_LORA + KV_LORA:]
        q = (rmsnorm(q_c, q_a_gain) @ w_qb).reshape(B, T, MLA_HEADS, QK_HEAD)
        kv = (rmsnorm(kv_c, kv_a_gain) @ w_kvb).reshape(B, T, MLA_HEADS, QK_NOPE + V_DIM)
        k = jnp.concatenate(
            [kv[..., :QK_NOPE], jnp.broadcast_to(k_pe[:, :, None, :], (B, T, MLA_HEADS, QK_ROPE))],
            axis=-1)
        v = kv[..., QK_NOPE:]
        q = rmsnorm(q, q_gain)
        k = rmsnorm(k, k_gain)
        if use_rope:
            q = jnp.concatenate([q[..., :QK_NOPE], apply_axial_rope(q[..., QK_NOPE:], ang_r, ang_c)], -1)
            k = jnp.concatenate([k[..., :QK_NOPE], apply_axial_rope(k[..., QK_NOPE:], ang_r, ang_c)], -1)
        return q, k, v

    B, N, _ = h_lat.shape
    scale = QK_HEAD ** -0.5
    q_l, k_l, v_l = project(h_lat, True)
    q_c, k_c, v_c = project(h_ctx, False)
    k_all = jnp.concatenate([k_c, k_l], axis=1)
    v_all = jnp.concatenate([v_c, v_l], axis=1)
    nb = N // Q_BLOCK
    qb = jnp.moveaxis(q_l.reshape(B, nb, Q_BLOCK, MLA_HEADS, QK_HEAD), 1, 0)
    o = lax.map(lambda qq: softmax_attend(qq, k_all, v_all, scale), qb)
    o_lat = jnp.moveaxis(o, 0, 1).reshape(B, N, MLA_HEADS * V_DIM) @ w_o
    o_ctx = None
    if with_ctx:
        L = h_ctx.shape[1]
        o_ctx = softmax_attend(q_c, k_c, v_c, scale).reshape(B, L, MLA_HEADS * V_DIM) @ w_o
    return o_lat, o_ctx


def na_mixer(h_lat, h_ctx, w_qkv, q_gain, k_gain, rpb, w_o, with_ctx):
    def project(h):
        B, T, _ = h.shape
        qkv = (h @ w_qkv).reshape(B, T, 3, NA_HEADS, NA_HEAD_DIM)
        return rmsnorm(qkv[:, :, 0], q_gain), rmsnorm(qkv[:, :, 1], k_gain), qkv[:, :, 2]

    B, N, _ = h_lat.shape
    rows = N // GRID_W
    kh = min(NA_KH, rows)
    scale = NA_HEAD_DIM ** -0.5
    q_l, k_l, v_l = project(h_lat)
    q_c, k_c, v_c = project(h_ctx)
    qg = q_l.reshape(B, rows, GRID_W, NA_HEADS, NA_HEAD_DIM)
    kg = k_l.reshape(B, rows, GRID_W, NA_HEADS, NA_HEAD_DIM)
    vg = v_l.reshape(B, rows, GRID_W, NA_HEADS, NA_HEAD_DIM)

    col = jnp.arange(GRID_W)
    col_start = jnp.clip(col - NA_KW // 2, 0, GRID_W - NA_KW)
    col_mask = (col[None, :] >= col_start[:, None]) & (col[None, :] < col_start[:, None] + NA_KW)
    dc_idx = jnp.clip(col[None, :] - col[:, None], -(NA_KW - 1), NA_KW - 1) + NA_KW - 1
    row_start = jnp.clip(jnp.arange(rows) - kh // 2, 0, rows - kh)

    def row_fn(r):
        r0 = row_start[r]
        k_win = lax.dynamic_slice_in_dim(kg, r0, kh, axis=1)
        v_win = lax.dynamic_slice_in_dim(vg, r0, kh, axis=1)
        q_r = lax.dynamic_index_in_dim(qg, r, axis=1, keepdims=False)
        dr = r0 + jnp.arange(kh) - r
        bias = rpb[:, dr + NA_KH - 1][:, :, dc_idx].transpose(0, 2, 1, 3)
        s_win = (jnp.einsum('bqhd,bjkhd->bhqjk', q_r, k_win).astype(jnp.float32) * scale
                 + bias[None].astype(jnp.float32))
        s_win = jnp.where(col_mask[None, None, :, None, :], s_win, -jnp.inf)
        s_ctx = jnp.einsum('bqhd,bkhd->bhqk', q_r, k_c).astype(jnp.float32) * scale
        s = jnp.concatenate([s_win.reshape(B, NA_HEADS, GRID_W, kh * GRID_W), s_ctx], axis=-1)
        p = jax.nn.softmax(s, axis=-1).astype(v_l.dtype)
        p_win = p[..., :kh * GRID_W].reshape(B, NA_HEADS, GRID_W, kh, GRID_W)
        p_ctx = p[..., kh * GRID_W:]
        return (jnp.einsum('bhqjk,bjkhd->bqhd', p_win, v_win)
                + jnp.einsum('bhqk,bkhd->bqhd', p_ctx, v_c))

    o = lax.map(row_fn, jnp.arange(rows))
    o_lat = jnp.moveaxis(o, 0, 1).reshape(B, N, D_MODEL) @ w_o
    o_ctx = None
    if with_ctx:
        L = h_ctx.shape[1]
        o_ctx = softmax_attend(q_c, k_c, v_c, scale).reshape(B, L, D_MODEL) @ w_o
    return o_lat, o_ctx


def ec_moe(h, router_w, w_gate, w_up, w_down):
    B, T, D = h.shape
    cap = EC_FACTOR * T // N_EXPERTS
    aff = jax.nn.softmax((h @ router_w).astype(jnp.float32), axis=-1)
    g, idx = lax.top_k(jnp.swapaxes(aff, 1, 2), cap)
    xs = jax.vmap(lambda hb, ib: hb[ib])(h, idx)
    hid = (jax.nn.silu(jnp.einsum('becd,edf->becf', xs, w_gate))
           * jnp.einsum('becd,edf->becf', xs, w_up))
    y = jnp.einsum('becf,efd->becd', hid, w_down) * g[..., None].astype(h.dtype)
    return jax.vmap(
        lambda yb, ib: jnp.zeros((T, D), yb.dtype).at[ib.reshape(-1)].add(yb.reshape(-1, D)))(y, idx)


def setup_inputs(seed: int = 0) -> dict:
    key = jax.random.key(seed)
    ks = jax.random.split(key, 28)
    f32 = jnp.float32
    n_mla = (DEPTH + 1) // 2
    n_na = DEPTH // 2

    def nrm(k, shape, scale):
        return jax.random.normal(k, shape, f32) * scale

    def gain(k, shape):
        return 1.0 + 0.05 * jax.random.normal(k, shape, f32)

    return {
        'x': nrm(ks[0], (BATCH, SEQ, D_MODEL), 1.0),
        'c': nrm(ks[1], (BATCH, D_MODEL), 1.0),
        'ctx': nrm(ks[2], (BATCH, CTX_LEN, D_MODEL), 1.0),
        'c_ctx': nrm(ks[3], (D_MODEL,), 1.0),
        'ada_w': nrm(ks[4], (DEPTH, D_MODEL, 6 * D_MODEL), 0.5 * D_MODEL ** -0.5),
        'ada_b': nrm(ks[5], (DEPTH, 6 * D_MODEL), 0.02),
        'norm_mix': gain(ks[6], (DEPTH, D_MODEL)),
        'norm_ffn': gain(ks[7], (DEPTH, D_MODEL)),
        'mla_w_in': nrm(ks[8], (n_mla, D_MODEL, Q_LORA + KV_LORA + QK_ROPE), D_MODEL ** -0.5),
        'mla_q_a_gain': gain(ks[9], (n_mla, Q_LORA)),
        'mla_kv_a_gain': gain(ks[10], (n_mla, KV_LORA)),
        'mla_w_qb': nrm(ks[11], (n_mla, Q_LORA, MLA_HEADS * QK_HEAD), Q_LORA ** -0.5),
        'mla_w_kvb': nrm(ks[12], (n_mla, KV_LORA, MLA_HEADS * (QK_NOPE + V_DIM)), KV_LORA ** -0.5),
        'mla_q_gain': gain(ks[13], (n_mla, QK_HEAD)),
        'mla_k_gain': gain(ks[14], (n_mla, QK_HEAD)),
        'mla_w_o': nrm(ks[15], (n_mla, MLA_HEADS * V_DIM, D_MODEL), (MLA_HEADS * V_DIM) ** -0.5),
        'na_w_qkv': nrm(ks[16], (n_na, D_MODEL, 3 * D_MODEL), D_MODEL ** -0.5),
        'na_q_gain': gain(ks[17], (n_na, NA_HEAD_DIM)),
        'na_k_gain': gain(ks[18], (n_na, NA_HEAD_DIM)),
        'na_rpb': nrm(ks[19], (n_na, NA_HEADS, 2 * NA_KH - 1, 2 * NA_KW - 1), 0.1),
        'na_w_o': nrm(ks[20], (n_na, D_MODEL, D_MODEL), D_MODEL ** -0.5),
        'router_w': nrm(ks[21], (DEPTH, D_MODEL, N_EXPERTS), D_MODEL ** -0.5),
        'moe_w_gate': nrm(ks[22], (DEPTH, N_EXPERTS, D_MODEL, EXPERT_FF), D_MODEL ** -0.5),
        'moe_w_up': nrm(ks[23], (DEPTH, N_EXPERTS, D_MODEL, EXPERT_FF), D_MODEL ** -0.5),
        'moe_w_down': nrm(ks[24], (DEPTH, N_EXPERTS, EXPERT_FF, D_MODEL), EXPERT_FF ** -0.5),
    }


def reference(x, c, ctx, c_ctx, ada_w, ada_b, norm_mix, norm_ffn,
              mla_w_in, mla_q_a_gain, mla_kv_a_gain, mla_w_qb, mla_w_kvb, mla_q_gain, mla_k_gain, mla_w_o,
              na_w_qkv, na_q_gain, na_k_gain, na_rpb, na_w_o,
              router_w, moe_w_gate, moe_w_up, moe_w_down):
    B, N, _ = x.shape
    ang_r, ang_c = axial_angles(N, QK_ROPE)
    c_act = jax.nn.silu(c)
    cctx_act = jax.nn.silu(c_ctx)
    x_lat, x_ctx = x, ctx
    for i in range(DEPTH):
        with_ctx = i < DEPTH - 1
        mod_l = (c_act @ ada_w[i] + ada_b[i])[:, None, :]
        mod_c = (cctx_act @ ada_w[i] + ada_b[i])[None, None, :]
        sh_a, sc_a, g_a, sh_f, sc_f, g_f = jnp.split(mod_l, 6, axis=-1)
        csh_a, csc_a, cg_a, csh_f, csc_f, cg_f = jnp.split(mod_c, 6, axis=-1)

        h_lat = modulate(rmsnorm(x_lat, norm_mix[i]), sh_a, sc_a)
        h_ctx = modulate(rmsnorm(x_ctx, norm_mix[i]), csh_a, csc_a)
        j = i // N_MIXERS
        if i % N_MIXERS == 0:
            o_lat, o_ctx = mla_mixer(h_lat, h_ctx, mla_w_in[j], mla_q_a_gain[j], mla_kv_a_gain[j],
                                     mla_w_qb[j], mla_w_kvb[j], mla_q_gain[j], mla_k_gain[j],
                                     mla_w_o[j], ang_r, ang_c, with_ctx)
        else:
            o_lat, o_ctx = na_mixer(h_lat, h_ctx, na_w_qkv[j], na_q_gain[j], na_k_gain[j],
                                    na_rpb[j], na_w_o[j], with_ctx)
        x_lat = x_lat + g_a * o_lat

        f_lat = modulate(rmsnorm(x_lat, norm_ffn[i]), sh_f, sc_f)
        x_lat = x_lat + g_f * ec_moe(f_lat, router_w[i], moe_w_gate[i], moe_w_up[i], moe_w_down[i])

        if with_ctx:
            x_ctx = x_ctx + cg_a * o_ctx
            f_ctx = modulate(rmsnorm(x_ctx, norm_ffn[i]), csh_f, csc_f)
            x_ctx = x_ctx + cg_f * ec_moe(f_ctx, router_w[i], moe_w_gate[i], moe_w_up[i], moe_w_down[i])
    return x_lat
```

```cpp
#include <hip/hip_runtime.h>
#include <cstdio>
#include <cstdint>

#define GAS __attribute__((address_space(1)))
#define LAS __attribute__((address_space(3)))
typedef unsigned short bf16;
typedef short bf16x8 __attribute__((ext_vector_type(8)));
typedef short s16x4 __attribute__((ext_vector_type(4)));
typedef float f32x2 __attribute__((ext_vector_type(2)));
typedef float f32x4 __attribute__((ext_vector_type(4)));
typedef float f32x16 __attribute__((ext_vector_type(16)));
typedef unsigned u32x4 __attribute__((ext_vector_type(4)));
typedef unsigned u32x2 __attribute__((ext_vector_type(2)));

constexpr int NL = 16384, NC = 256, NTOK = NL + NC, DM = 2048, NH = 16;
constexpr int QLORA = 512, KVLORA = 512, ROPE_D = 64, NOPE_D = 128, QKH = 192, VD = 128;
constexpr int WIN_N = 1088, WIN_NP = 1280;
constexpr int NE = 16, FF = 1408, CAPL = 2048, CAPC = 32, EROWS = 2304;
constexpr float EPS = 1e-6f;
constexpr float LOG2E = 1.4426950408889634f;

constexpr size_t MiB = (size_t)1 << 20;
constexpr size_t WS_CTL = 0, CTL_ZERO_BYTES = 1 * MiB;
constexpr size_t WS_MODP = 1 * MiB;
static_assert((size_t)NTOK * 64 * 4 + 64 * 1024 <= 4608 * 1024 && 4608 * 1024 + (size_t)NTOK * 20 * 4 <= 6 * MiB, "small tables");
constexpr size_t WS_KPER = WS_MODP + 64 * 1024;
constexpr size_t WS_PS = WS_MODP + 4608 * 1024;
constexpr size_t WS_MOD = 7 * MiB;
constexpr size_t WS_AFF = 8 * MiB;
constexpr size_t WS_IDX = 8 * MiB + 1280 * 1024;
constexpr size_t WS_GATE = WS_IDX + 256 * 1024;
constexpr size_t WS_SLOT = 10 * MiB;
constexpr size_t WS_WIN_T = 12 * MiB, WS_WQB_T = 17 * MiB, WS_WKVB_T = 20 * MiB, WS_WO0_T = 24 * MiB, WS_WQKV_T = 32 * MiB, WS_WO1_T = 56 * MiB;
constexpr size_t WS_WGU_T = 64 * MiB;
constexpr size_t WS_WD_T = 416 * MiB;
constexpr size_t WS_HB = 592 * MiB;
constexpr size_t WS_X1 = 657 * MiB;
constexpr size_t WS_R = 787 * MiB;
constexpr size_t WS_AB = WS_R, WS_QN = WS_R + 41 * MiB, WS_KVN = WS_R + 58 * MiB, WS_QRAW = WS_R + 75 * MiB, WS_KVRAW = WS_R + 173 * MiB, WS_KPE = WS_R + 303 * MiB, WS_OB = WS_R + 336 * MiB;
constexpr size_t WS_QKV1 = WS_R;
constexpr size_t WS_XS = WS_R, WS_HID = WS_R + 144 * MiB, WS_YB = WS_R + 243 * MiB;
constexpr size_t WS_END = WS_R + 401 * MiB;
static_assert((size_t)NTOK * WIN_NP * 2 <= 41 * MiB && (size_t)NTOK * 512 * 2 <= 17 * MiB && (size_t)NTOK * 3072 * 2 <= 98 * MiB && (size_t)NTOK * 4096 * 2 <= 130 * MiB && (size_t)NTOK * 1024 * 2 <= 33 * MiB && (size_t)NTOK * 2048 * 2 <= 65 * MiB, "region A");
static_assert((size_t)NE * EROWS * 2048 * 2 <= 144 * MiB && (size_t)NE * EROWS * FF * 2 <= 99 * MiB && (size_t)NTOK * 6144 * 2 <= 195 * MiB, "region B");
constexpr size_t WGU_L = (size_t)NE * 2816 * 2048, WD_L = (size_t)NE * 2048 * FF;

constexpr int CW_BAR = 4096;
constexpr int CW_WORK = 128;
constexpr int CW_DONE = 256;
constexpr int CW_KMAX = 64;

__device__ __forceinline__ unsigned cvtpk(float lo, float hi) { unsigned r; asm("v_cvt_pk_bf16_f32 %0, %1, %2" : "=v"(r) : "v"(lo), "v"(hi)); return r; }
__device__ __forceinline__ float bflo(unsigned u) { return __uint_as_float(u << 16); }
__device__ __forceinline__ float bfhi(unsigned u) { return __uint_as_float(u & 0xffff0000u); }
__device__ __forceinline__ float wave_sum(float v) {
#pragma unroll
    for (int o = 1; o < 64; o <<= 1) v += __shfl_xor(v, o);
    return v;
}
__device__ __forceinline__ int wave_sum_i(int v) {
#pragma unroll
    for (int o = 1; o < 64; o <<= 1) v += __shfl_xor(v, o);
    return v;
}
__device__ __forceinline__ int ltid() { int t = threadIdx.x; asm volatile("" : "+v"(t)); return t; }
namespace pg8 {
#define PG8_LAS __attribute__((address_space(3)))
typedef unsigned short bf16_t;
typedef short bf16x8 __attribute__((ext_vector_type(8)));
typedef float f32x4 __attribute__((ext_vector_type(4)));
typedef unsigned u32x4 __attribute__((ext_vector_type(4)));
constexpr int BM = 256, BK = 64, HALF = 128, HTB = HALF * BK * 2  , STAGE_BYTES = 8 * HTB, NXCD = 8, WGM = 8;

__host__ __device__ __forceinline__ int lds_byte(int r, int c) { const int st = (r >> 4) * 2 + (c >> 5), rr = r & 15, cc = c & 31, ob = rr * 64 + cc * 2; return st * 1024 + (ob ^ (((ob >> 9) & 1) << 5)); }
__host__ __device__ __forceinline__ void stage_rc(int b, int& R, int& C) { const int st = b / 1024, sb = b % 1024, swz = sb ^ (((sb >> 9) & 1) << 5); R = (st >> 1) * 16 + swz / 64; C = (st & 1) * 32 + (swz % 64) / 2; }
__host__ __device__ __forceinline__ int perm32(int rho) { const int n = rho >> 4, i = rho & 15; return 8 * (i >> 2) + 4 * n + (i & 3); }

struct Unit { int pm, pn; };
struct Gemm { const bf16_t* A; const bf16_t* Bt; int M, N, K; int lda = 0; };

struct StaticOrder {
    int nM, nN, nwg, G, c;
    __host__ __device__ void init(int M, int N, int G_, int c_) { nM = M / BM; nN = N / BM; nwg = nM * nN; G = G_; c = c_; }
    __host__ __device__ bool next(int i, Unit& u) const {
        const long L = (long)i * G + c; if (L >= nwg) return false;
        int wgid = (int)L; { const int q = nwg / NXCD, r = nwg % NXCD, xcd = wgid % NXCD, off = wgid / NXCD; wgid = (xcd < r ? xcd * (q + 1) : r * (q + 1) + (xcd - r) * q) + off; }
        const int nig = WGM * nN, gid = wgid / nig, fm = gid * WGM, gsz = (nM - fm) < WGM ? (nM - fm) : WGM;
        u.pm = fm + ((wgid % nig) % gsz); u.pn = (wgid % nig) / gsz; return true;
    }
    __device__ __forceinline__ void a_ready(const Unit&) const {}
    __device__ __forceinline__ void done(const Unit&) const {}
};

__device__ __forceinline__ unsigned cvt_pk_bf16(float lo, float hi) { unsigned r; asm volatile("v_cvt_pk_bf16_f32 %0, %1, %2" : "=v"(r) : "v"(lo), "v"(hi)); return r; }
typedef float f32x2 __attribute__((ext_vector_type(2)));
template <class Epi, class Sched, bool ALIGN_EPI = false, bool SP2 = false>
__device__ __forceinline__ void gemm_phase(PG8_LAS unsigned char* lds, const Gemm g, const Sched& S, const Epi& E) {
    const int tid = ltid(), wid = __builtin_amdgcn_readfirstlane(tid >> 6), lane = tid & 63, wr = wid >> 2, wc = wid & 3, fr = lane & 15, fq = lane >> 4;
    const int K = g.K, nt = K / BK, lda = g.lda ? g.lda : K;
    unsigned voffA[2], voffB[2];
#pragma unroll
    for (int i = 0; i < 2; ++i) { int R, C; stage_rc(tid * 16 + i * 8192, R, C); const int Rb = Epi::PERM ? ((R & ~31) + perm32(R & 31)) : R;
        voffA[i] = (unsigned)(R * lda + C) * 2u; voffB[i] = (unsigned)(Rb * K + C) * 2u; }
    const size_t kstep = (size_t)(BK * 2);
    const size_t hstep = (size_t)HALF * K * 2;
    const size_t tstep = 2 * hstep;
    const size_t hstepA = (size_t)HALF * lda * 2, tstepA = 2 * hstepA;
    const unsigned ldsw = (unsigned)wid * 1024u;
    const int aoff = lds_byte(wr * 64 + fr, fq * 8), boff = lds_byte(wc * 32 + fr, fq * 8);
#define PG8_SA(b, h) (((b) * 2 + (h)) * HTB)
#define PG8_SB(b, h) ((4 + (b) * 2 + (h)) * HTB)
#define PG8_STAGE(bufoff, gbase, voff) do { _Pragma("unroll") for (int _i = 0; _i < 2; ++_i) \
        __builtin_amdgcn_global_load_lds((const unsigned*)((const char*)(gbase) + (voff)[_i]), (PG8_LAS unsigned*)(lds + (bufoff) + ldsw + _i * 8192), 16, 0, 0); } while (0)
#define PG8_LDA(dst, b, h) do { _Pragma("unroll") for (int m = 0; m < 4; ++m) _Pragma("unroll") for (int k = 0; k < 2; ++k) dst[m][k] = *(const PG8_LAS bf16x8*)(lds + PG8_SA(b, h) + aoff + m * 2048 + k * 1024); } while (0)
#define PG8_LDB(dst, b, h) do { _Pragma("unroll") for (int n = 0; n < 2; ++n) _Pragma("unroll") for (int k = 0; k < 2; ++k) dst[n][k] = *(const PG8_LAS bf16x8*)(lds + PG8_SB(b, h) + boff + n * 2048 + k * 1024); } while (0)
#define PG8_MMA(ai, bj, At, Bt) do { __builtin_amdgcn_s_setprio(1); _Pragma("unroll") for (int m = 0; m < 4; ++m) _Pragma("unroll") for (int n = 0; n < 2; ++n) _Pragma("unroll") for (int k = 0; k < 2; ++k) \
        acc[ai][bj][m][n] = __builtin_amdgcn_mfma_f32_16x16x32_bf16(Bt[n][k], At[m][k], acc[ai][bj][m][n], 0, 0, 0); __builtin_amdgcn_s_setprio(0); } while (0)
#define PG8_WAIT_V(n) asm volatile("s_waitcnt vmcnt(" #n ")" ::: "memory")
#define PG8_WAIT_L(n) asm volatile("s_waitcnt lgkmcnt(" #n ")" ::: "memory")
#define PG8_BAR __builtin_amdgcn_s_barrier()
#define PG8_SCHED __builtin_amdgcn_sched_barrier(0)
    Unit cur, nxt; int ui = 0;
    if (!S.next(0, cur)) return;
    f32x4 acc[2][2][4][2];
#pragma unroll
    for (int a = 0; a < 2; ++a)
#pragma unroll
        for (int b = 0; b < 2; ++b)
#pragma unroll
            for (int m = 0; m < 4; ++m)
#pragma unroll
                for (int n = 0; n < 2; ++n) acc[a][b][m][n] = (f32x4){0.f, 0.f, 0.f, 0.f};
    bf16x8 At[4][2], B0[2][2], B1[2][2];
    const char* cA = (const char*)g.A + (size_t)cur.pm * tstepA; const char* cB = (const char*)g.Bt + (size_t)cur.pn * tstep;
    S.a_ready(cur);
    if constexpr (SP2) {
        PG8_STAGE(PG8_SB(0, 0), cB, voffB); PG8_STAGE(PG8_SB(0, 1), cB + hstep, voffB); PG8_STAGE(PG8_SA(0, 0), cA, voffA); PG8_STAGE(PG8_SA(0, 1), cA + hstepA, voffA);
        if (wr == 1) PG8_BAR;
        PG8_WAIT_V(2); PG8_BAR;
        PG8_STAGE(PG8_SB(1, 0), cB + kstep, voffB); PG8_STAGE(PG8_SA(1, 0), cA + kstep, voffA); PG8_STAGE(PG8_SB(1, 1), cB + hstep + kstep, voffB);
        PG8_WAIT_V(6); PG8_BAR;
    } else {
        PG8_STAGE(PG8_SB(0, 0), cB, voffB); PG8_STAGE(PG8_SA(0, 0), cA, voffA); PG8_STAGE(PG8_SB(0, 1), cB + hstep, voffB); PG8_STAGE(PG8_SA(0, 1), cA + hstepA, voffA);
        if (wr == 1) PG8_BAR;
        PG8_WAIT_V(4); PG8_BAR;
        PG8_STAGE(PG8_SB(1, 0), cB + kstep, voffB); PG8_STAGE(PG8_SA(1, 0), cA + kstep, voffA); PG8_STAGE(PG8_SB(1, 1), cB + hstep + kstep, voffB);
        PG8_WAIT_V(6); PG8_BAR;
    }
    for (;;) {
        const bool has_next = S.next(ui + 1, nxt);
        const char* nA = has_next ? (const char*)g.A + (size_t)nxt.pm * tstepA : cA; const char* nB = has_next ? (const char*)g.Bt + (size_t)nxt.pn * tstep : cB;
        for (int t = 0; t < nt; t += 2) {
            const bool last = (t == nt - 2);
            const char* a1 = cA + (size_t)(t + 1) * kstep;
            const char* a2 = last ? nA : cA + (size_t)(t + 2) * kstep; const char* b2 = last ? nB : cB + (size_t)(t + 2) * kstep;
            const char* a3 = a2 + kstep; const char* b3 = b2 + kstep;
            if (last && has_next) S.a_ready(nxt);
            if constexpr (SP2) {
            PG8_LDB(B0, 0, 0); PG8_LDB(B1, 0, 1); PG8_SCHED; PG8_LDA(At, 0, 0); PG8_STAGE(PG8_SA(1, 1), a1 + hstepA, voffA);
            PG8_WAIT_V(8); PG8_WAIT_L(0); PG8_BAR; PG8_MMA(0, 0, At, B0); PG8_MMA(0, 1, At, B1); PG8_BAR; PG8_SCHED;
            PG8_LDA(At, 0, 1); PG8_STAGE(PG8_SB(0, 0), b2, voffB); PG8_STAGE(PG8_SB(0, 1), b2 + hstep, voffB); PG8_STAGE(PG8_SA(0, 0), a2, voffA);
            PG8_WAIT_V(8); PG8_WAIT_L(0); PG8_BAR; PG8_MMA(1, 0, At, B0); PG8_MMA(1, 1, At, B1); PG8_BAR; PG8_SCHED;
            PG8_LDB(B0, 1, 0); PG8_LDB(B1, 1, 1); PG8_SCHED; PG8_LDA(At, 1, 0); PG8_STAGE(PG8_SA(0, 1), a2 + hstepA, voffA);
            PG8_WAIT_V(8); PG8_WAIT_L(0); PG8_BAR; PG8_MMA(0, 0, At, B0); PG8_MMA(0, 1, At, B1); PG8_BAR; PG8_SCHED;
            PG8_LDA(At, 1, 1); PG8_STAGE(PG8_SB(1, 0), b3, voffB); PG8_STAGE(PG8_SB(1, 1), b3 + hstep, voffB); PG8_STAGE(PG8_SA(1, 0), a3, voffA);
            PG8_WAIT_V(8); PG8_WAIT_L(0); PG8_BAR; PG8_MMA(1, 0, At, B0); PG8_MMA(1, 1, At, B1); PG8_BAR; PG8_SCHED;
            } else {
            PG8_LDB(B0, 0, 0); PG8_SCHED; PG8_LDA(At, 0, 0); PG8_STAGE(PG8_SA(1, 1), a1 + hstepA, voffA);
            PG8_WAIT_L(8); PG8_BAR; PG8_WAIT_L(0); PG8_MMA(0, 0, At, B0); PG8_BAR; PG8_SCHED;
            PG8_LDB(B1, 0, 1); PG8_STAGE(PG8_SB(0, 0), b2, voffB);
            PG8_BAR; PG8_WAIT_L(0); PG8_MMA(0, 1, At, B1); PG8_BAR;
            PG8_LDA(At, 0, 1); PG8_STAGE(PG8_SA(0, 0), a2, voffA);
            PG8_BAR; PG8_WAIT_L(0); PG8_MMA(1, 0, At, B0); PG8_BAR; PG8_SCHED;
            PG8_STAGE(PG8_SB(0, 1), b2 + hstep, voffB);
            PG8_WAIT_V(6); PG8_BAR; PG8_MMA(1, 1, At, B1); PG8_BAR;
            PG8_LDB(B0, 1, 0); PG8_SCHED; PG8_LDA(At, 1, 0); PG8_STAGE(PG8_SA(0, 1), a2 + hstepA, voffA);
            PG8_WAIT_L(8); PG8_BAR; PG8_WAIT_L(0); PG8_MMA(0, 0, At, B0); PG8_BAR; PG8_SCHED;
            PG8_LDB(B1, 1, 1); PG8_STAGE(PG8_SB(1, 0), b3, voffB);
            PG8_BAR; PG8_WAIT_L(0); PG8_MMA(0, 1, At, B1); PG8_BAR;
            PG8_LDA(At, 1, 1); PG8_STAGE(PG8_SA(1, 0), a3, voffA);
            PG8_BAR; PG8_WAIT_L(0); PG8_MMA(1, 0, At, B0); PG8_BAR; PG8_SCHED;
            PG8_STAGE(PG8_SB(1, 1), b3 + hstep, voffB);
            PG8_WAIT_V(6); PG8_BAR; PG8_MMA(1, 1, At, B1); PG8_BAR;
            }
        }
        if constexpr (ALIGN_EPI) { if (wr == 0) PG8_BAR; }
        if constexpr (!Epi::AFTER_DRAIN) { E(acc, cur, wr, wc, fr, fq); S.done(cur); }
        if (!has_next) break;
#pragma unroll
        for (int a = 0; a < 2; ++a)
#pragma unroll
            for (int b = 0; b < 2; ++b)
#pragma unroll
                for (int m = 0; m < 4; ++m)
#pragma unroll
                    for (int n = 0; n < 2; ++n) acc[a][b][m][n] = (f32x4){0.f, 0.f, 0.f, 0.f};
        cur = nxt; cA = nA; cB = nB; ++ui;
        if constexpr (ALIGN_EPI) { if (wr == 1) PG8_BAR; }
    }
    PG8_WAIT_V(0);
    if constexpr (!ALIGN_EPI) { if (wr == 0) PG8_BAR; }
    PG8_BAR;
    if constexpr (Epi::AFTER_DRAIN) { E.fused(acc, cur, wr, wc, fr, fq, lds, wid, lane); S.done(cur); }
#undef PG8_SA
#undef PG8_SB
#undef PG8_STAGE
#undef PG8_LDA
#undef PG8_LDB
#undef PG8_MMA
#undef PG8_WAIT_V
#undef PG8_WAIT_L
#undef PG8_BAR
#undef PG8_SCHED
}
template <class Epi, class Sched, bool ALIGN_EPI = false, bool SP2 = false>
__device__ __forceinline__ void gemm_phase_gather(PG8_LAS unsigned char* lds, const Gemm g, const int* __restrict__ rowidx, const Sched& S, const Epi& E) {
    static_assert(SP2, "gather variant: SP2 loop only");
    const int tid = ltid(), wid = __builtin_amdgcn_readfirstlane(tid >> 6), lane = tid & 63, wr = wid >> 2, wc = wid & 3, fr = lane & 15, fq = lane >> 4;
    const int K = g.K, nt = K / BK;
    unsigned voffA[2], voffB[2];
#pragma unroll
    for (int i = 0; i < 2; ++i) { int R, C; stage_rc(tid * 16 + i * 8192, R, C); const int Rb = Epi::PERM ? ((R & ~31) + perm32(R & 31)) : R;
        voffA[i] = (unsigned)(R * K + C) * 2u; voffB[i] = (unsigned)(Rb * K + C) * 2u; }
    const size_t kstep = (size_t)(BK * 2);
    const size_t hstep = (size_t)HALF * K * 2;
    const size_t tstep = 2 * hstep;
    const unsigned ldsw = (unsigned)wid * 1024u;
    const int aoff = lds_byte(wr * 64 + fr, fq * 8), boff = lds_byte(wc * 32 + fr, fq * 8);
#define PG8_SA(b, h) (((b) * 2 + (h)) * HTB)
#define PG8_SB(b, h) ((4 + (b) * 2 + (h)) * HTB)
#define PG8_STAGE(bufoff, gbase, voff) do { _Pragma("unroll") for (int _i = 0; _i < 2; ++_i) \
        __builtin_amdgcn_global_load_lds((const unsigned*)((const char*)(gbase) + (voff)[_i]), (PG8_LAS unsigned*)(lds + (bufoff) + ldsw + _i * 8192), 16, 0, 0); } while (0)
#define PG8_LDA(dst, b, h) do { _Pragma("unroll") for (int m = 0; m < 4; ++m) _Pragma("unroll") for (int k = 0; k < 2; ++k) dst[m][k] = *(const PG8_LAS bf16x8*)(lds + PG8_SA(b, h) + aoff + m * 2048 + k * 1024); } while (0)
#define PG8_LDB(dst, b, h) do { _Pragma("unroll") for (int n = 0; n < 2; ++n) _Pragma("unroll") for (int k = 0; k < 2; ++k) dst[n][k] = *(const PG8_LAS bf16x8*)(lds + PG8_SB(b, h) + boff + n * 2048 + k * 1024); } while (0)
#define PG8_MMA(ai, bj, At, Bt) do { __builtin_amdgcn_s_setprio(1); _Pragma("unroll") for (int m = 0; m < 4; ++m) _Pragma("unroll") for (int n = 0; n < 2; ++n) _Pragma("unroll") for (int k = 0; k < 2; ++k) \
        acc[ai][bj][m][n] = __builtin_amdgcn_mfma_f32_16x16x32_bf16(Bt[n][k], At[m][k], acc[ai][bj][m][n], 0, 0, 0); __builtin_amdgcn_s_setprio(0); } while (0)
#define PG8_WAIT_V(n) asm volatile("s_waitcnt vmcnt(" #n ")" ::: "memory")
#define PG8_WAIT_L(n) asm volatile("s_waitcnt lgkmcnt(" #n ")" ::: "memory")
#define PG8_BAR __builtin_amdgcn_s_barrier()
#define PG8_SCHED __builtin_amdgcn_sched_barrier(0)
    Unit cur, nxt; int ui = 0;
    if (!S.next(0, cur)) return;
    int RA[2], CA[2];
#pragma unroll
    for (int i = 0; i < 2; ++i) stage_rc(tid * 16 + i * 8192, RA[i], CA[i]);
    unsigned vA0[2], vA1[2], nvA0[2], nvA1[2];
#define PG8_GOFF(u, d0, d1) do { _Pragma("unroll") for (int i = 0; i < 2; ++i) { \
        int t0_ = rowidx[(u).pm * BM + RA[i]], t1_ = rowidx[(u).pm * BM + HALF + RA[i]]; t0_ = t0_ < 0 ? 0 : t0_; t1_ = t1_ < 0 ? 0 : t1_; \
        d0[i] = (unsigned)(t0_ * K + CA[i]) * 2u; d1[i] = (unsigned)(t1_ * K + CA[i]) * 2u; } } while (0)
    PG8_GOFF(cur, vA0, vA1);
    f32x4 acc[2][2][4][2];
#pragma unroll
    for (int a = 0; a < 2; ++a)
#pragma unroll
        for (int b = 0; b < 2; ++b)
#pragma unroll
            for (int m = 0; m < 4; ++m)
#pragma unroll
                for (int n = 0; n < 2; ++n) acc[a][b][m][n] = (f32x4){0.f, 0.f, 0.f, 0.f};
    bf16x8 At[4][2], B0[2][2], B1[2][2];
    const char* cA = (const char*)g.A; const char* cB = (const char*)g.Bt + (size_t)cur.pn * tstep;
    S.a_ready(cur);
    if constexpr (SP2) {
        PG8_STAGE(PG8_SB(0, 0), cB, voffB); PG8_STAGE(PG8_SB(0, 1), cB + hstep, voffB); PG8_STAGE(PG8_SA(0, 0), cA, vA0); PG8_STAGE(PG8_SA(0, 1), cA, vA1);
        if (wr == 1) PG8_BAR;
        PG8_WAIT_V(2); PG8_BAR;
        PG8_STAGE(PG8_SB(1, 0), cB + kstep, voffB); PG8_STAGE(PG8_SA(1, 0), cA + kstep, vA0); PG8_STAGE(PG8_SB(1, 1), cB + hstep + kstep, voffB);
        PG8_WAIT_V(6); PG8_BAR;
    } else {
        PG8_STAGE(PG8_SB(0, 0), cB, voffB); PG8_STAGE(PG8_SA(0, 0), cA, voffA); PG8_STAGE(PG8_SB(0, 1), cB + hstep, voffB); PG8_STAGE(PG8_SA(0, 1), cA + hstep, voffA);
        if (wr == 1) PG8_BAR;
        PG8_WAIT_V(4); PG8_BAR;
        PG8_STAGE(PG8_SB(1, 0), cB + kstep, voffB); PG8_STAGE(PG8_SA(1, 0), cA + kstep, voffA); PG8_STAGE(PG8_SB(1, 1), cB + hstep + kstep, voffB);
        PG8_WAIT_V(6); PG8_BAR;
    }
    for (;;) {
        const bool has_next = S.next(ui + 1, nxt);
        if (has_next) PG8_GOFF(nxt, nvA0, nvA1); else { nvA0[0] = vA0[0]; nvA0[1] = vA0[1]; nvA1[0] = vA1[0]; nvA1[1] = vA1[1]; }
        const char* nA = cA; const char* nB = has_next ? (const char*)g.Bt + (size_t)nxt.pn * tstep : cB;
        for (int t = 0; t < nt; t += 2) {
            const bool last = (t == nt - 2);
            const char* a1 = cA + (size_t)(t + 1) * kstep;
            const char* a2 = last ? nA : cA + (size_t)(t + 2) * kstep; const char* b2 = last ? nB : cB + (size_t)(t + 2) * kstep;
            const char* a3 = a2 + kstep; const char* b3 = b2 + kstep;
            unsigned wA0[2], wA1[2]; wA0[0] = last ? nvA0[0] : vA0[0]; wA0[1] = last ? nvA0[1] : vA0[1]; wA1[0] = last ? nvA1[0] : vA1[0]; wA1[1] = last ? nvA1[1] : vA1[1];
            if (last && has_next) S.a_ready(nxt);
            if constexpr (SP2) {
            PG8_LDB(B0, 0, 0); PG8_LDB(B1, 0, 1); PG8_SCHED; PG8_LDA(At, 0, 0); PG8_STAGE(PG8_SA(1, 1), a1, vA1);
            PG8_WAIT_V(8); PG8_WAIT_L(0); PG8_BAR; PG8_MMA(0, 0, At, B0); PG8_MMA(0, 1, At, B1); PG8_BAR; PG8_SCHED;
            PG8_LDA(At, 0, 1); PG8_STAGE(PG8_SB(0, 0), b2, voffB); PG8_STAGE(PG8_SB(0, 1), b2 + hstep, voffB); PG8_STAGE(PG8_SA(0, 0), a2, wA0);
            PG8_WAIT_V(8); PG8_WAIT_L(0); PG8_BAR; PG8_MMA(1, 0, At, B0); PG8_MMA(1, 1, At, B1); PG8_BAR; PG8_SCHED;
            PG8_LDB(B0, 1, 0); PG8_LDB(B1, 1, 1); PG8_SCHED; PG8_LDA(At, 1, 0); PG8_STAGE(PG8_SA(0, 1), a2, wA1);
            PG8_WAIT_V(8); PG8_WAIT_L(0); PG8_BAR; PG8_MMA(0, 0, At, B0); PG8_MMA(0, 1, At, B1); PG8_BAR; PG8_SCHED;
            PG8_LDA(At, 1, 1); PG8_STAGE(PG8_SB(1, 0), b3, voffB); PG8_STAGE(PG8_SB(1, 1), b3 + hstep, voffB); PG8_STAGE(PG8_SA(1, 0), a3, wA0);
            PG8_WAIT_V(8); PG8_WAIT_L(0); PG8_BAR; PG8_MMA(1, 0, At, B0); PG8_MMA(1, 1, At, B1); PG8_BAR; PG8_SCHED;
            } else {
            PG8_LDB(B0, 0, 0); PG8_SCHED; PG8_LDA(At, 0, 0); PG8_STAGE(PG8_SA(1, 1), a1 + hstep, voffA);
            PG8_WAIT_L(8); PG8_BAR; PG8_WAIT_L(0); PG8_MMA(0, 0, At, B0); PG8_BAR; PG8_SCHED;
            PG8_LDB(B1, 0, 1); PG8_STAGE(PG8_SB(0, 0), b2, voffB);
            PG8_BAR; PG8_WAIT_L(0); PG8_MMA(0, 1, At, B1); PG8_BAR;
            PG8_LDA(At, 0, 1); PG8_STAGE(PG8_SA(0, 0), a2, voffA);
            PG8_BAR; PG8_WAIT_L(0); PG8_MMA(1, 0, At, B0); PG8_BAR; PG8_SCHED;
            PG8_STAGE(PG8_SB(0, 1), b2 + hstep, voffB);
            PG8_WAIT_V(6); PG8_BAR; PG8_MMA(1, 1, At, B1); PG8_BAR;
            PG8_LDB(B0, 1, 0); PG8_SCHED; PG8_LDA(At, 1, 0); PG8_STAGE(PG8_SA(0, 1), a2 + hstep, voffA);
            PG8_WAIT_L(8); PG8_BAR; PG8_WAIT_L(0); PG8_MMA(0, 0, At, B0); PG8_BAR; PG8_SCHED;
            PG8_LDB(B1, 1, 1); PG8_STAGE(PG8_SB(1, 0), b3, voffB);
            PG8_BAR; PG8_WAIT_L(0); PG8_MMA(0, 1, At, B1); PG8_BAR;
            PG8_LDA(At, 1, 1); PG8_STAGE(PG8_SA(1, 0), a3, voffA);
            PG8_BAR; PG8_WAIT_L(0); PG8_MMA(1, 0, At, B0); PG8_BAR; PG8_SCHED;
            PG8_STAGE(PG8_SB(1, 1), b3 + hstep, voffB);
            PG8_WAIT_V(6); PG8_BAR; PG8_MMA(1, 1, At, B1); PG8_BAR;
            }
        }
        if constexpr (ALIGN_EPI) { if (wr == 0) PG8_BAR; }
        if constexpr (!Epi::AFTER_DRAIN) { E(acc, cur, wr, wc, fr, fq); S.done(cur); }
        if (!has_next) break;
#pragma unroll
        for (int a = 0; a < 2; ++a)
#pragma unroll
            for (int b = 0; b < 2; ++b)
#pragma unroll
                for (int m = 0; m < 4; ++m)
#pragma unroll
                    for (int n = 0; n < 2; ++n) acc[a][b][m][n] = (f32x4){0.f, 0.f, 0.f, 0.f};
        cur = nxt; cA = nA; cB = nB; ++ui; vA0[0] = nvA0[0]; vA0[1] = nvA0[1]; vA1[0] = nvA1[0]; vA1[1] = nvA1[1];
        if constexpr (ALIGN_EPI) { if (wr == 1) PG8_BAR; }
    }
    PG8_WAIT_V(0);
    if constexpr (!ALIGN_EPI) { if (wr == 0) PG8_BAR; }
    PG8_BAR;
    if constexpr (Epi::AFTER_DRAIN) { E.fused(acc, cur, wr, wc, fr, fq, lds, wid, lane); S.done(cur); }
#undef PG8_GOFF
#undef PG8_SA
#undef PG8_SB
#undef PG8_STAGE
#undef PG8_LDA
#undef PG8_LDB
#undef PG8_MMA
#undef PG8_WAIT_V
#undef PG8_WAIT_L
#undef PG8_BAR
#undef PG8_SCHED
}
}
namespace pg8 {
struct EpiBf16P {
    static constexpr bool PERM = true, AFTER_DRAIN = false;
    bf16_t* O; int ldc;
    __device__ __forceinline__ void operator()(const f32x4 (&acc)[2][2][4][2], const Unit& u, int wr, int wc, int fr, int fq) const {
        const int row0 = u.pm * BM + wr * 64 + fr, col0 = u.pn * BM + wc * 32 + 8 * fq;
#pragma unroll
        for (int ai = 0; ai < 2; ++ai)
#pragma unroll
            for (int m = 0; m < 4; ++m) { bf16_t* rowp = O + (size_t)(row0 + ai * HALF + m * 16) * ldc + col0;
#pragma unroll
                for (int bj = 0; bj < 2; ++bj) { const f32x4 v0 = acc[ai][bj][m][0], v1 = acc[ai][bj][m][1];
                    u32x4 w; w.x = cvt_pk_bf16(v0[0], v0[1]); w.y = cvt_pk_bf16(v0[2], v0[3]); w.z = cvt_pk_bf16(v1[0], v1[1]); w.w = cvt_pk_bf16(v1[2], v1[3]);
                    *(u32x4*)(rowp + bj * HALF) = w; } }
    }
};
struct EpiWin {
    static constexpr bool PERM = true, AFTER_DRAIN = false;
    bf16_t* O; float* ps; float* kper; const float* gk; const float* rtab;
    __device__ __forceinline__ void operator()(const f32x4 (&acc)[2][2][4][2], const Unit& u, int wr, int wc, int fr, int fq) const {
        const int row0 = u.pm * BM + wr * 64 + fr, col0 = u.pn * BM + wc * 32 + 8 * fq;
#pragma unroll
        for (int ai = 0; ai < 2; ++ai)
#pragma unroll
            for (int m = 0; m < 4; ++m) { const int row = row0 + ai * HALF + m * 16; bf16_t* rowp = O + (size_t)row * 1280 + col0;
                float s = 0.f;
#pragma unroll
                for (int bj = 0; bj < 2; ++bj) { const f32x4 v0 = acc[ai][bj][m][0], v1 = acc[ai][bj][m][1];
                    s += ((v0[0] * v0[0] + v0[1] * v0[1]) + (v0[2] * v0[2] + v0[3] * v0[3])) + ((v1[0] * v1[0] + v1[1] * v1[1]) + (v1[2] * v1[2] + v1[3] * v1[3]));
                    u32x4 w; w.x = cvt_pk_bf16(v0[0], v0[1]); w.y = cvt_pk_bf16(v0[2], v0[3]); w.z = cvt_pk_bf16(v1[0], v1[1]); w.w = cvt_pk_bf16(v1[2], v1[3]);
                    *(u32x4*)(rowp + bj * HALF) = w; }
                s += __shfl_xor(s, 16); s += __shfl_xor(s, 32);
                if (fq == 0) ps[(size_t)row * 20 + u.pn * 4 + wc] = s; }
        if (u.pn == 4 && wc < 2) {
            const int D0 = wc * 32 + 8 * fq, jt = 8 * (fq & 1); const bool second = (fq & 2) != 0;
            const f32x4 g0 = *(const f32x4*)(gk + 128 + D0), g1 = *(const f32x4*)(gk + 128 + D0 + 4);
#pragma unroll
            for (int ai = 0; ai < 2; ++ai)
#pragma unroll
                for (int m = 0; m < 4; ++m) { const int row = row0 + ai * HALF + m * 16;
                    f32x4 x0 = acc[ai][0][m][0] * g0, x1 = acc[ai][0][m][1] * g1;
                    f32x4 p0, p1;
#pragma unroll
                    for (int i = 0; i < 4; ++i) { p0[i] = __shfl_xor(x0[i], 32); p1[i] = __shfl_xor(x1[i], 32); }
                    if (row < 16384) { const int pos = wc ? (row & 63) : ((row >> 6) & 255);
                        const f32x4 c0 = *(const f32x4*)(rtab + pos * 16 + jt), c1 = *(const f32x4*)(rtab + pos * 16 + jt + 4), s0 = *(const f32x4*)(rtab + 4096 + pos * 16 + jt), s1 = *(const f32x4*)(rtab + 4096 + pos * 16 + jt + 4);
                        x0 = second ? (x0 * c0 + p0 * s0) : (x0 * c0 - p0 * s0); x1 = second ? (x1 * c1 + p1 * s1) : (x1 * c1 - p1 * s1); }
                    *(f32x4*)(kper + (size_t)row * 64 + D0) = x0; *(f32x4*)(kper + (size_t)row * 64 + D0 + 4) = x1; }
        }
    }
};
struct EpiQkvNorm {
    static constexpr bool PERM = true, AFTER_DRAIN = false;
    bf16_t* O; const float* gq; const float* gk; PG8_LAS float* part;
    __device__ __forceinline__ void operator()(const f32x4 (&acc_in)[2][2][4][2], const Unit& u, int wr, int wc, int fr, int fq) const {
        const int row0 = u.pm * BM + wr * 64 + fr, col0 = u.pn * BM + wc * 32 + 8 * fq;
        f32x4 acc[2][2][4][2];
#pragma unroll
        for (int ai = 0; ai < 2; ++ai)
#pragma unroll
            for (int bj = 0; bj < 2; ++bj)
#pragma unroll
                for (int m = 0; m < 4; ++m) { acc[ai][bj][m][0] = acc_in[ai][bj][m][0]; acc[ai][bj][m][1] = acc_in[ai][bj][m][1]; }
        if (u.pn < 16) {
            const float* gp = (u.pn < 8 ? gq : gk) + wc * 32 + 8 * fq;
            const f32x4 g0 = *(const f32x4*)gp, g1 = *(const f32x4*)(gp + 4);
#pragma unroll
            for (int ai = 0; ai < 2; ++ai)
#pragma unroll
                for (int bj = 0; bj < 2; ++bj)
#pragma unroll
                    for (int m = 0; m < 4; ++m) { const f32x4 v0 = acc[ai][bj][m][0], v1 = acc[ai][bj][m][1];
                        float s = ((v0[0] * v0[0] + v0[1] * v0[1]) + (v0[2] * v0[2] + v0[3] * v0[3])) + ((v1[0] * v1[0] + v1[1] * v1[1]) + (v1[2] * v1[2] + v1[3] * v1[3]));
                        s += __shfl_xor(s, 16); s += __shfl_xor(s, 32);
                        if (fq == 0) part[((ai * HALF + wr * 64 + m * 16 + fr) * 2 + bj) * 4 + wc] = s; }
            asm volatile("s_waitcnt lgkmcnt(0)" ::: "memory"); __builtin_amdgcn_s_barrier();
#pragma unroll
            for (int ai = 0; ai < 2; ++ai)
#pragma unroll
                for (int bj = 0; bj < 2; ++bj)
#pragma unroll
                    for (int m = 0; m < 4; ++m) { const f32x4 p = *(const PG8_LAS f32x4*)(part + ((ai * HALF + wr * 64 + m * 16 + fr) * 2 + bj) * 4);
                        const float rs = __builtin_amdgcn_rsqf(((p[0] + p[1]) + (p[2] + p[3])) * (1.f / 128.f) + 1e-6f);
                        acc[ai][bj][m][0] = acc[ai][bj][m][0] * rs * g0; acc[ai][bj][m][1] = acc[ai][bj][m][1] * rs * g1; }
            asm volatile("s_waitcnt lgkmcnt(0)" ::: "memory"); __builtin_amdgcn_s_barrier();
        }
#pragma unroll
        for (int ai = 0; ai < 2; ++ai)
#pragma unroll
            for (int m = 0; m < 4; ++m) { bf16_t* rowp = O + (size_t)(row0 + ai * HALF + m * 16) * 6144 + col0;
#pragma unroll
                for (int bj = 0; bj < 2; ++bj) { const f32x4 v0 = acc[ai][bj][m][0], v1 = acc[ai][bj][m][1];
                    u32x4 w; w.x = cvt_pk_bf16(v0[0], v0[1]); w.y = cvt_pk_bf16(v0[2], v0[3]); w.z = cvt_pk_bf16(v1[0], v1[1]); w.w = cvt_pk_bf16(v1[2], v1[3]);
                    *(u32x4*)(rowp + bj * HALF) = w; } }
    }
};
struct EpiKv {
    static constexpr bool PERM = true, AFTER_DRAIN = false;
    bf16_t* O; const float* gk; const float* kper; const float* ps; PG8_LAS float* part; unsigned char* vt;
    __device__ __forceinline__ void operator()(const f32x4 (&acc)[2][2][4][2], const Unit& u, int wr, int wc, int fr, int fq) const {
        const int row0 = u.pm * BM + wr * 64 + fr, h = u.pn;
        const f32x4 g0 = *(const f32x4*)(gk + wc * 32 + 8 * fq), g1 = *(const f32x4*)(gk + wc * 32 + 8 * fq + 4);
#pragma unroll
        for (int ai = 0; ai < 2; ++ai)
#pragma unroll
            for (int m = 0; m < 4; ++m) { const f32x4 v0 = acc[ai][0][m][0], v1 = acc[ai][0][m][1];
                float s = ((v0[0] * v0[0] + v0[1] * v0[1]) + (v0[2] * v0[2] + v0[3] * v0[3])) + ((v1[0] * v1[0] + v1[1] * v1[1]) + (v1[2] * v1[2] + v1[3] * v1[3]));
                s += __shfl_xor(s, 16); s += __shfl_xor(s, 32);
                if (fq == 0) part[(ai * HALF + wr * 64 + m * 16 + fr) * 4 + wc] = s; }
        asm volatile("s_waitcnt lgkmcnt(0)" ::: "memory"); __builtin_amdgcn_s_barrier();
        float rkv_[2][4];
#pragma unroll
        for (int ai = 0; ai < 2; ++ai)
#pragma unroll
            for (int m = 0; m < 4; ++m) { const int row = row0 + ai * HALF + m * 16;
                const f32x4 p = *(const PG8_LAS f32x4*)(part + (ai * HALF + wr * 64 + m * 16 + fr) * 4);
                const f32x4 q2 = *(const f32x4*)(ps + (size_t)row * 20 + 8), q3 = *(const f32x4*)(ps + (size_t)row * 20 + 12), q4 = *(const f32x4*)(ps + (size_t)row * 20 + 16);
                const float rkv = __builtin_amdgcn_rsqf((((q2[0] + q2[1]) + (q2[2] + q2[3])) + ((q3[0] + q3[1]) + (q3[2] + q3[3]))) * (1.f / 512.f) + 1e-6f);
                rkv_[ai][m] = rkv;
                const float rs = __builtin_amdgcn_rsqf((((p[0] + p[1]) + (p[2] + p[3])) * (rkv * rkv) + ((q4[0] + q4[1]) + (q4[2] + q4[3]))) * (1.f / 192.f) + 1e-6f) * 0.32267250623034593f;
                const float rsn = rs * rkv;
                unsigned char* slot = (unsigned char*)O + (size_t)row * 8192 + h * 512;
                const f32x4 v0 = acc[ai][0][m][0] * rsn * g0, v1 = acc[ai][0][m][1] * rsn * g1;
                int w0 = 0, w1 = 0;
                w0 = __builtin_amdgcn_cvt_pk_fp8_f32(v0[0], v0[1], w0, false); w0 = __builtin_amdgcn_cvt_pk_fp8_f32(v0[2], v0[3], w0, true);
                w1 = __builtin_amdgcn_cvt_pk_fp8_f32(v1[0], v1[1], w1, false); w1 = __builtin_amdgcn_cvt_pk_fp8_f32(v1[2], v1[3], w1, true);
                u32x2 kw; kw.x = (unsigned)w0; kw.y = (unsigned)w1; *(u32x2*)(slot + wc * 32 + 8 * fq) = kw;
                const f32x4 r4 = *(const f32x4*)(kper + (size_t)row * 64 + wc * 16 + 4 * fq) * rs;
                int w2 = 0; w2 = __builtin_amdgcn_cvt_pk_fp8_f32(r4[0], r4[1], w2, false); w2 = __builtin_amdgcn_cvt_pk_fp8_f32(r4[2], r4[3], w2, true);
                *(unsigned*)(slot + 128 + wc * 16 + 4 * fq) = (unsigned)w2;
            }
        asm volatile("s_waitcnt lgkmcnt(0)" ::: "memory"); __builtin_amdgcn_s_barrier();
        const int mq = fr & 3, aq = fr >> 2;
        const unsigned sel01 = (unsigned)mq | ((unsigned)(4 + mq) << 8);
        const int sd = 8 * (aq & 1) + 4 * (mq >> 1) + 2 * (mq & 1) + (aq >> 1);
#pragma unroll
        for (int ai = 0; ai < 2; ++ai) {
            unsigned char* tile = vt + ((size_t)h * (16640 / 64) + (size_t)(u.pm * 4 + ai * 2 + wr)) * 8192 + (size_t)(wc * 32 + 8 * fq) * 64 + 4 * sd;
#pragma unroll
            for (int j = 0; j < 8; ++j) {
                int L = 0;
                L = __builtin_amdgcn_cvt_pk_fp8_f32(acc[ai][1][0][j >> 2][j & 3] * rkv_[ai][0], acc[ai][1][1][j >> 2][j & 3] * rkv_[ai][1], L, false);
                L = __builtin_amdgcn_cvt_pk_fp8_f32(acc[ai][1][2][j >> 2][j & 3] * rkv_[ai][2], acc[ai][1][3][j >> 2][j & 3] * rkv_[ai][3], L, true);
                const unsigned x0 = (unsigned)__builtin_amdgcn_mov_dpp(L, 0x00, 0xf, 0xf, false), x1 = (unsigned)__builtin_amdgcn_mov_dpp(L, 0x55, 0xf, 0xf, false);
                const unsigned x2 = (unsigned)__builtin_amdgcn_mov_dpp(L, 0xAA, 0xf, 0xf, false), x3 = (unsigned)__builtin_amdgcn_mov_dpp(L, 0xFF, 0xf, 0xf, false);
                const unsigned t01 = __builtin_amdgcn_perm(x1, x0, sel01), t23 = __builtin_amdgcn_perm(x3, x2, sel01);
                *(unsigned*)(tile + j * 64) = __builtin_amdgcn_perm(t23, t01, 0x05040100u);
            }
        }
    }
};
struct EpiRes {
    static constexpr bool PERM = false, AFTER_DRAIN = false;
    float* out; const float* res_lat; const float* res_ctx; const float* g_lat; const float* g_ctx;
    __device__ __forceinline__ void operator()(const f32x4 (&acc)[2][2][4][2], const Unit& u, int wr, int wc, int fr, int fq) const {
        const bool isctx = (u.pm >= 64);
        const int row0 = u.pm * BM + wr * 64 + fr, col0 = u.pn * BM + wc * 32 + 4 * fq;
        const float* res = isctx ? res_ctx : res_lat; const float* gv = isctx ? g_ctx : g_lat; const int rsub = isctx ? 16384 : 0;
        f32x4 g4[2][2];
#pragma unroll
        for (int bj = 0; bj < 2; ++bj)
#pragma unroll
            for (int n = 0; n < 2; ++n) g4[bj][n] = *(const f32x4*)(gv + col0 + bj * HALF + n * 16);
#pragma unroll
        for (int ai = 0; ai < 2; ++ai)
#pragma unroll
            for (int m = 0; m < 4; ++m) { const int row = row0 + ai * HALF + m * 16; float* op = out + (size_t)row * 2048 + col0; const float* rp = res + (size_t)(row - rsub) * 2048 + col0;
#pragma unroll
                for (int bj = 0; bj < 2; ++bj)
#pragma unroll
                    for (int n = 0; n < 2; ++n) { const f32x4 r = *(const f32x4*)(rp + bj * HALF + n * 16); *(f32x4*)(op + bj * HALF + n * 16) = r + g4[bj][n] * acc[ai][bj][m][n]; } }
    }
};
template <bool RESB>
struct EpiResB {
    static constexpr bool PERM = true, AFTER_DRAIN = false;
    bf16_t* out; const void* res_lat; const void* res_ctx; const float* g_lat; const float* g_ctx;
    __device__ __forceinline__ void operator()(const f32x4 (&acc)[2][2][4][2], const Unit& u, int wr, int wc, int fr, int fq) const {
        const bool isctx = (u.pm >= 64);
        const int row0 = u.pm * BM + wr * 64 + fr, col0 = u.pn * BM + wc * 32 + 8 * fq;
        const void* res = isctx ? res_ctx : res_lat; const float* gv = isctx ? g_ctx : g_lat; const int rsub = (!RESB && isctx) ? 16384 : 0;
        f32x4 g4[2][2];
#pragma unroll
        for (int bj = 0; bj < 2; ++bj)
#pragma unroll
            for (int n = 0; n < 2; ++n) g4[bj][n] = *(const f32x4*)(gv + col0 + bj * HALF + n * 4);
#pragma unroll
        for (int ai = 0; ai < 2; ++ai)
#pragma unroll
            for (int m = 0; m < 4; ++m) { const int row = row0 + ai * HALF + m * 16; bf16_t* op = out + (size_t)row * 2048 + col0;
#pragma unroll
                for (int bj = 0; bj < 2; ++bj) { f32x4 r0, r1;
                    if constexpr (RESB) { const u32x4 w = *(const u32x4*)((const bf16_t*)res + (size_t)row * 2048 + col0 + bj * HALF);
                        r0 = (f32x4){__uint_as_float(w.x << 16), __uint_as_float(w.x & 0xffff0000u), __uint_as_float(w.y << 16), __uint_as_float(w.y & 0xffff0000u)};
                        r1 = (f32x4){__uint_as_float(w.z << 16), __uint_as_float(w.z & 0xffff0000u), __uint_as_float(w.w << 16), __uint_as_float(w.w & 0xffff0000u)}; }
                    else { const float* rp = (const float*)res + (size_t)(row - rsub) * 2048 + col0 + bj * HALF; r0 = *(const f32x4*)rp; r1 = *(const f32x4*)(rp + 4); }
                    const f32x4 v0 = r0 + g4[bj][0] * acc[ai][bj][m][0], v1 = r1 + g4[bj][1] * acc[ai][bj][m][1];
                    u32x4 w; w.x = cvt_pk_bf16(v0[0], v0[1]); w.y = cvt_pk_bf16(v0[2], v0[3]); w.z = cvt_pk_bf16(v1[0], v1[1]); w.w = cvt_pk_bf16(v1[2], v1[3]);
                    *(u32x4*)(op + bj * HALF) = w; } }
    }
};
struct EpiSwiGLU {
    static constexpr bool PERM = true, AFTER_DRAIN = false;
    bf16_t* H;
    __device__ __forceinline__ void operator()(const f32x4 (&acc)[2][2][4][2], const Unit& u, int wr, int wc, int fr, int fq) const {
        const int e = u.pm / 9, nl = u.pn - e * 11;
        const int row0 = u.pm * BM + wr * 64 + fr, col0 = nl * 128 + wc * 32 + 8 * fq;
#pragma unroll
        for (int ai = 0; ai < 2; ++ai)
#pragma unroll
            for (int m = 0; m < 4; ++m) { bf16_t* rowp = H + (size_t)(row0 + ai * HALF + m * 16) * 1408 + col0;
                float hv[8];
#pragma unroll
                for (int n = 0; n < 2; ++n)
#pragma unroll
                    for (int i = 0; i < 4; ++i) { const float g = acc[ai][0][m][n][i], up = acc[ai][1][m][n][i];
                        const float s = g * __builtin_amdgcn_rcpf(1.f + __builtin_amdgcn_exp2f(-1.4426950408889634f * g)); hv[n * 4 + i] = s * up; }
                u32x4 w; w.x = cvt_pk_bf16(hv[0], hv[1]); w.y = cvt_pk_bf16(hv[2], hv[3]); w.z = cvt_pk_bf16(hv[4], hv[5]); w.w = cvt_pk_bf16(hv[6], hv[7]);
                *(u32x4*)rowp = w; }
    }
};
struct EpiDown {
    static constexpr bool PERM = true, AFTER_DRAIN = false;
    bf16_t* Y; const float* gate;
    __device__ __forceinline__ void operator()(const f32x4 (&acc)[2][2][4][2], const Unit& u, int wr, int wc, int fr, int fq) const {
        const int e = u.pm / 9, nl = u.pn - e * 8;
        const int row0 = u.pm * BM + wr * 64 + fr, col0 = nl * BM + wc * 32 + 8 * fq;
#pragma unroll
        for (int ai = 0; ai < 2; ++ai)
#pragma unroll
            for (int m = 0; m < 4; ++m) { const int row = row0 + ai * HALF + m * 16; const float gt = gate[row]; bf16_t* rowp = Y + (size_t)row * 2048 + col0;
#pragma unroll
                for (int bj = 0; bj < 2; ++bj) { const f32x4 v0 = acc[ai][bj][m][0] * gt, v1 = acc[ai][bj][m][1] * gt;
                    u32x4 w; w.x = cvt_pk_bf16(v0[0], v0[1]); w.y = cvt_pk_bf16(v0[2], v0[3]); w.z = cvt_pk_bf16(v1[0], v1[1]); w.w = cvt_pk_bf16(v1[2], v1[3]);
                    *(u32x4*)(rowp + bj * HALF) = w; } }
    }
};
struct GroupedOrder {
    int tm, tn, total, G, c;
    __device__ void init(int tm_, int tn_, int G_, int c_) { tm = tm_; tn = tn_; total = NE_ * tm_ * tn_; G = G_; c = c_; }
    static constexpr int NE_ = 16;
    __device__ bool next(int i, Unit& u) const {
        int L = i * G + c; if (L >= total) return false;
        if ((total & 7) == 0) L = (L & 7) * (total >> 3) + (L >> 3);
        const int per = tm * tn, e = L / per, r = L - e * per, pml = r / tn, pnl = r - pml * tn;
        u.pm = e * 9 + pml; u.pn = e * tn + pnl; return true;
    }
    __device__ __forceinline__ void a_ready(const Unit&) const {}
    __device__ __forceinline__ void done(const Unit&) const {}
};
}
namespace att {
constexpr int NW = 8, QBLK = 32, KVBLK = 64;
constexpr int SHM_V = 16384, SHM_KN = 16384, SHM_KP = 8192;
constexpr int OFF_V = 0, OFF_KN = 32768, OFF_KP = 65536, OFF_WS = 81920, OFF_BIAS = 83968;
constexpr int ATT_LDS = OFF_BIAS + 4096;
constexpr float THR = 8.f;
#define KSWZ(row, colB) ((row) * 256 + ((colB) ^ (((row) & 15) << 4)))
#define KPSWZ(row, colB) ((row) * 128 + ((colB) ^ ((((row) >> 1) & 7) << 4)))
#define SBAR() __builtin_amdgcn_sched_barrier(0)
__device__ __forceinline__ int crow(int r, int hi) { return (r & 3) + 8 * (r >> 2) + 4 * hi; }
__device__ __forceinline__ unsigned cvtpk_v(float lo, float hi) { unsigned r; asm volatile("v_cvt_pk_bf16_f32 %0, %1, %2" : "=v"(r) : "v"(lo), "v"(hi)); return r; }

template <int DUMMY = 0>
__device__ __forceinline__ void partialSM(f32x16& p0, f32x16& p1, float& m_reg, float& mn, float& alpha, const float C, const float thr_raw) {
    float pmax = p0[0];
#pragma unroll
    for (int r = 1; r < 16; ++r) pmax = fmaxf(pmax, p0[r]);
#pragma unroll
    for (int r = 0; r < 16; ++r) pmax = fmaxf(pmax, p1[r]);
    { auto rr = __builtin_amdgcn_permlane32_swap(__float_as_uint(pmax), __float_as_uint(pmax), false, false);
      pmax = fmaxf(__uint_as_float(rr[0]), __uint_as_float(rr[1])); }
    if (__builtin_expect(__all(pmax - m_reg <= thr_raw), 1)) { mn = m_reg; alpha = 1.f; }
    else { mn = fmaxf(m_reg, pmax); alpha = __builtin_amdgcn_exp2f((m_reg - mn) * C); m_reg = mn; }
    const float mnC = -mn * C;
#pragma unroll
    for (int r = 0; r < 16; ++r) p0[r] = fmaf(p0[r], C, mnC);
#pragma unroll
    for (int r = 0; r < 16; ++r) p1[r] = fmaf(p1[r], C, mnC);
#pragma unroll
    for (int r = 0; r < 16; ++r) p0[r] = __builtin_amdgcn_exp2f(p0[r]);
}
__device__ __forceinline__ void sm_static(f32x16& p0, f32x16& p1, const float C, const float negm) {
#pragma unroll
    for (int r = 0; r < 16; ++r) p0[r] = fmaf(p0[r], C, negm);
#pragma unroll
    for (int r = 0; r < 16; ++r) p1[r] = fmaf(p1[r], C, negm);
#pragma unroll
    for (int r = 0; r < 16; ++r) p0[r] = __builtin_amdgcn_exp2f(p0[r]);
}
__device__ __forceinline__ void partialSM_na(f32x16& p0, f32x16& p1, float& m_reg, float& mn, float& alpha, const float C, int kr, int qrow, int rs, int lb, int lm, int lb2, const LAS float* btab) {
    const bool isctx = (kr == -1), rowok = (kr >= rs) && (kr < rs + 8);
    const int vm0 = isctx ? -1 : (rowok ? lm : 0), vm1 = isctx ? -1 : (rowok ? lb2 : 0);
    const LAS float* brow = (isctx || !rowok) ? (btab + 600) : (btab + (kr - qrow + 7) * 31 + lb);
    constexpr unsigned NEGB = 0xff61b1e6u;
#define NA_GRP(P, VM, R0, KOFF) do { _Pragma("unroll") for (int r = R0; r < R0 + 8; ++r) { const int kc0 = (r & 3) + 8 * (r >> 2); \
        const unsigned v_ = (unsigned)__builtin_amdgcn_sbfe(VM, kc0, 1);     \
        unsigned bm_; asm("v_bfi_b32 %0, %1, %2, %3" : "=v"(bm_) : "v"(v_), "v"(brow[kc0 + KOFF]), "v"(NEGB));       \
        P[r] = fmaf(P[r], C, __uint_as_float(bm_)); } SBAR(); } while (0)
    NA_GRP(p0, vm0, 0, 0); NA_GRP(p0, vm0, 8, 0); NA_GRP(p1, vm1, 0, 32); NA_GRP(p1, vm1, 8, 32);
#undef NA_GRP
    float pmax = p0[0];
#pragma unroll
    for (int r = 1; r < 16; ++r) pmax = fmaxf(pmax, p0[r]);
#pragma unroll
    for (int r = 0; r < 16; ++r) pmax = fmaxf(pmax, p1[r]);
    { auto rr = __builtin_amdgcn_permlane32_swap(__float_as_uint(pmax), __float_as_uint(pmax), false, false);
      pmax = fmaxf(__uint_as_float(rr[0]), __uint_as_float(rr[1])); }
    if (__builtin_expect(__all(pmax - m_reg <= THR * LOG2E), 1)) { mn = m_reg; alpha = 1.f; }
    else { mn = fmaxf(m_reg, pmax); alpha = __builtin_amdgcn_exp2f(m_reg - mn); m_reg = mn; }
    p0 = p0 - mn; p1 = p1 - mn;
#pragma unroll
    for (int r = 0; r < 16; ++r) p0[r] = __builtin_amdgcn_exp2f(p0[r]);
}
__device__ __forceinline__ void finishSM(f32x16& p0, f32x16& p1, float alpha, float& l_reg, bf16x8& pa0, bf16x8& pa1, bf16x8& pa2, bf16x8& pa3) {
#pragma unroll
    for (int r = 0; r < 16; ++r) p1[r] = __builtin_amdgcn_exp2f(p1[r]);
    f32x2 ps2 = {0.f, 0.f};
#pragma unroll
    for (int r = 0; r < 16; r += 2) { ps2 += (f32x2){p0[r], p0[r + 1]}; ps2 += (f32x2){p1[r], p1[r + 1]}; }
    float ps = ps2.x + ps2.y;
    { auto rr = __builtin_amdgcn_permlane32_swap(__float_as_uint(ps), __float_as_uint(ps), false, false);
      ps = __uint_as_float(rr[0]) + __uint_as_float(rr[1]); }
    l_reg = l_reg * alpha + ps;
#define PK4(P, BASE, OUT) do { unsigned a0 = cvtpk_v(P[BASE + 0], P[BASE + 1]), a1 = cvtpk_v(P[BASE + 2], P[BASE + 3]);   \
    unsigned b0 = cvtpk_v(P[BASE + 4], P[BASE + 5]), b1 = cvtpk_v(P[BASE + 6], P[BASE + 7]);                              \
    auto r0 = __builtin_amdgcn_permlane32_swap(a0, b0, false, false); auto r1 = __builtin_amdgcn_permlane32_swap(a1, b1, false, false); \
    u32x4 w = {r0[0], r1[0], r0[1], r1[1]}; OUT = __builtin_bit_cast(bf16x8, w); } while (0)
    PK4(p0, 0, pa0); PK4(p0, 8, pa1); PK4(p1, 0, pa2); PK4(p1, 8, pa3);
#undef PK4
}
#ifndef ATT_PRIO
#define ATT_PRIO 0
#endif
template <int NPE>
__device__ __forceinline__ void qkt(f32x16& p0, f32x16& p1, const LAS char* Kn, const LAS char* Kp, const bf16x8* qr, int r32, int hi) {
    p0 = f32x16{}; p1 = f32x16{};
#if ATT_PRIO
    __builtin_amdgcn_s_setprio(1);
#endif
#pragma unroll
    for (int d0 = 0; d0 < 8; ++d0) { const int cb = (d0 * 16 + hi * 8) * 2;
        const bf16x8 b0 = *(const LAS bf16x8*)(Kn + KSWZ(r32, cb));
        const bf16x8 b1 = *(const LAS bf16x8*)(Kn + KSWZ(32 + r32, cb));
        p0 = __builtin_amdgcn_mfma_f32_32x32x16_bf16(b0, qr[d0], p0, 0, 0, 0);
        p1 = __builtin_amdgcn_mfma_f32_32x32x16_bf16(b1, qr[d0], p1, 0, 0, 0); }
#pragma unroll
    for (int d0 = 0; d0 < NPE; ++d0) { const int cb = (d0 * 16 + hi * 8) * 2;
        const bf16x8 b0 = *(const LAS bf16x8*)(Kp + KPSWZ(r32, cb));
        const bf16x8 b1 = *(const LAS bf16x8*)(Kp + KPSWZ(32 + r32, cb));
        p0 = __builtin_amdgcn_mfma_f32_32x32x16_bf16(b0, qr[8 + d0], p0, 0, 0, 0);
        p1 = __builtin_amdgcn_mfma_f32_32x32x16_bf16(b1, qr[8 + d0], p1, 0, 0, 0); }
#if ATT_PRIO
    __builtin_amdgcn_s_setprio(0);
#endif
}
__device__ __forceinline__ int v_st(int k, int c) { const int kk = (k & ~0xC) | ((k & 4) << 1) | ((k & 8) >> 1); return ((kk >> 3) * 4 + (c >> 5)) * 512 + ((kk & 7) * 32 + (c & 31)) * 2; }
__device__ __forceinline__ int v_rd_base(int lane) { return ((lane & 3) << 3) | (((lane >> 2) & 3) << 6) | (((lane >> 4) & 1) << 5) | (((lane >> 5) & 1) << 8); }
constexpr int v_rd_off(int d0, int ks, int half) { return d0 * 512 + ks * 4096 + half * 2048; }
typedef short v4i16_t __attribute__((ext_vector_type(4)));
#ifndef PV_ASM
#define PV_ASM 0
#endif
#if PV_ASM
template <int OFF> __device__ __forceinline__ s16x4 tr_read(int vb) {
    s16x4 r; asm volatile("ds_read_b64_tr_b16 %0, %1 offset:%2" : "=&v"(r) : "v"(vb), "i"(OFF) : "memory"); return r;
}
#else
template <int OFF> __device__ __forceinline__ s16x4 tr_read(int vb) {
    return __builtin_bit_cast(s16x4, __builtin_amdgcn_ds_read_tr16_b64_v4i16((LAS v4i16_t*)(unsigned)(vb + OFF)));
}
#endif
template <int D0> __device__ __forceinline__ void pv_one(f32x16& od, int vb, bf16x8 pa0, bf16x8 pa1, bf16x8 pa2, bf16x8 pa3) {
    const s16x4 l0 = tr_read<v_rd_off(D0, 0, 0)>(vb), h0 = tr_read<v_rd_off(D0, 0, 1)>(vb), l1 = tr_read<v_rd_off(D0, 1, 0)>(vb), h1 = tr_read<v_rd_off(D0, 1, 1)>(vb);
    const s16x4 l2 = tr_read<v_rd_off(D0, 2, 0)>(vb), h2 = tr_read<v_rd_off(D0, 2, 1)>(vb), l3 = tr_read<v_rd_off(D0, 3, 0)>(vb), h3 = tr_read<v_rd_off(D0, 3, 1)>(vb);
#if PV_ASM
    asm volatile("s_waitcnt lgkmcnt(0)" ::: "memory"); SBAR();
#endif
#define PK(L, H) (bf16x8){L[0], L[1], L[2], L[3], H[0], H[1], H[2], H[3]}
#if ATT_PRIO
    __builtin_amdgcn_s_setprio(1);
#endif
    od = __builtin_amdgcn_mfma_f32_32x32x16_bf16(pa0, PK(l0, h0), od, 0, 0, 0);
    od = __builtin_amdgcn_mfma_f32_32x32x16_bf16(pa1, PK(l1, h1), od, 0, 0, 0);
    od = __builtin_amdgcn_mfma_f32_32x32x16_bf16(pa2, PK(l2, h2), od, 0, 0, 0);
    od = __builtin_amdgcn_mfma_f32_32x32x16_bf16(pa3, PK(l3, h3), od, 0, 0, 0);
#if ATT_PRIO
    __builtin_amdgcn_s_setprio(0);
#endif
#undef PK
}
__device__ __forceinline__ void pv_d0(f32x16* o, int vb, bf16x8 pa0, bf16x8 pa1, bf16x8 pa2, bf16x8 pa3) {
    pv_one<0>(o[0], vb, pa0, pa1, pa2, pa3); pv_one<1>(o[1], vb, pa0, pa1, pa2, pa3); pv_one<2>(o[2], vb, pa0, pa1, pa2, pa3); pv_one<3>(o[3], vb, pa0, pa1, pa2, pa3);
}

#define RESC(a) do { if (__any((a) < 1.f)) { if (hi == 0) al_l[r32] = (a); asm volatile("s_waitcnt lgkmcnt(0)" ::: "memory"); \
    _Pragma("unroll") for (int d = 0; d < 4; ++d) _Pragma("unroll") for (int r = 0; r < 16; ++r) o[d][r] *= al_l[crow(r, hi)]; } } while (0)

typedef int v8i __attribute__((ext_vector_type(8)));
constexpr int KPITCH = 208, VPITCH = 80, MSLOT = 23552, M_KN = 0, M_VT = 13312, M_WS = 122880;
static_assert(64 * KPITCH == M_VT && M_VT + 128 * VPITCH == MSLOT && 5 * MSLOT <= M_WS, "MLA slot layout");
__device__ __forceinline__ void glds16(const void* gsrc, unsigned lds_dst) { unsigned keep;
    asm volatile("s_mov_b32 %0, m0\n\ts_mov_b32 m0, %2\n\ts_nop 0\n\tglobal_load_lds_dwordx4 %1, off\n\ts_mov_b32 m0, %0" : "=&s"(keep) : "v"(gsrc), "s"(lds_dst) : "memory"); }
__device__ __forceinline__ void glds16s(const void* sbase, unsigned voff, unsigned lds_dst) { unsigned keep;
    asm volatile("s_mov_b32 %0, m0\n\ts_mov_b32 m0, %3\n\ts_nop 0\n\tglobal_load_lds_dwordx4 %1, %2\n\ts_mov_b32 m0, %0" : "=&s"(keep) : "v"(voff), "s"(sbase), "s"(lds_dst) : "memory"); }
#define WAIT_BAR0() asm volatile("s_waitcnt vmcnt(0) lgkmcnt(0)\n\ts_barrier" ::: "memory")
__device__ __forceinline__ void qkt8(f32x16& p0, f32x16& p1, const f32x16& bias, const LAS char* Kl, const v8i* q8) {
#pragma unroll
    for (int ks = 0; ks < 3; ++ks) {
        const u32x4 a0 = *(const LAS u32x4*)(Kl + 64 * ks), a1 = *(const LAS u32x4*)(Kl + 64 * ks + 16);
        const u32x4 b0 = *(const LAS u32x4*)(Kl + 32 * KPITCH + 64 * ks), b1 = *(const LAS u32x4*)(Kl + 32 * KPITCH + 64 * ks + 16);
        const v8i ka = {(int)a0.x, (int)a0.y, (int)a0.z, (int)a0.w, (int)a1.x, (int)a1.y, (int)a1.z, (int)a1.w};
        const v8i kb = {(int)b0.x, (int)b0.y, (int)b0.z, (int)b0.w, (int)b1.x, (int)b1.y, (int)b1.z, (int)b1.w};
        p0 = __builtin_amdgcn_mfma_scale_f32_32x32x64_f8f6f4(ka, q8[ks], ks ? p0 : bias, 0, 0, 0, 0, 0, 0);
        p1 = __builtin_amdgcn_mfma_scale_f32_32x32x64_f8f6f4(kb, q8[ks], ks ? p1 : bias, 0, 0, 0, 0, 0, 0); }
}
__device__ __forceinline__ float vmax2(float a, float b) { float d; asm("v_max_f32 %0, %1, %2" : "=v"(d) : "v"(a), "v"(b)); return d; }
template <bool FIRST>
__device__ __forceinline__ void sm8_a(f32x16& p0, f32x16& p1, f32x16& bias, f32x16* o, LAS float* al_l, int r32, int hi) {
    float xm = __builtin_fmaxf(__builtin_fmaxf(p0[0], p0[1]), p1[0]), xn = __builtin_fmaxf(__builtin_fmaxf(p0[2], p0[3]), p1[1]);
    xm = __builtin_fmaxf(__builtin_fmaxf(xm, p1[2]), p1[3]);
#pragma unroll
    for (int r = 4; r < 16; r += 4) { xm = __builtin_fmaxf(__builtin_fmaxf(xm, p0[r]), p0[r + 1]); xn = __builtin_fmaxf(__builtin_fmaxf(xn, p0[r + 2]), p0[r + 3]);
        xm = __builtin_fmaxf(__builtin_fmaxf(xm, p1[r]), p1[r + 1]); xn = __builtin_fmaxf(__builtin_fmaxf(xn, p1[r + 2]), p1[r + 3]); }
    xm = __builtin_fmaxf(xm, xn);
    { auto rr = __builtin_amdgcn_permlane32_swap(__float_as_uint(xm), __float_as_uint(xm), false, false);
      xm = vmax2(__uint_as_float(rr[0]), __uint_as_float(rr[1])); }
    if (FIRST || !__builtin_expect(__all(xm <= 8.5f), 1)) {
        const float dl = FIRST ? xm - 7.f : fmaxf(xm - 7.f, 0.f);
#pragma unroll
        for (int r = 0; r < 16; ++r) { bias[r] -= dl; p0[r] -= dl; p1[r] -= dl; }
        if (!FIRST) {
            if (hi == 0) al_l[r32] = __builtin_amdgcn_exp2f(-dl);
            asm volatile("s_waitcnt lgkmcnt(0)" ::: "memory");
#pragma unroll
            for (int d = 0; d < 5; ++d)
#pragma unroll
                for (int r = 0; r < 16; ++r) o[d][r] *= al_l[crow(r, hi)];
        }
    }
    asm volatile("" : "+v"(bias));
}
__device__ __forceinline__ void sm8_b(f32x16& p0, f32x16& p1, v8i& pa) {
#pragma unroll
    for (int r = 0; r < 16; ++r) p0[r] = __builtin_amdgcn_exp2f(p0[r]);
#pragma unroll
    for (int r = 0; r < 16; ++r) p1[r] = __builtin_amdgcn_exp2f(p1[r]);
#pragma unroll
    for (int w = 0; w < 4; ++w) { int x = pa[w]; x = __builtin_amdgcn_cvt_pk_fp8_f32(p0[4 * w], p0[4 * w + 1], x, false); x = __builtin_amdgcn_cvt_pk_fp8_f32(p0[4 * w + 2], p0[4 * w + 3], x, true); pa[w] = x; }
#pragma unroll
    for (int w = 0; w < 4; ++w) { int x = pa[4 + w]; x = __builtin_amdgcn_cvt_pk_fp8_f32(p1[4 * w], p1[4 * w + 1], x, false); x = __builtin_amdgcn_cvt_pk_fp8_f32(p1[4 * w + 2], p1[4 * w + 3], x, true); pa[4 + w] = x; }
}
__device__ __forceinline__ void pv8(f32x16* o, const LAS char* Vl, const v8i pa, const v8i ones) {
#pragma unroll
    for (int d0 = 0; d0 < 4; ++d0) { const LAS char* row = Vl + 32 * d0 * VPITCH;
        const u32x4 b0 = *(const LAS u32x4*)(row), b1 = *(const LAS u32x4*)(row + 16);
        const v8i vb = {(int)b0.x, (int)b0.y, (int)b0.z, (int)b0.w, (int)b1.x, (int)b1.y, (int)b1.z, (int)b1.w};
        o[d0] = __builtin_amdgcn_mfma_scale_f32_32x32x64_f8f6f4(pa, vb, o[d0], 0, 0, 0, 0, 0, 0); }
    o[4] = __builtin_amdgcn_mfma_scale_f32_32x32x64_f8f6f4(pa, ones, o[4], 0, 0, 0, 0, 0, 0);
}
#ifndef MLA_ALPHA
#define MLA_ALPHA 1.0f
#endif
__device__ __forceinline__ void mla_unit(const unsigned char* __restrict__ Q8, const unsigned char* __restrict__ K8, const unsigned char* __restrict__ Vt, bf16* __restrict__ Ob, int seq, LAS char* lds,
                                         const float* __restrict__ qgain, const float* __restrict__ rtab, const float* __restrict__ ps, int tok0, bool lat) {
    const int tid = ltid(), lane = tid & 63, r32 = lane & 31, hi = lane >> 5; const int wid = __builtin_amdgcn_readfirstlane(tid >> 6);
    LAS float* wsx = (LAS float*)(lds + M_WS) + wid * 64; LAS float* al_l = wsx + 32;
    unsigned d_off[3]; bool d_isk[3]; unsigned d_dst[3];
#pragma unroll
    for (int i = 0; i < 3; ++i) { int P = 3 * wid + i; if (P > 22) P = 22; d_isk[i] = P < 13; d_dst[i] = P * 1024;
        if (P < 13) { const int g = 64 * P + lane, row = g / 13, ch = g - 13 * row; d_off[i] = row * 8192 + (ch < 12 ? ch : 0) * 16; }
        else { const int g = 64 * (P - 13) + lane, d = g / 5, ch = g - 5 * d; d_off[i] = d * 64 + (ch < 4 ? ch : 0) * 16; } }
#define DMA_TILE(t, slot) do { const unsigned sb_ = (unsigned)((slot) * MSLOT); const unsigned char* kb_ = K8 + (size_t)(t) * 64 * 8192; const unsigned char* vb_ = Vt + (size_t)(t) * 8192; \
    glds16s(d_isk[0] ? kb_ : vb_, d_off[0], sb_ + d_dst[0]); glds16s(d_isk[1] ? kb_ : vb_, d_off[1], sb_ + d_dst[1]); glds16s(d_isk[2] ? kb_ : vb_, d_off[2], sb_ + d_dst[2]); } while (0)
    const int klane = r32 * KPITCH + hi * 32, vlane = M_VT + r32 * VPITCH + hi * 32;
    DMA_TILE(0, 0); DMA_TILE(1, 1);
    f32x16 o[5] = {}; v8i q8[3];
    { const unsigned char* Qw = Q8 + (size_t)(wid * QBLK + r32) * 6144 + hi * 64;
      float f[3][32];
#pragma unroll
      for (int ks = 0; ks < 3; ++ks)
#pragma unroll
          for (int c = 0; c < 4; ++c) { const u32x4 x = *(const u32x4*)(Qw + 128 * ks + 16 * c);
              f[ks][8 * c + 0] = bflo(x.x); f[ks][8 * c + 1] = bfhi(x.x); f[ks][8 * c + 2] = bflo(x.y); f[ks][8 * c + 3] = bfhi(x.y);
              f[ks][8 * c + 4] = bflo(x.z); f[ks][8 * c + 5] = bfhi(x.z); f[ks][8 * c + 6] = bflo(x.w); f[ks][8 * c + 7] = bfhi(x.w); }
      float ss = 0.f;
#pragma unroll
      for (int ks = 0; ks < 3; ++ks)
#pragma unroll
          for (int i = 0; i < 32; ++i) ss += f[ks][i] * f[ks][i];
      { auto rr = __builtin_amdgcn_permlane32_swap(__float_as_uint(ss), __float_as_uint(ss), false, false); ss = __uint_as_float(rr[0]) + __uint_as_float(rr[1]); }
      const float* psr = ps + (size_t)(tok0 + wid * QBLK + r32) * 20; const f32x4 s0 = *(const f32x4*)psr, s1 = *(const f32x4*)(psr + 4);
      const float rq = __builtin_amdgcn_rsqf((((s0[0] + s0[1]) + (s0[2] + s0[3])) + ((s1[0] + s1[1]) + (s1[2] + s1[3]))) * (1.f / 512.f) + EPS);
      const float rs = __builtin_amdgcn_rsqf(ss * (rq * rq) * (1.f / 192.f) + EPS) * rq * 0.32267250623034593f;
#pragma unroll
      for (int ks = 0; ks < 3; ++ks)
#pragma unroll
          for (int c = 0; c < 8; ++c) { const f32x4 g = *(const f32x4*)(qgain + 64 * ks + 32 * hi + 4 * c);
              f[ks][4 * c] *= rs * g.x; f[ks][4 * c + 1] *= rs * g.y; f[ks][4 * c + 2] *= rs * g.z; f[ks][4 * c + 3] *= rs * g.w; }
      if (lat) { const int t = tok0 + wid * QBLK + r32, pos = hi ? (t & 63) : ((t >> 6) & 255);
#pragma unroll
          for (int c = 0; c < 4; ++c) { const f32x4 cs = *(const f32x4*)(rtab + pos * 16 + 4 * c), sn = *(const f32x4*)(rtab + 4096 + pos * 16 + 4 * c);
#pragma unroll
              for (int i = 0; i < 4; ++i) { const float x1 = f[2][4 * c + i], x2 = f[2][16 + 4 * c + i]; f[2][4 * c + i] = x1 * cs[i] - x2 * sn[i]; f[2][16 + 4 * c + i] = x2 * cs[i] + x1 * sn[i]; } } }
#pragma unroll
      for (int ks = 0; ks < 3; ++ks)
#pragma unroll
          for (int w = 0; w < 8; ++w) { int x = 0; x = __builtin_amdgcn_cvt_pk_fp8_f32(f[ks][4 * w], f[ks][4 * w + 1], x, false); x = __builtin_amdgcn_cvt_pk_fp8_f32(f[ks][4 * w + 2], f[ks][4 * w + 3], x, true); q8[ks][w] = x; } }
    f32x16 pA0, pA1, pB0, pB1, bias = {}; v8i pa = {}; const int NT = seq / KVBLK;
    v8i ones = {0x38383838, 0x38383838, 0x38383838, 0x38383838, 0x38383838, 0x38383838, 0x38383838, 0x38383838};
    asm volatile("" : "+v"(ones));
    int sl = 0;
#define SLOT(k) ((sl + (k)) >= 5 ? (sl + (k)) - 5 : (sl + (k)))
#define KS_(k) (lds + SLOT(k) * MSLOT + klane)
#define VS_(k) (lds + SLOT(k) * MSLOT + vlane)
    if (2 < NT) DMA_TILE(2, 2);
    WAIT_BAR0();
    qkt8(pA0, pA1, bias, lds + klane, q8); sm8_a<true>(pA0, pA1, bias, o, al_l, r32, hi);
#define DSTEP(DMA_STMTS) do { \
        qkt8(pB0, pB1, bias, KS_(1), q8); \
        DMA_STMTS                                                  \
        sm8_b(pA0, pA1, pa); \
        pv8(o, VS_(0), pa, ones); sm8_a<false>(pB0, pB1, bias, o, al_l, r32, hi); \
        qkt8(pA0, pA1, bias, KS_(2), q8); sm8_b(pB0, pB1, pa); \
        pv8(o, VS_(1), pa, ones); sm8_a<false>(pA0, pA1, bias, o, al_l, r32, hi); \
        SBAR(); WAIT_BAR0(); \
        sl = SLOT(2); } while (0)
    int j = 1;
    for (; j + 3 < NT; j += 2) DSTEP(DMA_TILE(j + 2, SLOT(3)); DMA_TILE(j + 3, SLOT(4)););
    DSTEP(DMA_TILE(j + 2, SLOT(3)););
#undef DSTEP
    qkt8(pB0, pB1, bias, KS_(1), q8); sm8_b(pA0, pA1, pa);
    pv8(o, VS_(0), pa, ones); sm8_a<false>(pB0, pB1, bias, o, al_l, r32, hi);
    sm8_b(pB0, pB1, pa);
    pv8(o, VS_(1), pa, ones);
#undef SLOT
#undef KS_
#undef VS_
    float rli[16];
#pragma unroll
    for (int r = 0; r < 16; ++r) rli[r] = __builtin_amdgcn_rcpf(o[4][r]);
    bf16* Ow = Ob + (size_t)(wid * QBLK) * 2048;
#pragma unroll
    for (int r = 0; r < 16; ++r) { const int orow = crow(r, hi);
#pragma unroll
        for (int d0 = 0; d0 < 4; ++d0) Ow[(size_t)orow * 2048 + d0 * 32 + r32] = (bf16)(cvtpk_v(o[d0][r] * rli[r] * MLA_ALPHA, 0.f) & 0xffffu); }
    WAIT_BAR0();
#undef DMA_TILE
#undef ROT
}

constexpr int NSLOT_B = 32768, N_V = 0, N_K = 16384, N_BIAS = 124928;
__device__ __forceinline__ void na_unit(const bf16* __restrict__ QKV, int h, int rb, const float* __restrict__ rpb_h, bf16* __restrict__ Ob, LAS char* lds) {
    const int tid = ltid(), lane = tid & 63, r32 = lane & 31, hi = lane >> 5; const int wid = __builtin_amdgcn_readfirstlane(tid >> 6);
    LAS float* wsx = (LAS float*)(lds + M_WS) + wid * 64; LAS float* li_l = wsx; LAS float* al_l = wsx + 32;
    LAS float* btab = (LAS float*)(lds + N_BIAS) + 128;
    constexpr float C = 0.08838834764831845f * LOG2E;
    for (int i = tid; i < 15 * 31; i += 512) btab[i] = rpb_h[i] * LOG2E;
    if (tid < 64) btab[600 + tid] = 0.f;
    const int qrow = rb * 4 + (wid >> 1), qcol = (wid & 1) * 32 + r32;
    const int rs = min(max(qrow - 4, 0), 248), cs = min(max(qcol - 8, 0), 48);
    const int lb = 15 - qcol + 4 * hi;
    const unsigned long long wmask = 0xFFFFull << cs;
    const int lm = (int)(unsigned)(wmask >> (4 * hi)), lb2 = (int)(unsigned)(wmask >> (32 + 4 * hi));
    const int lo = min(max(rb * 4 - 4, 0), 248), hr = min(max(rb * 4 + 3 - 4, 0), 248) + 7, cnt = hr - lo + 1;
    const int NT = (4 + cnt + 1) & ~1;
#define TKEY0(t) ((t) < 4 ? NL + 64 * (t) : 64 * min(lo + (t) - 4, hr))
#define TKR(t) ((t) < 4 ? -1 : ((t) - 4 < cnt ? lo + (t) - 4 : -1000))
    const bf16* Kh = QKV + 2048 + h * 128; const bf16* Vh = QKV + 4096 + h * 128;
    int k_off[2], v_off[2];
#pragma unroll
    for (int i = 0; i < 2; ++i) { const int p = 2 * wid + i;
        { const int row = 4 * p + (lane >> 4), lch = (lane & 15) ^ (row & 15); k_off[i] = row * 6144 + lch * 8; }
        { const int s = 2 * p + (lane >> 5), kk = (s >> 2) * 8 + ((lane & 31) >> 2), key = (kk & ~0xC) | ((kk & 4) << 1) | ((kk & 8) >> 1), col = (s & 3) * 32 + (lane & 3) * 8; v_off[i] = key * 6144 + col; } }
#define DMA_TILE(t, slot) do { const size_t kb_ = (size_t)TKEY0(t) * 6144; const unsigned sb_ = (unsigned)((slot) * NSLOT_B); \
    glds16(Vh + kb_ + v_off[0], sb_ + N_V + (2 * wid) * 1024); glds16(Vh + kb_ + v_off[1], sb_ + N_V + (2 * wid + 1) * 1024); \
    glds16(Kh + kb_ + k_off[0], sb_ + N_K + (2 * wid) * 1024); glds16(Kh + kb_ + k_off[1], sb_ + N_K + (2 * wid + 1) * 1024); } while (0)
    DMA_TILE(0, 0); DMA_TILE(1, 1);
    float m_reg = -1e30f, l_reg = 0; f32x16 o[4] = {}; bf16x8 qr[8];
    const bf16* Qw = QKV + (size_t)(rb * 256 + wid * QBLK + r32) * 6144 + h * 128 + hi * 8;
#pragma unroll
    for (int d0 = 0; d0 < 8; ++d0) qr[d0] = *(const bf16x8*)(Qw + d0 * 16);
    const int vbl = N_V + v_rd_base(lane);
    f32x16 pA0, pA1, pB0, pB1; float mnA, mnB, alA, alB; bf16x8 pa0, pa1, pa2, pa3;
    int s_prev = 0, s_cur = 1, s_next = 2;
#define ROT() do { const int t_ = s_prev; s_prev = s_cur; s_cur = s_next; s_next = t_; } while (0)
    WAIT_BAR0();
    qkt<0>(pA0, pA1, lds + N_K, lds, qr, r32, hi); partialSM_na(pA0, pA1, m_reg, mnA, alA, C, TKR(0), qrow, rs, lb, lm, lb2, btab);
    for (int j = 1; j + 1 < NT; j += 2) {
        DMA_TILE(j + 1, s_next);
        SBAR(); qkt<0>(pB0, pB1, lds + s_cur * NSLOT_B + N_K, lds, qr, r32, hi);
        finishSM(pA0, pA1, alA, l_reg, pa0, pa1, pa2, pa3); SBAR();
        pv_d0(o, vbl + s_prev * NSLOT_B, pa0, pa1, pa2, pa3); partialSM_na(pB0, pB1, m_reg, mnB, alB, C, TKR(j), qrow, rs, lb, lm, lb2, btab);
        RESC(alB);
        WAIT_BAR0(); ROT();
        DMA_TILE(j + 2, s_next);
        SBAR(); qkt<0>(pA0, pA1, lds + s_cur * NSLOT_B + N_K, lds, qr, r32, hi);
        finishSM(pB0, pB1, alB, l_reg, pa0, pa1, pa2, pa3); SBAR();
        pv_d0(o, vbl + s_prev * NSLOT_B, pa0, pa1, pa2, pa3); partialSM_na(pA0, pA1, m_reg, mnA, alA, C, TKR(j + 1), qrow, rs, lb, lm, lb2, btab);
        RESC(alA);
        WAIT_BAR0(); ROT();
    }
    SBAR(); qkt<0>(pB0, pB1, lds + s_cur * NSLOT_B + N_K, lds, qr, r32, hi);
    finishSM(pA0, pA1, alA, l_reg, pa0, pa1, pa2, pa3); SBAR();
    pv_d0(o, vbl + s_prev * NSLOT_B, pa0, pa1, pa2, pa3); partialSM_na(pB0, pB1, m_reg, mnB, alB, C, TKR(NT - 1), qrow, rs, lb, lm, lb2, btab);
    RESC(alB);
    finishSM(pB0, pB1, alB, l_reg, pa0, pa1, pa2, pa3); SBAR();
    pv_d0(o, vbl + s_cur * NSLOT_B, pa0, pa1, pa2, pa3);
    if (hi == 0) li_l[r32] = l_reg; asm volatile("s_waitcnt lgkmcnt(0)" ::: "memory");
    float rli[16];
#pragma unroll
    for (int r = 0; r < 16; ++r) rli[r] = __builtin_amdgcn_rcpf(li_l[crow(r, hi)]);
    bf16* Ow = Ob + (size_t)(rb * 256 + wid * QBLK) * 2048 + h * 128;
#pragma unroll
    for (int r = 0; r < 16; ++r) { const int orow = crow(r, hi);
#pragma unroll
        for (int d0 = 0; d0 < 4; ++d0) Ow[(size_t)orow * 2048 + d0 * 32 + r32] = (bf16)(cvtpk_v(o[d0][r] * rli[r], 0.f) & 0xffffu); }
    WAIT_BAR0();
#undef DMA_TILE
#undef ROT
#undef TKEY0
#undef TKR
}
#undef RESC
}
namespace thin {
__device__ __constant__ float ROPE_INV[16] = {1.0f, 0.5623413251903491f, 0.31622776601683794f, 0.1778279410038923f, 0.1f, 0.05623413251903491f, 0.03162277660168379f, 0.01778279410038923f,
                                              0.01f, 0.005623413251903491f, 0.0031622776601683794f, 0.001778279410038923f, 0.001f, 0.0005623413251903491f, 0.00031622776601683794f, 0.0001778279410038923f};

__device__ __forceinline__ void tr_tile(const float* __restrict__ src, int ld_src, bf16* __restrict__ dst, int ld_dst, LAS float* T, const float* __restrict__ kgain = nullptr) {
    const int tid = ltid(), kr = tid >> 4, c4 = tid & 15;
    f32x4 v[4];
#pragma unroll
    for (int i = 0; i < 4; ++i) v[i] = *(const f32x4*)(src + (size_t)(kr + 32 * i) * ld_src + c4 * 4);
    if (kgain) {
#pragma unroll
        for (int i = 0; i < 4; ++i) v[i] = v[i] * kgain[kr + 32 * i]; }
    __syncthreads();
#pragma unroll
    for (int i = 0; i < 4; ++i) {
#pragma unroll
        for (int j = 0; j < 4; ++j) T[(c4 * 4 + j) * 129 + kr + 32 * i] = v[i][j]; }
    __syncthreads();
    const int n = tid >> 3, kc = (tid & 7) * 16; const LAS float* s = T + n * 129 + kc;
    u32x4 w0, w1;
    w0.x = cvtpk(s[0], s[1]); w0.y = cvtpk(s[2], s[3]); w0.z = cvtpk(s[4], s[5]); w0.w = cvtpk(s[6], s[7]);
    w1.x = cvtpk(s[8], s[9]); w1.y = cvtpk(s[10], s[11]); w1.z = cvtpk(s[12], s[13]); w1.w = cvtpk(s[14], s[15]);
    bf16* d = dst + (size_t)n * ld_dst + kc;
    *(u32x4*)d = w0; *(u32x4*)(d + 8) = w1;
}
__device__ __forceinline__ void tr_job(const float* src, int K, int N, bf16* dst, int t, LAS float* T, const float* kgain = nullptr) {
    const int nkt = K / 128, nt = t / nkt, kt = t - nt * nkt;
    tr_tile(src + (size_t)(kt * 128) * N + nt * 64, N, dst + (size_t)(nt * 64) * K + kt * 128, K, T, kgain ? kgain + kt * 128 : nullptr);
}

struct In {
    const float *x, *c, *ctx, *c_ctx, *ada_w, *ada_b, *norm_mix, *norm_ffn, *mla_w_in, *mla_q_a_gain, *mla_kv_a_gain, *mla_w_qb, *mla_w_kvb, *mla_q_gain, *mla_k_gain, *mla_w_o,
                *na_w_qkv, *na_q_gain, *na_k_gain, *na_rpb, *na_w_o, *router_w, *moe_w_gate, *moe_w_up, *moe_w_down;
};

constexpr int TL_GU = 16 * 2 * 352, TL_D = 16 * 352, TL_QKV = 96 * 16, TL_WO1 = 32 * 16;
constexpr int TL_E0 = TL_GU, TL_E1 = TL_E0 + TL_D, TL_E2 = TL_E1 + TL_QKV, TL_E3 = TL_E2 + TL_WO1, TL_E4 = TL_E3 + TL_GU, TL_ALL = TL_E4 + TL_D;
constexpr int LIM_MOE0 = TL_E1, LIM_NA = TL_E3, LIM_GU1 = TL_E4, LIM_ALL = TL_ALL;
__device__ __forceinline__ void late_tile(const In& in, unsigned char* ws, int t, LAS float* T) {
    int l = 0;
    if (t >= TL_E3) { t -= TL_E3; l = 1; }
    else if (t >= TL_E1) { t -= TL_E1;
        if (t < TL_QKV) tr_job(in.na_w_qkv, 2048, 6144, (bf16*)(ws + WS_WQKV_T), t, T);
        else tr_job(in.na_w_o, 2048, 2048, (bf16*)(ws + WS_WO1_T), t - TL_QKV, T);
        return; }
    if (t < TL_GU) {
        const int e = t / 704, r = t - e * 704, which = r / 352, tt = r - which * 352, nt = tt >> 4, kt = tt & 15, le = l * 16 + e;
        const float* src = (which ? in.moe_w_up : in.moe_w_gate) + (size_t)le * 2048 * FF;
        const int n0 = nt * 64, drow = (n0 >> 7) * 256 + which * 128 + (n0 & 127);
        bf16* dst = (bf16*)(ws + WS_WGU_T) + (size_t)le * 2816 * 2048;
        tr_tile(src + (size_t)(kt * 128) * FF + n0, FF, dst + (size_t)drow * 2048 + kt * 128, 2048, T);
    } else {
        t -= TL_GU; const int e = t / 352, tt = t - e * 352, le = l * 16 + e;
        tr_job(in.moe_w_down + (size_t)le * FF * 2048, FF, 2048, (bf16*)(ws + WS_WD_T) + (size_t)le * 2048 * FF, tt, T); }
}
__device__ __forceinline__ void late_work(const In& in, unsigned char* ws, LAS unsigned char* lds, int G, int phase, int limit) {
    const int tid = ltid();
    LAS float* T = (LAS float*)lds; LAS int* sh = (LAS int*)(lds + 40960);
    unsigned* work = (unsigned*)(ws + WS_CTL) + CW_WORK; unsigned* done = (unsigned*)(ws + WS_CTL) + CW_DONE + 64 * (phase < 0 ? 0 : phase);
    __syncthreads();
    if (phase >= 0 && tid == 0) __hip_atomic_fetch_add(done, 1u, __ATOMIC_RELAXED, __HIP_MEMORY_SCOPE_AGENT);
    for (;;) {
        if (tid == 0) { int t = -1;
            bool go = true;
            if (phase >= 0) go = __hip_atomic_load(done, __ATOMIC_RELAXED, __HIP_MEMORY_SCOPE_AGENT) < (unsigned)G;
            if (go) t = (int)__hip_atomic_fetch_add(work, 1u, __ATOMIC_RELAXED, __HIP_MEMORY_SCOPE_AGENT);
            sh[0] = t; }
        __syncthreads();
        const int t = sh[0];
        if (t < 0 || t >= TL_ALL) break;
        late_tile(in, ws, t, T);
        __syncthreads();
        if (phase < 0 && t >= limit) break;
    }
    __syncthreads();
}

__device__ __forceinline__ void phase_prologue(const In& in, unsigned char* ws, LAS unsigned char* lds, int G, int bid) {
    const int tid = ltid();
    {
        LAS float* sl = (LAS float*)lds; LAS float* sc_ = sl + 2048; LAS float* red = sc_ + 2048;
        for (int i = tid; i < 2048; i += 512) { const float a = in.c[i], b = in.c_ctx[i]; sl[i] = a / (1.f + __expf(-a)); sc_[i] = b / (1.f + __expf(-b)); }
        __syncthreads();
        float* mod = (float*)(ws + WS_MOD);
        for (int item = bid; item < 256; item += G) {
            const int cg = item * 96, l = cg / 12288, n0 = cg - l * 12288;
            if (tid < 384) {
                const int rl = tid / 24, c4 = tid - rl * 24;
                const float* wp = in.ada_w + ((size_t)l * 2048 + rl) * 12288 + n0 + c4 * 4;
                f32x4 al = {0.f, 0.f, 0.f, 0.f}, ac = {0.f, 0.f, 0.f, 0.f};
#pragma unroll 8
                for (int i = 0; i < 128; ++i) { const f32x4 w = *(const f32x4*)(wp + (size_t)(16 * i) * 12288); const float a = sl[rl + 16 * i], b = sc_[rl + 16 * i]; al += w * a; ac += w * b; }
                *(LAS f32x4*)(red + rl * 96 + c4 * 4) = al; *(LAS f32x4*)(red + 1536 + rl * 96 + c4 * 4) = ac;
            }
            __syncthreads();
            if (tid < 192) { const int v = tid / 96, j = tid - v * 96; float s = in.ada_b[l * 12288 + n0 + j];
#pragma unroll
                for (int k = 0; k < 16; ++k) s += red[v * 1536 + k * 96 + j];
                mod[(size_t)(l * 2 + v) * 12288 + n0 + j] = s; }
            __syncthreads();
        }
    }
    if (bid == 0) { float* gt = (float*)(ws + WS_MODP);
        for (int i = tid; i < 4096; i += 512) { const int pos = i >> 4, j = i & 15; float s, c; sincosf((float)pos * ROPE_INV[j], &s, &c); gt[i] = c; gt[4096 + i] = s; } }
    LAS float* T = (LAS float*)lds;
    constexpr int T_WIN = 17 * 16, T_QB = 48 * 4, T_KVB = 64 * 4, T_WO = 32 * 16;
    constexpr int T_ALL = T_WIN + T_QB + T_KVB + T_WO;
    bf16* win_t = (bf16*)(ws + WS_WIN_T);
    for (size_t i = (size_t)bid * 512 + tid; i < (size_t)(WIN_NP - WIN_N) * 2048 / 8; i += (size_t)G * 512) ((u32x4*)(win_t + (size_t)WIN_N * 2048))[i] = (u32x4){0u, 0u, 0u, 0u};
    for (int t0 = bid; t0 < T_ALL; t0 += G) {
        int t = t0;
        if (t < T_WIN) { tr_job(in.mla_w_in, 2048, WIN_N, win_t, t, T); continue; } t -= T_WIN;
        if (t < T_QB) { tr_job(in.mla_w_qb, 512, 3072, (bf16*)(ws + WS_WQB_T), t, T, in.mla_q_a_gain); continue; } t -= T_QB;
        if (t < T_KVB) { tr_job(in.mla_w_kvb, 512, 4096, (bf16*)(ws + WS_WKVB_T), t, T, in.mla_kv_a_gain); continue; } t -= T_KVB;
        tr_job(in.mla_w_o, 2048, 2048, (bf16*)(ws + WS_WO0_T), t, T);
    }
}
__device__ __forceinline__ const float* modv(const unsigned char* ws, int l, int v, int chunk) { return (const float*)(ws + WS_MOD) + (size_t)(l * 2 + v) * 12288 + chunk * 2048; }

__device__ __forceinline__ void norm_mod_row(f32x4 (&v)[8], const float* gain, const float* sh, const float* sc, int lane) {
    float ss = 0.f;
#pragma unroll
    for (int j = 0; j < 8; ++j) ss += (v[j].x * v[j].x + v[j].y * v[j].y) + (v[j].z * v[j].z + v[j].w * v[j].w);
    const float rs = __builtin_amdgcn_rsqf(wave_sum(ss) * (1.f / 2048.f) + EPS);
#pragma unroll
    for (int j = 0; j < 8; ++j) { const int c = 4 * (lane + 64 * j); const f32x4 g = *(const f32x4*)(gain + c), a = *(const f32x4*)(sc + c), b = *(const f32x4*)(sh + c);
        v[j] = v[j] * rs * g * (a + 1.f) + b; }
}
__device__ __forceinline__ void stage_mod_lds(LAS float* ga, LAS float* sb, const float* gain, const float* sh, const float* sc, int tid) {
    *(LAS f32x4*)(ga + 4 * tid) = *(const f32x4*)(gain + 4 * tid) * (*(const f32x4*)(sc + 4 * tid) + 1.f); *(LAS f32x4*)(sb + 4 * tid) = *(const f32x4*)(sh + 4 * tid);
}
__device__ __forceinline__ void norm_mod_row_lds(f32x4 (&v)[8], const LAS float* ga, const LAS float* sb, int lane) {
    float ss = 0.f;
#pragma unroll
    for (int j = 0; j < 8; ++j) ss += (v[j].x * v[j].x + v[j].y * v[j].y) + (v[j].z * v[j].z + v[j].w * v[j].w);
    const float rs = __builtin_amdgcn_rsqf(wave_sum(ss) * (1.f / 2048.f) + EPS);
#pragma unroll
    for (int j = 0; j < 8; ++j) { const int c = 4 * (lane + 64 * j); v[j] = v[j] * rs * *(const LAS f32x4*)(ga + c) + *(const LAS f32x4*)(sb + c); }
}
__device__ __forceinline__ int rcol(int lane, int j) { return 8 * (lane + 64 * (j >> 1)) + 4 * (j & 1); }
__device__ __forceinline__ int lpos(int c) { return 4 * (((c >> 3) & 63) + 64 * (2 * (c >> 9) + ((c >> 2) & 1))) + (c & 3); }
__device__ __forceinline__ void stage_mod_lds8(LAS float* ga, LAS float* sb, const float* gain, const float* sh, const float* sc, int tid) {
    const int p = lpos(4 * tid);
    *(LAS f32x4*)(ga + p) = *(const f32x4*)(gain + 4 * tid) * (*(const f32x4*)(sc + 4 * tid) + 1.f); *(LAS f32x4*)(sb + p) = *(const f32x4*)(sh + 4 * tid);
}
__device__ __forceinline__ void load_row_bf16x8(u32x4 (&w)[4], const bf16* row, int lane) {
#pragma unroll
    for (int g = 0; g < 4; ++g) w[g] = *(const u32x4*)(row + 8 * (lane + 64 * g));
}
__device__ __forceinline__ void unpack_row8(f32x4 (&a)[8], const u32x4 (&w)[4]) {
#pragma unroll
    for (int g = 0; g < 4; ++g) { a[2 * g] = (f32x4){bflo(w[g].x), bfhi(w[g].x), bflo(w[g].y), bfhi(w[g].y)}; a[2 * g + 1] = (f32x4){bflo(w[g].z), bfhi(w[g].z), bflo(w[g].w), bfhi(w[g].w)}; }
}
__device__ __forceinline__ void store_row_bf16x8(bf16* orow, const f32x4 (&v)[8], int lane) {
#pragma unroll
    for (int g = 0; g < 4; ++g) { u32x4 w; w.x = cvtpk(v[2 * g].x, v[2 * g].y); w.y = cvtpk(v[2 * g].z, v[2 * g].w); w.z = cvtpk(v[2 * g + 1].x, v[2 * g + 1].y); w.w = cvtpk(v[2 * g + 1].z, v[2 * g + 1].w);
        *(u32x4*)(orow + 8 * (lane + 64 * g)) = w; }
}
__device__ __forceinline__ void norm_mod_row8(f32x4 (&v)[8], const float* gain, const float* sh, const float* sc, int lane) {
    float ss = 0.f;
#pragma unroll
    for (int j = 0; j < 8; ++j) ss += (v[j].x * v[j].x + v[j].y * v[j].y) + (v[j].z * v[j].z + v[j].w * v[j].w);
    const float rs = __builtin_amdgcn_rsqf(wave_sum(ss) * (1.f / 2048.f) + EPS);
#pragma unroll
    for (int j = 0; j < 8; ++j) { const int c = rcol(lane, j); const f32x4 g = *(const f32x4*)(gain + c), a = *(const f32x4*)(sc + c), b = *(const f32x4*)(sh + c);
        v[j] = v[j] * rs * g * (a + 1.f) + b; }
}
__device__ __forceinline__ f32x4 bf4(const u32x2 w) { return (f32x4){bflo(w.x), bfhi(w.x), bflo(w.y), bfhi(w.y)}; }
__device__ __forceinline__ void store_row_bf16(bf16* orow, const f32x4 (&v)[8], int lane) {
#pragma unroll
    for (int j = 0; j < 8; ++j) { u32x2 w; w.x = cvtpk(v[j].x, v[j].y); w.y = cvtpk(v[j].z, v[j].w); *(u32x2*)(orow + 4 * (lane + 64 * j)) = w; }
}
__device__ __forceinline__ void phase_norm_in(const In& in, unsigned char* ws, LAS unsigned char* lds, int G, int bid) {
    const int lane = ltid() & 63, gw = bid * 8 + (ltid() >> 6), NGW = G * 8;
    bf16* hb = (bf16*)(ws + WS_HB);
    LAS float* mv = (LAS float*)lds;
    stage_mod_lds(mv, mv + 2048, in.norm_mix, modv(ws, 0, 0, 0), modv(ws, 0, 0, 1), ltid());
    stage_mod_lds(mv + 4096, mv + 6144, in.norm_mix, modv(ws, 0, 1, 0), modv(ws, 0, 1, 1), ltid());
    __syncthreads();
    f32x4 a[8], nx[8];
#define NI_LOAD(dst, rw) do { const float* xr_ = ((rw) >= NL) ? in.ctx + (size_t)((rw) - NL) * 2048 : in.x + (size_t)(rw) * 2048; \
    _Pragma("unroll") for (int j = 0; j < 8; ++j) dst[j] = *(const f32x4*)(xr_ + 4 * (lane + 64 * j)); } while (0)
    if (gw < NTOK) NI_LOAD(a, gw);
    for (int row = gw; row < NTOK; row += NGW) {
        const int v = row >= NL;
        if (row + NGW < NTOK) NI_LOAD(nx, row + NGW);
        norm_mod_row_lds(a, mv + v * 4096, mv + v * 4096 + 2048, lane);
        store_row_bf16(hb + (size_t)row * 2048, a, lane);
#pragma unroll
        for (int j = 0; j < 8; ++j) a[j] = nx[j];
    }
#undef NI_LOAD
    __syncthreads();
}
__device__ __forceinline__ void phase_rownorm_a(const In& in, unsigned char* ws, int G, int bid) {
    const int lane = ltid() & 63, gw = bid * 8 + (ltid() >> 6), NGW = G * 8;
    const bf16* ab = (const bf16*)(ws + WS_AB); bf16* qn = (bf16*)(ws + WS_QN); bf16* kvn = (bf16*)(ws + WS_KVN);
    float gq[8], gk[8];
#pragma unroll
    for (int i = 0; i < 8; ++i) { gq[i] = in.mla_q_a_gain[lane * 8 + i]; gk[i] = in.mla_kv_a_gain[lane * 8 + i]; }
    u32x4 qn_, kn_;
    if (gw < NTOK) { qn_ = *(const u32x4*)(ab + (size_t)gw * WIN_NP + lane * 8); kn_ = *(const u32x4*)(ab + (size_t)gw * WIN_NP + 512 + lane * 8); }
    for (int row = gw; row < NTOK; row += NGW) {
        const u32x4 q = qn_, k = kn_;
        if (row + NGW < NTOK) { qn_ = *(const u32x4*)(ab + (size_t)(row + NGW) * WIN_NP + lane * 8); kn_ = *(const u32x4*)(ab + (size_t)(row + NGW) * WIN_NP + 512 + lane * 8); }
        float qf[8] = {bflo(q.x), bfhi(q.x), bflo(q.y), bfhi(q.y), bflo(q.z), bfhi(q.z), bflo(q.w), bfhi(q.w)};
        float kf[8] = {bflo(k.x), bfhi(k.x), bflo(k.y), bfhi(k.y), bflo(k.z), bfhi(k.z), bflo(k.w), bfhi(k.w)};
        float sq = 0.f, sk = 0.f;
#pragma unroll
        for (int i = 0; i < 8; ++i) { sq += qf[i] * qf[i]; sk += kf[i] * kf[i]; }
        const float rq = __builtin_amdgcn_rsqf(wave_sum(sq) * (1.f / 512.f) + EPS), rk = __builtin_amdgcn_rsqf(wave_sum(sk) * (1.f / 512.f) + EPS);
        u32x4 wq, wk;
        wq.x = cvtpk(qf[0] * rq * gq[0], qf[1] * rq * gq[1]); wq.y = cvtpk(qf[2] * rq * gq[2], qf[3] * rq * gq[3]); wq.z = cvtpk(qf[4] * rq * gq[4], qf[5] * rq * gq[5]); wq.w = cvtpk(qf[6] * rq * gq[6], qf[7] * rq * gq[7]);
        wk.x = cvtpk(kf[0] * rk * gk[0], kf[1] * rk * gk[1]); wk.y = cvtpk(kf[2] * rk * gk[2], kf[3] * rk * gk[3]); wk.z = cvtpk(kf[4] * rk * gk[4], kf[5] * rk * gk[5]); wk.w = cvtpk(kf[6] * rk * gk[6], kf[7] * rk * gk[7]);
        *(u32x4*)(qn + (size_t)row * 512 + lane * 8) = wq; *(u32x4*)(kvn + (size_t)row * 512 + lane * 8) = wk;
    }
}
__device__ __forceinline__ void unpack8(const u32x4 q, float (&f)[8]) { f[0] = bflo(q.x); f[1] = bfhi(q.x); f[2] = bflo(q.y); f[3] = bfhi(q.y); f[4] = bflo(q.z); f[5] = bfhi(q.z); f[6] = bflo(q.w); f[7] = bfhi(q.w); }
__device__ __forceinline__ u32x4 pack8(const float (&f)[8]) { u32x4 w; w.x = cvtpk(f[0], f[1]); w.y = cvtpk(f[2], f[3]); w.z = cvtpk(f[4], f[5]); w.w = cvtpk(f[6], f[7]); return w; }
__device__ __forceinline__ u32x2 pack8_fp8(const float (&f)[8]) { int w0 = 0, w1 = 0;
    w0 = __builtin_amdgcn_cvt_pk_fp8_f32(f[0], f[1], w0, false); w0 = __builtin_amdgcn_cvt_pk_fp8_f32(f[2], f[3], w0, true);
    w1 = __builtin_amdgcn_cvt_pk_fp8_f32(f[4], f[5], w1, false); w1 = __builtin_amdgcn_cvt_pk_fp8_f32(f[6], f[7], w1, true);
    u32x2 r; r.x = (unsigned)w0; r.y = (unsigned)w1; return r; }
__device__ __forceinline__ float sumsq8(const u32x4 q) { float f[8]; unpack8(q, f); float s = 0.f;
#pragma unroll
    for (int i = 0; i < 8; ++i) s += f[i] * f[i];
    return s; }

__device__ __forceinline__ void rope64(float (&pe)[64], const LAS float* ct, const LAS float* st, int row, int col) {
#pragma unroll
    for (int j = 0; j < 16; ++j) { const float c = ct[row * 16 + j], s = st[row * 16 + j]; const float x1 = pe[j], x2 = pe[16 + j]; pe[j] = x1 * c - x2 * s; pe[16 + j] = x2 * c + x1 * s; }
#pragma unroll
    for (int j = 0; j < 16; ++j) { const float c = ct[col * 16 + j], s = st[col * 16 + j]; const float x1 = pe[32 + j], x2 = pe[48 + j]; pe[32 + j] = x1 * c - x2 * s; pe[48 + j] = x2 * c + x1 * s; }
}
__device__ __forceinline__ void phase_headnorm_rope(const In& in, unsigned char* ws, LAS unsigned char* lds, int G, int bid) {
    const int tid = ltid();
    bf16* kvraw = (bf16*)(ws + WS_KVRAW);
    __syncthreads();
    {
        const int lane = tid & 63, wid = tid >> 6, c = lane & 15, q = lane >> 4;
        LAS unsigned* img = (LAS unsigned*)(lds + 36864) + wid * 2048;
        unsigned char* vtb = ws + WS_KPE;
        for (int it = bid * 8 + wid; it < NH * (NTOK / 64); it += G * 8) {
            const int h = it / (NTOK / 64), T = it - h * (NTOK / 64);
            const bf16* vp = kvraw + (size_t)(T * 64) * 4096 + h * 256 + 128 + c * 8;
#pragma unroll
            for (int m = 0; m < 4; ++m) { const int gi = 4 * m + q;
                const int sd = 8 * (gi & 1) + 4 * (gi >> 3) + ((gi & 7) >> 1);
                float f0[8], f1[8], f2[8], f3[8];
                unpack8(*(const u32x4*)(vp + (size_t)(4 * gi) * 4096), f0); unpack8(*(const u32x4*)(vp + (size_t)(4 * gi + 1) * 4096), f1);
                unpack8(*(const u32x4*)(vp + (size_t)(4 * gi + 2) * 4096), f2); unpack8(*(const u32x4*)(vp + (size_t)(4 * gi + 3) * 4096), f3);
#pragma unroll
                for (int i = 0; i < 8; ++i) { int w = 0; w = __builtin_amdgcn_cvt_pk_fp8_f32(f0[i], f1[i], w, false); w = __builtin_amdgcn_cvt_pk_fp8_f32(f2[i], f3[i], w, true);
                    img[(c * 8 + i) * 16 + sd] = (unsigned)w; } }
            asm volatile("s_waitcnt lgkmcnt(0)" ::: "memory");
            u32x4* dst = (u32x4*)(vtb + (size_t)it * 8192);
#pragma unroll
            for (int k = 0; k < 8; ++k) dst[k * 64 + lane] = *(const LAS u32x4*)(img + (k * 64 + lane) * 4);
            asm volatile("s_waitcnt lgkmcnt(0)" ::: "memory");
        }
    }
}
__device__ __forceinline__ void phase_na_headnorm(const In& in, unsigned char* ws, int G, int bid) {
    bf16* qkv = (bf16*)(ws + WS_QKV1);
    const int tid = ltid(), lane = tid & 63, c = lane & 15, gw = bid * 8 + (tid >> 6), NGW = G * 8;
    const f32x4 gq0 = *(const f32x4*)(in.na_q_gain + c * 8), gq1 = *(const f32x4*)(in.na_q_gain + c * 8 + 4), gk0 = *(const f32x4*)(in.na_k_gain + c * 8), gk1 = *(const f32x4*)(in.na_k_gain + c * 8 + 4);
    constexpr int NIT = NTOK * 32 / 4;
    for (int pp = gw; pp < NIT; pp += 4 * NGW) {
        bf16* qp[4]; u32x4 raw[4]; bool isk[4], act[4];
#pragma unroll
        for (int u = 0; u < 4; ++u) { const int pi = pp + u * NGW; act[u] = pi < NIT; const int p = (act[u] ? pi : pp) * 4 + (lane >> 4), t = p >> 5, hh = p & 31; isk[u] = (hh >> 4) != 0;
            qp[u] = qkv + (size_t)t * 6144 + hh * 128 + c * 8; raw[u] = *(const u32x4*)qp[u]; }
#pragma unroll
        for (int u = 0; u < 4; ++u) {
            float f[8]; unpack8(raw[u], f);
            float ss = 0.f;
#pragma unroll
            for (int i = 0; i < 8; ++i) ss += f[i] * f[i];
#pragma unroll
            for (int o = 1; o < 16; o <<= 1) ss += __shfl_xor(ss, o);
            const float rs = __builtin_amdgcn_rsqf(ss * (1.f / 128.f) + EPS);
            const f32x4 g0 = isk[u] ? gk0 : gq0, g1 = isk[u] ? gk1 : gq1;
            f[0] *= rs * g0.x; f[1] *= rs * g0.y; f[2] *= rs * g0.z; f[3] *= rs * g0.w; f[4] *= rs * g1.x; f[5] *= rs * g1.y; f[6] *= rs * g1.z; f[7] *= rs * g1.w;
            if (act[u]) *(u32x4*)qp[u] = pack8(f);
        }
    }
}
__device__ __forceinline__ void phase_router(const In& in, unsigned char* ws, LAS unsigned char* lds, int G, int bid, int l, int nrows) {
    const int tid = ltid(), lane = tid & 63, gw = bid * 8 + (tid >> 6), NGW = G * 8;
    LAS float* rwT = (LAS float*)lds;
    const float* rw = in.router_w + (size_t)l * 2048 * 16;
    for (int i = tid; i < 2048 * 16; i += 512) rwT[(i & 15) * 2048 + lpos(i >> 4)] = rw[i];
    LAS float* mv = (LAS float*)(lds + 131072);
    stage_mod_lds8(mv, mv + 2048, in.norm_ffn + l * 2048, modv(ws, l, 0, 3), modv(ws, l, 0, 4), tid);
    __syncthreads();
    const bf16* x1 = (const bf16*)(ws + WS_X1); bf16* hb = (bf16*)(ws + WS_HB); float* aff = (float*)(ws + WS_AFF);
    f32x4 a[8]; u32x4 nx[4], cu[4];
    if (gw < nrows) load_row_bf16x8(cu, x1 + (size_t)gw * 2048, lane);
    for (int row = gw; row < nrows; row += NGW) {
        const int v = row >= NL;
        if (row + NGW < nrows) load_row_bf16x8(nx, x1 + (size_t)(row + NGW) * 2048, lane);
        unpack_row8(a, cu);
        if (!v) norm_mod_row_lds(a, mv, mv + 2048, lane); else norm_mod_row8(a, in.norm_ffn + l * 2048, modv(ws, l, 1, 3), modv(ws, l, 1, 4), lane);
        store_row_bf16x8(hb + (size_t)row * 2048, a, lane);
        float lg[16];
#pragma unroll
        for (int e = 0; e < 16; ++e) { float s = 0.f;
#pragma unroll
            for (int j = 0; j < 8; ++j) { const f32x4 w = *(const LAS f32x4*)(rwT + e * 2048 + 4 * (lane + 64 * j)); s += (a[j].x * w.x + a[j].y * w.y) + (a[j].z * w.z + a[j].w * w.w); }
            lg[e] = s; __builtin_amdgcn_sched_barrier(0); }
        float v8[8], v4[4], v2[2], v1;
        { const bool up = (lane & 32) != 0;
#pragma unroll
          for (int i = 0; i < 8; ++i) { const float snd = up ? lg[i] : lg[8 + i], kp = up ? lg[8 + i] : lg[i]; v8[i] = kp + __shfl_xor(snd, 32); } }
        { const bool up = (lane & 16) != 0;
#pragma unroll
          for (int i = 0; i < 4; ++i) { const float snd = up ? v8[i] : v8[4 + i], kp = up ? v8[4 + i] : v8[i]; v4[i] = kp + __shfl_xor(snd, 16); } }
        { const bool up = (lane & 8) != 0;
#pragma unroll
          for (int i = 0; i < 2; ++i) { const float snd = up ? v4[i] : v4[2 + i], kp = up ? v4[2 + i] : v4[i]; v2[i] = kp + __shfl_xor(snd, 8); } }
        { const bool up = (lane & 4) != 0; const float snd = up ? v2[0] : v2[1], kp = up ? v2[1] : v2[0]; v1 = kp + __shfl_xor(snd, 4); }
        v1 += __shfl_xor(v1, 2); v1 += __shfl_xor(v1, 1);
        float mx = v1;
#pragma unroll
        for (int o = 4; o < 64; o <<= 1) mx = fmaxf(mx, __shfl_xor(mx, o));
        const float ex = __expf(v1 - mx);
        float den = ex;
#pragma unroll
        for (int o = 4; o < 64; o <<= 1) den += __shfl_xor(den, o);
        if ((lane & 3) == 0) { const int e = ((lane >> 5) & 1) * 8 + ((lane >> 4) & 1) * 4 + ((lane >> 3) & 1) * 2 + ((lane >> 2) & 1); aff[(size_t)e * NTOK + row] = ex / den; }
#pragma unroll
        for (int g = 0; g < 4; ++g) cu[g] = nx[g];
    }
    __syncthreads();
}
__device__ __forceinline__ int block_sum_i(int v, LAS int* red, int tid) {
    v = wave_sum_i(v);
    __syncthreads();
    if ((tid & 63) == 0) red[tid >> 6] = v;
    __syncthreads();
    int s = 0;
#pragma unroll
    for (int w = 0; w < 8; ++w) s += red[w];
    return s;
}
__device__ __forceinline__ void phase_topk(unsigned char* ws, LAS unsigned char* lds, int G, int bid, int nprob) {
    const int tid = ltid(), lane = tid & 63, wid = tid >> 6;
    LAS int* red = (LAS int*)lds; LAS int* scan = red + 16;
    const float* aff = (const float*)(ws + WS_AFF); int* idx = (int*)(ws + WS_IDX); float* gate = (float*)(ws + WS_GATE); int* slot = (int*)(ws + WS_SLOT);
    for (int pb = bid; pb < nprob; pb += G) {
        const int e = pb & 15, isctx = pb >> 4;
        const int n = isctx ? NC : NL, k = isctx ? CAPC : CAPL, tok0 = isctx ? NL : 0, slot0 = isctx ? CAPL : 0;
        const int per = n / 512;
        unsigned key[32];
        const float* ap = aff + (size_t)e * NTOK + tok0;
        if (!isctx) {
#pragma unroll
            for (int j = 0; j < 8; ++j) { const u32x4 q = *(const u32x4*)(ap + tid * 32 + j * 4); key[j * 4] = q.x; key[j * 4 + 1] = q.y; key[j * 4 + 2] = q.z; key[j * 4 + 3] = q.w; }
        } else {
#pragma unroll
            for (int j = 0; j < 32; ++j) key[j] = 0u;
            if (tid < NC) key[0] = __float_as_uint(ap[tid]);
        }
        (void)per;
        unsigned lo = 0u, hi = 0x7f800000u;
        while (hi - lo > 1u) {
            const unsigned mid = lo + ((hi - lo) >> 1);
            int c = 32;
#pragma unroll
            for (int j = 0; j < 32; ++j) c += ((int)key[j] - (int)mid) >> 31;
            c = block_sum_i(c, red, tid);
            if (c >= k) lo = mid; else hi = mid;
        }
        const unsigned T = lo;
        int cg = 32, ce = 32;
#pragma unroll
        for (int j = 0; j < 32; ++j) { cg += ((int)key[j] - (int)(T + 1u)) >> 31; ce += ((int)key[j] - (int)T) >> 31; }
        ce -= cg;
        if (isctx && tid >= NC) { cg = 0; ce = 0; }
        int sg = cg, se = ce;
#pragma unroll
        for (int o = 1; o < 64; o <<= 1) { const int a = __shfl_up(sg, o), b = __shfl_up(se, o); if (lane >= o) { sg += a; se += b; } }
        __syncthreads();
        if (lane == 63) { scan[wid] = sg; scan[8 + wid] = se; }
        __syncthreads();
        int bg = 0, be = 0, totg = 0;
#pragma unroll
        for (int w = 0; w < 8; ++w) { const int a = scan[w], b = scan[8 + w]; if (w < wid) { bg += a; be += b; } totg += a; }
        const int need_eq = k - totg;
        int g_before = bg + sg - cg, e_before = be + se - ce;
        const int nmine = isctx ? (tid < NC ? 1 : 0) : 32;
#pragma unroll
        for (int j = 0; j < 32; ++j) {
            if (j < nmine) {
                const int i = isctx ? tid : tid * 32 + j;
                const bool gt = key[j] > T, eq = key[j] == T;
                const bool sel = gt || (eq && e_before < need_eq);
                const int s = g_before + min(e_before, need_eq);
                if (sel) { idx[e * EROWS + slot0 + s] = tok0 + i; gate[e * EROWS + slot0 + s] = __uint_as_float(key[j]); }
                slot[(size_t)(tok0 + i) * 16 + e] = sel ? slot0 + s : -1;
                g_before += gt ? 1 : 0; e_before += eq ? 1 : 0;
            }
        }
        if (isctx) { for (int s = CAPL + CAPC + tid; s < EROWS; s += 512) { idx[e * EROWS + s] = -1; gate[e * EROWS + s] = 0.f; } }
        __syncthreads();
    }
}
__device__ __forceinline__ void phase_gather(unsigned char* ws, int G, int bid, int rows_per_e) {
    const int lane = ltid() & 63, gw = bid * 8 + (ltid() >> 6), NGW = G * 8;
    const bf16* hb = (const bf16*)(ws + WS_HB); bf16* xs = (bf16*)(ws + WS_XS); const int* idx = (const int*)(ws + WS_IDX);
    for (int r = gw; r < NE * rows_per_e; r += NGW) {
        const int e = r / rows_per_e, s = r - e * rows_per_e; const int t = idx[e * EROWS + s];
        u32x4 v[4];
#pragma unroll
        for (int j = 0; j < 4; ++j) v[j] = (t >= 0) ? *(const u32x4*)(hb + (size_t)t * 2048 + (lane + 64 * j) * 8) : (u32x4){0u, 0u, 0u, 0u};
#pragma unroll
        for (int j = 0; j < 4; ++j) *(u32x4*)(xs + ((size_t)e * EROWS + s) * 2048 + (lane + 64 * j) * 8) = v[j];
    }
}
__device__ __forceinline__ void phase_combine(const In& in, unsigned char* ws, LAS unsigned char* lds, float* out, int G, int bid, int l, int nrows) {
    const int tid = ltid(), lane = tid & 63, gw = bid * 8 + (tid >> 6), NGW = G * 8;
    bf16* x1 = (bf16*)(ws + WS_X1); const bf16* yb = (const bf16*)(ws + WS_YB); const int* slot = (const int*)(ws + WS_SLOT); bf16* hb = (bf16*)(ws + WS_HB);
    LAS float* mv = (LAS float*)lds;
    for (int v = 0; v < (nrows > NL ? 2 : 1); ++v) {
        *(LAS f32x4*)(mv + v * 6144 + lpos(4 * tid)) = *(const f32x4*)(modv(ws, l, v, 5) + 4 * tid);
        if (l == 0) stage_mod_lds8(mv + v * 6144 + 2048, mv + v * 6144 + 4096, in.norm_mix + 2048, modv(ws, 1, v, 0), modv(ws, 1, v, 1), tid); }
    __syncthreads();
    int nslot = (gw < nrows) ? slot[(size_t)gw * 16 + (lane & 15)] : -1;
    for (int row = gw; row < nrows; row += NGW) {
        const LAS float* mvv = mv + (row >= NL ? 6144 : 0);
        const int myslot = nslot;
        f32x4 a[8];
#pragma unroll
        for (int j = 0; j < 1; ++j) { u32x4 xw[4]; load_row_bf16x8(xw, x1 + (size_t)row * 2048, lane); unpack_row8(a, xw); }
        if (row + NGW < nrows) nslot = slot[(size_t)(row + NGW) * 16 + (lane & 15)];
        f32x4 acc[8];
#pragma unroll
        for (int j = 0; j < 8; ++j) acc[j] = (f32x4){0.f, 0.f, 0.f, 0.f};
        unsigned m = (unsigned)__ballot(myslot >= 0) & 0xffffu;
        while (m) {
            const int e0 = __builtin_ctz(m); m &= m - 1u;
            const bool two = m != 0u; const int e1 = two ? __builtin_ctz(m) : e0; if (two) m &= m - 1u;
            const bf16* y0 = yb + ((size_t)e0 * EROWS + __shfl(myslot, e0)) * 2048; const bf16* y1 = yb + ((size_t)e1 * EROWS + __shfl(myslot, e1)) * 2048;
            u32x4 w0[4], w1[4];
            load_row_bf16x8(w0, y0, lane);
            if (two) load_row_bf16x8(w1, y1, lane);
#pragma unroll
            for (int g = 0; g < 4; ++g) { acc[2 * g].x += bflo(w0[g].x); acc[2 * g].y += bfhi(w0[g].x); acc[2 * g].z += bflo(w0[g].y); acc[2 * g].w += bfhi(w0[g].y);
                acc[2 * g + 1].x += bflo(w0[g].z); acc[2 * g + 1].y += bfhi(w0[g].z); acc[2 * g + 1].z += bflo(w0[g].w); acc[2 * g + 1].w += bfhi(w0[g].w); }
            if (two) {
#pragma unroll
                for (int g = 0; g < 4; ++g) { acc[2 * g].x += bflo(w1[g].x); acc[2 * g].y += bfhi(w1[g].x); acc[2 * g].z += bflo(w1[g].y); acc[2 * g].w += bfhi(w1[g].y);
                    acc[2 * g + 1].x += bflo(w1[g].z); acc[2 * g + 1].y += bfhi(w1[g].z); acc[2 * g + 1].z += bflo(w1[g].w); acc[2 * g + 1].w += bfhi(w1[g].w); } }
        }
#pragma unroll
        for (int j = 0; j < 8; ++j) a[j] = a[j] + *(const LAS f32x4*)(mvv + 4 * (lane + 64 * j)) * acc[j];
        if (l == 0) {
            store_row_bf16x8(x1 + (size_t)row * 2048, a, lane);
            norm_mod_row_lds(a, mvv + 2048, mvv + 4096, lane);
            store_row_bf16x8(hb + (size_t)row * 2048, a, lane);
        } else {
#pragma unroll
            for (int j = 0; j < 8; ++j) *(f32x4*)(out + (size_t)row * 2048 + rcol(lane, j)) = a[j];
        }
    }
    __syncthreads();
}
}
#define XB_TMO      128
#define XB_XCNT(j)  (256  + 64 * (j))
#define XB_XSUB(j)  (1280 + 64 * (j))
#define XB_XGEN(j)  (2304 + 64 * (j))
#define XB_TOP      3328
#define XB_TOPGEN   3392
#define XCD_BAR_WORDS 3456
#define XB_SPIN_CAP (1u << 22)

__device__ __forceinline__ unsigned xb_ld(unsigned* p)              { return __hip_atomic_load(p, __ATOMIC_RELAXED, __HIP_MEMORY_SCOPE_AGENT); }
__device__ __forceinline__ unsigned xb_add(unsigned* p, unsigned v) { return __hip_atomic_fetch_add(p, v, __ATOMIC_RELAXED, __HIP_MEMORY_SCOPE_AGENT); }
__device__ __forceinline__ unsigned xb_xcc_id() { return (unsigned)__builtin_amdgcn_s_getreg((3 << 11) | 20) & 0xFu; }
#define XB_SPIN(cond, bar) do { unsigned _sp = 0; while (cond) { __builtin_amdgcn_s_sleep(1); \
    if ((++_sp & 255u) == 0u) { if (xb_ld(&(bar)[XB_TMO])) break; if (_sp > XB_SPIN_CAP) { atomicAdd(&(bar)[XB_TMO], 1u); break; } } } } while (0)

struct XcdBarrier { unsigned* bar; unsigned x; volatile LAS unsigned* st; };

__device__ __forceinline__ XcdBarrier xcd_barrier_post(unsigned* bar, volatile LAS unsigned* st) {
    XcdBarrier b; b.bar = bar; b.x = xb_xcc_id(); b.st = st;
    if (threadIdx.x == 0) (void)xb_add(&bar[XB_XCNT(b.x)], 1u);
    return b;
}
__device__ __forceinline__ void xcd_barrier_complete(unsigned* bar, unsigned x, unsigned& nloc, unsigned& nx) {
    const unsigned G = gridDim.x * gridDim.y * gridDim.z;
    unsigned sum, cnt, mine, sp = 0u;
    for (;;) {
        sum = 0u; cnt = 0u; mine = 0u;
#pragma unroll
        for (unsigned j = 0; j < 16; ++j) { const unsigned c = xb_ld(&bar[XB_XCNT(j)]); sum += c; cnt += (c > 0u) ? 1u : 0u; mine = (j == x) ? c : mine; }
        if (sum == G) break;
        __builtin_amdgcn_s_sleep(1);
        if ((++sp & 255u) == 0u) { if (xb_ld(&bar[XB_TMO])) break; if (sp > XB_SPIN_CAP) { atomicAdd(&bar[XB_TMO], 1u); break; } }
    }
    nloc = mine > 0u ? mine : 1u; nx = cnt > 0u ? cnt : 1u;
}
__device__ __forceinline__ void xcd_barrier(const XcdBarrier& b) {
    asm volatile("s_waitcnt vmcnt(0)" ::: "memory");
    __syncthreads();
    if (threadIdx.x == 0) {
        unsigned* bar = b.bar;
        __builtin_amdgcn_s_waitcnt(0);
        unsigned nloc = b.st[0], nx = b.st[1];
        if (nloc == 0u) { xcd_barrier_complete(bar, b.x, nloc, nx); b.st[0] = nloc; b.st[1] = nx; }
        const unsigned old = xb_add(&bar[XB_XSUB(b.x)], 1u);
        const unsigned gen = old / nloc;
        if (old + 1u == (gen + 1u) * nloc) {
            __builtin_amdgcn_fence(__ATOMIC_RELEASE, "agent");
            asm volatile("s_waitcnt vmcnt(0)" ::: "memory");
            const unsigned og = xb_add(&bar[XB_TOP], 1u);
            const unsigned tg = og / nx;
            if (og + 1u == (tg + 1u) * nx) xb_add(&bar[XB_TOPGEN], 1u);
            else XB_SPIN(xb_ld(&bar[XB_TOPGEN]) == tg, bar);
            __builtin_amdgcn_fence(__ATOMIC_ACQUIRE, "agent");
            xb_add(&bar[XB_XGEN(b.x)], 1u);
            asm volatile("s_waitcnt vmcnt(0)" ::: "memory");
        } else {
            XB_SPIN(xb_ld(&bar[XB_XGEN(b.x)]) == gen, bar);
            __builtin_amdgcn_fence(__ATOMIC_ACQUIRE, "agent");
            asm volatile("s_waitcnt vmcnt(0)" ::: "memory");
        }
    }
    __syncthreads();
}

#ifndef MK_PER_PHASE
#define MK_PER_PHASE 0
#endif
constexpr int NPHASE = 25;
constexpr int LDS_BYTES = 148480;
constexpr int MISC_OFF = 147456 + 64;

struct Args { thin::In in; float* out; unsigned char* ws; int ph_lo, ph_hi; };
#define CAS __attribute__((address_space(4)))
typedef const CAS Args* ArgsP;
__device__ __forceinline__ ArgsP opaque(ArgsP p) { asm volatile("" : "+s"(p)); return p; }
__device__ __forceinline__ thin::In load_in(ArgsP A) { thin::In r;
    r.x = A->in.x; r.c = A->in.c; r.ctx = A->in.ctx; r.c_ctx = A->in.c_ctx; r.ada_w = A->in.ada_w; r.ada_b = A->in.ada_b; r.norm_mix = A->in.norm_mix; r.norm_ffn = A->in.norm_ffn;
    r.mla_w_in = A->in.mla_w_in; r.mla_q_a_gain = A->in.mla_q_a_gain; r.mla_kv_a_gain = A->in.mla_kv_a_gain; r.mla_w_qb = A->in.mla_w_qb; r.mla_w_kvb = A->in.mla_w_kvb;
    r.mla_q_gain = A->in.mla_q_gain; r.mla_k_gain = A->in.mla_k_gain; r.mla_w_o = A->in.mla_w_o; r.na_w_qkv = A->in.na_w_qkv; r.na_q_gain = A->in.na_q_gain; r.na_k_gain = A->in.na_k_gain;
    r.na_rpb = A->in.na_rpb; r.na_w_o = A->in.na_w_o; r.router_w = A->in.router_w; r.moe_w_gate = A->in.moe_w_gate; r.moe_w_up = A->in.moe_w_up; r.moe_w_down = A->in.moe_w_down; return r; }

__global__ void __launch_bounds__(512, 2) fwd_kernel(Args args) {
    extern __shared__ __attribute__((aligned(16))) unsigned char lds_raw[];
    LAS unsigned char* lds = (LAS unsigned char*)lds_raw;
    const int tid = threadIdx.x, G = gridDim.x, bid = blockIdx.x;
    ArgsP ap = (ArgsP)__builtin_amdgcn_kernarg_segment_ptr();
    volatile LAS unsigned* MISC = (volatile LAS unsigned*)(lds + MISC_OFF);
    if (tid < 32) MISC[tid] = 0u;
    __syncthreads();
    XcdBarrier bar; bar.bar = (unsigned*)(ap->ws + WS_CTL) + CW_BAR; bar.x = 0; bar.st = MISC + 8;
    if (!MK_PER_PHASE) bar = xcd_barrier_post((unsigned*)(ap->ws + WS_CTL) + CW_BAR, MISC + 8);
    const int lo = ap->ph_lo, hi = ap->ph_hi;
#ifndef DBG_ONLY
#define DBG_ONLY -1
#endif
#ifndef DBG_MASK
#define DBG_MASK 0xFFFFFFFFu
#endif
#ifndef REPMASK
#define REPMASK 0u
#endif
#define RP(k) for (int rep_ = 0; rep_ < 1 + (int)((REPMASK >> (k)) & 1u); ++rep_)
#define EN(k) ((DBG_ONLY < 0 || DBG_ONLY == (k)) && ((DBG_MASK >> (k)) & 1u))
#define IN(k) ({ int lo_ = lo, hi_ = hi; asm volatile("" : "+s"(lo_), "+s"(hi_)); (lo_ <= (k) && (k) < hi_); })
#define SEAM(k) do { if (IN(k) && IN((k) + 1)) xcd_barrier(bar); else __syncthreads(); } while (0)
#define PH_ARGS() ArgsP A_ = opaque(ap); const thin::In in = load_in(A_); unsigned char* const ws = A_->ws; (void)in; (void)ws

    if (EN(0) && IN(0)) { PH_ARGS(); RP(0) thin::phase_prologue(in, ws, lds, G, bid); } SEAM(0);
    if (EN(2) && IN(2)) { PH_ARGS(); RP(2) thin::phase_norm_in(in, ws, lds, G, bid); } SEAM(2);
    if (EN(3) && IN(3)) { PH_ARGS(); RP(3) {
        pg8::Gemm g{(const bf16*)(ws + WS_HB), (const bf16*)(ws + WS_WIN_T), NTOK, WIN_NP, 2048}; pg8::StaticOrder S; S.init(NTOK, WIN_NP, G, bid);
        pg8::EpiWin E{(bf16*)(ws + WS_AB), (float*)(ws + WS_PS), (float*)(ws + WS_KPER), in.mla_k_gain, (const float*)(ws + WS_MODP)};
        pg8::gemm_phase<pg8::EpiWin, pg8::StaticOrder, true, true>(lds, g, S, E);
    } thin::late_work(in, ws, lds, G, 3, 0); } SEAM(3);
    if (EN(5) && IN(5)) { PH_ARGS(); RP(5) {
        { pg8::Gemm g{(const bf16*)(ws + WS_AB), (const bf16*)(ws + WS_WQB_T), NTOK, 3072, 512, WIN_NP}; pg8::StaticOrder S; S.init(NTOK, 3072, G, bid);
          pg8::EpiBf16P E{(bf16*)(ws + WS_QRAW), 3072};
          pg8::gemm_phase<pg8::EpiBf16P, pg8::StaticOrder, true, true>(lds, g, S, E); }
        __syncthreads();
        { pg8::Gemm g{(const bf16*)(ws + WS_AB) + 512, (const bf16*)(ws + WS_WKVB_T), NTOK, 4096, 512, WIN_NP}; pg8::StaticOrder S; S.init(NTOK, 4096, G, (bid + 28) % G);
          pg8::EpiKv E{(bf16*)(ws + WS_KVRAW), in.mla_k_gain, (const float*)(ws + WS_KPER), (const float*)(ws + WS_PS), (LAS float*)(lds + 131072), ws + WS_KPE};
          pg8::gemm_phase<pg8::EpiKv, pg8::StaticOrder, true, true>(lds, g, S, E); }
    } thin::late_work(in, ws, lds, G, 5, 0); } SEAM(5);
    if (EN(7) && IN(7)) { PH_ARGS(); RP(7) {
        const unsigned char* q8 = ws + WS_QRAW; const unsigned char* k8 = ws + WS_KVRAW; const unsigned char* vt = ws + WS_KPE; bf16* ob = (bf16*)(ws + WS_OB);
        const int nun = (G == 256) ? 5 : 0;
        for (int i = 0; i < nun; ++i) {
            const int x = bid & 7, rr = bid >> 3;
            int h, qb; bool isctx = false;
            if (i < 4) { h = 2 * x + (i >> 1); qb = rr * 2 + (i & 1); }
            else { if (rr >= 2) break; h = 2 * x + rr; qb = 0; isctx = true; }
            __syncthreads();
            if (!isctx) att::mla_unit(q8 + (size_t)(qb * 256) * 6144 + h * 384, k8 + h * 512, vt + (size_t)h * (NTOK / 64) * 8192, ob + (size_t)(qb * 256) * 2048 + h * 128, NTOK, (LAS char*)lds, in.mla_q_gain, (const float*)(ws + WS_MODP), (const float*)(ws + WS_PS), qb * 256, true);
            else att::mla_unit(q8 + (size_t)NL * 6144 + h * 384, k8 + (size_t)NL * 8192 + h * 512, vt + ((size_t)h * (NTOK / 64) + NL / 64) * 8192, ob + (size_t)NL * 2048 + h * 128, NC, (LAS char*)lds, in.mla_q_gain, (const float*)(ws + WS_MODP), (const float*)(ws + WS_PS), NL, false);
        }
        if (G != 256)
        for (int u = bid; u < 1040; u += G) {
            __syncthreads();
            if (u < 1024) { const int h = u >> 6, qb = u & 63;
                att::mla_unit(q8 + (size_t)(qb * 256) * 6144 + h * 384, k8 + h * 512, vt + (size_t)h * (NTOK / 64) * 8192, ob + (size_t)(qb * 256) * 2048 + h * 128, NTOK, (LAS char*)lds, in.mla_q_gain, (const float*)(ws + WS_MODP), (const float*)(ws + WS_PS), qb * 256, true);
            } else { const int h = u - 1024;
                att::mla_unit(q8 + (size_t)NL * 6144 + h * 384, k8 + (size_t)NL * 8192 + h * 512, vt + ((size_t)h * (NTOK / 64) + NL / 64) * 8192, ob + (size_t)NL * 2048 + h * 128, NC, (LAS char*)lds, in.mla_q_gain, (const float*)(ws + WS_MODP), (const float*)(ws + WS_PS), NL, false); }
        }
    } thin::late_work(in, ws, lds, G, 7, 0); } SEAM(7);
    if (EN(8) && IN(8)) { PH_ARGS(); RP(8) {
        pg8::Gemm g{(const bf16*)(ws + WS_OB), (const bf16*)(ws + WS_WO0_T), NTOK, 2048, 2048}; pg8::StaticOrder S; S.init(NTOK, 2048, G, bid);
        pg8::EpiResB<false> E{(bf16*)(ws + WS_X1), in.x, in.ctx, thin::modv(ws, 0, 0, 2), thin::modv(ws, 0, 1, 2)};
        pg8::gemm_phase<pg8::EpiResB<false>, pg8::StaticOrder, true, true>(lds, g, S, E);
    } thin::late_work(in, ws, lds, G, 8, 0); } SEAM(8);
#define MOE_PHASES(L, PB, PC) \
    if (EN(9) && IN(PB + 0)) { PH_ARGS(); RP(9) thin::phase_router(in, ws, lds, G, bid, L, L ? NL : NTOK); } SEAM(PB + 0); \
    if (EN(10) && IN(PB + 1)) { PH_ARGS(); RP(10) thin::phase_topk(ws, lds, G, bid, L ? 16 : 32); thin::late_work(in, ws, lds, G, PB + 1, 0); thin::late_work(in, ws, lds, G, -1, L ? thin::LIM_GU1 : thin::LIM_MOE0); } SEAM(PB + 1); \
    if (EN(12) && IN(PB + 3)) { PH_ARGS(); RP(12) { \
        pg8::Gemm g{(const bf16*)(ws + WS_HB), (const bf16*)(ws + WS_WGU_T) + (size_t)L * WGU_L, NE * EROWS, NE * 2816, 2048}; \
        pg8::GroupedOrder S; S.init(L ? 8 : 9, 11, G, bid); \
        pg8::EpiSwiGLU E{(bf16*)(ws + WS_HID)}; \
        pg8::gemm_phase_gather<pg8::EpiSwiGLU, pg8::GroupedOrder, true, true>(lds, g, (const int*)(ws + WS_IDX), S, E);     \
    } thin::late_work(in, ws, lds, G, PB + 3, 0); if (L == 1) thin::late_work(in, ws, lds, G, -1, thin::LIM_ALL); } SEAM(PB + 3);     \
    if (EN(13) && IN(PB + 4)) { PH_ARGS(); RP(13) { \
        pg8::Gemm g{(const bf16*)(ws + WS_HID), (const bf16*)(ws + WS_WD_T) + (size_t)L * WD_L, NE * EROWS, NE * 2048, FF}; \
        pg8::GroupedOrder S; S.init(L ? 8 : 9, 8, G, bid); \
        pg8::EpiDown E{(bf16*)(ws + WS_YB), (const float*)(ws + WS_GATE)}; \
        pg8::gemm_phase<pg8::EpiDown, pg8::GroupedOrder, true, true>(lds, g, S, E); \
    } if (L == 0) thin::late_work(in, ws, lds, G, PB + 4, 0); } SEAM(PB + 4); \
    if (EN(14) && IN(PC)) { PH_ARGS(); RP(14) thin::phase_combine(in, ws, lds, A_->out, G, bid, L, L ? NL : NTOK); if (L == 0) thin::late_work(in, ws, lds, G, -1, thin::LIM_NA); }

    MOE_PHASES(0, 9, 14)
    SEAM(14);
    if (EN(15) && IN(15)) { PH_ARGS(); RP(15) {
        pg8::Gemm g{(const bf16*)(ws + WS_HB), (const bf16*)(ws + WS_WQKV_T), NTOK, 6144, 2048}; pg8::StaticOrder S; S.init(NTOK, 6144, G, bid);
        pg8::EpiQkvNorm E{(bf16*)(ws + WS_QKV1), in.na_q_gain, in.na_k_gain, (LAS float*)(lds + 131072)};
        pg8::gemm_phase<pg8::EpiQkvNorm, pg8::StaticOrder, true, true>(lds, g, S, E);
    } thin::late_work(in, ws, lds, G, 15, 0); } SEAM(15);
    if (EN(17) && IN(17)) { PH_ARGS(); RP(17) {
        for (int u = bid; u < 1024; u += G) { const int h = u >> 6, rb = u & 63;
            __syncthreads();
            att::na_unit((const bf16*)(ws + WS_QKV1), h, rb, in.na_rpb + h * 465, (bf16*)(ws + WS_OB), (LAS char*)lds); }
    } thin::late_work(in, ws, lds, G, 17, 0); } SEAM(17);
    if (EN(18) && IN(18)) { PH_ARGS(); RP(18) {
        pg8::Gemm g{(const bf16*)(ws + WS_OB), (const bf16*)(ws + WS_WO1_T), NL, 2048, 2048}; pg8::StaticOrder S; S.init(NL, 2048, G, bid);
        pg8::EpiResB<true> E{(bf16*)(ws + WS_X1), ws + WS_X1, ws + WS_X1, thin::modv(ws, 1, 0, 2), thin::modv(ws, 1, 0, 2)};
        pg8::gemm_phase<pg8::EpiResB<true>, pg8::StaticOrder, true, true>(lds, g, S, E);
    } thin::late_work(in, ws, lds, G, 18, 0); } SEAM(18);
    MOE_PHASES(1, 19, 24)
#undef MOE_PHASES
#undef IN
#undef SEAM
}

extern "C" void kernel_launch(void* const* d_in, const int* in_sizes, int n_in, void* d_out, int out_size, void* d_ws, size_t ws_size, hipStream_t stream) {
    static int grid = 0;
    if (grid == 0) {
        if (n_in != 25 || in_sizes[0] != NL * DM || out_size != NL * DM || ws_size < WS_END) {
            fprintf(stderr, "kernel_launch: unexpected problem: n_in %d in0 %d out %d ws %zu (need %zu)\n", n_in, n_in > 0 ? in_sizes[0] : -1, out_size, ws_size, (size_t)WS_END); grid = -1; return; }
        int dev = 0, cus = 0, per_cu = 0;
        if (hipGetDevice(&dev) != hipSuccess || hipDeviceGetAttribute(&cus, hipDeviceAttributeMultiprocessorCount, dev) != hipSuccess) { grid = -1; return; }
        if (hipFuncSetAttribute((const void*)fwd_kernel, hipFuncAttributeMaxDynamicSharedMemorySize, LDS_BYTES) != hipSuccess) { fprintf(stderr, "kernel_launch: hipFuncSetAttribute failed\n"); grid = -1; return; }
        if (hipOccupancyMaxActiveBlocksPerMultiprocessor(&per_cu, (const void*)fwd_kernel, 512, LDS_BYTES) != hipSuccess || per_cu < 1)
            fprintf(stderr, "kernel_launch: note: occupancy query reports %d workgroups per CU\n", per_cu);
        (void)hipGetLastError();
        grid = cus;
    }
    if (grid < 0) return;
    if (hipMemsetAsync((char*)d_ws + WS_CTL, 0, CTL_ZERO_BYTES, stream) != hipSuccess) { fprintf(stderr, "kernel_launch: memset failed\n"); return; }
    Args a{};
    const float** ip = (const float**)&a.in;
    for (int i = 0; i < 25; ++i) ip[i] = (const float*)d_in[i];
    a.out = (float*)d_out; a.ws = (unsigned char*)d_ws;
#if MK_PER_PHASE
    for (int p = 0; p < NPHASE; ++p) { a.ph_lo = p; a.ph_hi = p + 1;
        hipLaunchKernelGGL(fwd_kernel, dim3(grid), dim3(512), LDS_BYTES, stream, a); }
#else
    a.ph_lo = 0; a.ph_hi = NPHASE;
    hipLaunchKernelGGL(fwd_kernel, dim3(grid), dim3(512), LDS_BYTES, stream, a);
#endif
    const hipError_t le = hipPeekAtLastError();
    if (le != hipSuccess) fprintf(stderr, "kernel_launch: launch failed: %s\n", hipGetErrorName(le));
}
```

```cpp
#include <hip/hip_runtime.h>
#include <cstdio>
#include <cstdint>

#define GAS __attribute__((address_space(1)))
#define LAS __attribute__((address_space(3)))
typedef unsigned short bf16;
typedef short bf16x8 __attribute__((ext_vector_type(8)));
typedef short s16x4 __attribute__((ext_vector_type(4)));
typedef float f32x2 __attribute__((ext_vector_type(2)));
typedef float f32x4 __attribute__((ext_vector_type(4)));
typedef float f32x16 __attribute__((ext_vector_type(16)));
typedef unsigned u32x4 __attribute__((ext_vector_type(4)));
typedef unsigned u32x2 __attribute__((ext_vector_type(2)));

constexpr int NL = 16384, NC = 256, NTOK = NL + NC, DM = 2048, NH = 16;
constexpr int QLORA = 512, KVLORA = 512, ROPE_D = 64, NOPE_D = 128, QKH = 192, VD = 128;
constexpr int WIN_N = 1088, WIN_NP = 1280;
constexpr int NE = 16, FF = 1408, CAPL = 2048, CAPC = 32, EROWS = 2304;
constexpr float EPS = 1e-6f;
constexpr float LOG2E = 1.4426950408889634f;

constexpr size_t MiB = (size_t)1 << 20;
constexpr size_t WS_CTL = 0, CTL_ZERO_BYTES = 1 * MiB;
constexpr size_t WS_MODP = 1 * MiB;
static_assert((size_t)NTOK * 64 * 4 + 64 * 1024 <= 4608 * 1024 && 4608 * 1024 + (size_t)NTOK * 20 * 4 <= 6 * MiB, "small tables");
constexpr size_t WS_KPER = WS_MODP + 64 * 1024;
constexpr size_t WS_PS = WS_MODP + 4608 * 1024;
constexpr size_t WS_MOD = 7 * MiB;
constexpr size_t WS_AFF = 8 * MiB;
constexpr size_t WS_IDX = 8 * MiB + 1280 * 1024;
constexpr size_t WS_GATE = WS_IDX + 256 * 1024;
constexpr size_t WS_SLOT = 10 * MiB;
constexpr size_t WS_WIN_T = 12 * MiB, WS_WQB_T = 17 * MiB, WS_WKVB_T = 20 * MiB, WS_WO0_T = 24 * MiB, WS_WQKV_T = 32 * MiB, WS_WO1_T = 56 * MiB;
constexpr size_t WS_WGU_T = 64 * MiB;
constexpr size_t WS_WD_T = 416 * MiB;
constexpr size_t WS_HB = 592 * MiB;
constexpr size_t WS_X1 = 657 * MiB;
constexpr size_t WS_R = 787 * MiB;
constexpr size_t WS_AB = WS_R, WS_QN = WS_R + 41 * MiB, WS_KVN = WS_R + 58 * MiB, WS_QRAW = WS_R + 75 * MiB, WS_KVRAW = WS_R + 173 * MiB, WS_KPE = WS_R + 303 * MiB, WS_OB = WS_R + 336 * MiB;
constexpr size_t WS_QKV1 = WS_R;
constexpr size_t WS_XS = WS_R, WS_HID = WS_R + 144 * MiB, WS_YB = WS_R + 243 * MiB;
constexpr size_t WS_END = WS_R + 401 * MiB;
static_assert((size_t)NTOK * WIN_NP * 2 <= 41 * MiB && (size_t)NTOK * 512 * 2 <= 17 * MiB && (size_t)NTOK * 3072 * 2 <= 98 * MiB && (size_t)NTOK * 4096 * 2 <= 130 * MiB && (size_t)NTOK * 1024 * 2 <= 33 * MiB && (size_t)NTOK * 2048 * 2 <= 65 * MiB, "region A");
static_assert((size_t)NE * EROWS * 2048 * 2 <= 144 * MiB && (size_t)NE * EROWS * FF * 2 <= 99 * MiB && (size_t)NTOK * 6144 * 2 <= 195 * MiB, "region B");
constexpr size_t WGU_L = (size_t)NE * 2816 * 2048, WD_L = (size_t)NE * 2048 * FF;

constexpr int CW_BAR = 4096;
constexpr int CW_WORK = 128;
constexpr int CW_DONE = 256;
constexpr int CW_KMAX = 64;

__device__ __forceinline__ unsigned cvtpk(float lo, float hi) { unsigned r; asm("v_cvt_pk_bf16_f32 %0, %1, %2" : "=v"(r) : "v"(lo), "v"(hi)); return r; }
__device__ __forceinline__ float bflo(unsigned u) { return __uint_as_float(u << 16); }
__device__ __forceinline__ float bfhi(unsigned u) { return __uint_as_float(u & 0xffff0000u); }
__device__ __forceinline__ float wave_sum(float v) {
#pragma unroll
    for (int o = 1; o < 64; o <<= 1) v += __shfl_xor(v, o);
    return v;
}
__device__ __forceinline__ int wave_sum_i(int v) {
#pragma unroll
    for (int o = 1; o < 64; o <<= 1) v += __shfl_xor(v, o);
    return v;
}
__device__ __forceinline__ int ltid() { int t = threadIdx.x; asm volatile("" : "+v"(t)); return t; }
namespace pg8 {
#define PG8_LAS __attribute__((address_space(3)))
typedef unsigned short bf16_t;
typedef short bf16x8 __attribute__((ext_vector_type(8)));
typedef float f32x4 __attribute__((ext_vector_type(4)));
typedef unsigned u32x4 __attribute__((ext_vector_type(4)));
constexpr int BM = 256, BK = 64, HALF = 128, HTB = HALF * BK * 2  , STAGE_BYTES = 8 * HTB, NXCD = 8, WGM = 8;

__host__ __device__ __forceinline__ int lds_byte(int r, int c) { const int st = (r >> 4) * 2 + (c >> 5), rr = r & 15, cc = c & 31, ob = rr * 64 + cc * 2; return st * 1024 + (ob ^ (((ob >> 9) & 1) << 5)); }
__host__ __device__ __forceinline__ void stage_rc(int b, int& R, int& C) { const int st = b / 1024, sb = b % 1024, swz = sb ^ (((sb >> 9) & 1) << 5); R = (st >> 1) * 16 + swz / 64; C = (st & 1) * 32 + (swz % 64) / 2; }
__host__ __device__ __forceinline__ int perm32(int rho) { const int n = rho >> 4, i = rho & 15; return 8 * (i >> 2) + 4 * n + (i & 3); }

struct Unit { int pm, pn; };
struct Gemm { const bf16_t* A; const bf16_t* Bt; int M, N, K; int lda = 0; };

struct StaticOrder {
    int nM, nN, nwg, G, c;
    __host__ __device__ void init(int M, int N, int G_, int c_) { nM = M / BM; nN = N / BM; nwg = nM * nN; G = G_; c = c_; }
    __host__ __device__ bool next(int i, Unit& u) const {
        const long L = (long)i * G + c; if (L >= nwg) return false;
        int wgid = (int)L; { const int q = nwg / NXCD, r = nwg % NXCD, xcd = wgid % NXCD, off = wgid / NXCD; wgid = (xcd < r ? xcd * (q + 1) : r * (q + 1) + (xcd - r) * q) + off; }
        const int nig = WGM * nN, gid = wgid / nig, fm = gid * WGM, gsz = (nM - fm) < WGM ? (nM - fm) : WGM;
        u.pm = fm + ((wgid % nig) % gsz); u.pn = (wgid % nig) / gsz; return true;
    }
    __device__ __forceinline__ void a_ready(const Unit&) const {}
    __device__ __forceinline__ void done(const Unit&) const {}
};

__device__ __forceinline__ unsigned cvt_pk_bf16(float lo, float hi) { unsigned r; asm volatile("v_cvt_pk_bf16_f32 %0, %1, %2" : "=v"(r) : "v"(lo), "v"(hi)); return r; }
typedef float f32x2 __attribute__((ext_vector_type(2)));
template <class Epi, class Sched, bool ALIGN_EPI = false, bool SP2 = false>
__device__ __forceinline__ void gemm_phase(PG8_LAS unsigned char* lds, const Gemm g, const Sched& S, const Epi& E) {
    const int tid = ltid(), wid = __builtin_amdgcn_readfirstlane(tid >> 6), lane = tid & 63, wr = wid >> 2, wc = wid & 3, fr = lane & 15, fq = lane >> 4;
    const int K = g.K, nt = K / BK, lda = g.lda ? g.lda : K;
    unsigned voffA[2], voffB[2];
#pragma unroll
    for (int i = 0; i < 2; ++i) { int R, C; stage_rc(tid * 16 + i * 8192, R, C); const int Rb = Epi::PERM ? ((R & ~31) + perm32(R & 31)) : R;
        voffA[i] = (unsigned)(R * lda + C) * 2u; voffB[i] = (unsigned)(Rb * K + C) * 2u; }
    const size_t kstep = (size_t)(BK * 2);
    const size_t hstep = (size_t)HALF * K * 2;
    const size_t tstep = 2 * hstep;
    const size_t hstepA = (size_t)HALF * lda * 2, tstepA = 2 * hstepA;
    const unsigned ldsw = (unsigned)wid * 1024u;
    const int aoff = lds_byte(wr * 64 + fr, fq * 8), boff = lds_byte(wc * 32 + fr, fq * 8);
#define PG8_SA(b, h) (((b) * 2 + (h)) * HTB)
#define PG8_SB(b, h) ((4 + (b) * 2 + (h)) * HTB)
#define PG8_STAGE(bufoff, gbase, voff) do { _Pragma("unroll") for (int _i = 0; _i < 2; ++_i) \
        __builtin_amdgcn_global_load_lds((const unsigned*)((const char*)(gbase) + (voff)[_i]), (PG8_LAS unsigned*)(lds + (bufoff) + ldsw + _i * 8192), 16, 0, 0); } while (0)
#define PG8_LDA(dst, b, h) do { _Pragma("unroll") for (int m = 0; m < 4; ++m) _Pragma("unroll") for (int k = 0; k < 2; ++k) dst[m][k] = *(const PG8_LAS bf16x8*)(lds + PG8_SA(b, h) + aoff + m * 2048 + k * 1024); } while (0)
#define PG8_LDB(dst, b, h) do { _Pragma("unroll") for (int n = 0; n < 2; ++n) _Pragma("unroll") for (int k = 0; k < 2; ++k) dst[n][k] = *(const PG8_LAS bf16x8*)(lds + PG8_SB(b, h) + boff + n * 2048 + k * 1024); } while (0)
#define PG8_MMA(ai, bj, At, Bt) do { __builtin_amdgcn_s_setprio(1); _Pragma("unroll") for (int m = 0; m < 4; ++m) _Pragma("unroll") for (int n = 0; n < 2; ++n) _Pragma("unroll") for (int k = 0; k < 2; ++k) \
        acc[ai][bj][m][n] = __builtin_amdgcn_mfma_f32_16x16x32_bf16(Bt[n][k], At[m][k], acc[ai][bj][m][n], 0, 0, 0); __builtin_amdgcn_s_setprio(0); } while (0)
#define PG8_WAIT_V(n) asm volatile("s_waitcnt vmcnt(" #n ")" ::: "memory")
#define PG8_WAIT_L(n) asm volatile("s_waitcnt lgkmcnt(" #n ")" ::: "memory")
#define PG8_BAR __builtin_amdgcn_s_barrier()
#define PG8_SCHED __builtin_amdgcn_sched_barrier(0)
    Unit cur, nxt; int ui = 0;
    if (!S.next(0, cur)) return;
    f32x4 acc[2][2][4][2];
#pragma unroll
    for (int a = 0; a < 2; ++a)
#pragma unroll
        for (int b = 0; b < 2; ++b)
#pragma unroll
            for (int m = 0; m < 4; ++m)
#pragma unroll
                for (int n = 0; n < 2; ++n) acc[a][b][m][n] = (f32x4){0.f, 0.f, 0.f, 0.f};
    bf16x8 At[4][2], B0[2][2], B1[2][2];
    const char* cA = (const char*)g.A + (size_t)cur.pm * tstepA; const char* cB = (const char*)g.Bt + (size_t)cur.pn * tstep;
    S.a_ready(cur);
    if constexpr (SP2) {
        PG8_STAGE(PG8_SB(0, 0), cB, voffB); PG8_STAGE(PG8_SB(0, 1), cB + hstep, voffB); PG8_STAGE(PG8_SA(0, 0), cA, voffA); PG8_STAGE(PG8_SA(0, 1), cA + hstepA, voffA);
        if (wr == 1) PG8_BAR;
        PG8_WAIT_V(2); PG8_BAR;
        PG8_STAGE(PG8_SB(1, 0), cB + kstep, voffB); PG8_STAGE(PG8_SA(1, 0), cA + kstep, voffA); PG8_STAGE(PG8_SB(1, 1), cB + hstep + kstep, voffB);
        PG8_WAIT_V(6); PG8_BAR;
    } else {
        PG8_STAGE(PG8_SB(0, 0), cB, voffB); PG8_STAGE(PG8_SA(0, 0), cA, voffA); PG8_STAGE(PG8_SB(0, 1), cB + hstep, voffB); PG8_STAGE(PG8_SA(0, 1), cA + hstepA, voffA);
        if (wr == 1) PG8_BAR;
        PG8_WAIT_V(4); PG8_BAR;
        PG8_STAGE(PG8_SB(1, 0), cB + kstep, voffB); PG8_STAGE(PG8_SA(1, 0), cA + kstep, voffA); PG8_STAGE(PG8_SB(1, 1), cB + hstep + kstep, voffB);
        PG8_WAIT_V(6); PG8_BAR;
    }
    for (;;) {
        const bool has_next = S.next(ui + 1, nxt);
        const char* nA = has_next ? (const char*)g.A + (size_t)nxt.pm * tstepA : cA; const char* nB = has_next ? (const char*)g.Bt + (size_t)nxt.pn * tstep : cB;
        for (int t = 0; t < nt; t += 2) {
            const bool last = (t == nt - 2);
            const char* a1 = cA + (size_t)(t + 1) * kstep;
            const char* a2 = last ? nA : cA + (size_t)(t + 2) * kstep; const char* b2 = last ? nB : cB + (size_t)(t + 2) * kstep;
            const char* a3 = a2 + kstep; const char* b3 = b2 + kstep;
            if (last && has_next) S.a_ready(nxt);
            if constexpr (SP2) {
            PG8_LDB(B0, 0, 0); PG8_LDB(B1, 0, 1); PG8_SCHED; PG8_LDA(At, 0, 0); PG8_STAGE(PG8_SA(1, 1), a1 + hstepA, voffA);
            PG8_WAIT_V(8); PG8_WAIT_L(0); PG8_BAR; PG8_MMA(0, 0, At, B0); PG8_MMA(0, 1, At, B1); PG8_BAR; PG8_SCHED;
            PG8_LDA(At, 0, 1); PG8_STAGE(PG8_SB(0, 0), b2, voffB); PG8_STAGE(PG8_SB(0, 1), b2 + hstep, voffB); PG8_STAGE(PG8_SA(0, 0), a2, voffA);
            PG8_WAIT_V(8); PG8_WAIT_L(0); PG8_BAR; PG8_MMA(1, 0, At, B0); PG8_MMA(1, 1, At, B1); PG8_BAR; PG8_SCHED;
            PG8_LDB(B0, 1, 0); PG8_LDB(B1, 1, 1); PG8_SCHED; PG8_LDA(At, 1, 0); PG8_STAGE(PG8_SA(0, 1), a2 + hstepA, voffA);
            PG8_WAIT_V(8); PG8_WAIT_L(0); PG8_BAR; PG8_MMA(0, 0, At, B0); PG8_MMA(0, 1, At, B1); PG8_BAR; PG8_SCHED;
            PG8_LDA(At, 1, 1); PG8_STAGE(PG8_SB(1, 0), b3, voffB); PG8_STAGE(PG8_SB(1, 1), b3 + hstep, voffB); PG8_STAGE(PG8_SA(1, 0), a3, voffA);
            PG8_WAIT_V(8); PG8_WAIT_L(0); PG8_BAR; PG8_MMA(1, 0, At, B0); PG8_MMA(1, 1, At, B1); PG8_BAR; PG8_SCHED;
            } else {
            PG8_LDB(B0, 0, 0); PG8_SCHED; PG8_LDA(At, 0, 0); PG8_STAGE(PG8_SA(1, 1), a1 + hstepA, voffA);
            PG8_WAIT_L(8); PG8_BAR; PG8_WAIT_L(0); PG8_MMA(0, 0, At, B0); PG8_BAR; PG8_SCHED;
            PG8_LDB(B1, 0, 1); PG8_STAGE(PG8_SB(0, 0), b2, voffB);
            PG8_BAR; PG8_WAIT_L(0); PG8_MMA(0, 1, At, B1); PG8_BAR;
            PG8_LDA(At, 0, 1); PG8_STAGE(PG8_SA(0, 0), a2, voffA);
            PG8_BAR; PG8_WAIT_L(0); PG8_MMA(1, 0, At, B0); PG8_BAR; PG8_SCHED;
            PG8_STAGE(PG8_SB(0, 1), b2 + hstep, voffB);
            PG8_WAIT_V(6); PG8_BAR; PG8_MMA(1, 1, At, B1); PG8_BAR;
            PG8_LDB(B0, 1, 0); PG8_SCHED; PG8_LDA(At, 1, 0); PG8_STAGE(PG8_SA(0, 1), a2 + hstepA, voffA);
            PG8_WAIT_L(8); PG8_BAR; PG8_WAIT_L(0); PG8_MMA(0, 0, At, B0); PG8_BAR; PG8_SCHED;
            PG8_LDB(B1, 1, 1); PG8_STAGE(PG8_SB(1, 0), b3, voffB);
            PG8_BAR; PG8_WAIT_L(0); PG8_MMA(0, 1, At, B1); PG8_BAR;
            PG8_LDA(At, 1, 1); PG8_STAGE(PG8_SA(1, 0), a3, voffA);
            PG8_BAR; PG8_WAIT_L(0); PG8_MMA(1, 0, At, B0); PG8_BAR; PG8_SCHED;
            PG8_STAGE(PG8_SB(1, 1), b3 + hstep, voffB);
            PG8_WAIT_V(6); PG8_BAR; PG8_MMA(1, 1, At, B1); PG8_BAR;
            }
        }
        if constexpr (ALIGN_EPI) { if (wr == 0) PG8_BAR; }
        if constexpr (!Epi::AFTER_DRAIN) { E(acc, cur, wr, wc, fr, fq); S.done(cur); }
        if (!has_next) break;
#pragma unroll
        for (int a = 0; a < 2; ++a)
#pragma unroll
            for (int b = 0; b < 2; ++b)
#pragma unroll
                for (int m = 0; m < 4; ++m)
#pragma unroll
                    for (int n = 0; n < 2; ++n) acc[a][b][m][n] = (f32x4){0.f, 0.f, 0.f, 0.f};
        cur = nxt; cA = nA; cB = nB; ++ui;
        if constexpr (ALIGN_EPI) { if (wr == 1) PG8_BAR; }
    }
    PG8_WAIT_V(0);
    if constexpr (!ALIGN_EPI) { if (wr == 0) PG8_BAR; }
    PG8_BAR;
    if constexpr (Epi::AFTER_DRAIN) { E.fused(acc, cur, wr, wc, fr, fq, lds, wid, lane); S.done(cur); }
#undef PG8_SA
#undef PG8_SB
#undef PG8_STAGE
#undef PG8_LDA
#undef PG8_LDB
#undef PG8_MMA
#undef PG8_WAIT_V
#undef PG8_WAIT_L
#undef PG8_BAR
#undef PG8_SCHED
}
template <class Epi, class Sched, bool ALIGN_EPI = false, bool SP2 = false>
__device__ __forceinline__ void gemm_phase_gather(PG8_LAS unsigned char* lds, const Gemm g, const int* __restrict__ rowidx, const Sched& S, const Epi& E) {
    static_assert(SP2, "gather variant: SP2 loop only");
    const int tid = ltid(), wid = __builtin_amdgcn_readfirstlane(tid >> 6), lane = tid & 63, wr = wid >> 2, wc = wid & 3, fr = lane & 15, fq = lane >> 4;
    const int K = g.K, nt = K / BK;
    unsigned voffA[2], voffB[2];
#pragma unroll
    for (int i = 0; i < 2; ++i) { int R, C; stage_rc(tid * 16 + i * 8192, R, C); const int Rb = Epi::PERM ? ((R & ~31) + perm32(R & 31)) : R;
        voffA[i] = (unsigned)(R * K + C) * 2u; voffB[i] = (unsigned)(Rb * K + C) * 2u; }
    const size_t kstep = (size_t)(BK * 2);
    const size_t hstep = (size_t)HALF * K * 2;
    const size_t tstep = 2 * hstep;
    const unsigned ldsw = (unsigned)wid * 1024u;
    const int aoff = lds_byte(wr * 64 + fr, fq * 8), boff = lds_byte(wc * 32 + fr, fq * 8);
#define PG8_SA(b, h) (((b) * 2 + (h)) * HTB)
#define PG8_SB(b, h) ((4 + (b) * 2 + (h)) * HTB)
#define PG8_STAGE(bufoff, gbase, voff) do { _Pragma("unroll") for (int _i = 0; _i < 2; ++_i) \
        __builtin_amdgcn_global_load_lds((const unsigned*)((const char*)(gbase) + (voff)[_i]), (PG8_LAS unsigned*)(lds + (bufoff) + ldsw + _i * 8192), 16, 0, 0); } while (0)
#define PG8_LDA(dst, b, h) do { _Pragma("unroll") for (int m = 0; m < 4; ++m) _Pragma("unroll") for (int k = 0; k < 2; ++k) dst[m][k] = *(const PG8_LAS bf16x8*)(lds + PG8_SA(b, h) + aoff + m * 2048 + k * 1024); } while (0)
#define PG8_LDB(dst, b, h) do { _Pragma("unroll") for (int n = 0; n < 2; ++n) _Pragma("unroll") for (int k = 0; k < 2; ++k) dst[n][k] = *(const PG8_LAS bf16x8*)(lds + PG8_SB(b, h) + boff + n * 2048 + k * 1024); } while (0)
#define PG8_MMA(ai, bj, At, Bt) do { __builtin_amdgcn_s_setprio(1); _Pragma("unroll") for (int m = 0; m < 4; ++m) _Pragma("unroll") for (int n = 0; n < 2; ++n) _Pragma("unroll") for (int k = 0; k < 2; ++k) \
        acc[ai][bj][m][n] = __builtin_amdgcn_mfma_f32_16x16x32_bf16(Bt[n][k], At[m][k], acc[ai][bj][m][n], 0, 0, 0); __builtin_amdgcn_s_setprio(0); } while (0)
#define PG8_WAIT_V(n) asm volatile("s_waitcnt vmcnt(" #n ")" ::: "memory")
#define PG8_WAIT_L(n) asm volatile("s_waitcnt lgkmcnt(" #n ")" ::: "memory")
#define PG8_BAR __builtin_amdgcn_s_barrier()
#define PG8_SCHED __builtin_amdgcn_sched_barrier(0)
    Unit cur, nxt; int ui = 0;
    if (!S.next(0, cur)) return;
    int RA[2], CA[2];
#pragma unroll
    for (int i = 0; i < 2; ++i) stage_rc(tid * 16 + i * 8192, RA[i], CA[i]);
    unsigned vA0[2], vA1[2], nvA0[2], nvA1[2];
#define PG8_GOFF(u, d0, d1) do { _Pragma("unroll") for (int i = 0; i < 2; ++i) { \
        int t0_ = rowidx[(u).pm * BM + RA[i]], t1_ = rowidx[(u).pm * BM + HALF + RA[i]]; t0_ = t0_ < 0 ? 0 : t0_; t1_ = t1_ < 0 ? 0 : t1_; \
        d0[i] = (unsigned)(t0_ * K + CA[i]) * 2u; d1[i] = (unsigned)(t1_ * K + CA[i]) * 2u; } } while (0)
    PG8_GOFF(cur, vA0, vA1);
    f32x4 acc[2][2][4][2];
#pragma unroll
    for (int a = 0; a < 2; ++a)
#pragma unroll
        for (int b = 0; b < 2; ++b)
#pragma unroll
            for (int m = 0; m < 4; ++m)
#pragma unroll
                for (int n = 0; n < 2; ++n) acc[a][b][m][n] = (f32x4){0.f, 0.f, 0.f, 0.f};
    bf16x8 At[4][2], B0[2][2], B1[2][2];
    const char* cA = (const char*)g.A; const char* cB = (const char*)g.Bt + (size_t)cur.pn * tstep;
    S.a_ready(cur);
    if constexpr (SP2) {
        PG8_STAGE(PG8_SB(0, 0), cB, voffB); PG8_STAGE(PG8_SB(0, 1), cB + hstep, voffB); PG8_STAGE(PG8_SA(0, 0), cA, vA0); PG8_STAGE(PG8_SA(0, 1), cA, vA1);
        if (wr == 1) PG8_BAR;
        PG8_WAIT_V(2); PG8_BAR;
        PG8_STAGE(PG8_SB(1, 0), cB + kstep, voffB); PG8_STAGE(PG8_SA(1, 0), cA + kstep, vA0); PG8_STAGE(PG8_SB(1, 1), cB + hstep + kstep, voffB);
        PG8_WAIT_V(6); PG8_BAR;
    } else {
        PG8_STAGE(PG8_SB(0, 0), cB, voffB); PG8_STAGE(PG8_SA(0, 0), cA, voffA); PG8_STAGE(PG8_SB(0, 1), cB + hstep, voffB); PG8_STAGE(PG8_SA(0, 1), cA + hstep, voffA);
        if (wr == 1) PG8_BAR;
        PG8_WAIT_V(4); PG8_BAR;
        PG8_STAGE(PG8_SB(1, 0), cB + kstep, voffB); PG8_STAGE(PG8_SA(1, 0), cA + kstep, voffA); PG8_STAGE(PG8_SB(1, 1), cB + hstep + kstep, voffB);
        PG8_WAIT_V(6); PG8_BAR;
    }
    for (;;) {
        const bool has_next = S.next(ui + 1, nxt);
        if (has_next) PG8_GOFF(nxt, nvA0, nvA1); else { nvA0[0] = vA0[0]; nvA0[1] = vA0[1]; nvA1[0] = vA1[0]; nvA1[1] = vA1[1]; }
        const char* nA = cA; const char* nB = has_next ? (const char*)g.Bt + (size_t)nxt.pn * tstep : cB;
        for (int t = 0; t < nt; t += 2) {
            const bool last = (t == nt - 2);
            const char* a1 = cA + (size_t)(t + 1) * kstep;
            const char* a2 = last ? nA : cA + (size_t)(t + 2) * kstep; const char* b2 = last ? nB : cB + (size_t)(t + 2) * kstep;
            const char* a3 = a2 + kstep; const char* b3 = b2 + kstep;
            unsigned wA0[2], wA1[2]; wA0[0] = last ? nvA0[0] : vA0[0]; wA0[1] = last ? nvA0[1] : vA0[1]; wA1[0] = last ? nvA1[0] : vA1[0]; wA1[1] = last ? nvA1[1] : vA1[1];
            if (last && has_next) S.a_ready(nxt);
            if constexpr (SP2) {
            PG8_LDB(B0, 0, 0); PG8_LDB(B1, 0, 1); PG8_SCHED; PG8_LDA(At, 0, 0); PG8_STAGE(PG8_SA(1, 1), a1, vA1);
            PG8_WAIT_V(8); PG8_WAIT_L(0); PG8_BAR; PG8_MMA(0, 0, At, B0); PG8_MMA(0, 1, At, B1); PG8_BAR; PG8_SCHED;
            PG8_LDA(At, 0, 1); PG8_STAGE(PG8_SB(0, 0), b2, voffB); PG8_STAGE(PG8_SB(0, 1), b2 + hstep, voffB); PG8_STAGE(PG8_SA(0, 0), a2, wA0);
            PG8_WAIT_V(8); PG8_WAIT_L(0); PG8_BAR; PG8_MMA(1, 0, At, B0); PG8_MMA(1, 1, At, B1); PG8_BAR; PG8_SCHED;
            PG8_LDB(B0, 1, 0); PG8_LDB(B1, 1, 1); PG8_SCHED; PG8_LDA(At, 1, 0); PG8_STAGE(PG8_SA(0, 1), a2, wA1);
            PG8_WAIT_V(8); PG8_WAIT_L(0); PG8_BAR; PG8_MMA(0, 0, At, B0); PG8_MMA(0, 1, At, B1); PG8_BAR; PG8_SCHED;
            PG8_LDA(At, 1, 1); PG8_STAGE(PG8_SB(1, 0), b3, voffB); PG8_STAGE(PG8_SB(1, 1), b3 + hstep, voffB); PG8_STAGE(PG8_SA(1, 0), a3, wA0);
            PG8_WAIT_V(8); PG8_WAIT_L(0); PG8_BAR; PG8_MMA(1, 0, At, B0); PG8_MMA(1, 1, At, B1); PG8_BAR; PG8_SCHED;
            } else {
            PG8_LDB(B0, 0, 0); PG8_SCHED; PG8_LDA(At, 0, 0); PG8_STAGE(PG8_SA(1, 1), a1 + hstep, voffA);
            PG8_WAIT_L(8); PG8_BAR; PG8_WAIT_L(0); PG8_MMA(0, 0, At, B0); PG8_BAR; PG8_SCHED;
            PG8_LDB(B1, 0, 1); PG8_STAGE(PG8_SB(0, 0), b2, voffB);
            PG8_BAR; PG8_WAIT_L(0); PG8_MMA(0, 1, At, B1); PG8_BAR;
            PG8_LDA(At, 0, 1); PG8_STAGE(PG8_SA(0, 0), a2, voffA);
            PG8_BAR; PG8_WAIT_L(0); PG8_MMA(1, 0, At, B0); PG8_BAR; PG8_SCHED;
            PG8_STAGE(PG8_SB(0, 1), b2 + hstep, voffB);
            PG8_WAIT_V(6); PG8_BAR; PG8_MMA(1, 1, At, B1); PG8_BAR;
            PG8_LDB(B0, 1, 0); PG8_SCHED; PG8_LDA(At, 1, 0); PG8_STAGE(PG8_SA(0, 1), a2 + hstep, voffA);
            PG8_WAIT_L(8); PG8_BAR; PG8_WAIT_L(0); PG8_MMA(0, 0, At, B0); PG8_BAR; PG8_SCHED;
            PG8_LDB(B1, 1, 1); PG8_STAGE(PG8_SB(1, 0), b3, voffB);
            PG8_BAR; PG8_WAIT_L(0); PG8_MMA(0, 1, At, B1); PG8_BAR;
            PG8_LDA(At, 1, 1); PG8_STAGE(PG8_SA(1, 0), a3, voffA);
            PG8_BAR; PG8_WAIT_L(0); PG8_MMA(1, 0, At, B0); PG8_BAR; PG8_SCHED;
            PG8_STAGE(PG8_SB(1, 1), b3 + hstep, voffB);
            PG8_WAIT_V(6); PG8_BAR; PG8_MMA(1, 1, At, B1); PG8_BAR;
            }
        }
        if constexpr (ALIGN_EPI) { if (wr == 0) PG8_BAR; }
        if constexpr (!Epi::AFTER_DRAIN) { E(acc, cur, wr, wc, fr, fq); S.done(cur); }
        if (!has_next) break;
#pragma unroll
        for (int a = 0; a < 2; ++a)
#pragma unroll
            for (int b = 0; b < 2; ++b)
#pragma unroll
                for (int m = 0; m < 4; ++m)
#pragma unroll
                    for (int n = 0; n < 2; ++n) acc[a][b][m][n] = (f32x4){0.f, 0.f, 0.f, 0.f};
        cur = nxt; cA = nA; cB = nB; ++ui; vA0[0] = nvA0[0]; vA0[1] = nvA0[1]; vA1[0] = nvA1[0]; vA1[1] = nvA1[1];
        if constexpr (ALIGN_EPI) { if (wr == 1) PG8_BAR; }
    }
    PG8_WAIT_V(0);
    if constexpr (!ALIGN_EPI) { if (wr == 0) PG8_BAR; }
    PG8_BAR;
    if constexpr (Epi::AFTER_DRAIN) { E.fused(acc, cur, wr, wc, fr, fq, lds, wid, lane); S.done(cur); }
#undef PG8_GOFF
#undef PG8_SA
#undef PG8_SB
#undef PG8_STAGE
#undef PG8_LDA
#undef PG8_LDB
#undef PG8_MMA
#undef PG8_WAIT_V
#undef PG8_WAIT_L
#undef PG8_BAR
#undef PG8_SCHED
}
}
namespace pg8 {
struct EpiBf16P {
    static constexpr bool PERM = true, AFTER_DRAIN = false;
    bf16_t* O; int ldc;
    __device__ __forceinline__ void operator()(const f32x4 (&acc)[2][2][4][2], const Unit& u, int wr, int wc, int fr, int fq) const {
        const int row0 = u.pm * BM + wr * 64 + fr, col0 = u.pn * BM + wc * 32 + 8 * fq;
#pragma unroll
        for (int ai = 0; ai < 2; ++ai)
#pragma unroll
            for (int m = 0; m < 4; ++m) { bf16_t* rowp = O + (size_t)(row0 + ai * HALF + m * 16) * ldc + col0;
#pragma unroll
                for (int bj = 0; bj < 2; ++bj) { const f32x4 v0 = acc[ai][bj][m][0], v1 = acc[ai][bj][m][1];
                    u32x4 w; w.x = cvt_pk_bf16(v0[0], v0[1]); w.y = cvt_pk_bf16(v0[2], v0[3]); w.z = cvt_pk_bf16(v1[0], v1[1]); w.w = cvt_pk_bf16(v1[2], v1[3]);
                    *(u32x4*)(rowp + bj * HALF) = w; } }
    }
};
struct EpiWin {
    static constexpr bool PERM = true, AFTER_DRAIN = false;
    bf16_t* O; float* ps; float* kper; const float* gk; const float* rtab;
    __device__ __forceinline__ void operator()(const f32x4 (&acc)[2][2][4][2], const Unit& u, int wr, int wc, int fr, int fq) const {
        const int row0 = u.pm * BM + wr * 64 + fr, col0 = u.pn * BM + wc * 32 + 8 * fq;
#pragma unroll
        for (int ai = 0; ai < 2; ++ai)
#pragma unroll
            for (int m = 0; m < 4; ++m) { const int row = row0 + ai * HALF + m * 16; bf16_t* rowp = O + (size_t)row * 1280 + col0;
                float s = 0.f;
#pragma unroll
                for (int bj = 0; bj < 2; ++bj) { const f32x4 v0 = acc[ai][bj][m][0], v1 = acc[ai][bj][m][1];
                    s += ((v0[0] * v0[0] + v0[1] * v0[1]) + (v0[2] * v0[2] + v0[3] * v0[3])) + ((v1[0] * v1[0] + v1[1] * v1[1]) + (v1[2] * v1[2] + v1[3] * v1[3]));
                    u32x4 w; w.x = cvt_pk_bf16(v0[0], v0[1]); w.y = cvt_pk_bf16(v0[2], v0[3]); w.z = cvt_pk_bf16(v1[0], v1[1]); w.w = cvt_pk_bf16(v1[2], v1[3]);
                    *(u32x4*)(rowp + bj * HALF) = w; }
                s += __shfl_xor(s, 16); s += __shfl_xor(s, 32);
                if (fq == 0) ps[(size_t)row * 20 + u.pn * 4 + wc] = s; }
        if (u.pn == 4 && wc < 2) {
            const int D0 = wc * 32 + 8 * fq, jt = 8 * (fq & 1); const bool second = (fq & 2) != 0;
            const f32x4 g0 = *(const f32x4*)(gk + 128 + D0), g1 = *(const f32x4*)(gk + 128 + D0 + 4);
#pragma unroll
            for (int ai = 0; ai < 2; ++ai)
#pragma unroll
                for (int m = 0; m < 4; ++m) { const int row = row0 + ai * HALF + m * 16;
                    f32x4 x0 = acc[ai][0][m][0] * g0, x1 = acc[ai][0][m][1] * g1;
                    f32x4 p0, p1;
#pragma unroll
                    for (int i = 0; i < 4; ++i) { p0[i] = __shfl_xor(x0[i], 32); p1[i] = __shfl_xor(x1[i], 32); }
                    if (row < 16384) { const int pos = wc ? (row & 63) : ((row >> 6) & 255);
                        const f32x4 c0 = *(const f32x4*)(rtab + pos * 16 + jt), c1 = *(const f32x4*)(rtab + pos * 16 + jt + 4), s0 = *(const f32x4*)(rtab + 4096 + pos * 16 + jt), s1 = *(const f32x4*)(rtab + 4096 + pos * 16 + jt + 4);
                        x0 = second ? (x0 * c0 + p0 * s0) : (x0 * c0 - p0 * s0); x1 = second ? (x1 * c1 + p1 * s1) : (x1 * c1 - p1 * s1); }
                    *(f32x4*)(kper + (size_t)row * 64 + D0) = x0; *(f32x4*)(kper + (size_t)row * 64 + D0 + 4) = x1; }
        }
    }
};
struct EpiQkvNorm {
    static constexpr bool PERM = true, AFTER_DRAIN = false;
    bf16_t* O; const float* gq; const float* gk; PG8_LAS float* part;
    __device__ __forceinline__ void operator()(const f32x4 (&acc_in)[2][2][4][2], const Unit& u, int wr, int wc, int fr, int fq) const {
        const int row0 = u.pm * BM + wr * 64 + fr, col0 = u.pn * BM + wc * 32 + 8 * fq;
        f32x4 acc[2][2][4][2];
#pragma unroll
        for (int ai = 0; ai < 2; ++ai)
#pragma unroll
            for (int bj = 0; bj < 2; ++bj)
#pragma unroll
                for (int m = 0; m < 4; ++m) { acc[ai][bj][m][0] = acc_in[ai][bj][m][0]; acc[ai][bj][m][1] = acc_in[ai][bj][m][1]; }
        if (u.pn < 16) {
            const float* gp = (u.pn < 8 ? gq : gk) + wc * 32 + 8 * fq;
            const f32x4 g0 = *(const f32x4*)gp, g1 = *(const f32x4*)(gp + 4);
#pragma unroll
            for (int ai = 0; ai < 2; ++ai)
#pragma unroll
                for (int bj = 0; bj < 2; ++bj)
#pragma unroll
                    for (int m = 0; m < 4; ++m) { const f32x4 v0 = acc[ai][bj][m][0], v1 = acc[ai][bj][m][1];
                        float s = ((v0[0] * v0[0] + v0[1] * v0[1]) + (v0[2] * v0[2] + v0[3] * v0[3])) + ((v1[0] * v1[0] + v1[1] * v1[1]) + (v1[2] * v1[2] + v1[3] * v1[3]));
                        s += __shfl_xor(s, 16); s += __shfl_xor(s, 32);
                        if (fq == 0) part[((ai * HALF + wr * 64 + m * 16 + fr) * 2 + bj) * 4 + wc] = s; }
            asm volatile("s_waitcnt lgkmcnt(0)" ::: "memory"); __builtin_amdgcn_s_barrier();
#pragma unroll
            for (int ai = 0; ai < 2; ++ai)
#pragma unroll
                for (int bj = 0; bj < 2; ++bj)
#pragma unroll
                    for (int m = 0; m < 4; ++m) { const f32x4 p = *(const PG8_LAS f32x4*)(part + ((ai * HALF + wr * 64 + m * 16 + fr) * 2 + bj) * 4);
                        const float rs = __builtin_amdgcn_rsqf(((p[0] + p[1]) + (p[2] + p[3])) * (1.f / 128.f) + 1e-6f);
                        acc[ai][bj][m][0] = acc[ai][bj][m][0] * rs * g0; acc[ai][bj][m][1] = acc[ai][bj][m][1] * rs * g1; }
            asm volatile("s_waitcnt lgkmcnt(0)" ::: "memory"); __builtin_amdgcn_s_barrier();
        }
#pragma unroll
        for (int ai = 0; ai < 2; ++ai)
#pragma unroll
            for (int m = 0; m < 4; ++m) { bf16_t* rowp = O + (size_t)(row0 + ai * HALF + m * 16) * 6144 + col0;
#pragma unroll
                for (int bj = 0; bj < 2; ++bj) { const f32x4 v0 = acc[ai][bj][m][0], v1 = acc[ai][bj][m][1];
                    u32x4 w; w.x = cvt_pk_bf16(v0[0], v0[1]); w.y = cvt_pk_bf16(v0[2], v0[3]); w.z = cvt_pk_bf16(v1[0], v1[1]); w.w = cvt_pk_bf16(v1[2], v1[3]);
                    *(u32x4*)(rowp + bj * HALF) = w; } }
    }
};
struct EpiKv {
    static constexpr bool PERM = true, AFTER_DRAIN = false;
    bf16_t* O; const float* gk; const float* kper; const float* ps; PG8_LAS float* part; unsigned char* vt;
    __device__ __forceinline__ void operator()(const f32x4 (&acc)[2][2][4][2], const Unit& u, int wr, int wc, int fr, int fq) const {
        const int row0 = u.pm * BM + wr * 64 + fr, h = u.pn;
        const f32x4 g0 = *(const f32x4*)(gk + wc * 32 + 8 * fq), g1 = *(const f32x4*)(gk + wc * 32 + 8 * fq + 4);
#pragma unroll
        for (int ai = 0; ai < 2; ++ai)
#pragma unroll
            for (int m = 0; m < 4; ++m) { const f32x4 v0 = acc[ai][0][m][0], v1 = acc[ai][0][m][1];
                float s = ((v0[0] * v0[0] + v0[1] * v0[1]) + (v0[2] * v0[2] + v0[3] * v0[3])) + ((v1[0] * v1[0] + v1[1] * v1[1]) + (v1[2] * v1[2] + v1[3] * v1[3]));
                s += __shfl_xor(s, 16); s += __shfl_xor(s, 32);
                if (fq == 0) part[(ai * HALF + wr * 64 + m * 16 + fr) * 4 + wc] = s; }
        asm volatile("s_waitcnt lgkmcnt(0)" ::: "memory"); __builtin_amdgcn_s_barrier();
        float rkv_[2][4];
#pragma unroll
        for (int ai = 0; ai < 2; ++ai)
#pragma unroll
            for (int m = 0; m < 4; ++m) { const int row = row0 + ai * HALF + m * 16;
                const f32x4 p = *(const PG8_LAS f32x4*)(part + (ai * HALF + wr * 64 + m * 16 + fr) * 4);
                const f32x4 q2 = *(const f32x4*)(ps + (size_t)row * 20 + 8), q3 = *(const f32x4*)(ps + (size_t)row * 20 + 12), q4 = *(const f32x4*)(ps + (size_t)row * 20 + 16);
                const float rkv = __builtin_amdgcn_rsqf((((q2[0] + q2[1]) + (q2[2] + q2[3])) + ((q3[0] + q3[1]) + (q3[2] + q3[3]))) * (1.f / 512.f) + 1e-6f);
                rkv_[ai][m] = rkv;
                const float rs = __builtin_amdgcn_rsqf((((p[0] + p[1]) + (p[2] + p[3])) * (rkv * rkv) + ((q4[0] + q4[1]) + (q4[2] + q4[3]))) * (1.f / 192.f) + 1e-6f) * 0.32267250623034593f;
                const float rsn = rs * rkv;
                unsigned char* slot = (unsigned char*)O + (size_t)row * 8192 + h * 512;
                const f32x4 v0 = acc[ai][0][m][0] * rsn * g0, v1 = acc[ai][0][m][1] * rsn * g1;
                int w0 = 0, w1 = 0;
                w0 = __builtin_amdgcn_cvt_pk_fp8_f32(v0[0], v0[1], w0, false); w0 = __builtin_amdgcn_cvt_pk_fp8_f32(v0[2], v0[3], w0, true);
                w1 = __builtin_amdgcn_cvt_pk_fp8_f32(v1[0], v1[1], w1, false); w1 = __builtin_amdgcn_cvt_pk_fp8_f32(v1[2], v1[3], w1, true);
                u32x2 kw; kw.x = (unsigned)w0; kw.y = (unsigned)w1; *(u32x2*)(slot + wc * 32 + 8 * fq) = kw;
                const f32x4 r4 = *(const f32x4*)(kper + (size_t)row * 64 + wc * 16 + 4 * fq) * rs;
                int w2 = 0; w2 = __builtin_amdgcn_cvt_pk_fp8_f32(r4[0], r4[1], w2, false); w2 = __builtin_amdgcn_cvt_pk_fp8_f32(r4[2], r4[3], w2, true);
                *(unsigned*)(slot + 128 + wc * 16 + 4 * fq) = (unsigned)w2;
            }
        asm volatile("s_waitcnt lgkmcnt(0)" ::: "memory"); __builtin_amdgcn_s_barrier();
        const int mq = fr & 3, aq = fr >> 2;
        const unsigned sel01 = (unsigned)mq | ((unsigned)(4 + mq) << 8);
        const int sd = 8 * (aq & 1) + 4 * (mq >> 1) + 2 * (mq & 1) + (aq >> 1);
#pragma unroll
        for (int ai = 0; ai < 2; ++ai) {
            unsigned char* tile = vt + ((size_t)h * (16640 / 64) + (size_t)(u.pm * 4 + ai * 2 + wr)) * 8192 + (size_t)(wc * 32 + 8 * fq) * 64 + 4 * sd;
#pragma unroll
            for (int j = 0; j < 8; ++j) {
                int L = 0;
                L = __builtin_amdgcn_cvt_pk_fp8_f32(acc[ai][1][0][j >> 2][j & 3] * rkv_[ai][0], acc[ai][1][1][j >> 2][j & 3] * rkv_[ai][1], L, false);
                L = __builtin_amdgcn_cvt_pk_fp8_f32(acc[ai][1][2][j >> 2][j & 3] * rkv_[ai][2], acc[ai][1][3][j >> 2][j & 3] * rkv_[ai][3], L, true);
                const unsigned x0 = (unsigned)__builtin_amdgcn_mov_dpp(L, 0x00, 0xf, 0xf, false), x1 = (unsigned)__builtin_amdgcn_mov_dpp(L, 0x55, 0xf, 0xf, false);
                const unsigned x2 = (unsigned)__builtin_amdgcn_mov_dpp(L, 0xAA, 0xf, 0xf, false), x3 = (unsigned)__builtin_amdgcn_mov_dpp(L, 0xFF, 0xf, 0xf, false);
                const unsigned t01 = __builtin_amdgcn_perm(x1, x0, sel01), t23 = __builtin_amdgcn_perm(x3, x2, sel01);
                *(unsigned*)(tile + j * 64) = __builtin_amdgcn_perm(t23, t01, 0x05040100u);
            }
        }
    }
};
struct EpiRes {
    static constexpr bool PERM = false, AFTER_DRAIN = false;
    float* out; const float* res_lat; const float* res_ctx; const float* g_lat; const float* g_ctx;
    __device__ __forceinline__ void operator()(const f32x4 (&acc)[2][2][4][2], const Unit& u, int wr, int wc, int fr, int fq) const {
        const bool isctx = (u.pm >= 64);
        const int row0 = u.pm * BM + wr * 64 + fr, col0 = u.pn * BM + wc * 32 + 4 * fq;
        const float* res = isctx ? res_ctx : res_lat; const float* gv = isctx ? g_ctx : g_lat; const int rsub = isctx ? 16384 : 0;
        f32x4 g4[2][2];
#pragma unroll
        for (int bj = 0; bj < 2; ++bj)
#pragma unroll
            for (int n = 0; n < 2; ++n) g4[bj][n] = *(const f32x4*)(gv + col0 + bj * HALF + n * 16);
#pragma unroll
        for (int ai = 0; ai < 2; ++ai)
#pragma unroll
            for (int m = 0; m < 4; ++m) { const int row = row0 + ai * HALF + m * 16; float* op = out + (size_t)row * 2048 + col0; const float* rp = res + (size_t)(row - rsub) * 2048 + col0;
#pragma unroll
                for (int bj = 0; bj < 2; ++bj)
#pragma unroll
                    for (int n = 0; n < 2; ++n) { const f32x4 r = *(const f32x4*)(rp + bj * HALF + n * 16); *(f32x4*)(op + bj * HALF + n * 16) = r + g4[bj][n] * acc[ai][bj][m][n]; } }
    }
};
template <bool RESB>
struct EpiResB {
    static constexpr bool PERM = true, AFTER_DRAIN = false;
    bf16_t* out; const void* res_lat; const void* res_ctx; const float* g_lat; const float* g_ctx;
    __device__ __forceinline__ void operator()(const f32x4 (&acc)[2][2][4][2], const Unit& u, int wr, int wc, int fr, int fq) const {
        const bool isctx = (u.pm >= 64);
        const int row0 = u.pm * BM + wr * 64 + fr, col0 = u.pn * BM + wc * 32 + 8 * fq;
        const void* res = isctx ? res_ctx : res_lat; const float* gv = isctx ? g_ctx : g_lat; const int rsub = (!RESB && isctx) ? 16384 : 0;
        f32x4 g4[2][2];
#pragma unroll
        for (int bj = 0; bj < 2; ++bj)
#pragma unroll
            for (int n = 0; n < 2; ++n) g4[bj][n] = *(const f32x4*)(gv + col0 + bj * HALF + n * 4);
#pragma unroll
        for (int ai = 0; ai < 2; ++ai)
#pragma unroll
            for (int m = 0; m < 4; ++m) { const int row = row0 + ai * HALF + m * 16; bf16_t* op = out + (size_t)row * 2048 + col0;
#pragma unroll
                for (int bj = 0; bj < 2; ++bj) { f32x4 r0, r1;
                    if constexpr (RESB) { const u32x4 w = *(const u32x4*)((const bf16_t*)res + (size_t)row * 2048 + col0 + bj * HALF);
                        r0 = (f32x4){__uint_as_float(w.x << 16), __uint_as_float(w.x & 0xffff0000u), __uint_as_float(w.y << 16), __uint_as_float(w.y & 0xffff0000u)};
                        r1 = (f32x4){__uint_as_float(w.z << 16), __uint_as_float(w.z & 0xffff0000u), __uint_as_float(w.w << 16), __uint_as_float(w.w & 0xffff0000u)}; }
                    else { const float* rp = (const float*)res + (size_t)(row - rsub) * 2048 + col0 + bj * HALF; r0 = *(const f32x4*)rp; r1 = *(const f32x4*)(rp + 4); }
                    const f32x4 v0 = r0 + g4[bj][0] * acc[ai][bj][m][0], v1 = r1 + g4[bj][1] * acc[ai][bj][m][1];
                    u32x4 w; w.x = cvt_pk_bf16(v0[0], v0[1]); w.y = cvt_pk_bf16(v0[2], v0[3]); w.z = cvt_pk_bf16(v1[0], v1[1]); w.w = cvt_pk_bf16(v1[2], v1[3]);
                    *(u32x4*)(op + bj * HALF) = w; } }
    }
};
struct EpiSwiGLU {
    static constexpr bool PERM = true, AFTER_DRAIN = false;
    bf16_t* H;
    __device__ __forceinline__ void operator()(const f32x4 (&acc)[2][2][4][2], const Unit& u, int wr, int wc, int fr, int fq) const {
        const int e = u.pm / 9, nl = u.pn - e * 11;
        const int row0 = u.pm * BM + wr * 64 + fr, col0 = nl * 128 + wc * 32 + 8 * fq;
#pragma unroll
        for (int ai = 0; ai < 2; ++ai)
#pragma unroll
            for (int m = 0; m < 4; ++m) { bf16_t* rowp = H + (size_t)(row0 + ai * HALF + m * 16) * 1408 + col0;
                float hv[8];
#pragma unroll
                for (int n = 0; n < 2; ++n)
#pragma unroll
                    for (int i = 0; i < 4; ++i) { const float g = acc[ai][0][m][n][i], up = acc[ai][1][m][n][i];
                        const float s = g * __builtin_amdgcn_rcpf(1.f + __builtin_amdgcn_exp2f(-1.4426950408889634f * g)); hv[n * 4 + i] = s * up; }
                u32x4 w; w.x = cvt_pk_bf16(hv[0], hv[1]); w.y = cvt_pk_bf16(hv[2], hv[3]); w.z = cvt_pk_bf16(hv[4], hv[5]); w.w = cvt_pk_bf16(hv[6], hv[7]);
                *(u32x4*)rowp = w; }
    }
};
struct EpiDown {
    static constexpr bool PERM = true, AFTER_DRAIN = false;
    bf16_t* Y; const float* gate;
    __device__ __forceinline__ void operator()(const f32x4 (&acc)[2][2][4][2], const Unit& u, int wr, int wc, int fr, int fq) const {
        const int e = u.pm / 9, nl = u.pn - e * 8;
        const int row0 = u.pm * BM + wr * 64 + fr, col0 = nl * BM + wc * 32 + 8 * fq;
#pragma unroll
        for (int ai = 0; ai < 2; ++ai)
#pragma unroll
            for (int m = 0; m < 4; ++m) { const int row = row0 + ai * HALF + m * 16; const float gt = gate[row]; bf16_t* rowp = Y + (size_t)row * 2048 + col0;
#pragma unroll
                for (int bj = 0; bj < 2; ++bj) { const f32x4 v0 = acc[ai][bj][m][0] * gt, v1 = acc[ai][bj][m][1] * gt;
                    u32x4 w; w.x = cvt_pk_bf16(v0[0], v0[1]); w.y = cvt_pk_bf16(v0[2], v0[3]); w.z = cvt_pk_bf16(v1[0], v1[1]); w.w = cvt_pk_bf16(v1[2], v1[3]);
                    *(u32x4*)(rowp + bj * HALF) = w; } }
    }
};
struct GroupedOrder {
    int tm, tn, total, G, c;
    __device__ void init(int tm_, int tn_, int G_, int c_) { tm = tm_; tn = tn_; total = NE_ * tm_ * tn_; G = G_; c = c_; }
    static constexpr int NE_ = 16;
    __device__ bool next(int i, Unit& u) const {
        int L = i * G + c; if (L >= total) return false;
        if ((total & 7) == 0) L = (L & 7) * (total >> 3) + (L >> 3);
        const int per = tm * tn, e = L / per, r = L - e * per, pml = r / tn, pnl = r - pml * tn;
        u.pm = e * 9 + pml; u.pn = e * tn + pnl; return true;
    }
    __device__ __forceinline__ void a_ready(const Unit&) const {}
    __device__ __forceinline__ void done(const Unit&) const {}
};
}
namespace att {
constexpr int NW = 8, QBLK = 32, KVBLK = 64;
constexpr int SHM_V = 16384, SHM_KN = 16384, SHM_KP = 8192;
constexpr int OFF_V = 0, OFF_KN = 32768, OFF_KP = 65536, OFF_WS = 81920, OFF_BIAS = 83968;
constexpr int ATT_LDS = OFF_BIAS + 4096;
constexpr float THR = 8.f;
#define KSWZ(row, colB) ((row) * 256 + ((colB) ^ (((row) & 15) << 4)))
#define KPSWZ(row, colB) ((row) * 128 + ((colB) ^ ((((row) >> 1) & 7) << 4)))
#define SBAR() __builtin_amdgcn_sched_barrier(0)
__device__ __forceinline__ int crow(int r, int hi) { return (r & 3) + 8 * (r >> 2) + 4 * hi; }
__device__ __forceinline__ unsigned cvtpk_v(float lo, float hi) { unsigned r; asm volatile("v_cvt_pk_bf16_f32 %0, %1, %2" : "=v"(r) : "v"(lo), "v"(hi)); return r; }

template <int DUMMY = 0>
__device__ __forceinline__ void partialSM(f32x16& p0, f32x16& p1, float& m_reg, float& mn, float& alpha, const float C, const float thr_raw) {
    float pmax = p0[0];
#pragma unroll
    for (int r = 1; r < 16; ++r) pmax = fmaxf(pmax, p0[r]);
#pragma unroll
    for (int r = 0; r < 16; ++r) pmax = fmaxf(pmax, p1[r]);
    { auto rr = __builtin_amdgcn_permlane32_swap(__float_as_uint(pmax), __float_as_uint(pmax), false, false);
      pmax = fmaxf(__uint_as_float(rr[0]), __uint_as_float(rr[1])); }
    if (__builtin_expect(__all(pmax - m_reg <= thr_raw), 1)) { mn = m_reg; alpha = 1.f; }
    else { mn = fmaxf(m_reg, pmax); alpha = __builtin_amdgcn_exp2f((m_reg - mn) * C); m_reg = mn; }
    const float mnC = -mn * C;
#pragma unroll
    for (int r = 0; r < 16; ++r) p0[r] = fmaf(p0[r], C, mnC);
#pragma unroll
    for (int r = 0; r < 16; ++r) p1[r] = fmaf(p1[r], C, mnC);
#pragma unroll
    for (int r = 0; r < 16; ++r) p0[r] = __builtin_amdgcn_exp2f(p0[r]);
}
__device__ __forceinline__ void sm_static(f32x16& p0, f32x16& p1, const float C, const float negm) {
#pragma unroll
    for (int r = 0; r < 16; ++r) p0[r] = fmaf(p0[r], C, negm);
#pragma unroll
    for (int r = 0; r < 16; ++r) p1[r] = fmaf(p1[r], C, negm);
#pragma unroll
    for (int r = 0; r < 16; ++r) p0[r] = __builtin_amdgcn_exp2f(p0[r]);
}
__device__ __forceinline__ void partialSM_na(f32x16& p0, f32x16& p1, float& m_reg, float& mn, float& alpha, const float C, int kr, int qrow, int rs, int lb, int lm, int lb2, const LAS float* btab) {
    const bool isctx = (kr == -1), rowok = (kr >= rs) && (kr < rs + 8);
    const int vm0 = isctx ? -1 : (rowok ? lm : 0), vm1 = isctx ? -1 : (rowok ? lb2 : 0);
    const LAS float* brow = (isctx || !rowok) ? (btab + 600) : (btab + (kr - qrow + 7) * 31 + lb);
    constexpr unsigned NEGB = 0xff61b1e6u;
#define NA_GRP(P, VM, R0, KOFF) do { _Pragma("unroll") for (int r = R0; r < R0 + 8; ++r) { const int kc0 = (r & 3) + 8 * (r >> 2); \
        const unsigned v_ = (unsigned)__builtin_amdgcn_sbfe(VM, kc0, 1);     \
        unsigned bm_; asm("v_bfi_b32 %0, %1, %2, %3" : "=v"(bm_) : "v"(v_), "v"(brow[kc0 + KOFF]), "v"(NEGB));       \
        P[r] = fmaf(P[r], C, __uint_as_float(bm_)); } SBAR(); } while (0)
    NA_GRP(p0, vm0, 0, 0); NA_GRP(p0, vm0, 8, 0); NA_GRP(p1, vm1, 0, 32); NA_GRP(p1, vm1, 8, 32);
#undef NA_GRP
    float pmax = p0[0];
#pragma unroll
    for (int r = 1; r < 16; ++r) pmax = fmaxf(pmax, p0[r]);
#pragma unroll
    for (int r = 0; r < 16; ++r) pmax = fmaxf(pmax, p1[r]);
    { auto rr = __builtin_amdgcn_permlane32_swap(__float_as_uint(pmax), __float_as_uint(pmax), false, false);
      pmax = fmaxf(__uint_as_float(rr[0]), __uint_as_float(rr[1])); }
    if (__builtin_expect(__all(pmax - m_reg <= THR * LOG2E), 1)) { mn = m_reg; alpha = 1.f; }
    else { mn = fmaxf(m_reg, pmax); alpha = __builtin_amdgcn_exp2f(m_reg - mn); m_reg = mn; }
    p0 = p0 - mn; p1 = p1 - mn;
#pragma unroll
    for (int r = 0; r < 16; ++r) p0[r] = __builtin_amdgcn_exp2f(p0[r]);
}
__device__ __forceinline__ void finishSM(f32x16& p0, f32x16& p1, float alpha, float& l_reg, bf16x8& pa0, bf16x8& pa1, bf16x8& pa2, bf16x8& pa3) {
#pragma unroll
    for (int r = 0; r < 16; ++r) p1[r] = __builtin_amdgcn_exp2f(p1[r]);
    f32x2 ps2 = {0.f, 0.f};
#pragma unroll
    for (int r = 0; r < 16; r += 2) { ps2 += (f32x2){p0[r], p0[r + 1]}; ps2 += (f32x2){p1[r], p1[r + 1]}; }
    float ps = ps2.x + ps2.y;
    { auto rr = __builtin_amdgcn_permlane32_swap(__float_as_uint(ps), __float_as_uint(ps), false, false);
      ps = __uint_as_float(rr[0]) + __uint_as_float(rr[1]); }
    l_reg = l_reg * alpha + ps;
#define PK4(P, BASE, OUT) do { unsigned a0 = cvtpk_v(P[BASE + 0], P[BASE + 1]), a1 = cvtpk_v(P[BASE + 2], P[BASE + 3]);   \
    unsigned b0 = cvtpk_v(P[BASE + 4], P[BASE + 5]), b1 = cvtpk_v(P[BASE + 6], P[BASE + 7]);                              \
    auto r0 = __builtin_amdgcn_permlane32_swap(a0, b0, false, false); auto r1 = __builtin_amdgcn_permlane32_swap(a1, b1, false, false); \
    u32x4 w = {r0[0], r1[0], r0[1], r1[1]}; OUT = __builtin_bit_cast(bf16x8, w); } while (0)
    PK4(p0, 0, pa0); PK4(p0, 8, pa1); PK4(p1, 0, pa2); PK4(p1, 8, pa3);
#undef PK4
}
#ifndef ATT_PRIO
#define ATT_PRIO 0
#endif
template <int NPE>
__device__ __forceinline__ void qkt(f32x16& p0, f32x16& p1, const LAS char* Kn, const LAS char* Kp, const bf16x8* qr, int r32, int hi) {
    p0 = f32x16{}; p1 = f32x16{};
#if ATT_PRIO
    __builtin_amdgcn_s_setprio(1);
#endif
#pragma unroll
    for (int d0 = 0; d0 < 8; ++d0) { const int cb = (d0 * 16 + hi * 8) * 2;
        const bf16x8 b0 = *(const LAS bf16x8*)(Kn + KSWZ(r32, cb));
        const bf16x8 b1 = *(const LAS bf16x8*)(Kn + KSWZ(32 + r32, cb));
        p0 = __builtin_amdgcn_mfma_f32_32x32x16_bf16(b0, qr[d0], p0, 0, 0, 0);
        p1 = __builtin_amdgcn_mfma_f32_32x32x16_bf16(b1, qr[d0], p1, 0, 0, 0); }
#pragma unroll
    for (int d0 = 0; d0 < NPE; ++d0) { const int cb = (d0 * 16 + hi * 8) * 2;
        const bf16x8 b0 = *(const LAS bf16x8*)(Kp + KPSWZ(r32, cb));
        const bf16x8 b1 = *(const LAS bf16x8*)(Kp + KPSWZ(32 + r32, cb));
        p0 = __builtin_amdgcn_mfma_f32_32x32x16_bf16(b0, qr[8 + d0], p0, 0, 0, 0);
        p1 = __builtin_amdgcn_mfma_f32_32x32x16_bf16(b1, qr[8 + d0], p1, 0, 0, 0); }
#if ATT_PRIO
    __builtin_amdgcn_s_setprio(0);
#endif
}
__device__ __forceinline__ int v_st(int k, int c) { const int kk = (k & ~0xC) | ((k & 4) << 1) | ((k & 8) >> 1); return ((kk >> 3) * 4 + (c >> 5)) * 512 + ((kk & 7) * 32 + (c & 31)) * 2; }
__device__ __forceinline__ int v_rd_base(int lane) { return ((lane & 3) << 3) | (((lane >> 2) & 3) << 6) | (((lane >> 4) & 1) << 5) | (((lane >> 5) & 1) << 8); }
constexpr int v_rd_off(int d0, int ks, int half) { return d0 * 512 + ks * 4096 + half * 2048; }
typedef short v4i16_t __attribute__((ext_vector_type(4)));
#ifndef PV_ASM
#define PV_ASM 0
#endif
#if PV_ASM
template <int OFF> __device__ __forceinline__ s16x4 tr_read(int vb) {
    s16x4 r; asm volatile("ds_read_b64_tr_b16 %0, %1 offset:%2" : "=&v"(r) : "v"(vb), "i"(OFF) : "memory"); return r;
}
#else
template <int OFF> __device__ __forceinline__ s16x4 tr_read(int vb) {
    return __builtin_bit_cast(s16x4, __builtin_amdgcn_ds_read_tr16_b64_v4i16((LAS v4i16_t*)(unsigned)(vb + OFF)));
}
#endif
template <int D0> __device__ __forceinline__ void pv_one(f32x16& od, int vb, bf16x8 pa0, bf16x8 pa1, bf16x8 pa2, bf16x8 pa3) {
    const s16x4 l0 = tr_read<v_rd_off(D0, 0, 0)>(vb), h0 = tr_read<v_rd_off(D0, 0, 1)>(vb), l1 = tr_read<v_rd_off(D0, 1, 0)>(vb), h1 = tr_read<v_rd_off(D0, 1, 1)>(vb);
    const s16x4 l2 = tr_read<v_rd_off(D0, 2, 0)>(vb), h2 = tr_read<v_rd_off(D0, 2, 1)>(vb), l3 = tr_read<v_rd_off(D0, 3, 0)>(vb), h3 = tr_read<v_rd_off(D0, 3, 1)>(vb);
#if PV_ASM
    asm volatile("s_waitcnt lgkmcnt(0)" ::: "memory"); SBAR();
#endif
#define PK(L, H) (bf16x8){L[0], L[1], L[2], L[3], H[0], H[1], H[2], H[3]}
#if ATT_PRIO
    __builtin_amdgcn_s_setprio(1);
#endif
    od = __builtin_amdgcn_mfma_f32_32x32x16_bf16(pa0, PK(l0, h0), od, 0, 0, 0);
    od = __builtin_amdgcn_mfma_f32_32x32x16_bf16(pa1, PK(l1, h1), od, 0, 0, 0);
    od = __builtin_amdgcn_mfma_f32_32x32x16_bf16(pa2, PK(l2, h2), od, 0, 0, 0);
    od = __builtin_amdgcn_mfma_f32_32x32x16_bf16(pa3, PK(l3, h3), od, 0, 0, 0);
#if ATT_PRIO
    __builtin_amdgcn_s_setprio(0);
#endif
#undef PK
}
__device__ __forceinline__ void pv_d0(f32x16* o, int vb, bf16x8 pa0, bf16x8 pa1, bf16x8 pa2, bf16x8 pa3) {
    pv_one<0>(o[0], vb, pa0, pa1, pa2, pa3); pv_one<1>(o[1], vb, pa0, pa1, pa2, pa3); pv_one<2>(o[2], vb, pa0, pa1, pa2, pa3); pv_one<3>(o[3], vb, pa0, pa1, pa2, pa3);
}

#define RESC(a) do { if (__any((a) < 1.f)) { if (hi == 0) al_l[r32] = (a); asm volatile("s_waitcnt lgkmcnt(0)" ::: "memory"); \
    _Pragma("unroll") for (int d = 0; d < 4; ++d) _Pragma("unroll") for (int r = 0; r < 16; ++r) o[d][r] *= al_l[crow(r, hi)]; } } while (0)

typedef int v8i __attribute__((ext_vector_type(8)));
constexpr int KPITCH = 208, VPITCH = 80, MSLOT = 23552, M_KN = 0, M_VT = 13312, M_WS = 122880;
static_assert(64 * KPITCH == M_VT && M_VT + 128 * VPITCH == MSLOT && 5 * MSLOT <= M_WS, "MLA slot layout");
__device__ __forceinline__ void glds16(const void* gsrc, unsigned lds_dst) { unsigned keep;
    asm volatile("s_mov_b32 %0, m0\n\ts_mov_b32 m0, %2\n\ts_nop 0\n\tglobal_load_lds_dwordx4 %1, off\n\ts_mov_b32 m0, %0" : "=&s"(keep) : "v"(gsrc), "s"(lds_dst) : "memory"); }
__device__ __forceinline__ void glds16s(const void* sbase, unsigned voff, unsigned lds_dst) { unsigned keep;
    asm volatile("s_mov_b32 %0, m0\n\ts_mov_b32 m0, %3\n\ts_nop 0\n\tglobal_load_lds_dwordx4 %1, %2\n\ts_mov_b32 m0, %0" : "=&s"(keep) : "v"(voff), "s"(sbase), "s"(lds_dst) : "memory"); }
#define WAIT_BAR0() asm volatile("s_waitcnt vmcnt(0) lgkmcnt(0)\n\ts_barrier" ::: "memory")
__device__ __forceinline__ void qkt8(f32x16& p0, f32x16& p1, const f32x16& bias, const LAS char* Kl, const v8i* q8) {
#pragma unroll
    for (int ks = 0; ks < 3; ++ks) {
        const u32x4 a0 = *(const LAS u32x4*)(Kl + 64 * ks), a1 = *(const LAS u32x4*)(Kl + 64 * ks + 16);
        const u32x4 b0 = *(const LAS u32x4*)(Kl + 32 * KPITCH + 64 * ks), b1 = *(const LAS u32x4*)(Kl + 32 * KPITCH + 64 * ks + 16);
        const v8i ka = {(int)a0.x, (int)a0.y, (int)a0.z, (int)a0.w, (int)a1.x, (int)a1.y, (int)a1.z, (int)a1.w};
        const v8i kb = {(int)b0.x, (int)b0.y, (int)b0.z, (int)b0.w, (int)b1.x, (int)b1.y, (int)b1.z, (int)b1.w};
        p0 = __builtin_amdgcn_mfma_scale_f32_32x32x64_f8f6f4(ka, q8[ks], ks ? p0 : bias, 0, 0, 0, 0, 0, 0);
        p1 = __builtin_amdgcn_mfma_scale_f32_32x32x64_f8f6f4(kb, q8[ks], ks ? p1 : bias, 0, 0, 0, 0, 0, 0); }
}
__device__ __forceinline__ float vmax2(float a, float b) { float d; asm("v_max_f32 %0, %1, %2" : "=v"(d) : "v"(a), "v"(b)); return d; }
template <bool FIRST>
__device__ __forceinline__ void sm8_a(f32x16& p0, f32x16& p1, f32x16& bias, f32x16* o, LAS float* al_l, int r32, int hi) {
    float xm = __builtin_fmaxf(__builtin_fmaxf(p0[0], p0[1]), p1[0]), xn = __builtin_fmaxf(__builtin_fmaxf(p0[2], p0[3]), p1[1]);
    xm = __builtin_fmaxf(__builtin_fmaxf(xm, p1[2]), p1[3]);
#pragma unroll
    for (int r = 4; r < 16; r += 4) { xm = __builtin_fmaxf(__builtin_fmaxf(xm, p0[r]), p0[r + 1]); xn = __builtin_fmaxf(__builtin_fmaxf(xn, p0[r + 2]), p0[r + 3]);
        xm = __builtin_fmaxf(__builtin_fmaxf(xm, p1[r]), p1[r + 1]); xn = __builtin_fmaxf(__builtin_fmaxf(xn, p1[r + 2]), p1[r + 3]); }
    xm = __builtin_fmaxf(xm, xn);
    { auto rr = __builtin_amdgcn_permlane32_swap(__float_as_uint(xm), __float_as_uint(xm), false, false);
      xm = vmax2(__uint_as_float(rr[0]), __uint_as_float(rr[1])); }
    if (FIRST || !__builtin_expect(__all(xm <= 8.5f), 1)) {
        const float dl = FIRST ? xm - 7.f : fmaxf(xm - 7.f, 0.f);
#pragma unroll
        for (int r = 0; r < 16; ++r) { bias[r] -= dl; p0[r] -= dl; p1[r] -= dl; }
        if (!FIRST) {
            if (hi == 0) al_l[r32] = __builtin_amdgcn_exp2f(-dl);
            asm volatile("s_waitcnt lgkmcnt(0)" ::: "memory");
#pragma unroll
            for (int d = 0; d < 5; ++d)
#pragma unroll
                for (int r = 0; r < 16; ++r) o[d][r] *= al_l[crow(r, hi)];
        }
    }
    asm volatile("" : "+v"(bias));
}
__device__ __forceinline__ void sm8_b(f32x16& p0, f32x16& p1, v8i& pa) {
#pragma unroll
    for (int r = 0; r < 16; ++r) p0[r] = __builtin_amdgcn_exp2f(p0[r]);
#pragma unroll
    for (int r = 0; r < 16; ++r) p1[r] = __builtin_amdgcn_exp2f(p1[r]);
#pragma unroll
    for (int w = 0; w < 4; ++w) { int x = pa[w]; x = __builtin_amdgcn_cvt_pk_fp8_f32(p0[4 * w], p0[4 * w + 1], x, false); x = __builtin_amdgcn_cvt_pk_fp8_f32(p0[4 * w + 2], p0[4 * w + 3], x, true); pa[w] = x; }
#pragma unroll
    for (int w = 0; w < 4; ++w) { int x = pa[4 + w]; x = __builtin_amdgcn_cvt_pk_fp8_f32(p1[4 * w], p1[4 * w + 1], x, false); x = __builtin_amdgcn_cvt_pk_fp8_f32(p1[4 * w + 2], p1[4 * w + 3], x, true); pa[4 + w] = x; }
}
__device__ __forceinline__ void pv8(f32x16* o, const LAS char* Vl, const v8i pa, const v8i ones) {
#pragma unroll
    for (int d0 = 0; d0 < 4; ++d0) { const LAS char* row = Vl + 32 * d0 * VPITCH;
        const u32x4 b0 = *(const LAS u32x4*)(row), b1 = *(const LAS u32x4*)(row + 16);
        const v8i vb = {(int)b0.x, (int)b0.y, (int)b0.z, (int)b0.w, (int)b1.x, (int)b1.y, (int)b1.z, (int)b1.w};
        o[d0] = __builtin_amdgcn_mfma_scale_f32_32x32x64_f8f6f4(pa, vb, o[d0], 0, 0, 0, 0, 0, 0); }
    o[4] = __builtin_amdgcn_mfma_scale_f32_32x32x64_f8f6f4(pa, ones, o[4], 0, 0, 0, 0, 0, 0);
}
#ifndef MLA_ALPHA
#define MLA_ALPHA 1.0f
#endif
__device__ __forceinline__ void mla_unit(const unsigned char* __restrict__ Q8, const unsigned char* __restrict__ K8, const unsigned char* __restrict__ Vt, bf16* __restrict__ Ob, int seq, LAS char* lds,
                                         const float* __restrict__ qgain, const float* __restrict__ rtab, const float* __restrict__ ps, int tok0, bool lat) {
    const int tid = ltid(), lane = tid & 63, r32 = lane & 31, hi = lane >> 5; const int wid = __builtin_amdgcn_readfirstlane(tid >> 6);
    LAS float* wsx = (LAS float*)(lds + M_WS) + wid * 64; LAS float* al_l = wsx + 32;
    unsigned d_off[3]; bool d_isk[3]; unsigned d_dst[3];
#pragma unroll
    for (int i = 0; i < 3; ++i) { int P = 3 * wid + i; if (P > 22) P = 22; d_isk[i] = P < 13; d_dst[i] = P * 1024;
        if (P < 13) { const int g = 64 * P + lane, row = g / 13, ch = g - 13 * row; d_off[i] = row * 8192 + (ch < 12 ? ch : 0) * 16; }
        else { const int g = 64 * (P - 13) + lane, d = g / 5, ch = g - 5 * d; d_off[i] = d * 64 + (ch < 4 ? ch : 0) * 16; } }
#define DMA_TILE(t, slot) do { const unsigned sb_ = (unsigned)((slot) * MSLOT); const unsigned char* kb_ = K8 + (size_t)(t) * 64 * 8192; const unsigned char* vb_ = Vt + (size_t)(t) * 8192; \
    glds16s(d_isk[0] ? kb_ : vb_, d_off[0], sb_ + d_dst[0]); glds16s(d_isk[1] ? kb_ : vb_, d_off[1], sb_ + d_dst[1]); glds16s(d_isk[2] ? kb_ : vb_, d_off[2], sb_ + d_dst[2]); } while (0)
    const int klane = r32 * KPITCH + hi * 32, vlane = M_VT + r32 * VPITCH + hi * 32;
    DMA_TILE(0, 0); DMA_TILE(1, 1);
    f32x16 o[5] = {}; v8i q8[3];
    { const unsigned char* Qw = Q8 + (size_t)(wid * QBLK + r32) * 6144 + hi * 64;
      float f[3][32];
#pragma unroll
      for (int ks = 0; ks < 3; ++ks)
#pragma unroll
          for (int c = 0; c < 4; ++c) { const u32x4 x = *(const u32x4*)(Qw + 128 * ks + 16 * c);
              f[ks][8 * c + 0] = bflo(x.x); f[ks][8 * c + 1] = bfhi(x.x); f[ks][8 * c + 2] = bflo(x.y); f[ks][8 * c + 3] = bfhi(x.y);
              f[ks][8 * c + 4] = bflo(x.z); f[ks][8 * c + 5] = bfhi(x.z); f[ks][8 * c + 6] = bflo(x.w); f[ks][8 * c + 7] = bfhi(x.w); }
      float ss = 0.f;
#pragma unroll
      for (int ks = 0; ks < 3; ++ks)
#pragma unroll
          for (int i = 0; i < 32; ++i) ss += f[ks][i] * f[ks][i];
      { auto rr = __builtin_amdgcn_permlane32_swap(__float_as_uint(ss), __float_as_uint(ss), false, false); ss = __uint_as_float(rr[0]) + __uint_as_float(rr[1]); }
      const float* psr = ps + (size_t)(tok0 + wid * QBLK + r32) * 20; const f32x4 s0 = *(const f32x4*)psr, s1 = *(const f32x4*)(psr + 4);
      const float rq = __builtin_amdgcn_rsqf((((s0[0] + s0[1]) + (s0[2] + s0[3])) + ((s1[0] + s1[1]) + (s1[2] + s1[3]))) * (1.f / 512.f) + EPS);
      const float rs = __builtin_amdgcn_rsqf(ss * (rq * rq) * (1.f / 192.f) + EPS) * rq * 0.32267250623034593f;
#pragma unroll
      for (int ks = 0; ks < 3; ++ks)
#pragma unroll
          for (int c = 0; c < 8; ++c) { const f32x4 g = *(const f32x4*)(qgain + 64 * ks + 32 * hi + 4 * c);
              f[ks][4 * c] *= rs * g.x; f[ks][4 * c + 1] *= rs * g.y; f[ks][4 * c + 2] *= rs * g.z; f[ks][4 * c + 3] *= rs * g.w; }
      if (lat) { const int t = tok0 + wid * QBLK + r32, pos = hi ? (t & 63) : ((t >> 6) & 255);
#pragma unroll
          for (int c = 0; c < 4; ++c) { const f32x4 cs = *(const f32x4*)(rtab + pos * 16 + 4 * c), sn = *(const f32x4*)(rtab + 4096 + pos * 16 + 4 * c);
#pragma unroll
              for (int i = 0; i < 4; ++i) { const float x1 = f[2][4 * c + i], x2 = f[2][16 + 4 * c + i]; f[2][4 * c + i] = x1 * cs[i] - x2 * sn[i]; f[2][16 + 4 * c + i] = x2 * cs[i] + x1 * sn[i]; } } }
#pragma unroll
      for (int ks = 0; ks < 3; ++ks)
#pragma unroll
          for (int w = 0; w < 8; ++w) { int x = 0; x = __builtin_amdgcn_cvt_pk_fp8_f32(f[ks][4 * w], f[ks][4 * w + 1], x, false); x = __builtin_amdgcn_cvt_pk_fp8_f32(f[ks][4 * w + 2], f[ks][4 * w + 3], x, true); q8[ks][w] = x; } }
    f32x16 pA0, pA1, pB0, pB1, bias = {}; v8i pa = {}; const int NT = seq / KVBLK;
    v8i ones = {0x38383838, 0x38383838, 0x38383838, 0x38383838, 0x38383838, 0x38383838, 0x38383838, 0x38383838};
    asm volatile("" : "+v"(ones));
    int sl = 0;
#define SLOT(k) ((sl + (k)) >= 5 ? (sl + (k)) - 5 : (sl + (k)))
#define KS_(k) (lds + SLOT(k) * MSLOT + klane)
#define VS_(k) (lds + SLOT(k) * MSLOT + vlane)
    if (2 < NT) DMA_TILE(2, 2);
    WAIT_BAR0();
    qkt8(pA0, pA1, bias, lds + klane, q8); sm8_a<true>(pA0, pA1, bias, o, al_l, r32, hi);
#define DSTEP(DMA_STMTS) do { \
        qkt8(pB0, pB1, bias, KS_(1), q8); \
        DMA_STMTS                                                  \
        sm8_b(pA0, pA1, pa); \
        pv8(o, VS_(0), pa, ones); sm8_a<false>(pB0, pB1, bias, o, al_l, r32, hi); \
        qkt8(pA0, pA1, bias, KS_(2), q8); sm8_b(pB0, pB1, pa); \
        pv8(o, VS_(1), pa, ones); sm8_a<false>(pA0, pA1, bias, o, al_l, r32, hi); \
        SBAR(); WAIT_BAR0(); \
        sl = SLOT(2); } while (0)
    int j = 1;
    for (; j + 3 < NT; j += 2) DSTEP(DMA_TILE(j + 2, SLOT(3)); DMA_TILE(j + 3, SLOT(4)););
    DSTEP(DMA_TILE(j + 2, SLOT(3)););
#undef DSTEP
    qkt8(pB0, pB1, bias, KS_(1), q8); sm8_b(pA0, pA1, pa);
    pv8(o, VS_(0), pa, ones); sm8_a<false>(pB0, pB1, bias, o, al_l, r32, hi);
    sm8_b(pB0, pB1, pa);
    pv8(o, VS_(1), pa, ones);
#undef SLOT
#undef KS_
#undef VS_
    float rli[16];
#pragma unroll
    for (int r = 0; r < 16; ++r) rli[r] = __builtin_amdgcn_rcpf(o[4][r]);
    bf16* Ow = Ob + (size_t)(wid * QBLK) * 2048;
#pragma unroll
    for (int r = 0; r < 16; ++r) { const int orow = crow(r, hi);
#pragma unroll
        for (int d0 = 0; d0 < 4; ++d0) Ow[(size_t)orow * 2048 + d0 * 32 + r32] = (bf16)(cvtpk_v(o[d0][r] * rli[r] * MLA_ALPHA, 0.f) & 0xffffu); }
    WAIT_BAR0();
#undef DMA_TILE
#undef ROT
}

constexpr int NSLOT_B = 32768, N_V = 0, N_K = 16384, N_BIAS = 124928;
__device__ __forceinline__ void na_unit(const bf16* __restrict__ QKV, int h, int rb, const float* __restrict__ rpb_h, bf16* __restrict__ Ob, LAS char* lds) {
    const int tid = ltid(), lane = tid & 63, r32 = lane & 31, hi = lane >> 5; const int wid = __builtin_amdgcn_readfirstlane(tid >> 6);
    LAS float* wsx = (LAS float*)(lds + M_WS) + wid * 64; LAS float* li_l = wsx; LAS float* al_l = wsx + 32;
    LAS float* btab = (LAS float*)(lds + N_BIAS) + 128;
    constexpr float C = 0.08838834764831845f * LOG2E;
    for (int i = tid; i < 15 * 31; i += 512) btab[i] = rpb_h[i] * LOG2E;
    if (tid < 64) btab[600 + tid] = 0.f;
    const int qrow = rb * 4 + (wid >> 1), qcol = (wid & 1) * 32 + r32;
    const int rs = min(max(qrow - 4, 0), 248), cs = min(max(qcol - 8, 0), 48);
    const int lb = 15 - qcol + 4 * hi;
    const unsigned long long wmask = 0xFFFFull << cs;
    const int lm = (int)(unsigned)(wmask >> (4 * hi)), lb2 = (int)(unsigned)(wmask >> (32 + 4 * hi));
    const int lo = min(max(rb * 4 - 4, 0), 248), hr = min(max(rb * 4 + 3 - 4, 0), 248) + 7, cnt = hr - lo + 1;
    const int NT = (4 + cnt + 1) & ~1;
#define TKEY0(t) ((t) < 4 ? NL + 64 * (t) : 64 * min(lo + (t) - 4, hr))
#define TKR(t) ((t) < 4 ? -1 : ((t) - 4 < cnt ? lo + (t) - 4 : -1000))
    const bf16* Kh = QKV + 2048 + h * 128; const bf16* Vh = QKV + 4096 + h * 128;
    int k_off[2], v_off[2];
#pragma unroll
    for (int i = 0; i < 2; ++i) { const int p = 2 * wid + i;
        { const int row = 4 * p + (lane >> 4), lch = (lane & 15) ^ (row & 15); k_off[i] = row * 6144 + lch * 8; }
        { const int s = 2 * p + (lane >> 5), kk = (s >> 2) * 8 + ((lane & 31) >> 2), key = (kk & ~0xC) | ((kk & 4) << 1) | ((kk & 8) >> 1), col = (s & 3) * 32 + (lane & 3) * 8; v_off[i] = key * 6144 + col; } }
#define DMA_TILE(t, slot) do { const size_t kb_ = (size_t)TKEY0(t) * 6144; const unsigned sb_ = (unsigned)((slot) * NSLOT_B); \
    glds16(Vh + kb_ + v_off[0], sb_ + N_V + (2 * wid) * 1024); glds16(Vh + kb_ + v_off[1], sb_ + N_V + (2 * wid + 1) * 1024); \
    glds16(Kh + kb_ + k_off[0], sb_ + N_K + (2 * wid) * 1024); glds16(Kh + kb_ + k_off[1], sb_ + N_K + (2 * wid + 1) * 1024); } while (0)
    DMA_TILE(0, 0); DMA_TILE(1, 1);
    float m_reg = -1e30f, l_reg = 0; f32x16 o[4] = {}; bf16x8 qr[8];
    const bf16* Qw = QKV + (size_t)(rb * 256 + wid * QBLK + r32) * 6144 + h * 128 + hi * 8;
#pragma unroll
    for (int d0 = 0; d0 < 8; ++d0) qr[d0] = *(const bf16x8*)(Qw + d0 * 16);
    const int vbl = N_V + v_rd_base(lane);
    f32x16 pA0, pA1, pB0, pB1; float mnA, mnB, alA, alB; bf16x8 pa0, pa1, pa2, pa3;
    int s_prev = 0, s_cur = 1, s_next = 2;
#define ROT() do { const int t_ = s_prev; s_prev = s_cur; s_cur = s_next; s_next = t_; } while (0)
    WAIT_BAR0();
    qkt<0>(pA0, pA1, lds + N_K, lds, qr, r32, hi); partialSM_na(pA0, pA1, m_reg, mnA, alA, C, TKR(0), qrow, rs, lb, lm, lb2, btab);
    for (int j = 1; j + 1 < NT; j += 2) {
        DMA_TILE(j + 1, s_next);
        SBAR(); qkt<0>(pB0, pB1, lds + s_cur * NSLOT_B + N_K, lds, qr, r32, hi);
        finishSM(pA0, pA1, alA, l_reg, pa0, pa1, pa2, pa3); SBAR();
        pv_d0(o, vbl + s_prev * NSLOT_B, pa0, pa1, pa2, pa3); partialSM_na(pB0, pB1, m_reg, mnB, alB, C, TKR(j), qrow, rs, lb, lm, lb2, btab);
        RESC(alB);
        WAIT_BAR0(); ROT();
        DMA_TILE(j + 2, s_next);
        SBAR(); qkt<0>(pA0, pA1, lds + s_cur * NSLOT_B + N_K, lds, qr, r32, hi);
        finishSM(pB0, pB1, alB, l_reg, pa0, pa1, pa2, pa3); SBAR();
        pv_d0(o, vbl + s_prev * NSLOT_B, pa0, pa1, pa2, pa3); partialSM_na(pA0, pA1, m_reg, mnA, alA, C, TKR(j + 1), qrow, rs, lb, lm, lb2, btab);
        RESC(alA);
        WAIT_BAR0(); ROT();
    }
    SBAR(); qkt<0>(pB0, pB1, lds + s_cur * NSLOT_B + N_K, lds, qr, r32, hi);
    finishSM(pA0, pA1, alA, l_reg, pa0, pa1, pa2, pa3); SBAR();
    pv_d0(o, vbl + s_prev * NSLOT_B, pa0, pa1, pa2, pa3); partialSM_na(pB0, pB1, m_reg, mnB, alB, C, TKR(NT - 1), qrow, rs, lb, lm, lb2, btab);
    RESC(alB);
    finishSM(pB0, pB1, alB, l_reg, pa0, pa1, pa2, pa3); SBAR();
    pv_d0(o, vbl + s_cur * NSLOT_B, pa0, pa1, pa2, pa3);
    if (hi == 0) li_l[r32] = l_reg; asm volatile("s_waitcnt lgkmcnt(0)" ::: "memory");
    float rli[16];
#pragma unroll
    for (int r = 0; r < 16; ++r) rli[r] = __builtin_amdgcn_rcpf(li_l[crow(r, hi)]);
    bf16* Ow = Ob + (size_t)(rb * 256 + wid * QBLK) * 2048 + h * 128;
#pragma unroll
    for (int r = 0; r < 16; ++r) { const int orow = crow(r, hi);
#pragma unroll
        for (int d0 = 0; d0 < 4; ++d0) Ow[(size_t)orow * 2048 + d0 * 32 + r32] = (bf16)(cvtpk_v(o[d0][r] * rli[r], 0.f) & 0xffffu); }
    WAIT_BAR0();
#undef DMA_TILE
#undef ROT
#undef TKEY0
#undef TKR
}
#undef RESC
}
namespace thin {
__device__ __constant__ float ROPE_INV[16] = {1.0f, 0.5623413251903491f, 0.31622776601683794f, 0.1778279410038923f, 0.1f, 0.05623413251903491f, 0.03162277660168379f, 0.01778279410038923f,
                                              0.01f, 0.005623413251903491f, 0.0031622776601683794f, 0.001778279410038923f, 0.001f, 0.0005623413251903491f, 0.00031622776601683794f, 0.0001778279410038923f};

__device__ __forceinline__ void tr_tile(const float* __restrict__ src, int ld_src, bf16* __restrict__ dst, int ld_dst, LAS float* T, const float* __restrict__ kgain = nullptr) {
    const int tid = ltid(), kr = tid >> 4, c4 = tid & 15;
    f32x4 v[4];
#pragma unroll
    for (int i = 0; i < 4; ++i) v[i] = *(const f32x4*)(src + (size_t)(kr + 32 * i) * ld_src + c4 * 4);
    if (kgain) {
#pragma unroll
        for (int i = 0; i < 4; ++i) v[i] = v[i] * kgain[kr + 32 * i]; }
    __syncthreads();
#pragma unroll
    for (int i = 0; i < 4; ++i) {
#pragma unroll
        for (int j = 0; j < 4; ++j) T[(c4 * 4 + j) * 129 + kr + 32 * i] = v[i][j]; }
    __syncthreads();
    const int n = tid >> 3, kc = (tid & 7) * 16; const LAS float* s = T + n * 129 + kc;
    u32x4 w0, w1;
    w0.x = cvtpk(s[0], s[1]); w0.y = cvtpk(s[2], s[3]); w0.z = cvtpk(s[4], s[5]); w0.w = cvtpk(s[6], s[7]);
    w1.x = cvtpk(s[8], s[9]); w1.y = cvtpk(s[10], s[11]); w1.z = cvtpk(s[12], s[13]); w1.w = cvtpk(s[14], s[15]);
    bf16* d = dst + (size_t)n * ld_dst + kc;
    *(u32x4*)d = w0; *(u32x4*)(d + 8) = w1;
}
__device__ __forceinline__ void tr_job(const float* src, int K, int N, bf16* dst, int t, LAS float* T, const float* kgain = nullptr) {
    const int nkt = K / 128, nt = t / nkt, kt = t - nt * nkt;
    tr_tile(src + (size_t)(kt * 128) * N + nt * 64, N, dst + (size_t)(nt * 64) * K + kt * 128, K, T, kgain ? kgain + kt * 128 : nullptr);
}

struct In {
    const float *x, *c, *ctx, *c_ctx, *ada_w, *ada_b, *norm_mix, *norm_ffn, *mla_w_in, *mla_q_a_gain, *mla_kv_a_gain, *mla_w_qb, *mla_w_kvb, *mla_q_gain, *mla_k_gain, *mla_w_o,
                *na_w_qkv, *na_q_gain, *na_k_gain, *na_rpb, *na_w_o, *router_w, *moe_w_gate, *moe_w_up, *moe_w_down;
};

constexpr int TL_GU = 16 * 2 * 352, TL_D = 16 * 352, TL_QKV = 96 * 16, TL_WO1 = 32 * 16;
constexpr int TL_E0 = TL_GU, TL_E1 = TL_E0 + TL_D, TL_E2 = TL_E1 + TL_QKV, TL_E3 = TL_E2 + TL_WO1, TL_E4 = TL_E3 + TL_GU, TL_ALL = TL_E4 + TL_D;
constexpr int LIM_MOE0 = TL_E1, LIM_NA = TL_E3, LIM_GU1 = TL_E4, LIM_ALL = TL_ALL;
__device__ __forceinline__ void late_tile(const In& in, unsigned char* ws, int t, LAS float* T) {
    int l = 0;
    if (t >= TL_E3) { t -= TL_E3; l = 1; }
    else if (t >= TL_E1) { t -= TL_E1;
        if (t < TL_QKV) tr_job(in.na_w_qkv, 2048, 6144, (bf16*)(ws + WS_WQKV_T), t, T);
        else tr_job(in.na_w_o, 2048, 2048, (bf16*)(ws + WS_WO1_T), t - TL_QKV, T);
        return; }
    if (t < TL_GU) {
        const int e = t / 704, r = t - e * 704, which = r / 352, tt = r - which * 352, nt = tt >> 4, kt = tt & 15, le = l * 16 + e;
        const float* src = (which ? in.moe_w_up : in.moe_w_gate) + (size_t)le * 2048 * FF;
        const int n0 = nt * 64, drow = (n0 >> 7) * 256 + which * 128 + (n0 & 127);
        bf16* dst = (bf16*)(ws + WS_WGU_T) + (size_t)le * 2816 * 2048;
        tr_tile(src + (size_t)(kt * 128) * FF + n0, FF, dst + (size_t)drow * 2048 + kt * 128, 2048, T);
    } else {
        t -= TL_GU; const int e = t / 352, tt = t - e * 352, le = l * 16 + e;
        tr_job(in.moe_w_down + (size_t)le * FF * 2048, FF, 2048, (bf16*)(ws + WS_WD_T) + (size_t)le * 2048 * FF, tt, T); }
}
__device__ __forceinline__ void late_work(const In& in, unsigned char* ws, LAS unsigned char* lds, int G, int phase, int limit) {
    const int tid = ltid();
    LAS float* T = (LAS float*)lds; LAS int* sh = (LAS int*)(lds + 40960);
    unsigned* work = (unsigned*)(ws + WS_CTL) + CW_WORK; unsigned* done = (unsigned*)(ws + WS_CTL) + CW_DONE + 64 * (phase < 0 ? 0 : phase);
    __syncthreads();
    if (phase >= 0 && tid == 0) __hip_atomic_fetch_add(done, 1u, __ATOMIC_RELAXED, __HIP_MEMORY_SCOPE_AGENT);
    for (;;) {
        if (tid == 0) { int t = -1;
            bool go = true;
            if (phase >= 0) go = __hip_atomic_load(done, __ATOMIC_RELAXED, __HIP_MEMORY_SCOPE_AGENT) < (unsigned)G;
            if (go) t = (int)__hip_atomic_fetch_add(work, 1u, __ATOMIC_RELAXED, __HIP_MEMORY_SCOPE_AGENT);
            sh[0] = t; }
        __syncthreads();
        const int t = sh[0];
        if (t < 0 || t >= TL_ALL) break;
        late_tile(in, ws, t, T);
        __syncthreads();
        if (phase < 0 && t >= limit) break;
    }
    __syncthreads();
}

__device__ __forceinline__ void phase_prologue(const In& in, unsigned char* ws, LAS unsigned char* lds, int G, int bid) {
    const int tid = ltid();
    {
        LAS float* sl = (LAS float*)lds; LAS float* sc_ = sl + 2048; LAS float* red = sc_ + 2048;
        for (int i = tid; i < 2048; i += 512) { const float a = in.c[i], b = in.c_ctx[i]; sl[i] = a / (1.f + __expf(-a)); sc_[i] = b / (1.f + __expf(-b)); }
        __syncthreads();
        float* mod = (float*)(ws + WS_MOD);
        for (int item = bid; item < 256; item += G) {
            const int cg = item * 96, l = cg / 12288, n0 = cg - l * 12288;
            if (tid < 384) {
                const int rl = tid / 24, c4 = tid - rl * 24;
                const float* wp = in.ada_w + ((size_t)l * 2048 + rl) * 12288 + n0 + c4 * 4;
                f32x4 al = {0.f, 0.f, 0.f, 0.f}, ac = {0.f, 0.f, 0.f, 0.f};
#pragma unroll 8
                for (int i = 0; i < 128; ++i) { const f32x4 w = *(const f32x4*)(wp + (size_t)(16 * i) * 12288); const float a = sl[rl + 16 * i], b = sc_[rl + 16 * i]; al += w * a; ac += w * b; }
                *(LAS f32x4*)(red + rl * 96 + c4 * 4) = al; *(LAS f32x4*)(red + 1536 + rl * 96 + c4 * 4) = ac;
            }
            __syncthreads();
            if (tid < 192) { const int v = tid / 96, j = tid - v * 96; float s = in.ada_b[l * 12288 + n0 + j];
#pragma unroll
                for (int k = 0; k < 16; ++k) s += red[v * 1536 + k * 96 + j];
                mod[(size_t)(l * 2 + v) * 12288 + n0 + j] = s; }
            __syncthreads();
        }
    }
    if (bid == 0) { float* gt = (float*)(ws + WS_MODP);
        for (int i = tid; i < 4096; i += 512) { const int pos = i >> 4, j = i & 15; float s, c; sincosf((float)pos * ROPE_INV[j], &s, &c); gt[i] = c; gt[4096 + i] = s; } }
    LAS float* T = (LAS float*)lds;
    constexpr int T_WIN = 17 * 16, T_QB = 48 * 4, T_KVB = 64 * 4, T_WO = 32 * 16;
    constexpr int T_ALL = T_WIN + T_QB + T_KVB + T_WO;
    bf16* win_t = (bf16*)(ws + WS_WIN_T);
    for (size_t i = (size_t)bid * 512 + tid; i < (size_t)(WIN_NP - WIN_N) * 2048 / 8; i += (size_t)G * 512) ((u32x4*)(win_t + (size_t)WIN_N * 2048))[i] = (u32x4){0u, 0u, 0u, 0u};
    for (int t0 = bid; t0 < T_ALL; t0 += G) {
        int t = t0;
        if (t < T_WIN) { tr_job(in.mla_w_in, 2048, WIN_N, win_t, t, T); continue; } t -= T_WIN;
        if (t < T_QB) { tr_job(in.mla_w_qb, 512, 3072, (bf16*)(ws + WS_WQB_T), t, T, in.mla_q_a_gain); continue; } t -= T_QB;
        if (t < T_KVB) { tr_job(in.mla_w_kvb, 512, 4096, (bf16*)(ws + WS_WKVB_T), t, T, in.mla_kv_a_gain); continue; } t -= T_KVB;
        tr_job(in.mla_w_o, 2048, 2048, (bf16*)(ws + WS_WO0_T), t, T);
    }
}
__device__ __forceinline__ const float* modv(const unsigned char* ws, int l, int v, int chunk) { return (const float*)(ws + WS_MOD) + (size_t)(l * 2 + v) * 12288 + chunk * 2048; }

__device__ __forceinline__ void norm_mod_row(f32x4 (&v)[8], const float* gain, const float* sh, const float* sc, int lane) {
    float ss = 0.f;
#pragma unroll
    for (int j = 0; j < 8; ++j) ss += (v[j].x * v[j].x + v[j].y * v[j].y) + (v[j].z * v[j].z + v[j].w * v[j].w);
    const float rs = __builtin_amdgcn_rsqf(wave_sum(ss) * (1.f / 2048.f) + EPS);
#pragma unroll
    for (int j = 0; j < 8; ++j) { const int c = 4 * (lane + 64 * j); const f32x4 g = *(const f32x4*)(gain + c), a = *(const f32x4*)(sc + c), b = *(const f32x4*)(sh + c);
        v[j] = v[j] * rs * g * (a + 1.f) + b; }
}
__device__ __forceinline__ void stage_mod_lds(LAS float* ga, LAS float* sb, const float* gain, const float* sh, const float* sc, int tid) {
    *(LAS f32x4*)(ga + 4 * tid) = *(const f32x4*)(gain + 4 * tid) * (*(const f32x4*)(sc + 4 * tid) + 1.f); *(LAS f32x4*)(sb + 4 * tid) = *(const f32x4*)(sh + 4 * tid);
}
__device__ __forceinline__ void norm_mod_row_lds(f32x4 (&v)[8], const LAS float* ga, const LAS float* sb, int lane) {
    float ss = 0.f;
#pragma unroll
    for (int j = 0; j < 8; ++j) ss += (v[j].x * v[j].x + v[j].y * v[j].y) + (v[j].z * v[j].z + v[j].w * v[j].w);
    const float rs = __builtin_amdgcn_rsqf(wave_sum(ss) * (1.f / 2048.f) + EPS);
#pragma unroll
    for (int j = 0; j < 8; ++j) { const int c = 4 * (lane + 64 * j); v[j] = v[j] * rs * *(const LAS f32x4*)(ga + c) + *(const LAS f32x4*)(sb + c); }
}
__device__ __forceinline__ f32x4 bf4(const u32x2 w) { return (f32x4){bflo(w.x), bfhi(w.x), bflo(w.y), bfhi(w.y)}; }
__device__ __forceinline__ void store_row_bf16(bf16* orow, const f32x4 (&v)[8], int lane) {
#pragma unroll
    for (int j = 0; j < 8; ++j) { u32x2 w; w.x = cvtpk(v[j].x, v[j].y); w.y = cvtpk(v[j].z, v[j].w); *(u32x2*)(orow + 4 * (lane + 64 * j)) = w; }
}
__device__ __forceinline__ void phase_norm_in(const In& in, unsigned char* ws, LAS unsigned char* lds, int G, int bid) {
    const int lane = ltid() & 63, gw = bid * 8 + (ltid() >> 6), NGW = G * 8;
    bf16* hb = (bf16*)(ws + WS_HB);
    LAS float* mv = (LAS float*)lds;
    stage_mod_lds(mv, mv + 2048, in.norm_mix, modv(ws, 0, 0, 0), modv(ws, 0, 0, 1), ltid());
    stage_mod_lds(mv + 4096, mv + 6144, in.norm_mix, modv(ws, 0, 1, 0), modv(ws, 0, 1, 1), ltid());
    __syncthreads();
    f32x4 a[8], nx[8];
#define NI_LOAD(dst, rw) do { const float* xr_ = ((rw) >= NL) ? in.ctx + (size_t)((rw) - NL) * 2048 : in.x + (size_t)(rw) * 2048; \
    _Pragma("unroll") for (int j = 0; j < 8; ++j) dst[j] = *(const f32x4*)(xr_ + 4 * (lane + 64 * j)); } while (0)
    if (gw < NTOK) NI_LOAD(a, gw);
    for (int row = gw; row < NTOK; row += NGW) {
        const int v = row >= NL;
        if (row + NGW < NTOK) NI_LOAD(nx, row + NGW);
        norm_mod_row_lds(a, mv + v * 4096, mv + v * 4096 + 2048, lane);
        store_row_bf16(hb + (size_t)row * 2048, a, lane);
#pragma unroll
        for (int j = 0; j < 8; ++j) a[j] = nx[j];
    }
#undef NI_LOAD
    __syncthreads();
}
__device__ __forceinline__ void phase_rownorm_a(const In& in, unsigned char* ws, int G, int bid) {
    const int lane = ltid() & 63, gw = bid * 8 + (ltid() >> 6), NGW = G * 8;
    const bf16* ab = (const bf16*)(ws + WS_AB); bf16* qn = (bf16*)(ws + WS_QN); bf16* kvn = (bf16*)(ws + WS_KVN);
    float gq[8], gk[8];
#pragma unroll
    for (int i = 0; i < 8; ++i) { gq[i] = in.mla_q_a_gain[lane * 8 + i]; gk[i] = in.mla_kv_a_gain[lane * 8 + i]; }
    u32x4 qn_, kn_;
    if (gw < NTOK) { qn_ = *(const u32x4*)(ab + (size_t)gw * WIN_NP + lane * 8); kn_ = *(const u32x4*)(ab + (size_t)gw * WIN_NP + 512 + lane * 8); }
    for (int row = gw; row < NTOK; row += NGW) {
        const u32x4 q = qn_, k = kn_;
        if (row + NGW < NTOK) { qn_ = *(const u32x4*)(ab + (size_t)(row + NGW) * WIN_NP + lane * 8); kn_ = *(const u32x4*)(ab + (size_t)(row + NGW) * WIN_NP + 512 + lane * 8); }
        float qf[8] = {bflo(q.x), bfhi(q.x), bflo(q.y), bfhi(q.y), bflo(q.z), bfhi(q.z), bflo(q.w), bfhi(q.w)};
        float kf[8] = {bflo(k.x), bfhi(k.x), bflo(k.y), bfhi(k.y), bflo(k.z), bfhi(k.z), bflo(k.w), bfhi(k.w)};
        float sq = 0.f, sk = 0.f;
#pragma unroll
        for (int i = 0; i < 8; ++i) { sq += qf[i] * qf[i]; sk += kf[i] * kf[i]; }
        const float rq = __builtin_amdgcn_rsqf(wave_sum(sq) * (1.f / 512.f) + EPS), rk = __builtin_amdgcn_rsqf(wave_sum(sk) * (1.f / 512.f) + EPS);
        u32x4 wq, wk;
        wq.x = cvtpk(qf[0] * rq * gq[0], qf[1] * rq * gq[1]); wq.y = cvtpk(qf[2] * rq * gq[2], qf[3] * rq * gq[3]); wq.z = cvtpk(qf[4] * rq * gq[4], qf[5] * rq * gq[5]); wq.w = cvtpk(qf[6] * rq * gq[6], qf[7] * rq * gq[7]);
        wk.x = cvtpk(kf[0] * rk * gk[0], kf[1] * rk * gk[1]); wk.y = cvtpk(kf[2] * rk * gk[2], kf[3] * rk * gk[3]); wk.z = cvtpk(kf[4] * rk * gk[4], kf[5] * rk * gk[5]); wk.w = cvtpk(kf[6] * rk * gk[6], kf[7] * rk * gk[7]);
        *(u32x4*)(qn + (size_t)row * 512 + lane * 8) = wq; *(u32x4*)(kvn + (size_t)row * 512 + lane * 8) = wk;
    }
}
__device__ __forceinline__ void unpack8(const u32x4 q, float (&f)[8]) { f[0] = bflo(q.x); f[1] = bfhi(q.x); f[2] = bflo(q.y); f[3] = bfhi(q.y); f[4] = bflo(q.z); f[5] = bfhi(q.z); f[6] = bflo(q.w); f[7] = bfhi(q.w); }
__device__ __forceinline__ u32x4 pack8(const float (&f)[8]) { u32x4 w; w.x = cvtpk(f[0], f[1]); w.y = cvtpk(f[2], f[3]); w.z = cvtpk(f[4], f[5]); w.w = cvtpk(f[6], f[7]); return w; }
__device__ __forceinline__ u32x2 pack8_fp8(const float (&f)[8]) { int w0 = 0, w1 = 0;
    w0 = __builtin_amdgcn_cvt_pk_fp8_f32(f[0], f[1], w0, false); w0 = __builtin_amdgcn_cvt_pk_fp8_f32(f[2], f[3], w0, true);
    w1 = __builtin_amdgcn_cvt_pk_fp8_f32(f[4], f[5], w1, false); w1 = __builtin_amdgcn_cvt_pk_fp8_f32(f[6], f[7], w1, true);
    u32x2 r; r.x = (unsigned)w0; r.y = (unsigned)w1; return r; }
__device__ __forceinline__ float sumsq8(const u32x4 q) { float f[8]; unpack8(q, f); float s = 0.f;
#pragma unroll
    for (int i = 0; i < 8; ++i) s += f[i] * f[i];
    return s; }

__device__ __forceinline__ void rope64(float (&pe)[64], const LAS float* ct, const LAS float* st, int row, int col) {
#pragma unroll
    for (int j = 0; j < 16; ++j) { const float c = ct[row * 16 + j], s = st[row * 16 + j]; const float x1 = pe[j], x2 = pe[16 + j]; pe[j] = x1 * c - x2 * s; pe[16 + j] = x2 * c + x1 * s; }
#pragma unroll
    for (int j = 0; j < 16; ++j) { const float c = ct[col * 16 + j], s = st[col * 16 + j]; const float x1 = pe[32 + j], x2 = pe[48 + j]; pe[32 + j] = x1 * c - x2 * s; pe[48 + j] = x2 * c + x1 * s; }
}
__device__ __forceinline__ void phase_headnorm_rope(const In& in, unsigned char* ws, LAS unsigned char* lds, int G, int bid) {
    const int tid = ltid();
    bf16* kvraw = (bf16*)(ws + WS_KVRAW);
    __syncthreads();
    {
        const int lane = tid & 63, wid = tid >> 6, c = lane & 15, q = lane >> 4;
        LAS unsigned* img = (LAS unsigned*)(lds + 36864) + wid * 2048;
        unsigned char* vtb = ws + WS_KPE;
        for (int it = bid * 8 + wid; it < NH * (NTOK / 64); it += G * 8) {
            const int h = it / (NTOK / 64), T = it - h * (NTOK / 64);
            const bf16* vp = kvraw + (size_t)(T * 64) * 4096 + h * 256 + 128 + c * 8;
#pragma unroll
            for (int m = 0; m < 4; ++m) { const int gi = 4 * m + q;
                const int sd = 8 * (gi & 1) + 4 * (gi >> 3) + ((gi & 7) >> 1);
                float f0[8], f1[8], f2[8], f3[8];
                unpack8(*(const u32x4*)(vp + (size_t)(4 * gi) * 4096), f0); unpack8(*(const u32x4*)(vp + (size_t)(4 * gi + 1) * 4096), f1);
                unpack8(*(const u32x4*)(vp + (size_t)(4 * gi + 2) * 4096), f2); unpack8(*(const u32x4*)(vp + (size_t)(4 * gi + 3) * 4096), f3);
#pragma unroll
                for (int i = 0; i < 8; ++i) { int w = 0; w = __builtin_amdgcn_cvt_pk_fp8_f32(f0[i], f1[i], w, false); w = __builtin_amdgcn_cvt_pk_fp8_f32(f2[i], f3[i], w, true);
                    img[(c * 8 + i) * 16 + sd] = (unsigned)w; } }
            asm volatile("s_waitcnt lgkmcnt(0)" ::: "memory");
            u32x4* dst = (u32x4*)(vtb + (size_t)it * 8192);
#pragma unroll
            for (int k = 0; k < 8; ++k) dst[k * 64 + lane] = *(const LAS u32x4*)(img + (k * 64 + lane) * 4);
            asm volatile("s_waitcnt lgkmcnt(0)" ::: "memory");
        }
    }
}
__device__ __forceinline__ void phase_na_headnorm(const In& in, unsigned char* ws, int G, int bid) {
    bf16* qkv = (bf16*)(ws + WS_QKV1);
    const int tid = ltid(), lane = tid & 63, c = lane & 15, gw = bid * 8 + (tid >> 6), NGW = G * 8;
    const f32x4 gq0 = *(const f32x4*)(in.na_q_gain + c * 8), gq1 = *(const f32x4*)(in.na_q_gain + c * 8 + 4), gk0 = *(const f32x4*)(in.na_k_gain + c * 8), gk1 = *(const f32x4*)(in.na_k_gain + c * 8 + 4);
    constexpr int NIT = NTOK * 32 / 4;
    for (int pp = gw; pp < NIT; pp += 4 * NGW) {
        bf16* qp[4]; u32x4 raw[4]; bool isk[4], act[4];
#pragma unroll
        for (int u = 0; u < 4; ++u) { const int pi = pp + u * NGW; act[u] = pi < NIT; const int p = (act[u] ? pi : pp) * 4 + (lane >> 4), t = p >> 5, hh = p & 31; isk[u] = (hh >> 4) != 0;
            qp[u] = qkv + (size_t)t * 6144 + hh * 128 + c * 8; raw[u] = *(const u32x4*)qp[u]; }
#pragma unroll
        for (int u = 0; u < 4; ++u) {
            float f[8]; unpack8(raw[u], f);
            float ss = 0.f;
#pragma unroll
            for (int i = 0; i < 8; ++i) ss += f[i] * f[i];
#pragma unroll
            for (int o = 1; o < 16; o <<= 1) ss += __shfl_xor(ss, o);
            const float rs = __builtin_amdgcn_rsqf(ss * (1.f / 128.f) + EPS);
            const f32x4 g0 = isk[u] ? gk0 : gq0, g1 = isk[u] ? gk1 : gq1;
            f[0] *= rs * g0.x; f[1] *= rs * g0.y; f[2] *= rs * g0.z; f[3] *= rs * g0.w; f[4] *= rs * g1.x; f[5] *= rs * g1.y; f[6] *= rs * g1.z; f[7] *= rs * g1.w;
            if (act[u]) *(u32x4*)qp[u] = pack8(f);
        }
    }
}
__device__ __forceinline__ void phase_router(const In& in, unsigned char* ws, LAS unsigned char* lds, int G, int bid, int l, int nrows) {
    const int tid = ltid(), lane = tid & 63, gw = bid * 8 + (tid >> 6), NGW = G * 8;
    LAS float* rwT = (LAS float*)lds;
    const float* rw = in.router_w + (size_t)l * 2048 * 16;
    for (int i = tid; i < 2048 * 16; i += 512) rwT[(i & 15) * 2048 + (i >> 4)] = rw[i];
    LAS float* mv = (LAS float*)(lds + 131072);
    stage_mod_lds(mv, mv + 2048, in.norm_ffn + l * 2048, modv(ws, l, 0, 3), modv(ws, l, 0, 4), tid);
    __syncthreads();
    const bf16* x1 = (const bf16*)(ws + WS_X1); bf16* hb = (bf16*)(ws + WS_HB); float* aff = (float*)(ws + WS_AFF);
    f32x4 a[8]; u32x2 nx[8], cu[8];
    if (gw < nrows) {
#pragma unroll
        for (int j = 0; j < 8; ++j) cu[j] = *(const u32x2*)(x1 + (size_t)gw * 2048 + 4 * (lane + 64 * j)); }
    for (int row = gw; row < nrows; row += NGW) {
        const int v = row >= NL;
        if (row + NGW < nrows) {
#pragma unroll
            for (int j = 0; j < 8; ++j) nx[j] = *(const u32x2*)(x1 + (size_t)(row + NGW) * 2048 + 4 * (lane + 64 * j)); }
#pragma unroll
        for (int j = 0; j < 8; ++j) a[j] = bf4(cu[j]);
        if (!v) norm_mod_row_lds(a, mv, mv + 2048, lane); else norm_mod_row(a, in.norm_ffn + l * 2048, modv(ws, l, 1, 3), modv(ws, l, 1, 4), lane);
        store_row_bf16(hb + (size_t)row * 2048, a, lane);
        float lg[16];
#pragma unroll
        for (int e = 0; e < 16; ++e) { float s = 0.f;
#pragma unroll
            for (int j = 0; j < 8; ++j) { const f32x4 w = *(const LAS f32x4*)(rwT + e * 2048 + 4 * (lane + 64 * j)); s += (a[j].x * w.x + a[j].y * w.y) + (a[j].z * w.z + a[j].w * w.w); }
            lg[e] = s; __builtin_amdgcn_sched_barrier(0); }
        float v8[8], v4[4], v2[2], v1;
        { const bool up = (lane & 32) != 0;
#pragma unroll
          for (int i = 0; i < 8; ++i) { const float snd = up ? lg[i] : lg[8 + i], kp = up ? lg[8 + i] : lg[i]; v8[i] = kp + __shfl_xor(snd, 32); } }
        { const bool up = (lane & 16) != 0;
#pragma unroll
          for (int i = 0; i < 4; ++i) { const float snd = up ? v8[i] : v8[4 + i], kp = up ? v8[4 + i] : v8[i]; v4[i] = kp + __shfl_xor(snd, 16); } }
        { const bool up = (lane & 8) != 0;
#pragma unroll
          for (int i = 0; i < 2; ++i) { const float snd = up ? v4[i] : v4[2 + i], kp = up ? v4[2 + i] : v4[i]; v2[i] = kp + __shfl_xor(snd, 8); } }
        { const bool up = (lane & 4) != 0; const float snd = up ? v2[0] : v2[1], kp = up ? v2[1] : v2[0]; v1 = kp + __shfl_xor(snd, 4); }
        v1 += __shfl_xor(v1, 2); v1 += __shfl_xor(v1, 1);
        float mx = v1;
#pragma unroll
        for (int o = 4; o < 64; o <<= 1) mx = fmaxf(mx, __shfl_xor(mx, o));
        const float ex = __expf(v1 - mx);
        float den = ex;
#pragma unroll
        for (int o = 4; o < 64; o <<= 1) den += __shfl_xor(den, o);
        if ((lane & 3) == 0) { const int e = ((lane >> 5) & 1) * 8 + ((lane >> 4) & 1) * 4 + ((lane >> 3) & 1) * 2 + ((lane >> 2) & 1); aff[(size_t)e * NTOK + row] = ex / den; }
#pragma unroll
        for (int j = 0; j < 8; ++j) cu[j] = nx[j];
    }
    __syncthreads();
}
__device__ __forceinline__ int block_sum_i(int v, LAS int* red, int tid) {
    v = wave_sum_i(v);
    __syncthreads();
    if ((tid & 63) == 0) red[tid >> 6] = v;
    __syncthreads();
    int s = 0;
#pragma unroll
    for (int w = 0; w < 8; ++w) s += red[w];
    return s;
}
__device__ __forceinline__ void phase_topk(unsigned char* ws, LAS unsigned char* lds, int G, int bid, int nprob) {
    const int tid = ltid(), lane = tid & 63, wid = tid >> 6;
    LAS int* red = (LAS int*)lds; LAS int* scan = red + 16;
    const float* aff = (const float*)(ws + WS_AFF); int* idx = (int*)(ws + WS_IDX); float* gate = (float*)(ws + WS_GATE); int* slot = (int*)(ws + WS_SLOT);
    for (int pb = bid; pb < nprob; pb += G) {
        const int e = pb & 15, isctx = pb >> 4;
        const int n = isctx ? NC : NL, k = isctx ? CAPC : CAPL, tok0 = isctx ? NL : 0, slot0 = isctx ? CAPL : 0;
        const int per = n / 512;
        unsigned key[32];
        const float* ap = aff + (size_t)e * NTOK + tok0;
        if (!isctx) {
#pragma unroll
            for (int j = 0; j < 8; ++j) { const u32x4 q = *(const u32x4*)(ap + tid * 32 + j * 4); key[j * 4] = q.x; key[j * 4 + 1] = q.y; key[j * 4 + 2] = q.z; key[j * 4 + 3] = q.w; }
        } else {
#pragma unroll
            for (int j = 0; j < 32; ++j) key[j] = 0u;
            if (tid < NC) key[0] = __float_as_uint(ap[tid]);
        }
        (void)per;
        unsigned lo = 0u, hi = 0x7f800000u;
        while (hi - lo > 1u) {
            const unsigned mid = lo + ((hi - lo) >> 1);
            int c = 32;
#pragma unroll
            for (int j = 0; j < 32; ++j) c += ((int)key[j] - (int)mid) >> 31;
            c = block_sum_i(c, red, tid);
            if (c >= k) lo = mid; else hi = mid;
        }
        const unsigned T = lo;
        int cg = 32, ce = 32;
#pragma unroll
        for (int j = 0; j < 32; ++j) { cg += ((int)key[j] - (int)(T + 1u)) >> 31; ce += ((int)key[j] - (int)T) >> 31; }
        ce -= cg;
        if (isctx && tid >= NC) { cg = 0; ce = 0; }
        int sg = cg, se = ce;
#pragma unroll
        for (int o = 1; o < 64; o <<= 1) { const int a = __shfl_up(sg, o), b = __shfl_up(se, o); if (lane >= o) { sg += a; se += b; } }
        __syncthreads();
        if (lane == 63) { scan[wid] = sg; scan[8 + wid] = se; }
        __syncthreads();
        int bg = 0, be = 0, totg = 0;
#pragma unroll
        for (int w = 0; w < 8; ++w) { const int a = scan[w], b = scan[8 + w]; if (w < wid) { bg += a; be += b; } totg += a; }
        const int need_eq = k - totg;
        int g_before = bg + sg - cg, e_before = be + se - ce;
        const int nmine = isctx ? (tid < NC ? 1 : 0) : 32;
#pragma unroll
        for (int j = 0; j < 32; ++j) {
            if (j < nmine) {
                const int i = isctx ? tid : tid * 32 + j;
                const bool gt = key[j] > T, eq = key[j] == T;
                const bool sel = gt || (eq && e_before < need_eq);
                const int s = g_before + min(e_before, need_eq);
                if (sel) { idx[e * EROWS + slot0 + s] = tok0 + i; gate[e * EROWS + slot0 + s] = __uint_as_float(key[j]); }
                slot[(size_t)(tok0 + i) * 16 + e] = sel ? slot0 + s : -1;
                g_before += gt ? 1 : 0; e_before += eq ? 1 : 0;
            }
        }
        if (isctx) { for (int s = CAPL + CAPC + tid; s < EROWS; s += 512) { idx[e * EROWS + s] = -1; gate[e * EROWS + s] = 0.f; } }
        __syncthreads();
    }
}
__device__ __forceinline__ void phase_gather(unsigned char* ws, int G, int bid, int rows_per_e) {
    const int lane = ltid() & 63, gw = bid * 8 + (ltid() >> 6), NGW = G * 8;
    const bf16* hb = (const bf16*)(ws + WS_HB); bf16* xs = (bf16*)(ws + WS_XS); const int* idx = (const int*)(ws + WS_IDX);
    for (int r = gw; r < NE * rows_per_e; r += NGW) {
        const int e = r / rows_per_e, s = r - e * rows_per_e; const int t = idx[e * EROWS + s];
        u32x4 v[4];
#pragma unroll
        for (int j = 0; j < 4; ++j) v[j] = (t >= 0) ? *(const u32x4*)(hb + (size_t)t * 2048 + (lane + 64 * j) * 8) : (u32x4){0u, 0u, 0u, 0u};
#pragma unroll
        for (int j = 0; j < 4; ++j) *(u32x4*)(xs + ((size_t)e * EROWS + s) * 2048 + (lane + 64 * j) * 8) = v[j];
    }
}
__device__ __forceinline__ void phase_combine(const In& in, unsigned char* ws, LAS unsigned char* lds, float* out, int G, int bid, int l, int nrows) {
    const int tid = ltid(), lane = tid & 63, gw = bid * 8 + (tid >> 6), NGW = G * 8;
    bf16* x1 = (bf16*)(ws + WS_X1); const bf16* yb = (const bf16*)(ws + WS_YB); const int* slot = (const int*)(ws + WS_SLOT); bf16* hb = (bf16*)(ws + WS_HB);
    LAS float* mv = (LAS float*)lds;
    for (int v = 0; v < (nrows > NL ? 2 : 1); ++v) {
        *(LAS f32x4*)(mv + v * 6144 + 4 * tid) = *(const f32x4*)(modv(ws, l, v, 5) + 4 * tid);
        if (l == 0) stage_mod_lds(mv + v * 6144 + 2048, mv + v * 6144 + 4096, in.norm_mix + 2048, modv(ws, 1, v, 0), modv(ws, 1, v, 1), tid); }
    __syncthreads();
    int nslot = (gw < nrows) ? slot[(size_t)gw * 16 + (lane & 15)] : -1;
    for (int row = gw; row < nrows; row += NGW) {
        const LAS float* mvv = mv + (row >= NL ? 6144 : 0);
        const int myslot = nslot;
        f32x4 a[8];
#pragma unroll
        for (int j = 0; j < 8; ++j) a[j] = bf4(*(const u32x2*)(x1 + (size_t)row * 2048 + 4 * (lane + 64 * j)));
        if (row + NGW < nrows) nslot = slot[(size_t)(row + NGW) * 16 + (lane & 15)];
        f32x4 acc[8];
#pragma unroll
        for (int j = 0; j < 8; ++j) acc[j] = (f32x4){0.f, 0.f, 0.f, 0.f};
        unsigned m = (unsigned)__ballot(myslot >= 0) & 0xffffu;
        while (m) {
            const int e0 = __builtin_ctz(m); m &= m - 1u;
            const bool two = m != 0u; const int e1 = two ? __builtin_ctz(m) : e0; if (two) m &= m - 1u;
            const bf16* y0 = yb + ((size_t)e0 * EROWS + __shfl(myslot, e0)) * 2048; const bf16* y1 = yb + ((size_t)e1 * EROWS + __shfl(myslot, e1)) * 2048;
            u32x2 w0[8], w1[8];
#pragma unroll
            for (int j = 0; j < 8; ++j) w0[j] = *(const u32x2*)(y0 + 4 * (lane + 64 * j));
            if (two) {
#pragma unroll
                for (int j = 0; j < 8; ++j) w1[j] = *(const u32x2*)(y1 + 4 * (lane + 64 * j)); }
#pragma unroll
            for (int j = 0; j < 8; ++j) { acc[j].x += bflo(w0[j].x); acc[j].y += bfhi(w0[j].x); acc[j].z += bflo(w0[j].y); acc[j].w += bfhi(w0[j].y); }
            if (two) {
#pragma unroll
                for (int j = 0; j < 8; ++j) { acc[j].x += bflo(w1[j].x); acc[j].y += bfhi(w1[j].x); acc[j].z += bflo(w1[j].y); acc[j].w += bfhi(w1[j].y); } }
        }
#pragma unroll
        for (int j = 0; j < 8; ++j) a[j] = a[j] + *(const LAS f32x4*)(mvv + 4 * (lane + 64 * j)) * acc[j];
        if (l == 0) {
            store_row_bf16(x1 + (size_t)row * 2048, a, lane);
            norm_mod_row_lds(a, mvv + 2048, mvv + 4096, lane);
            store_row_bf16(hb + (size_t)row * 2048, a, lane);
        } else {
#pragma unroll
            for (int j = 0; j < 8; ++j) *(f32x4*)(out + (size_t)row * 2048 + 4 * (lane + 64 * j)) = a[j];
        }
    }
    __syncthreads();
}
}
#define XB_TMO      128
#define XB_XCNT(j)  (256  + 64 * (j))
#define XB_XSUB(j)  (1280 + 64 * (j))
#define XB_XGEN(j)  (2304 + 64 * (j))
#define XB_TOP      3328
#define XB_TOPGEN   3392
#define XCD_BAR_WORDS 3456
#define XB_SPIN_CAP (1u << 22)

__device__ __forceinline__ unsigned xb_ld(unsigned* p)              { return __hip_atomic_load(p, __ATOMIC_RELAXED, __HIP_MEMORY_SCOPE_AGENT); }
__device__ __forceinline__ unsigned xb_add(unsigned* p, unsigned v) { return __hip_atomic_fetch_add(p, v, __ATOMIC_RELAXED, __HIP_MEMORY_SCOPE_AGENT); }
__device__ __forceinline__ unsigned xb_xcc_id() { return (unsigned)__builtin_amdgcn_s_getreg((3 << 11) | 20) & 0xFu; }
#define XB_SPIN(cond, bar) do { unsigned _sp = 0; while (cond) { __builtin_amdgcn_s_sleep(1); \
    if ((++_sp & 255u) == 0u) { if (xb_ld(&(bar)[XB_TMO])) break; if (_sp > XB_SPIN_CAP) { atomicAdd(&(bar)[XB_TMO], 1u); break; } } } } while (0)

struct XcdBarrier { unsigned* bar; unsigned x; volatile LAS unsigned* st; };

__device__ __forceinline__ XcdBarrier xcd_barrier_post(unsigned* bar, volatile LAS unsigned* st) {
    XcdBarrier b; b.bar = bar; b.x = xb_xcc_id(); b.st = st;
    if (threadIdx.x == 0) (void)xb_add(&bar[XB_XCNT(b.x)], 1u);
    return b;
}
__device__ __forceinline__ void xcd_barrier_complete(unsigned* bar, unsigned x, unsigned& nloc, unsigned& nx) {
    const unsigned G = gridDim.x * gridDim.y * gridDim.z;
    unsigned sum, cnt, mine, sp = 0u;
    for (;;) {
        sum = 0u; cnt = 0u; mine = 0u;
#pragma unroll
        for (unsigned j = 0; j < 16; ++j) { const unsigned c = xb_ld(&bar[XB_XCNT(j)]); sum += c; cnt += (c > 0u) ? 1u : 0u; mine = (j == x) ? c : mine; }
        if (sum == G) break;
        __builtin_amdgcn_s_sleep(1);
        if ((++sp & 255u) == 0u) { if (xb_ld(&bar[XB_TMO])) break; if (sp > XB_SPIN_CAP) { atomicAdd(&bar[XB_TMO], 1u); break; } }
    }
    nloc = mine > 0u ? mine : 1u; nx = cnt > 0u ? cnt : 1u;
}
__device__ __forceinline__ void xcd_barrier(const XcdBarrier& b) {
    asm volatile("s_waitcnt vmcnt(0)" ::: "memory");
    __syncthreads();
    if (threadIdx.x == 0) {
        unsigned* bar = b.bar;
        __builtin_amdgcn_s_waitcnt(0);
        unsigned nloc = b.st[0], nx = b.st[1];
        if (nloc == 0u) { xcd_barrier_complete(bar, b.x, nloc, nx); b.st[0] = nloc; b.st[1] = nx; }
        const unsigned old = xb_add(&bar[XB_XSUB(b.x)], 1u);
        const unsigned gen = old / nloc;
        if (old + 1u == (gen + 1u) * nloc) {
            __builtin_amdgcn_fence(__ATOMIC_RELEASE, "agent");
            asm volatile("s_waitcnt vmcnt(0)" ::: "memory");
            const unsigned og = xb_add(&bar[XB_TOP], 1u);
            const unsigned tg = og / nx;
            if (og + 1u == (tg + 1u) * nx) xb_add(&bar[XB_TOPGEN], 1u);
            else XB_SPIN(xb_ld(&bar[XB_TOPGEN]) == tg, bar);
            __builtin_amdgcn_fence(__ATOMIC_ACQUIRE, "agent");
            xb_add(&bar[XB_XGEN(b.x)], 1u);
            asm volatile("s_waitcnt vmcnt(0)" ::: "memory");
        } else {
            XB_SPIN(xb_ld(&bar[XB_XGEN(b.x)]) == gen, bar);
            __builtin_amdgcn_fence(__ATOMIC_ACQUIRE, "agent");
            asm volatile("s_waitcnt vmcnt(0)" ::: "memory");
        }
    }
    __syncthreads();
}

#ifndef MK_PER_PHASE
#define MK_PER_PHASE 0
#endif
constexpr int NPHASE = 25;
constexpr int LDS_BYTES = 148480;
constexpr int MISC_OFF = 147456 + 64;

struct Args { thin::In in; float* out; unsigned char* ws; int ph_lo, ph_hi; };
#define CAS __attribute__((address_space(4)))
typedef const CAS Args* ArgsP;
__device__ __forceinline__ ArgsP opaque(ArgsP p) { asm volatile("" : "+s"(p)); return p; }
__device__ __forceinline__ thin::In load_in(ArgsP A) { thin::In r;
    r.x = A->in.x; r.c = A->in.c; r.ctx = A->in.ctx; r.c_ctx = A->in.c_ctx; r.ada_w = A->in.ada_w; r.ada_b = A->in.ada_b; r.norm_mix = A->in.norm_mix; r.norm_ffn = A->in.norm_ffn;
    r.mla_w_in = A->in.mla_w_in; r.mla_q_a_gain = A->in.mla_q_a_gain; r.mla_kv_a_gain = A->in.mla_kv_a_gain; r.mla_w_qb = A->in.mla_w_qb; r.mla_w_kvb = A->in.mla_w_kvb;
    r.mla_q_gain = A->in.mla_q_gain; r.mla_k_gain = A->in.mla_k_gain; r.mla_w_o = A->in.mla_w_o; r.na_w_qkv = A->in.na_w_qkv; r.na_q_gain = A->in.na_q_gain; r.na_k_gain = A->in.na_k_gain;
    r.na_rpb = A->in.na_rpb; r.na_w_o = A->in.na_w_o; r.router_w = A->in.router_w; r.moe_w_gate = A->in.moe_w_gate; r.moe_w_up = A->in.moe_w_up; r.moe_w_down = A->in.moe_w_down; return r; }

__global__ void __launch_bounds__(512, 2) fwd_kernel(Args args) {
    extern __shared__ __attribute__((aligned(16))) unsigned char lds_raw[];
    LAS unsigned char* lds = (LAS unsigned char*)lds_raw;
    const int tid = threadIdx.x, G = gridDim.x, bid = blockIdx.x;
    ArgsP ap = (ArgsP)__builtin_amdgcn_kernarg_segment_ptr();
    volatile LAS unsigned* MISC = (volatile LAS unsigned*)(lds + MISC_OFF);
    if (tid < 32) MISC[tid] = 0u;
    __syncthreads();
    XcdBarrier bar; bar.bar = (unsigned*)(ap->ws + WS_CTL) + CW_BAR; bar.x = 0; bar.st = MISC + 8;
    if (!MK_PER_PHASE) bar = xcd_barrier_post((unsigned*)(ap->ws + WS_CTL) + CW_BAR, MISC + 8);
    const int lo = ap->ph_lo, hi = ap->ph_hi;
#ifndef DBG_ONLY
#define DBG_ONLY -1
#endif
#ifndef DBG_MASK
#define DBG_MASK 0xFFFFFFFFu
#endif
#ifndef REPMASK
#define REPMASK 0u
#endif
#define RP(k) for (int rep_ = 0; rep_ < 1 + (int)((REPMASK >> (k)) & 1u); ++rep_)
#define EN(k) ((DBG_ONLY < 0 || DBG_ONLY == (k)) && ((DBG_MASK >> (k)) & 1u))
#define IN(k) ({ int lo_ = lo, hi_ = hi; asm volatile("" : "+s"(lo_), "+s"(hi_)); (lo_ <= (k) && (k) < hi_); })
#define SEAM(k) do { if (IN(k) && IN((k) + 1)) xcd_barrier(bar); else __syncthreads(); } while (0)
#define PH_ARGS() ArgsP A_ = opaque(ap); const thin::In in = load_in(A_); unsigned char* const ws = A_->ws; (void)in; (void)ws

    if (EN(0) && IN(0)) { PH_ARGS(); RP(0) thin::phase_prologue(in, ws, lds, G, bid); } SEAM(0);
    if (EN(2) && IN(2)) { PH_ARGS(); RP(2) thin::phase_norm_in(in, ws, lds, G, bid); } SEAM(2);
    if (EN(3) && IN(3)) { PH_ARGS(); RP(3) {
        pg8::Gemm g{(const bf16*)(ws + WS_HB), (const bf16*)(ws + WS_WIN_T), NTOK, WIN_NP, 2048}; pg8::StaticOrder S; S.init(NTOK, WIN_NP, G, bid);
        pg8::EpiWin E{(bf16*)(ws + WS_AB), (float*)(ws + WS_PS), (float*)(ws + WS_KPER), in.mla_k_gain, (const float*)(ws + WS_MODP)};
        pg8::gemm_phase<pg8::EpiWin, pg8::StaticOrder, true, true>(lds, g, S, E);
    } thin::late_work(in, ws, lds, G, 3, 0); } SEAM(3);
    if (EN(5) && IN(5)) { PH_ARGS(); RP(5) {
        { pg8::Gemm g{(const bf16*)(ws + WS_AB), (const bf16*)(ws + WS_WQB_T), NTOK, 3072, 512, WIN_NP}; pg8::StaticOrder S; S.init(NTOK, 3072, G, bid);
          pg8::EpiBf16P E{(bf16*)(ws + WS_QRAW), 3072};
          pg8::gemm_phase<pg8::EpiBf16P, pg8::StaticOrder, true, true>(lds, g, S, E); }
        __syncthreads();
        { pg8::Gemm g{(const bf16*)(ws + WS_AB) + 512, (const bf16*)(ws + WS_WKVB_T), NTOK, 4096, 512, WIN_NP}; pg8::StaticOrder S; S.init(NTOK, 4096, G, (bid + 28) % G);
          pg8::EpiKv E{(bf16*)(ws + WS_KVRAW), in.mla_k_gain, (const float*)(ws + WS_KPER), (const float*)(ws + WS_PS), (LAS float*)(lds + 131072), ws + WS_KPE};
          pg8::gemm_phase<pg8::EpiKv, pg8::StaticOrder, true, true>(lds, g, S, E); }
    } thin::late_work(in, ws, lds, G, 5, 0); } SEAM(5);
    if (EN(7) && IN(7)) { PH_ARGS(); RP(7) {
        const unsigned char* q8 = ws + WS_QRAW; const unsigned char* k8 = ws + WS_KVRAW; const unsigned char* vt = ws + WS_KPE; bf16* ob = (bf16*)(ws + WS_OB);
        const int nun = (G == 256) ? 5 : 0;
        for (int i = 0; i < nun; ++i) {
            const int x = bid & 7, rr = bid >> 3;
            int h, qb; bool isctx = false;
            if (i < 4) { h = 2 * x + (i >> 1); qb = rr * 2 + (i & 1); }
            else { if (rr >= 2) break; h = 2 * x + rr; qb = 0; isctx = true; }
            __syncthreads();
            if (!isctx) att::mla_unit(q8 + (size_t)(qb * 256) * 6144 + h * 384, k8 + h * 512, vt + (size_t)h * (NTOK / 64) * 8192, ob + (size_t)(qb * 256) * 2048 + h * 128, NTOK, (LAS char*)lds, in.mla_q_gain, (const float*)(ws + WS_MODP), (const float*)(ws + WS_PS), qb * 256, true);
            else att::mla_unit(q8 + (size_t)NL * 6144 + h * 384, k8 + (size_t)NL * 8192 + h * 512, vt + ((size_t)h * (NTOK / 64) + NL / 64) * 8192, ob + (size_t)NL * 2048 + h * 128, NC, (LAS char*)lds, in.mla_q_gain, (const float*)(ws + WS_MODP), (const float*)(ws + WS_PS), NL, false);
        }
        if (G != 256)
        for (int u = bid; u < 1040; u += G) {
            __syncthreads();
            if (u < 1024) { const int h = u >> 6, qb = u & 63;
                att::mla_unit(q8 + (size_t)(qb * 256) * 6144 + h * 384, k8 + h * 512, vt + (size_t)h * (NTOK / 64) * 8192, ob + (size_t)(qb * 256) * 2048 + h * 128, NTOK, (LAS char*)lds, in.mla_q_gain, (const float*)(ws + WS_MODP), (const float*)(ws + WS_PS), qb * 256, true);
            } else { const int h = u - 1024;
                att::mla_unit(q8 + (size_t)NL * 6144 + h * 384, k8 + (size_t)NL * 8192 + h * 512, vt + ((size_t)h * (NTOK / 64) + NL / 64) * 8192, ob + (size_t)NL * 2048 + h * 128, NC, (LAS char*)lds, in.mla_q_gain, (const float*)(ws + WS_MODP), (const float*)(ws + WS_PS), NL, false); }
        }
    } thin::late_work(in, ws, lds, G, 7, 0); } SEAM(7);
    if (EN(8) && IN(8)) { PH_ARGS(); RP(8) {
        pg8::Gemm g{(const bf16*)(ws + WS_OB), (const bf16*)(ws + WS_WO0_T), NTOK, 2048, 2048}; pg8::StaticOrder S; S.init(NTOK, 2048, G, bid);
        pg8::EpiResB<false> E{(bf16*)(ws + WS_X1), in.x, in.ctx, thin::modv(ws, 0, 0, 2), thin::modv(ws, 0, 1, 2)};
        pg8::gemm_phase<pg8::EpiResB<false>, pg8::StaticOrder, true, true>(lds, g, S, E);
    } thin::late_work(in, ws, lds, G, 8, 0); } SEAM(8);
#define MOE_PHASES(L, PB, PC) \
    if (EN(9) && IN(PB + 0)) { PH_ARGS(); RP(9) thin::phase_router(in, ws, lds, G, bid, L, L ? NL : NTOK); } SEAM(PB + 0); \
    if (EN(10) && IN(PB + 1)) { PH_ARGS(); RP(10) thin::phase_topk(ws, lds, G, bid, L ? 16 : 32); thin::late_work(in, ws, lds, G, PB + 1, 0); thin::late_work(in, ws, lds, G, -1, L ? thin::LIM_GU1 : thin::LIM_MOE0); } SEAM(PB + 1); \
    if (EN(12) && IN(PB + 3)) { PH_ARGS(); RP(12) { \
        pg8::Gemm g{(const bf16*)(ws + WS_HB), (const bf16*)(ws + WS_WGU_T) + (size_t)L * WGU_L, NE * EROWS, NE * 2816, 2048}; \
        pg8::GroupedOrder S; S.init(L ? 8 : 9, 11, G, bid); \
        pg8::EpiSwiGLU E{(bf16*)(ws + WS_HID)}; \
        pg8::gemm_phase_gather<pg8::EpiSwiGLU, pg8::GroupedOrder, true, true>(lds, g, (const int*)(ws + WS_IDX), S, E);     \
    } thin::late_work(in, ws, lds, G, PB + 3, 0); if (L == 1) thin::late_work(in, ws, lds, G, -1, thin::LIM_ALL); } SEAM(PB + 3);     \
    if (EN(13) && IN(PB + 4)) { PH_ARGS(); RP(13) { \
        pg8::Gemm g{(const bf16*)(ws + WS_HID), (const bf16*)(ws + WS_WD_T) + (size_t)L * WD_L, NE * EROWS, NE * 2048, FF}; \
        pg8::GroupedOrder S; S.init(L ? 8 : 9, 8, G, bid); \
        pg8::EpiDown E{(bf16*)(ws + WS_YB), (const float*)(ws + WS_GATE)}; \
        pg8::gemm_phase<pg8::EpiDown, pg8::GroupedOrder, true, true>(lds, g, S, E); \
    } if (L == 0) thin::late_work(in, ws, lds, G, PB + 4, 0); } SEAM(PB + 4); \
    if (EN(14) && IN(PC)) { PH_ARGS(); RP(14) thin::phase_combine(in, ws, lds, A_->out, G, bid, L, L ? NL : NTOK); if (L == 0) thin::late_work(in, ws, lds, G, -1, thin::LIM_NA); }

    MOE_PHASES(0, 9, 14)
    SEAM(14);
    if (EN(15) && IN(15)) { PH_ARGS(); RP(15) {
        pg8::Gemm g{(const bf16*)(ws + WS_HB), (const bf16*)(ws + WS_WQKV_T), NTOK, 6144, 2048}; pg8::StaticOrder S; S.init(NTOK, 6144, G, bid);
        pg8::EpiQkvNorm E{(bf16*)(ws + WS_QKV1), in.na_q_gain, in.na_k_gain, (LAS float*)(lds + 131072)};
        pg8::gemm_phase<pg8::EpiQkvNorm, pg8::StaticOrder, true, true>(lds, g, S, E);
    } thin::late_work(in, ws, lds, G, 15, 0); } SEAM(15);
    if (EN(17) && IN(17)) { PH_ARGS(); RP(17) {
        for (int u = bid; u < 1024; u += G) { const int h = u >> 6, rb = u & 63;
            __syncthreads();
            att::na_unit((const bf16*)(ws + WS_QKV1), h, rb, in.na_rpb + h * 465, (bf16*)(ws + WS_OB), (LAS char*)lds); }
    } thin::late_work(in, ws, lds, G, 17, 0); } SEAM(17);
    if (EN(18) && IN(18)) { PH_ARGS(); RP(18) {
        pg8::Gemm g{(const bf16*)(ws + WS_OB), (const bf16*)(ws + WS_WO1_T), NL, 2048, 2048}; pg8::StaticOrder S; S.init(NL, 2048, G, bid);
        pg8::EpiResB<true> E{(bf16*)(ws + WS_X1), ws + WS_X1, ws + WS_X1, thin::modv(ws, 1, 0, 2), thin::modv(ws, 1, 0, 2)};
        pg8::gemm_phase<pg8::EpiResB<true>, pg8::StaticOrder, true, true>(lds, g, S, E);
    } thin::late_work(in, ws, lds, G, 18, 0); } SEAM(18);
    MOE_PHASES(1, 19, 24)
#undef MOE_PHASES
#undef IN
#undef SEAM
}

extern "C" void kernel_launch(void* const* d_in, const int* in_sizes, int n_in, void* d_out, int out_size, void* d_ws, size_t ws_size, hipStream_t stream) {
    static int grid = 0;
    if (grid == 0) {
        if (n_in != 25 || in_sizes[0] != NL * DM || out_size != NL * DM || ws_size < WS_END) {
            fprintf(stderr, "kernel_launch: unexpected problem: n_in %d in0 %d out %d ws %zu (need %zu)\n", n_in, n_in > 0 ? in_sizes[0] : -1, out_size, ws_size, (size_t)WS_END); grid = -1; return; }
        int dev = 0, cus = 0, per_cu = 0;
        if (hipGetDevice(&dev) != hipSuccess || hipDeviceGetAttribute(&cus, hipDeviceAttributeMultiprocessorCount, dev) != hipSuccess) { grid = -1; return; }
        if (hipFuncSetAttribute((const void*)fwd_kernel, hipFuncAttributeMaxDynamicSharedMemorySize, LDS_BYTES) != hipSuccess) { fprintf(stderr, "kernel_launch: hipFuncSetAttribute failed\n"); grid = -1; return; }
        if (hipOccupancyMaxActiveBlocksPerMultiprocessor(&per_cu, (const void*)fwd_kernel, 512, LDS_BYTES) != hipSuccess || per_cu < 1)
            fprintf(stderr, "kernel_launch: note: occupancy query reports %d workgroups per CU\n", per_cu);
        (void)hipGetLastError();
        grid = cus;
    }
    if (grid < 0) return;
    if (hipMemsetAsync((char*)d_ws + WS_CTL, 0, CTL_ZERO_BYTES, stream) != hipSuccess) { fprintf(stderr, "kernel_launch: memset failed\n"); return; }
    Args a{};
    const float** ip = (const float**)&a.in;
    for (int i = 0; i < 25; ++i) ip[i] = (const float*)d_in[i];
    a.out = (float*)d_out; a.ws = (unsigned char*)d_ws;
#if MK_PER_PHASE
    for (int p = 0; p < NPHASE; ++p) { a.ph_lo = p; a.ph_hi = p + 1;
        hipLaunchKernelGGL(fwd_kernel, dim3(grid), dim3(512), LDS_BYTES, stream, a); }
#else
    a.ph_lo = 0; a.ph_hi = NPHASE;
    hipLaunchKernelGGL(fwd_kernel, dim3(grid), dim3(512), LDS_BYTES, stream, a);
#endif
    const hipError_t le = hipPeekAtLastError();
    if (le != hipSuccess) fprintf(stderr, "kernel_launch: launch failed: %s\n", hipGetErrorName(le));
}
```

```cpp
#include <hip/hip_runtime.h>
#include <cstdio>
#include <cstdint>

#define GAS __attribute__((address_space(1)))
#define LAS __attribute__((address_space(3)))
typedef unsigned short bf16;
typedef short bf16x8 __attribute__((ext_vector_type(8)));
typedef short s16x4 __attribute__((ext_vector_type(4)));
typedef float f32x2 __attribute__((ext_vector_type(2)));
typedef float f32x4 __attribute__((ext_vector_type(4)));
typedef float f32x16 __attribute__((ext_vector_type(16)));
typedef unsigned u32x4 __attribute__((ext_vector_type(4)));
typedef unsigned u32x2 __attribute__((ext_vector_type(2)));

constexpr int NL = 16384, NC = 256, NTOK = NL + NC, DM = 2048, NH = 16;
constexpr int QLORA = 512, KVLORA = 512, ROPE_D = 64, NOPE_D = 128, QKH = 192, VD = 128;
constexpr int WIN_N = 1088, WIN_NP = 1280;
constexpr int NE = 16, FF = 1408, CAPL = 2048, CAPC = 32, EROWS = 2304;
constexpr float EPS = 1e-6f;
constexpr float LOG2E = 1.4426950408889634f;

constexpr size_t MiB = (size_t)1 << 20;
constexpr size_t WS_CTL = 0, CTL_ZERO_BYTES = 1 * MiB;
constexpr size_t WS_MODP = 1 * MiB;
static_assert((size_t)NTOK * 64 * 4 + 64 * 1024 <= 4608 * 1024 && 4608 * 1024 + (size_t)NTOK * 20 * 4 <= 6 * MiB, "small tables");
constexpr size_t WS_KPER = WS_MODP + 64 * 1024;
constexpr size_t WS_PS = WS_MODP + 4608 * 1024;
constexpr size_t WS_MOD = 7 * MiB;
constexpr size_t WS_AFF = 8 * MiB;
constexpr size_t WS_IDX = 8 * MiB + 1280 * 1024;
constexpr size_t WS_GATE = WS_IDX + 256 * 1024;
constexpr size_t WS_SLOT = 10 * MiB;
constexpr size_t WS_WIN_T = 12 * MiB, WS_WQB_T = 17 * MiB, WS_WKVB_T = 20 * MiB, WS_WO0_T = 24 * MiB, WS_WQKV_T = 32 * MiB, WS_WO1_T = 56 * MiB;
constexpr size_t WS_WGU_T = 64 * MiB;
constexpr size_t WS_WD_T = 416 * MiB;
constexpr size_t WS_HB = 592 * MiB;
constexpr size_t WS_X1 = 657 * MiB;
constexpr size_t WS_R = 787 * MiB;
constexpr size_t WS_AB = WS_R, WS_QN = WS_R + 41 * MiB, WS_KVN = WS_R + 58 * MiB, WS_QRAW = WS_R + 75 * MiB, WS_KVRAW = WS_R + 173 * MiB, WS_KPE = WS_R + 303 * MiB, WS_OB = WS_R + 336 * MiB;
constexpr size_t WS_QKV1 = WS_R;
constexpr size_t WS_XS = WS_R, WS_HID = WS_R + 144 * MiB, WS_YB = WS_R + 243 * MiB;
constexpr size_t WS_END = WS_R + 401 * MiB;
static_assert((size_t)NTOK * WIN_NP * 2 <= 41 * MiB && (size_t)NTOK * 512 * 2 <= 17 * MiB && (size_t)NTOK * 3072 * 2 <= 98 * MiB && (size_t)NTOK * 4096 * 2 <= 130 * MiB && (size_t)NTOK * 1024 * 2 <= 33 * MiB && (size_t)NTOK * 2048 * 2 <= 65 * MiB, "region A");
static_assert((size_t)NE * EROWS * 2048 * 2 <= 144 * MiB && (size_t)NE * EROWS * FF * 2 <= 99 * MiB && (size_t)NTOK * 6144 * 2 <= 195 * MiB, "region B");
constexpr size_t WGU_L = (size_t)NE * 2816 * 2048, WD_L = (size_t)NE * 2048 * FF;

constexpr int CW_BAR = 4096;
constexpr int CW_WORK = 128;
constexpr int CW_DONE = 256;
constexpr int CW_KMAX = 64;

__device__ __forceinline__ unsigned cvtpk(float lo, float hi) { unsigned r; asm("v_cvt_pk_bf16_f32 %0, %1, %2" : "=v"(r) : "v"(lo), "v"(hi)); return r; }
__device__ __forceinline__ float bflo(unsigned u) { return __uint_as_float(u << 16); }
__device__ __forceinline__ float bfhi(unsigned u) { return __uint_as_float(u & 0xffff0000u); }
__device__ __forceinline__ float wave_sum(float v) {
#pragma unroll
    for (int o = 1; o < 64; o <<= 1) v += __shfl_xor(v, o);
    return v;
}
__device__ __forceinline__ int wave_sum_i(int v) {
#pragma unroll
    for (int o = 1; o < 64; o <<= 1) v += __shfl_xor(v, o);
    return v;
}
__device__ __forceinline__ int ltid() { int t = threadIdx.x; asm volatile("" : "+v"(t)); return t; }
namespace pg8 {
#define PG8_LAS __attribute__((address_space(3)))
typedef unsigned short bf16_t;
typedef short bf16x8 __attribute__((ext_vector_type(8)));
typedef float f32x4 __attribute__((ext_vector_type(4)));
typedef unsigned u32x4 __attribute__((ext_vector_type(4)));
constexpr int BM = 256, BK = 64, HALF = 128, HTB = HALF * BK * 2  , STAGE_BYTES = 8 * HTB, NXCD = 8, WGM = 8;

__host__ __device__ __forceinline__ int lds_byte(int r, int c) { const int st = (r >> 4) * 2 + (c >> 5), rr = r & 15, cc = c & 31, ob = rr * 64 + cc * 2; return st * 1024 + (ob ^ (((ob >> 9) & 1) << 5)); }
__host__ __device__ __forceinline__ void stage_rc(int b, int& R, int& C) { const int st = b / 1024, sb = b % 1024, swz = sb ^ (((sb >> 9) & 1) << 5); R = (st >> 1) * 16 + swz / 64; C = (st & 1) * 32 + (swz % 64) / 2; }
__host__ __device__ __forceinline__ int perm32(int rho) { const int n = rho >> 4, i = rho & 15; return 8 * (i >> 2) + 4 * n + (i & 3); }

struct Unit { int pm, pn; };
struct Gemm { const bf16_t* A; const bf16_t* Bt; int M, N, K; int lda = 0; };

struct StaticOrder {
    int nM, nN, nwg, G, c;
    __host__ __device__ void init(int M, int N, int G_, int c_) { nM = M / BM; nN = N / BM; nwg = nM * nN; G = G_; c = c_; }
    __host__ __device__ bool next(int i, Unit& u) const {
        const long L = (long)i * G + c; if (L >= nwg) return false;
        int wgid = (int)L; { const int q = nwg / NXCD, r = nwg % NXCD, xcd = wgid % NXCD, off = wgid / NXCD; wgid = (xcd < r ? xcd * (q + 1) : r * (q + 1) + (xcd - r) * q) + off; }
        const int nig = WGM * nN, gid = wgid / nig, fm = gid * WGM, gsz = (nM - fm) < WGM ? (nM - fm) : WGM;
        u.pm = fm + ((wgid % nig) % gsz); u.pn = (wgid % nig) / gsz; return true;
    }
    __device__ __forceinline__ void a_ready(const Unit&) const {}
    __device__ __forceinline__ void done(const Unit&) const {}
};

__device__ __forceinline__ unsigned cvt_pk_bf16(float lo, float hi) { unsigned r; asm volatile("v_cvt_pk_bf16_f32 %0, %1, %2" : "=v"(r) : "v"(lo), "v"(hi)); return r; }
typedef float f32x2 __attribute__((ext_vector_type(2)));
template <class Epi, class Sched, bool ALIGN_EPI = false, bool SP2 = false>
__device__ __forceinline__ void gemm_phase(PG8_LAS unsigned char* lds, const Gemm g, const Sched& S, const Epi& E) {
    const int tid = ltid(), wid = __builtin_amdgcn_readfirstlane(tid >> 6), lane = tid & 63, wr = wid >> 2, wc = wid & 3, fr = lane & 15, fq = lane >> 4;
    const int K = g.K, nt = K / BK, lda = g.lda ? g.lda : K;
    unsigned voffA[2], voffB[2];
#pragma unroll
    for (int i = 0; i < 2; ++i) { int R, C; stage_rc(tid * 16 + i * 8192, R, C); const int Rb = Epi::PERM ? ((R & ~31) + perm32(R & 31)) : R;
        voffA[i] = (unsigned)(R * lda + C) * 2u; voffB[i] = (unsigned)(Rb * K + C) * 2u; }
    const size_t kstep = (size_t)(BK * 2);
    const size_t hstep = (size_t)HALF * K * 2;
    const size_t tstep = 2 * hstep;
    const size_t hstepA = (size_t)HALF * lda * 2, tstepA = 2 * hstepA;
    const unsigned ldsw = (unsigned)wid * 1024u;
    const int aoff = lds_byte(wr * 64 + fr, fq * 8), boff = lds_byte(wc * 32 + fr, fq * 8);
#define PG8_SA(b, h) (((b) * 2 + (h)) * HTB)
#define PG8_SB(b, h) ((4 + (b) * 2 + (h)) * HTB)
#define PG8_STAGE(bufoff, gbase, voff) do { _Pragma("unroll") for (int _i = 0; _i < 2; ++_i) \
        __builtin_amdgcn_global_load_lds((const unsigned*)((const char*)(gbase) + (voff)[_i]), (PG8_LAS unsigned*)(lds + (bufoff) + ldsw + _i * 8192), 16, 0, 0); } while (0)
#define PG8_LDA(dst, b, h) do { _Pragma("unroll") for (int m = 0; m < 4; ++m) _Pragma("unroll") for (int k = 0; k < 2; ++k) dst[m][k] = *(const PG8_LAS bf16x8*)(lds + PG8_SA(b, h) + aoff + m * 2048 + k * 1024); } while (0)
#define PG8_LDB(dst, b, h) do { _Pragma("unroll") for (int n = 0; n < 2; ++n) _Pragma("unroll") for (int k = 0; k < 2; ++k) dst[n][k] = *(const PG8_LAS bf16x8*)(lds + PG8_SB(b, h) + boff + n * 2048 + k * 1024); } while (0)
#define PG8_MMA(ai, bj, At, Bt) do { __builtin_amdgcn_s_setprio(1); _Pragma("unroll") for (int m = 0; m < 4; ++m) _Pragma("unroll") for (int n = 0; n < 2; ++n) _Pragma("unroll") for (int k = 0; k < 2; ++k) \
        acc[ai][bj][m][n] = __builtin_amdgcn_mfma_f32_16x16x32_bf16(Bt[n][k], At[m][k], acc[ai][bj][m][n], 0, 0, 0); __builtin_amdgcn_s_setprio(0); } while (0)
#define PG8_WAIT_V(n) asm volatile("s_waitcnt vmcnt(" #n ")" ::: "memory")
#define PG8_WAIT_L(n) asm volatile("s_waitcnt lgkmcnt(" #n ")" ::: "memory")
#define PG8_BAR __builtin_amdgcn_s_barrier()
#define PG8_SCHED __builtin_amdgcn_sched_barrier(0)
    Unit cur, nxt; int ui = 0;
    if (!S.next(0, cur)) return;
    f32x4 acc[2][2][4][2];
#pragma unroll
    for (int a = 0; a < 2; ++a)
#pragma unroll
        for (int b = 0; b < 2; ++b)
#pragma unroll
            for (int m = 0; m < 4; ++m)
#pragma unroll
                for (int n = 0; n < 2; ++n) acc[a][b][m][n] = (f32x4){0.f, 0.f, 0.f, 0.f};
    bf16x8 At[4][2], B0[2][2], B1[2][2];
    const char* cA = (const char*)g.A + (size_t)cur.pm * tstepA; const char* cB = (const char*)g.Bt + (size_t)cur.pn * tstep;
    S.a_ready(cur);
    if constexpr (SP2) {
        PG8_STAGE(PG8_SB(0, 0), cB, voffB); PG8_STAGE(PG8_SB(0, 1), cB + hstep, voffB); PG8_STAGE(PG8_SA(0, 0), cA, voffA); PG8_STAGE(PG8_SA(0, 1), cA + hstepA, voffA);
        if (wr == 1) PG8_BAR;
        PG8_WAIT_V(2); PG8_BAR;
        PG8_STAGE(PG8_SB(1, 0), cB + kstep, voffB); PG8_STAGE(PG8_SA(1, 0), cA + kstep, voffA); PG8_STAGE(PG8_SB(1, 1), cB + hstep + kstep, voffB);
        PG8_WAIT_V(6); PG8_BAR;
    } else {
        PG8_STAGE(PG8_SB(0, 0), cB, voffB); PG8_STAGE(PG8_SA(0, 0), cA, voffA); PG8_STAGE(PG8_SB(0, 1), cB + hstep, voffB); PG8_STAGE(PG8_SA(0, 1), cA + hstepA, voffA);
        if (wr == 1) PG8_BAR;
        PG8_WAIT_V(4); PG8_BAR;
        PG8_STAGE(PG8_SB(1, 0), cB + kstep, voffB); PG8_STAGE(PG8_SA(1, 0), cA + kstep, voffA); PG8_STAGE(PG8_SB(1, 1), cB + hstep + kstep, voffB);
        PG8_WAIT_V(6); PG8_BAR;
    }
    for (;;) {
        const bool has_next = S.next(ui + 1, nxt);
        const char* nA = has_next ? (const char*)g.A + (size_t)nxt.pm * tstepA : cA; const char* nB = has_next ? (const char*)g.Bt + (size_t)nxt.pn * tstep : cB;
        for (int t = 0; t < nt; t += 2) {
            const bool last = (t == nt - 2);
            const char* a1 = cA + (size_t)(t + 1) * kstep;
            const char* a2 = last ? nA : cA + (size_t)(t + 2) * kstep; const char* b2 = last ? nB : cB + (size_t)(t + 2) * kstep;
            const char* a3 = a2 + kstep; const char* b3 = b2 + kstep;
            if (last && has_next) S.a_ready(nxt);
            if constexpr (SP2) {
            PG8_LDB(B0, 0, 0); PG8_LDB(B1, 0, 1); PG8_SCHED; PG8_LDA(At, 0, 0); PG8_STAGE(PG8_SA(1, 1), a1 + hstepA, voffA);
            PG8_WAIT_V(8); PG8_WAIT_L(0); PG8_BAR; PG8_MMA(0, 0, At, B0); PG8_MMA(0, 1, At, B1); PG8_BAR; PG8_SCHED;
            PG8_LDA(At, 0, 1); PG8_STAGE(PG8_SB(0, 0), b2, voffB); PG8_STAGE(PG8_SB(0, 1), b2 + hstep, voffB); PG8_STAGE(PG8_SA(0, 0), a2, voffA);
            PG8_WAIT_V(8); PG8_WAIT_L(0); PG8_BAR; PG8_MMA(1, 0, At, B0); PG8_MMA(1, 1, At, B1); PG8_BAR; PG8_SCHED;
            PG8_LDB(B0, 1, 0); PG8_LDB(B1, 1, 1); PG8_SCHED; PG8_LDA(At, 1, 0); PG8_STAGE(PG8_SA(0, 1), a2 + hstepA, voffA);
            PG8_WAIT_V(8); PG8_WAIT_L(0); PG8_BAR; PG8_MMA(0, 0, At, B0); PG8_MMA(0, 1, At, B1); PG8_BAR; PG8_SCHED;
            PG8_LDA(At, 1, 1); PG8_STAGE(PG8_SB(1, 0), b3, voffB); PG8_STAGE(PG8_SB(1, 1), b3 + hstep, voffB); PG8_STAGE(PG8_SA(1, 0), a3, voffA);
            PG8_WAIT_V(8); PG8_WAIT_L(0); PG8_BAR; PG8_MMA(1, 0, At, B0); PG8_MMA(1, 1, At, B1); PG8_BAR; PG8_SCHED;
            } else {
            PG8_LDB(B0, 0, 0); PG8_SCHED; PG8_LDA(At, 0, 0); PG8_STAGE(PG8_SA(1, 1), a1 + hstepA, voffA);
            PG8_WAIT_L(8); PG8_BAR; PG8_WAIT_L(0); PG8_MMA(0, 0, At, B0); PG8_BAR; PG8_SCHED;
            PG8_LDB(B1, 0, 1); PG8_STAGE(PG8_SB(0, 0), b2, voffB);
            PG8_BAR; PG8_WAIT_L(0); PG8_MMA(0, 1, At, B1); PG8_BAR;
            PG8_LDA(At, 0, 1); PG8_STAGE(PG8_SA(0, 0), a2, voffA);
            PG8_BAR; PG8_WAIT_L(0); PG8_MMA(1, 0, At, B0); PG8_BAR; PG8_SCHED;
            PG8_STAGE(PG8_SB(0, 1), b2 + hstep, voffB);
            PG8_WAIT_V(6); PG8_BAR; PG8_MMA(1, 1, At, B1); PG8_BAR;
            PG8_LDB(B0, 1, 0); PG8_SCHED; PG8_LDA(At, 1, 0); PG8_STAGE(PG8_SA(0, 1), a2 + hstepA, voffA);
            PG8_WAIT_L(8); PG8_BAR; PG8_WAIT_L(0); PG8_MMA(0, 0, At, B0); PG8_BAR; PG8_SCHED;
            PG8_LDB(B1, 1, 1); PG8_STAGE(PG8_SB(1, 0), b3, voffB);
            PG8_BAR; PG8_WAIT_L(0); PG8_MMA(0, 1, At, B1); PG8_BAR;
            PG8_LDA(At, 1, 1); PG8_STAGE(PG8_SA(1, 0), a3, voffA);
            PG8_BAR; PG8_WAIT_L(0); PG8_MMA(1, 0, At, B0); PG8_BAR; PG8_SCHED;
            PG8_STAGE(PG8_SB(1, 1), b3 + hstep, voffB);
            PG8_WAIT_V(6); PG8_BAR; PG8_MMA(1, 1, At, B1); PG8_BAR;
            }
        }
        if constexpr (ALIGN_EPI) { if (wr == 0) PG8_BAR; }
        if constexpr (!Epi::AFTER_DRAIN) { E(acc, cur, wr, wc, fr, fq); S.done(cur); }
        if (!has_next) break;
#pragma unroll
        for (int a = 0; a < 2; ++a)
#pragma unroll
            for (int b = 0; b < 2; ++b)
#pragma unroll
                for (int m = 0; m < 4; ++m)
#pragma unroll
                    for (int n = 0; n < 2; ++n) acc[a][b][m][n] = (f32x4){0.f, 0.f, 0.f, 0.f};
        cur = nxt; cA = nA; cB = nB; ++ui;
        if constexpr (ALIGN_EPI) { if (wr == 1) PG8_BAR; }
    }
    PG8_WAIT_V(0);
    if constexpr (!ALIGN_EPI) { if (wr == 0) PG8_BAR; }
    PG8_BAR;
    if constexpr (Epi::AFTER_DRAIN) { E.fused(acc, cur, wr, wc, fr, fq, lds, wid, lane); S.done(cur); }
#undef PG8_SA
#undef PG8_SB
#undef PG8_STAGE
#undef PG8_LDA
#undef PG8_LDB
#undef PG8_MMA
#undef PG8_WAIT_V
#undef PG8_WAIT_L
#undef PG8_BAR
#undef PG8_SCHED
}
template <class Epi, class Sched, bool ALIGN_EPI = false, bool SP2 = false>
__device__ __forceinline__ void gemm_phase_gather(PG8_LAS unsigned char* lds, const Gemm g, const int* __restrict__ rowidx, const Sched& S, const Epi& E) {
    static_assert(SP2, "gather variant: SP2 loop only");
    const int tid = ltid(), wid = __builtin_amdgcn_readfirstlane(tid >> 6), lane = tid & 63, wr = wid >> 2, wc = wid & 3, fr = lane & 15, fq = lane >> 4;
    const int K = g.K, nt = K / BK;
    unsigned voffA[2], voffB[2];
#pragma unroll
    for (int i = 0; i < 2; ++i) { int R, C; stage_rc(tid * 16 + i * 8192, R, C); const int Rb = Epi::PERM ? ((R & ~31) + perm32(R & 31)) : R;
        voffA[i] = (unsigned)(R * K + C) * 2u; voffB[i] = (unsigned)(Rb * K + C) * 2u; }
    const size_t kstep = (size_t)(BK * 2);
    const size_t hstep = (size_t)HALF * K * 2;
    const size_t tstep = 2 * hstep;
    const unsigned ldsw = (unsigned)wid * 1024u;
    const int aoff = lds_byte(wr * 64 + fr, fq * 8), boff = lds_byte(wc * 32 + fr, fq * 8);
#define PG8_SA(b, h) (((b) * 2 + (h)) * HTB)
#define PG8_SB(b, h) ((4 + (b) * 2 + (h)) * HTB)
#define PG8_STAGE(bufoff, gbase, voff) do { _Pragma("unroll") for (int _i = 0; _i < 2; ++_i) \
        __builtin_amdgcn_global_load_lds((const unsigned*)((const char*)(gbase) + (voff)[_i]), (PG8_LAS unsigned*)(lds + (bufoff) + ldsw + _i * 8192), 16, 0, 0); } while (0)
#define PG8_LDA(dst, b, h) do { _Pragma("unroll") for (int m = 0; m < 4; ++m) _Pragma("unroll") for (int k = 0; k < 2; ++k) dst[m][k] = *(const PG8_LAS bf16x8*)(lds + PG8_SA(b, h) + aoff + m * 2048 + k * 1024); } while (0)
#define PG8_LDB(dst, b, h) do { _Pragma("unroll") for (int n = 0; n < 2; ++n) _Pragma("unroll") for (int k = 0; k < 2; ++k) dst[n][k] = *(const PG8_LAS bf16x8*)(lds + PG8_SB(b, h) + boff + n * 2048 + k * 1024); } while (0)
#define PG8_MMA(ai, bj, At, Bt) do { __builtin_amdgcn_s_setprio(1); _Pragma("unroll") for (int m = 0; m < 4; ++m) _Pragma("unroll") for (int n = 0; n < 2; ++n) _Pragma("unroll") for (int k = 0; k < 2; ++k) \
        acc[ai][bj][m][n] = __builtin_amdgcn_mfma_f32_16x16x32_bf16(Bt[n][k], At[m][k], acc[ai][bj][m][n], 0, 0, 0); __builtin_amdgcn_s_setprio(0); } while (0)
#define PG8_WAIT_V(n) asm volatile("s_waitcnt vmcnt(" #n ")" ::: "memory")
#define PG8_WAIT_L(n) asm volatile("s_waitcnt lgkmcnt(" #n ")" ::: "memory")
#define PG8_BAR __builtin_amdgcn_s_barrier()
#define PG8_SCHED __builtin_amdgcn_sched_barrier(0)
    Unit cur, nxt; int ui = 0;
    if (!S.next(0, cur)) return;
    int RA[2], CA[2];
#pragma unroll
    for (int i = 0; i < 2; ++i) stage_rc(tid * 16 + i * 8192, RA[i], CA[i]);
    unsigned vA0[2], vA1[2], nvA0[2], nvA1[2];
#define PG8_GOFF(u, d0, d1) do { _Pragma("unroll") for (int i = 0; i < 2; ++i) { \
        int t0_ = rowidx[(u).pm * BM + RA[i]], t1_ = rowidx[(u).pm * BM + HALF + RA[i]]; t0_ = t0_ < 0 ? 0 : t0_; t1_ = t1_ < 0 ? 0 : t1_; \
        d0[i] = (unsigned)(t0_ * K + CA[i]) * 2u; d1[i] = (unsigned)(t1_ * K + CA[i]) * 2u; } } while (0)
    PG8_GOFF(cur, vA0, vA1);
    f32x4 acc[2][2][4][2];
#pragma unroll
    for (int a = 0; a < 2; ++a)
#pragma unroll
        for (int b = 0; b < 2; ++b)
#pragma unroll
            for (int m = 0; m < 4; ++m)
#pragma unroll
                for (int n = 0; n < 2; ++n) acc[a][b][m][n] = (f32x4){0.f, 0.f, 0.f, 0.f};
    bf16x8 At[4][2], B0[2][2], B1[2][2];
    const char* cA = (const char*)g.A; const char* cB = (const char*)g.Bt + (size_t)cur.pn * tstep;
    S.a_ready(cur);
    if constexpr (SP2) {
        PG8_STAGE(PG8_SB(0, 0), cB, voffB); PG8_STAGE(PG8_SB(0, 1), cB + hstep, voffB); PG8_STAGE(PG8_SA(0, 0), cA, vA0); PG8_STAGE(PG8_SA(0, 1), cA, vA1);
        if (wr == 1) PG8_BAR;
        PG8_WAIT_V(2); PG8_BAR;
        PG8_STAGE(PG8_SB(1, 0), cB + kstep, voffB); PG8_STAGE(PG8_SA(1, 0), cA + kstep, vA0); PG8_STAGE(PG8_SB(1, 1), cB + hstep + kstep, voffB);
        PG8_WAIT_V(6); PG8_BAR;
    } else {
        PG8_STAGE(PG8_SB(0, 0), cB, voffB); PG8_STAGE(PG8_SA(0, 0), cA, voffA); PG8_STAGE(PG8_SB(0, 1), cB + hstep, voffB); PG8_STAGE(PG8_SA(0, 1), cA + hstep, voffA);
        if (wr == 1) PG8_BAR;
        PG8_WAIT_V(4); PG8_BAR;
        PG8_STAGE(PG8_SB(1, 0), cB + kstep, voffB); PG8_STAGE(PG8_SA(1, 0), cA + kstep, voffA); PG8_STAGE(PG8_SB(1, 1), cB + hstep + kstep, voffB);
        PG8_WAIT_V(6); PG8_BAR;
    }
    for (;;) {
        const bool has_next = S.next(ui + 1, nxt);
        if (has_next) PG8_GOFF(nxt, nvA0, nvA1); else { nvA0[0] = vA0[0]; nvA0[1] = vA0[1]; nvA1[0] = vA1[0]; nvA1[1] = vA1[1]; }
        const char* nA = cA; const char* nB = has_next ? (const char*)g.Bt + (size_t)nxt.pn * tstep : cB;
        for (int t = 0; t < nt; t += 2) {
            const bool last = (t == nt - 2);
            const char* a1 = cA + (size_t)(t + 1) * kstep;
            const char* a2 = last ? nA : cA + (size_t)(t + 2) * kstep; const char* b2 = last ? nB : cB + (size_t)(t + 2) * kstep;
            const char* a3 = a2 + kstep; const char* b3 = b2 + kstep;
            unsigned wA0[2], wA1[2]; wA0[0] = last ? nvA0[0] : vA0[0]; wA0[1] = last ? nvA0[1] : vA0[1]; wA1[0] = last ? nvA1[0] : vA1[0]; wA1[1] = last ? nvA1[1] : vA1[1];
            if (last && has_next) S.a_ready(nxt);
            if constexpr (SP2) {
            PG8_LDB(B0, 0, 0); PG8_LDB(B1, 0, 1); PG8_SCHED; PG8_LDA(At, 0, 0); PG8_STAGE(PG8_SA(1, 1), a1, vA1);
            PG8_WAIT_V(8); PG8_WAIT_L(0); PG8_BAR; PG8_MMA(0, 0, At, B0); PG8_MMA(0, 1, At, B1); PG8_BAR; PG8_SCHED;
            PG8_LDA(At, 0, 1); PG8_STAGE(PG8_SB(0, 0), b2, voffB); PG8_STAGE(PG8_SB(0, 1), b2 + hstep, voffB); PG8_STAGE(PG8_SA(0, 0), a2, wA0);
            PG8_WAIT_V(8); PG8_WAIT_L(0); PG8_BAR; PG8_MMA(1, 0, At, B0); PG8_MMA(1, 1, At, B1); PG8_BAR; PG8_SCHED;
            PG8_LDB(B0, 1, 0); PG8_LDB(B1, 1, 1); PG8_SCHED; PG8_LDA(At, 1, 0); PG8_STAGE(PG8_SA(0, 1), a2, wA1);
            PG8_WAIT_V(8); PG8_WAIT_L(0); PG8_BAR; PG8_MMA(0, 0, At, B0); PG8_MMA(0, 1, At, B1); PG8_BAR; PG8_SCHED;
            PG8_LDA(At, 1, 1); PG8_STAGE(PG8_SB(1, 0), b3, voffB); PG8_STAGE(PG8_SB(1, 1), b3 + hstep, voffB); PG8_STAGE(PG8_SA(1, 0), a3, wA0);
            PG8_WAIT_V(8); PG8_WAIT_L(0); PG8_BAR; PG8_MMA(1, 0, At, B0); PG8_MMA(1, 1, At, B1); PG8_BAR; PG8_SCHED;
            } else {
            PG8_LDB(B0, 0, 0); PG8_SCHED; PG8_LDA(At, 0, 0); PG8_STAGE(PG8_SA(1, 1), a1 + hstep, voffA);
            PG8_WAIT_L(8); PG8_BAR; PG8_WAIT_L(0); PG8_MMA(0, 0, At, B0); PG8_BAR; PG8_SCHED;
            PG8_LDB(B1, 0, 1); PG8_STAGE(PG8_SB(0, 0), b2, voffB);
            PG8_BAR; PG8_WAIT_L(0); PG8_MMA(0, 1, At, B1); PG8_BAR;
            PG8_LDA(At, 0, 1); PG8_STAGE(PG8_SA(0, 0), a2, voffA);
            PG8_BAR; PG8_WAIT_L(0); PG8_MMA(1, 0, At, B0); PG8_BAR; PG8_SCHED;
            PG8_STAGE(PG8_SB(0, 1), b2 + hstep, voffB);
            PG8_WAIT_V(6); PG8_BAR; PG8_MMA(1, 1, At, B1); PG8_BAR;
            PG8_LDB(B0, 1, 0); PG8_SCHED; PG8_LDA(At, 1, 0); PG8_STAGE(PG8_SA(0, 1), a2 + hstep, voffA);
            PG8_WAIT_L(8); PG8_BAR; PG8_WAIT_L(0); PG8_MMA(0, 0, At, B0); PG8_BAR; PG8_SCHED;
            PG8_LDB(B1, 1, 1); PG8_STAGE(PG8_SB(1, 0), b3, voffB);
            PG8_BAR; PG8_WAIT_L(0); PG8_MMA(0, 1, At, B1); PG8_BAR;
            PG8_LDA(At, 1, 1); PG8_STAGE(PG8_SA(1, 0), a3, voffA);
            PG8_BAR; PG8_WAIT_L(0); PG8_MMA(1, 0, At, B0); PG8_BAR; PG8_SCHED;
            PG8_STAGE(PG8_SB(1, 1), b3 + hstep, voffB);
            PG8_WAIT_V(6); PG8_BAR; PG8_MMA(1, 1, At, B1); PG8_BAR;
            }
        }
        if constexpr (ALIGN_EPI) { if (wr == 0) PG8_BAR; }
        if constexpr (!Epi::AFTER_DRAIN) { E(acc, cur, wr, wc, fr, fq); S.done(cur); }
        if (!has_next) break;
#pragma unroll
        for (int a = 0; a < 2; ++a)
#pragma unroll
            for (int b = 0; b < 2; ++b)
#pragma unroll
                for (int m = 0; m < 4; ++m)
#pragma unroll
                    for (int n = 0; n < 2; ++n) acc[a][b][m][n] = (f32x4){0.f, 0.f, 0.f, 0.f};
        cur = nxt; cA = nA; cB = nB; ++ui; vA0[0] = nvA0[0]; vA0[1] = nvA0[1]; vA1[0] = nvA1[0]; vA1[1] = nvA1[1];
        if constexpr (ALIGN_EPI) { if (wr == 1) PG8_BAR; }
    }
    PG8_WAIT_V(0);
    if constexpr (!ALIGN_EPI) { if (wr == 0) PG8_BAR; }
    PG8_BAR;
    if constexpr (Epi::AFTER_DRAIN) { E.fused(acc, cur, wr, wc, fr, fq, lds, wid, lane); S.done(cur); }
#undef PG8_GOFF
#undef PG8_SA
#undef PG8_SB
#undef PG8_STAGE
#undef PG8_LDA
#undef PG8_LDB
#undef PG8_MMA
#undef PG8_WAIT_V
#undef PG8_WAIT_L
#undef PG8_BAR
#undef PG8_SCHED
}
}
namespace pg8 {
struct EpiBf16P {
    static constexpr bool PERM = true, AFTER_DRAIN = false;
    bf16_t* O; int ldc;
    __device__ __forceinline__ void operator()(const f32x4 (&acc)[2][2][4][2], const Unit& u, int wr, int wc, int fr, int fq) const {
        const int row0 = u.pm * BM + wr * 64 + fr, col0 = u.pn * BM + wc * 32 + 8 * fq;
#pragma unroll
        for (int ai = 0; ai < 2; ++ai)
#pragma unroll
            for (int m = 0; m < 4; ++m) { bf16_t* rowp = O + (size_t)(row0 + ai * HALF + m * 16) * ldc + col0;
#pragma unroll
                for (int bj = 0; bj < 2; ++bj) { const f32x4 v0 = acc[ai][bj][m][0], v1 = acc[ai][bj][m][1];
                    u32x4 w; w.x = cvt_pk_bf16(v0[0], v0[1]); w.y = cvt_pk_bf16(v0[2], v0[3]); w.z = cvt_pk_bf16(v1[0], v1[1]); w.w = cvt_pk_bf16(v1[2], v1[3]);
                    *(u32x4*)(rowp + bj * HALF) = w; } }
    }
};
struct EpiWin {
    static constexpr bool PERM = true, AFTER_DRAIN = false;
    bf16_t* O; float* ps; float* kper; const float* gk; const float* rtab;
    __device__ __forceinline__ void operator()(const f32x4 (&acc)[2][2][4][2], const Unit& u, int wr, int wc, int fr, int fq) const {
        const int row0 = u.pm * BM + wr * 64 + fr, col0 = u.pn * BM + wc * 32 + 8 * fq;
#pragma unroll
        for (int ai = 0; ai < 2; ++ai)
#pragma unroll
            for (int m = 0; m < 4; ++m) { const int row = row0 + ai * HALF + m * 16; bf16_t* rowp = O + (size_t)row * 1280 + col0;
                float s = 0.f;
#pragma unroll
                for (int bj = 0; bj < 2; ++bj) { const f32x4 v0 = acc[ai][bj][m][0], v1 = acc[ai][bj][m][1];
                    s += ((v0[0] * v0[0] + v0[1] * v0[1]) + (v0[2] * v0[2] + v0[3] * v0[3])) + ((v1[0] * v1[0] + v1[1] * v1[1]) + (v1[2] * v1[2] + v1[3] * v1[3]));
                    u32x4 w; w.x = cvt_pk_bf16(v0[0], v0[1]); w.y = cvt_pk_bf16(v0[2], v0[3]); w.z = cvt_pk_bf16(v1[0], v1[1]); w.w = cvt_pk_bf16(v1[2], v1[3]);
                    *(u32x4*)(rowp + bj * HALF) = w; }
                s += __shfl_xor(s, 16); s += __shfl_xor(s, 32);
                if (fq == 0) ps[(size_t)row * 20 + u.pn * 4 + wc] = s; }
        if (u.pn == 4 && wc < 2) {
            const int D0 = wc * 32 + 8 * fq, jt = 8 * (fq & 1); const bool second = (fq & 2) != 0;
            const f32x4 g0 = *(const f32x4*)(gk + 128 + D0), g1 = *(const f32x4*)(gk + 128 + D0 + 4);
#pragma unroll
            for (int ai = 0; ai < 2; ++ai)
#pragma unroll
                for (int m = 0; m < 4; ++m) { const int row = row0 + ai * HALF + m * 16;
                    f32x4 x0 = acc[ai][0][m][0] * g0, x1 = acc[ai][0][m][1] * g1;
                    f32x4 p0, p1;
#pragma unroll
                    for (int i = 0; i < 4; ++i) { p0[i] = __shfl_xor(x0[i], 32); p1[i] = __shfl_xor(x1[i], 32); }
                    if (row < 16384) { const int pos = wc ? (row & 63) : ((row >> 6) & 255);
                        const f32x4 c0 = *(const f32x4*)(rtab + pos * 16 + jt), c1 = *(const f32x4*)(rtab + pos * 16 + jt + 4), s0 = *(const f32x4*)(rtab + 4096 + pos * 16 + jt), s1 = *(const f32x4*)(rtab + 4096 + pos * 16 + jt + 4);
                        x0 = second ? (x0 * c0 + p0 * s0) : (x0 * c0 - p0 * s0); x1 = second ? (x1 * c1 + p1 * s1) : (x1 * c1 - p1 * s1); }
                    *(f32x4*)(kper + (size_t)row * 64 + D0) = x0; *(f32x4*)(kper + (size_t)row * 64 + D0 + 4) = x1; }
        }
    }
};
struct EpiQkvNorm {
    static constexpr bool PERM = true, AFTER_DRAIN = false;
    bf16_t* O; const float* gq; const float* gk; PG8_LAS float* part;
    __device__ __forceinline__ void operator()(const f32x4 (&acc_in)[2][2][4][2], const Unit& u, int wr, int wc, int fr, int fq) const {
        const int row0 = u.pm * BM + wr * 64 + fr, col0 = u.pn * BM + wc * 32 + 8 * fq;
        f32x4 acc[2][2][4][2];
#pragma unroll
        for (int ai = 0; ai < 2; ++ai)
#pragma unroll
            for (int bj = 0; bj < 2; ++bj)
#pragma unroll
                for (int m = 0; m < 4; ++m) { acc[ai][bj][m][0] = acc_in[ai][bj][m][0]; acc[ai][bj][m][1] = acc_in[ai][bj][m][1]; }
        if (u.pn < 16) {
            const float* gp = (u.pn < 8 ? gq : gk) + wc * 32 + 8 * fq;
            const f32x4 g0 = *(const f32x4*)gp, g1 = *(const f32x4*)(gp + 4);
#pragma unroll
            for (int ai = 0; ai < 2; ++ai)
#pragma unroll
                for (int bj = 0; bj < 2; ++bj)
#pragma unroll
                    for (int m = 0; m < 4; ++m) { const f32x4 v0 = acc[ai][bj][m][0], v1 = acc[ai][bj][m][1];
                        float s = ((v0[0] * v0[0] + v0[1] * v0[1]) + (v0[2] * v0[2] + v0[3] * v0[3])) + ((v1[0] * v1[0] + v1[1] * v1[1]) + (v1[2] * v1[2] + v1[3] * v1[3]));
                        s += __shfl_xor(s, 16); s += __shfl_xor(s, 32);
                        if (fq == 0) part[((ai * HALF + wr * 64 + m * 16 + fr) * 2 + bj) * 4 + wc] = s; }
            asm volatile("s_waitcnt lgkmcnt(0)" ::: "memory"); __builtin_amdgcn_s_barrier();
#pragma unroll
            for (int ai = 0; ai < 2; ++ai)
#pragma unroll
                for (int bj = 0; bj < 2; ++bj)
#pragma unroll
                    for (int m = 0; m < 4; ++m) { const f32x4 p = *(const PG8_LAS f32x4*)(part + ((ai * HALF + wr * 64 + m * 16 + fr) * 2 + bj) * 4);
                        const float rs = __builtin_amdgcn_rsqf(((p[0] + p[1]) + (p[2] + p[3])) * (1.f / 128.f) + 1e-6f);
                        acc[ai][bj][m][0] = acc[ai][bj][m][0] * rs * g0; acc[ai][bj][m][1] = acc[ai][bj][m][1] * rs * g1; }
            asm volatile("s_waitcnt lgkmcnt(0)" ::: "memory"); __builtin_amdgcn_s_barrier();
        }
#pragma unroll
        for (int ai = 0; ai < 2; ++ai)
#pragma unroll
            for (int m = 0; m < 4; ++m) { bf16_t* rowp = O + (size_t)(row0 + ai * HALF + m * 16) * 6144 + col0;
#pragma unroll
                for (int bj = 0; bj < 2; ++bj) { const f32x4 v0 = acc[ai][bj][m][0], v1 = acc[ai][bj][m][1];
                    u32x4 w; w.x = cvt_pk_bf16(v0[0], v0[1]); w.y = cvt_pk_bf16(v0[2], v0[3]); w.z = cvt_pk_bf16(v1[0], v1[1]); w.w = cvt_pk_bf16(v1[2], v1[3]);
                    *(u32x4*)(rowp + bj * HALF) = w; } }
    }
};
struct EpiKv {
    static constexpr bool PERM = true, AFTER_DRAIN = false;
    bf16_t* O; const float* gk; const float* kper; const float* ps; PG8_LAS float* part; unsigned char* vt;
    __device__ __forceinline__ void operator()(const f32x4 (&acc)[2][2][4][2], const Unit& u, int wr, int wc, int fr, int fq) const {
        const int row0 = u.pm * BM + wr * 64 + fr, h = u.pn;
        const f32x4 g0 = *(const f32x4*)(gk + wc * 32 + 8 * fq), g1 = *(const f32x4*)(gk + wc * 32 + 8 * fq + 4);
#pragma unroll
        for (int ai = 0; ai < 2; ++ai)
#pragma unroll
            for (int m = 0; m < 4; ++m) { const f32x4 v0 = acc[ai][0][m][0], v1 = acc[ai][0][m][1];
                float s = ((v0[0] * v0[0] + v0[1] * v0[1]) + (v0[2] * v0[2] + v0[3] * v0[3])) + ((v1[0] * v1[0] + v1[1] * v1[1]) + (v1[2] * v1[2] + v1[3] * v1[3]));
                s += __shfl_xor(s, 16); s += __shfl_xor(s, 32);
                if (fq == 0) part[(ai * HALF + wr * 64 + m * 16 + fr) * 4 + wc] = s; }
        asm volatile("s_waitcnt lgkmcnt(0)" ::: "memory"); __builtin_amdgcn_s_barrier();
        float rkv_[2][4];
#pragma unroll
        for (int ai = 0; ai < 2; ++ai)
#pragma unroll
            for (int m = 0; m < 4; ++m) { const int row = row0 + ai * HALF + m * 16;
                const f32x4 p = *(const PG8_LAS f32x4*)(part + (ai * HALF + wr * 64 + m * 16 + fr) * 4);
                const f32x4 q2 = *(const f32x4*)(ps + (size_t)row * 20 + 8), q3 = *(const f32x4*)(ps + (size_t)row * 20 + 12), q4 = *(const f32x4*)(ps + (size_t)row * 20 + 16);
                const float rkv = __builtin_amdgcn_rsqf((((q2[0] + q2[1]) + (q2[2] + q2[3])) + ((q3[0] + q3[1]) + (q3[2] + q3[3]))) * (1.f / 512.f) + 1e-6f);
                rkv_[ai][m] = rkv;
                const float rs = __builtin_amdgcn_rsqf((((p[0] + p[1]) + (p[2] + p[3])) * (rkv * rkv) + ((q4[0] + q4[1]) + (q4[2] + q4[3]))) * (1.f / 192.f) + 1e-6f) * 0.32267250623034593f;
                const float rsn = rs * rkv;
                unsigned char* slot = (unsigned char*)O + (size_t)row * 8192 + h * 512;
                const f32x4 v0 = acc[ai][0][m][0] * rsn * g0, v1 = acc[ai][0][m][1] * rsn * g1;
                int w0 = 0, w1 = 0;
                w0 = __builtin_amdgcn_cvt_pk_fp8_f32(v0[0], v0[1], w0, false); w0 = __builtin_amdgcn_cvt_pk_fp8_f32(v0[2], v0[3], w0, true);
                w1 = __builtin_amdgcn_cvt_pk_fp8_f32(v1[0], v1[1], w1, false); w1 = __builtin_amdgcn_cvt_pk_fp8_f32(v1[2], v1[3], w1, true);
                u32x2 kw; kw.x = (unsigned)w0; kw.y = (unsigned)w1; *(u32x2*)(slot + wc * 32 + 8 * fq) = kw;
                const f32x4 r4 = *(const f32x4*)(kper + (size_t)row * 64 + wc * 16 + 4 * fq) * rs;
                int w2 = 0; w2 = __builtin_amdgcn_cvt_pk_fp8_f32(r4[0], r4[1], w2, false); w2 = __builtin_amdgcn_cvt_pk_fp8_f32(r4[2], r4[3], w2, true);
                *(unsigned*)(slot + 128 + wc * 16 + 4 * fq) = (unsigned)w2;
            }
        asm volatile("s_waitcnt lgkmcnt(0)" ::: "memory"); __builtin_amdgcn_s_barrier();
        const int mq = fr & 3, aq = fr >> 2;
        const unsigned sel01 = (unsigned)mq | ((unsigned)(4 + mq) << 8);
        const int sd = 8 * (aq & 1) + 4 * (mq >> 1) + 2 * (mq & 1) + (aq >> 1);
#pragma unroll
        for (int ai = 0; ai < 2; ++ai) {
            unsigned char* tile = vt + ((size_t)h * (16640 / 64) + (size_t)(u.pm * 4 + ai * 2 + wr)) * 8192 + (size_t)(wc * 32 + 8 * fq) * 64 + 4 * sd;
#pragma unroll
            for (int j = 0; j < 8; ++j) {
                int L = 0;
                L = __builtin_amdgcn_cvt_pk_fp8_f32(acc[ai][1][0][j >> 2][j & 3] * rkv_[ai][0], acc[ai][1][1][j >> 2][j & 3] * rkv_[ai][1], L, false);
                L = __builtin_amdgcn_cvt_pk_fp8_f32(acc[ai][1][2][j >> 2][j & 3] * rkv_[ai][2], acc[ai][1][3][j >> 2][j & 3] * rkv_[ai][3], L, true);
                const unsigned x0 = (unsigned)__builtin_amdgcn_mov_dpp(L, 0x00, 0xf, 0xf, false), x1 = (unsigned)__builtin_amdgcn_mov_dpp(L, 0x55, 0xf, 0xf, false);
                const unsigned x2 = (unsigned)__builtin_amdgcn_mov_dpp(L, 0xAA, 0xf, 0xf, false), x3 = (unsigned)__builtin_amdgcn_mov_dpp(L, 0xFF, 0xf, 0xf, false);
                const unsigned t01 = __builtin_amdgcn_perm(x1, x0, sel01), t23 = __builtin_amdgcn_perm(x3, x2, sel01);
                *(unsigned*)(tile + j * 64) = __builtin_amdgcn_perm(t23, t01, 0x05040100u);
            }
        }
    }
};
struct EpiRes {
    static constexpr bool PERM = false, AFTER_DRAIN = false;
    float* out; const float* res_lat; const float* res_ctx; const float* g_lat; const float* g_ctx;
    __device__ __forceinline__ void operator()(const f32x4 (&acc)[2][2][4][2], const Unit& u, int wr, int wc, int fr, int fq) const {
        const bool isctx = (u.pm >= 64);
        const int row0 = u.pm * BM + wr * 64 + fr, col0 = u.pn * BM + wc * 32 + 4 * fq;
        const float* res = isctx ? res_ctx : res_lat; const float* gv = isctx ? g_ctx : g_lat; const int rsub = isctx ? 16384 : 0;
        f32x4 g4[2][2];
#pragma unroll
        for (int bj = 0; bj < 2; ++bj)
#pragma unroll
            for (int n = 0; n < 2; ++n) g4[bj][n] = *(const f32x4*)(gv + col0 + bj * HALF + n * 16);
#pragma unroll
        for (int ai = 0; ai < 2; ++ai)
#pragma unroll
            for (int m = 0; m < 4; ++m) { const int row = row0 + ai * HALF + m * 16; float* op = out + (size_t)row * 2048 + col0; const float* rp = res + (size_t)(row - rsub) * 2048 + col0;
#pragma unroll
                for (int bj = 0; bj < 2; ++bj)
#pragma unroll
                    for (int n = 0; n < 2; ++n) { const f32x4 r = *(const f32x4*)(rp + bj * HALF + n * 16); *(f32x4*)(op + bj * HALF + n * 16) = r + g4[bj][n] * acc[ai][bj][m][n]; } }
    }
};
template <bool RESB>
struct EpiResB {
    static constexpr bool PERM = true, AFTER_DRAIN = false;
    bf16_t* out; const void* res_lat; const void* res_ctx; const float* g_lat; const float* g_ctx;
    __device__ __forceinline__ void operator()(const f32x4 (&acc)[2][2][4][2], const Unit& u, int wr, int wc, int fr, int fq) const {
        const bool isctx = (u.pm >= 64);
        const int row0 = u.pm * BM + wr * 64 + fr, col0 = u.pn * BM + wc * 32 + 8 * fq;
        const void* res = isctx ? res_ctx : res_lat; const float* gv = isctx ? g_ctx : g_lat; const int rsub = (!RESB && isctx) ? 16384 : 0;
        f32x4 g4[2][2];
#pragma unroll
        for (int bj = 0; bj < 2; ++bj)
#pragma unroll
            for (int n = 0; n < 2; ++n) g4[bj][n] = *(const f32x4*)(gv + col0 + bj * HALF + n * 4);
#pragma unroll
        for (int ai = 0; ai < 2; ++ai)
#pragma unroll
            for (int m = 0; m < 4; ++m) { const int row = row0 + ai * HALF + m * 16; bf16_t* op = out + (size_t)row * 2048 + col0;
#pragma unroll
                for (int bj = 0; bj < 2; ++bj) { f32x4 r0, r1;
                    if constexpr (RESB) { const u32x4 w = *(const u32x4*)((const bf16_t*)res + (size_t)row * 2048 + col0 + bj * HALF);
                        r0 = (f32x4){__uint_as_float(w.x << 16), __uint_as_float(w.x & 0xffff0000u), __uint_as_float(w.y << 16), __uint_as_float(w.y & 0xffff0000u)};
                        r1 = (f32x4){__uint_as_float(w.z << 16), __uint_as_float(w.z & 0xffff0000u), __uint_as_float(w.w << 16), __uint_as_float(w.w & 0xffff0000u)}; }
                    else { const float* rp = (const float*)res + (size_t)(row - rsub) * 2048 + col0 + bj * HALF; r0 = *(const f32x4*)rp; r1 = *(const f32x4*)(rp + 4); }
                    const f32x4 v0 = r0 + g4[bj][0] * acc[ai][bj][m][0], v1 = r1 + g4[bj][1] * acc[ai][bj][m][1];
                    u32x4 w; w.x = cvt_pk_bf16(v0[0], v0[1]); w.y = cvt_pk_bf16(v0[2], v0[3]); w.z = cvt_pk_bf16(v1[0], v1[1]); w.w = cvt_pk_bf16(v1[2], v1[3]);
                    *(u32x4*)(op + bj * HALF) = w; } }
    }
};
struct EpiSwiGLU {
    static constexpr bool PERM = true, AFTER_DRAIN = false;
    bf16_t* H;
    __device__ __forceinline__ void operator()(const f32x4 (&acc)[2][2][4][2], const Unit& u, int wr, int wc, int fr, int fq) const {
        const int e = u.pm / 9, nl = u.pn - e * 11;
        const int row0 = u.pm * BM + wr * 64 + fr, col0 = nl * 128 + wc * 32 + 8 * fq;
#pragma unroll
        for (int ai = 0; ai < 2; ++ai)
#pragma unroll
            for (int m = 0; m < 4; ++m) { bf16_t* rowp = H + (size_t)(row0 + ai * HALF + m * 16) * 1408 + col0;
                float hv[8];
#pragma unroll
                for (int n = 0; n < 2; ++n)
#pragma unroll
                    for (int i = 0; i < 4; ++i) { const float g = acc[ai][0][m][n][i], up = acc[ai][1][m][n][i];
                        const float s = g * __builtin_amdgcn_rcpf(1.f + __builtin_amdgcn_exp2f(-1.4426950408889634f * g)); hv[n * 4 + i] = s * up; }
                u32x4 w; w.x = cvt_pk_bf16(hv[0], hv[1]); w.y = cvt_pk_bf16(hv[2], hv[3]); w.z = cvt_pk_bf16(hv[4], hv[5]); w.w = cvt_pk_bf16(hv[6], hv[7]);
                *(u32x4*)rowp = w; }
    }
};
struct EpiDown {
    static constexpr bool PERM = true, AFTER_DRAIN = false;
    bf16_t* Y; const float* gate;
    __device__ __forceinline__ void operator()(const f32x4 (&acc)[2][2][4][2], const Unit& u, int wr, int wc, int fr, int fq) const {
        const int e = u.pm / 9, nl = u.pn - e * 8;
        const int row0 = u.pm * BM + wr * 64 + fr, col0 = nl * BM + wc * 32 + 8 * fq;
#pragma unroll
        for (int ai = 0; ai < 2; ++ai)
#pragma unroll
            for (int m = 0; m < 4; ++m) { const int row = row0 + ai * HALF + m * 16; const float gt = gate[row]; bf16_t* rowp = Y + (size_t)row * 2048 + col0;
#pragma unroll
                for (int bj = 0; bj < 2; ++bj) { const f32x4 v0 = acc[ai][bj][m][0] * gt, v1 = acc[ai][bj][m][1] * gt;
                    u32x4 w; w.x = cvt_pk_bf16(v0[0], v0[1]); w.y = cvt_pk_bf16(v0[2], v0[3]); w.z = cvt_pk_bf16(v1[0], v1[1]); w.w = cvt_pk_bf16(v1[2], v1[3]);
                    *(u32x4*)(rowp + bj * HALF) = w; } }
    }
};
struct GroupedOrder {
    int tm, tn, total, G, c;
    __device__ void init(int tm_, int tn_, int G_, int c_) { tm = tm_; tn = tn_; total = NE_ * tm_ * tn_; G = G_; c = c_; }
    static constexpr int NE_ = 16;
    __device__ bool next(int i, Unit& u) const {
        int L = i * G + c; if (L >= total) return false;
        if ((total & 7) == 0) L = (L & 7) * (total >> 3) + (L >> 3);
        const int per = tm * tn, e = L / per, r = L - e * per, pml = r / tn, pnl = r - pml * tn;
        u.pm = e * 9 + pml; u.pn = e * tn + pnl; return true;
    }
    __device__ __forceinline__ void a_ready(const Unit&) const {}
    __device__ __forceinline__ void done(const Unit&) const {}
};
}
namespace att {
constexpr int NW = 8, QBLK = 32, KVBLK = 64;
constexpr int SHM_V = 16384, SHM_KN = 16384, SHM_KP = 8192;
constexpr int OFF_V = 0, OFF_KN = 32768, OFF_KP = 65536, OFF_WS = 81920, OFF_BIAS = 83968;
constexpr int ATT_LDS = OFF_BIAS + 4096;
constexpr float THR = 8.f;
#define KSWZ(row, colB) ((row) * 256 + ((colB) ^ (((row) & 15) << 4)))
#define KPSWZ(row, colB) ((row) * 128 + ((colB) ^ ((((row) >> 1) & 7) << 4)))
#define SBAR() __builtin_amdgcn_sched_barrier(0)
__device__ __forceinline__ int crow(int r, int hi) { return (r & 3) + 8 * (r >> 2) + 4 * hi; }
__device__ __forceinline__ unsigned cvtpk_v(float lo, float hi) { unsigned r; asm volatile("v_cvt_pk_bf16_f32 %0, %1, %2" : "=v"(r) : "v"(lo), "v"(hi)); return r; }

template <int DUMMY = 0>
__device__ __forceinline__ void partialSM(f32x16& p0, f32x16& p1, float& m_reg, float& mn, float& alpha, const float C, const float thr_raw) {
    float pmax = p0[0];
#pragma unroll
    for (int r = 1; r < 16; ++r) pmax = fmaxf(pmax, p0[r]);
#pragma unroll
    for (int r = 0; r < 16; ++r) pmax = fmaxf(pmax, p1[r]);
    { auto rr = __builtin_amdgcn_permlane32_swap(__float_as_uint(pmax), __float_as_uint(pmax), false, false);
      pmax = fmaxf(__uint_as_float(rr[0]), __uint_as_float(rr[1])); }
    if (__builtin_expect(__all(pmax - m_reg <= thr_raw), 1)) { mn = m_reg; alpha = 1.f; }
    else { mn = fmaxf(m_reg, pmax); alpha = __builtin_amdgcn_exp2f((m_reg - mn) * C); m_reg = mn; }
    const float mnC = -mn * C;
#pragma unroll
    for (int r = 0; r < 16; ++r) p0[r] = fmaf(p0[r], C, mnC);
#pragma unroll
    for (int r = 0; r < 16; ++r) p1[r] = fmaf(p1[r], C, mnC);
#pragma unroll
    for (int r = 0; r < 16; ++r) p0[r] = __builtin_amdgcn_exp2f(p0[r]);
}
__device__ __forceinline__ void sm_static(f32x16& p0, f32x16& p1, const float C, const float negm) {
#pragma unroll
    for (int r = 0; r < 16; ++r) p0[r] = fmaf(p0[r], C, negm);
#pragma unroll
    for (int r = 0; r < 16; ++r) p1[r] = fmaf(p1[r], C, negm);
#pragma unroll
    for (int r = 0; r < 16; ++r) p0[r] = __builtin_amdgcn_exp2f(p0[r]);
}
__device__ __forceinline__ void partialSM_na(f32x16& p0, f32x16& p1, float& m_reg, float& mn, float& alpha, const float C, int kr, int qrow, int rs, int lb, int lm, int lb2, const LAS float* btab) {
    const bool isctx = (kr == -1), rowok = (kr >= rs) && (kr < rs + 8);
    const int vm0 = isctx ? -1 : (rowok ? lm : 0), vm1 = isctx ? -1 : (rowok ? lb2 : 0);
    const LAS float* brow = (isctx || !rowok) ? (btab + 600) : (btab + (kr - qrow + 7) * 31 + lb);
    constexpr unsigned NEGB = 0xff61b1e6u;
#define NA_GRP(P, VM, R0, KOFF) do { _Pragma("unroll") for (int r = R0; r < R0 + 8; ++r) { const int kc0 = (r & 3) + 8 * (r >> 2); \
        const unsigned v_ = (unsigned)__builtin_amdgcn_sbfe(VM, kc0, 1);     \
        unsigned bm_; asm("v_bfi_b32 %0, %1, %2, %3" : "=v"(bm_) : "v"(v_), "v"(brow[kc0 + KOFF]), "v"(NEGB));       \
        P[r] = fmaf(P[r], C, __uint_as_float(bm_)); } SBAR(); } while (0)
    NA_GRP(p0, vm0, 0, 0); NA_GRP(p0, vm0, 8, 0); NA_GRP(p1, vm1, 0, 32); NA_GRP(p1, vm1, 8, 32);
#undef NA_GRP
    float pmax = p0[0];
#pragma unroll
    for (int r = 1; r < 16; ++r) pmax = fmaxf(pmax, p0[r]);
#pragma unroll
    for (int r = 0; r < 16; ++r) pmax = fmaxf(pmax, p1[r]);
    { auto rr = __builtin_amdgcn_permlane32_swap(__float_as_uint(pmax), __float_as_uint(pmax), false, false);
      pmax = fmaxf(__uint_as_float(rr[0]), __uint_as_float(rr[1])); }
    if (__builtin_expect(__all(pmax - m_reg <= THR * LOG2E), 1)) { mn = m_reg; alpha = 1.f; }
    else { mn = fmaxf(m_reg, pmax); alpha = __builtin_amdgcn_exp2f(m_reg - mn); m_reg = mn; }
    p0 = p0 - mn; p1 = p1 - mn;
#pragma unroll
    for (int r = 0; r < 16; ++r) p0[r] = __builtin_amdgcn_exp2f(p0[r]);
}
__device__ __forceinline__ void finishSM(f32x16& p0, f32x16& p1, float alpha, float& l_reg, bf16x8& pa0, bf16x8& pa1, bf16x8& pa2, bf16x8& pa3) {
#pragma unroll
    for (int r = 0; r < 16; ++r) p1[r] = __builtin_amdgcn_exp2f(p1[r]);
    f32x2 ps2 = {0.f, 0.f};
#pragma unroll
    for (int r = 0; r < 16; r += 2) { ps2 += (f32x2){p0[r], p0[r + 1]}; ps2 += (f32x2){p1[r], p1[r + 1]}; }
    float ps = ps2.x + ps2.y;
    { auto rr = __builtin_amdgcn_permlane32_swap(__float_as_uint(ps), __float_as_uint(ps), false, false);
      ps = __uint_as_float(rr[0]) + __uint_as_float(rr[1]); }
    l_reg = l_reg * alpha + ps;
#define PK4(P, BASE, OUT) do { unsigned a0 = cvtpk_v(P[BASE + 0], P[BASE + 1]), a1 = cvtpk_v(P[BASE + 2], P[BASE + 3]);   \
    unsigned b0 = cvtpk_v(P[BASE + 4], P[BASE + 5]), b1 = cvtpk_v(P[BASE + 6], P[BASE + 7]);                              \
    auto r0 = __builtin_amdgcn_permlane32_swap(a0, b0, false, false); auto r1 = __builtin_amdgcn_permlane32_swap(a1, b1, false, false); \
    u32x4 w = {r0[0], r1[0], r0[1], r1[1]}; OUT = __builtin_bit_cast(bf16x8, w); } while (0)
    PK4(p0, 0, pa0); PK4(p0, 8, pa1); PK4(p1, 0, pa2); PK4(p1, 8, pa3);
#undef PK4
}
#ifndef ATT_PRIO
#define ATT_PRIO 0
#endif
template <int NPE>
__device__ __forceinline__ void qkt(f32x16& p0, f32x16& p1, const LAS char* Kn, const LAS char* Kp, const bf16x8* qr, int r32, int hi) {
    p0 = f32x16{}; p1 = f32x16{};
#if ATT_PRIO
    __builtin_amdgcn_s_setprio(1);
#endif
#pragma unroll
    for (int d0 = 0; d0 < 8; ++d0) { const int cb = (d0 * 16 + hi * 8) * 2;
        const bf16x8 b0 = *(const LAS bf16x8*)(Kn + KSWZ(r32, cb));
        const bf16x8 b1 = *(const LAS bf16x8*)(Kn + KSWZ(32 + r32, cb));
        p0 = __builtin_amdgcn_mfma_f32_32x32x16_bf16(b0, qr[d0], p0, 0, 0, 0);
        p1 = __builtin_amdgcn_mfma_f32_32x32x16_bf16(b1, qr[d0], p1, 0, 0, 0); }
#pragma unroll
    for (int d0 = 0; d0 < NPE; ++d0) { const int cb = (d0 * 16 + hi * 8) * 2;
        const bf16x8 b0 = *(const LAS bf16x8*)(Kp + KPSWZ(r32, cb));
        const bf16x8 b1 = *(const LAS bf16x8*)(Kp + KPSWZ(32 + r32, cb));
        p0 = __builtin_amdgcn_mfma_f32_32x32x16_bf16(b0, qr[8 + d0], p0, 0, 0, 0);
        p1 = __builtin_amdgcn_mfma_f32_32x32x16_bf16(b1, qr[8 + d0], p1, 0, 0, 0); }
#if ATT_PRIO
    __builtin_amdgcn_s_setprio(0);
#endif
}
__device__ __forceinline__ int v_st(int k, int c) { const int kk = (k & ~0xC) | ((k & 4) << 1) | ((k & 8) >> 1); return ((kk >> 3) * 4 + (c >> 5)) * 512 + ((kk & 7) * 32 + (c & 31)) * 2; }
__device__ __forceinline__ int v_rd_base(int lane) { return ((lane & 3) << 3) | (((lane >> 2) & 3) << 6) | (((lane >> 4) & 1) << 5) | (((lane >> 5) & 1) << 8); }
constexpr int v_rd_off(int d0, int ks, int half) { return d0 * 512 + ks * 4096 + half * 2048; }
typedef short v4i16_t __attribute__((ext_vector_type(4)));
#ifndef PV_ASM
#define PV_ASM 0
#endif
#if PV_ASM
template <int OFF> __device__ __forceinline__ s16x4 tr_read(int vb) {
    s16x4 r; asm volatile("ds_read_b64_tr_b16 %0, %1 offset:%2" : "=&v"(r) : "v"(vb), "i"(OFF) : "memory"); return r;
}
#else
template <int OFF> __device__ __forceinline__ s16x4 tr_read(int vb) {
    return __builtin_bit_cast(s16x4, __builtin_amdgcn_ds_read_tr16_b64_v4i16((LAS v4i16_t*)(unsigned)(vb + OFF)));
}
#endif
template <int D0> __device__ __forceinline__ void pv_one(f32x16& od, int vb, bf16x8 pa0, bf16x8 pa1, bf16x8 pa2, bf16x8 pa3) {
    const s16x4 l0 = tr_read<v_rd_off(D0, 0, 0)>(vb), h0 = tr_read<v_rd_off(D0, 0, 1)>(vb), l1 = tr_read<v_rd_off(D0, 1, 0)>(vb), h1 = tr_read<v_rd_off(D0, 1, 1)>(vb);
    const s16x4 l2 = tr_read<v_rd_off(D0, 2, 0)>(vb), h2 = tr_read<v_rd_off(D0, 2, 1)>(vb), l3 = tr_read<v_rd_off(D0, 3, 0)>(vb), h3 = tr_read<v_rd_off(D0, 3, 1)>(vb);
#if PV_ASM
    asm volatile("s_waitcnt lgkmcnt(0)" ::: "memory"); SBAR();
#endif
#define PK(L, H) (bf16x8){L[0], L[1], L[2], L[3], H[0], H[1], H[2], H[3]}
#if ATT_PRIO
    __builtin_amdgcn_s_setprio(1);
#endif
    od = __builtin_amdgcn_mfma_f32_32x32x16_bf16(pa0, PK(l0, h0), od, 0, 0, 0);
    od = __builtin_amdgcn_mfma_f32_32x32x16_bf16(pa1, PK(l1, h1), od, 0, 0, 0);
    od = __builtin_amdgcn_mfma_f32_32x32x16_bf16(pa2, PK(l2, h2), od, 0, 0, 0);
    od = __builtin_amdgcn_mfma_f32_32x32x16_bf16(pa3, PK(l3, h3), od, 0, 0, 0);
#if ATT_PRIO
    __builtin_amdgcn_s_setprio(0);
#endif
#undef PK
}
__device__ __forceinline__ void pv_d0(f32x16* o, int vb, bf16x8 pa0, bf16x8 pa1, bf16x8 pa2, bf16x8 pa3) {
    pv_one<0>(o[0], vb, pa0, pa1, pa2, pa3); pv_one<1>(o[1], vb, pa0, pa1, pa2, pa3); pv_one<2>(o[2], vb, pa0, pa1, pa2, pa3); pv_one<3>(o[3], vb, pa0, pa1, pa2, pa3);
}

#define RESC(a) do { if (__any((a) < 1.f)) { if (hi == 0) al_l[r32] = (a); asm volatile("s_waitcnt lgkmcnt(0)" ::: "memory"); \
    _Pragma("unroll") for (int d = 0; d < 4; ++d) _Pragma("unroll") for (int r = 0; r < 16; ++r) o[d][r] *= al_l[crow(r, hi)]; } } while (0)

typedef int v8i __attribute__((ext_vector_type(8)));
constexpr int KPITCH = 208, VPITCH = 80, MSLOT = 23552, M_KN = 0, M_VT = 13312, M_WS = 122880;
static_assert(64 * KPITCH == M_VT && M_VT + 128 * VPITCH == MSLOT && 5 * MSLOT <= M_WS, "MLA slot layout");
__device__ __forceinline__ void glds16(const void* gsrc, unsigned lds_dst) { unsigned keep;
    asm volatile("s_mov_b32 %0, m0\n\ts_mov_b32 m0, %2\n\ts_nop 0\n\tglobal_load_lds_dwordx4 %1, off\n\ts_mov_b32 m0, %0" : "=&s"(keep) : "v"(gsrc), "s"(lds_dst) : "memory"); }
__device__ __forceinline__ void glds16s(const void* sbase, unsigned voff, unsigned lds_dst) { unsigned keep;
    asm volatile("s_mov_b32 %0, m0\n\ts_mov_b32 m0, %3\n\ts_nop 0\n\tglobal_load_lds_dwordx4 %1, %2\n\ts_mov_b32 m0, %0" : "=&s"(keep) : "v"(voff), "s"(sbase), "s"(lds_dst) : "memory"); }
#define WAIT_BAR0() asm volatile("s_waitcnt vmcnt(0) lgkmcnt(0)\n\ts_barrier" ::: "memory")
__device__ __forceinline__ void qkt8(f32x16& p0, f32x16& p1, const f32x16& bias, const LAS char* Kl, const v8i* q8) {
#pragma unroll
    for (int ks = 0; ks < 3; ++ks) {
        const u32x4 a0 = *(const LAS u32x4*)(Kl + 64 * ks), a1 = *(const LAS u32x4*)(Kl + 64 * ks + 16);
        const u32x4 b0 = *(const LAS u32x4*)(Kl + 32 * KPITCH + 64 * ks), b1 = *(const LAS u32x4*)(Kl + 32 * KPITCH + 64 * ks + 16);
        const v8i ka = {(int)a0.x, (int)a0.y, (int)a0.z, (int)a0.w, (int)a1.x, (int)a1.y, (int)a1.z, (int)a1.w};
        const v8i kb = {(int)b0.x, (int)b0.y, (int)b0.z, (int)b0.w, (int)b1.x, (int)b1.y, (int)b1.z, (int)b1.w};
        p0 = __builtin_amdgcn_mfma_scale_f32_32x32x64_f8f6f4(ka, q8[ks], ks ? p0 : bias, 0, 0, 0, 0, 0, 0);
        p1 = __builtin_amdgcn_mfma_scale_f32_32x32x64_f8f6f4(kb, q8[ks], ks ? p1 : bias, 0, 0, 0, 0, 0, 0); }
}
__device__ __forceinline__ float vmax2(float a, float b) { float d; asm("v_max_f32 %0, %1, %2" : "=v"(d) : "v"(a), "v"(b)); return d; }
template <bool FIRST>
__device__ __forceinline__ void sm8_a(f32x16& p0, f32x16& p1, f32x16& bias, f32x16* o, LAS float* al_l, int r32, int hi) {
    float xm = __builtin_fmaxf(__builtin_fmaxf(p0[0], p0[1]), p1[0]), xn = __builtin_fmaxf(__builtin_fmaxf(p0[2], p0[3]), p1[1]);
    xm = __builtin_fmaxf(__builtin_fmaxf(xm, p1[2]), p1[3]);
#pragma unroll
    for (int r = 4; r < 16; r += 4) { xm = __builtin_fmaxf(__builtin_fmaxf(xm, p0[r]), p0[r + 1]); xn = __builtin_fmaxf(__builtin_fmaxf(xn, p0[r + 2]), p0[r + 3]);
        xm = __builtin_fmaxf(__builtin_fmaxf(xm, p1[r]), p1[r + 1]); xn = __builtin_fmaxf(__builtin_fmaxf(xn, p1[r + 2]), p1[r + 3]); }
    xm = __builtin_fmaxf(xm, xn);
    { auto rr = __builtin_amdgcn_permlane32_swap(__float_as_uint(xm), __float_as_uint(xm), false, false);
      xm = vmax2(__uint_as_float(rr[0]), __uint_as_float(rr[1])); }
    if (FIRST || !__builtin_expect(__all(xm <= 8.5f), 1)) {
        const float dl = FIRST ? xm - 7.f : fmaxf(xm - 7.f, 0.f);
#pragma unroll
        for (int r = 0; r < 16; ++r) { bias[r] -= dl; p0[r] -= dl; p1[r] -= dl; }
        if (!FIRST) {
            if (hi == 0) al_l[r32] = __builtin_amdgcn_exp2f(-dl);
            asm volatile("s_waitcnt lgkmcnt(0)" ::: "memory");
#pragma unroll
            for (int d = 0; d < 5; ++d)
#pragma unroll
                for (int r = 0; r < 16; ++r) o[d][r] *= al_l[crow(r, hi)];
        }
    }
    asm volatile("" : "+v"(bias));
}
__device__ __forceinline__ void sm8_b(f32x16& p0, f32x16& p1, v8i& pa) {
#pragma unroll
    for (int r = 0; r < 16; ++r) p0[r] = __builtin_amdgcn_exp2f(p0[r]);
#pragma unroll
    for (int r = 0; r < 16; ++r) p1[r] = __builtin_amdgcn_exp2f(p1[r]);
#pragma unroll
    for (int w = 0; w < 4; ++w) { int x = pa[w]; x = __builtin_amdgcn_cvt_pk_fp8_f32(p0[4 * w], p0[4 * w + 1], x, false); x = __builtin_amdgcn_cvt_pk_fp8_f32(p0[4 * w + 2], p0[4 * w + 3], x, true); pa[w] = x; }
#pragma unroll
    for (int w = 0; w < 4; ++w) { int x = pa[4 + w]; x = __builtin_amdgcn_cvt_pk_fp8_f32(p1[4 * w], p1[4 * w + 1], x, false); x = __builtin_amdgcn_cvt_pk_fp8_f32(p1[4 * w + 2], p1[4 * w + 3], x, true); pa[4 + w] = x; }
}
__device__ __forceinline__ void pv8(f32x16* o, const LAS char* Vl, const v8i pa, const v8i ones) {
#pragma unroll
    for (int d0 = 0; d0 < 4; ++d0) { const LAS char* row = Vl + 32 * d0 * VPITCH;
        const u32x4 b0 = *(const LAS u32x4*)(row), b1 = *(const LAS u32x4*)(row + 16);
        const v8i vb = {(int)b0.x, (int)b0.y, (int)b0.z, (int)b0.w, (int)b1.x, (int)b1.y, (int)b1.z, (int)b1.w};
        o[d0] = __builtin_amdgcn_mfma_scale_f32_32x32x64_f8f6f4(pa, vb, o[d0], 0, 0, 0, 0, 0, 0); }
    o[4] = __builtin_amdgcn_mfma_scale_f32_32x32x64_f8f6f4(pa, ones, o[4], 0, 0, 0, 0, 0, 0);
}
#ifndef MLA_ALPHA
#define MLA_ALPHA 1.0f
#endif
__device__ __forceinline__ void mla_unit(const unsigned char* __restrict__ Q8, const unsigned char* __restrict__ K8, const unsigned char* __restrict__ Vt, bf16* __restrict__ Ob, int seq, LAS char* lds,
                                         const float* __restrict__ qgain, const float* __restrict__ rtab, const float* __restrict__ ps, int tok0, bool lat) {
    const int tid = ltid(), lane = tid & 63, r32 = lane & 31, hi = lane >> 5; const int wid = __builtin_amdgcn_readfirstlane(tid >> 6);
    LAS float* wsx = (LAS float*)(lds + M_WS) + wid * 64; LAS float* al_l = wsx + 32;
    unsigned d_off[3]; bool d_isk[3]; unsigned d_dst[3];
#pragma unroll
    for (int i = 0; i < 3; ++i) { int P = 3 * wid + i; if (P > 22) P = 22; d_isk[i] = P < 13; d_dst[i] = P * 1024;
        if (P < 13) { const int g = 64 * P + lane, row = g / 13, ch = g - 13 * row; d_off[i] = row * 8192 + (ch < 12 ? ch : 0) * 16; }
        else { const int g = 64 * (P - 13) + lane, d = g / 5, ch = g - 5 * d; d_off[i] = d * 64 + (ch < 4 ? ch : 0) * 16; } }
#define DMA_TILE(t, slot) do { const unsigned sb_ = (unsigned)((slot) * MSLOT); const unsigned char* kb_ = K8 + (size_t)(t) * 64 * 8192; const unsigned char* vb_ = Vt + (size_t)(t) * 8192; \
    glds16s(d_isk[0] ? kb_ : vb_, d_off[0], sb_ + d_dst[0]); glds16s(d_isk[1] ? kb_ : vb_, d_off[1], sb_ + d_dst[1]); glds16s(d_isk[2] ? kb_ : vb_, d_off[2], sb_ + d_dst[2]); } while (0)
    const int klane = r32 * KPITCH + hi * 32, vlane = M_VT + r32 * VPITCH + hi * 32;
    DMA_TILE(0, 0); DMA_TILE(1, 1);
    f32x16 o[5] = {}; v8i q8[3];
    { const unsigned char* Qw = Q8 + (size_t)(wid * QBLK + r32) * 6144 + hi * 64;
      float f[3][32];
#pragma unroll
      for (int ks = 0; ks < 3; ++ks)
#pragma unroll
          for (int c = 0; c < 4; ++c) { const u32x4 x = *(const u32x4*)(Qw + 128 * ks + 16 * c);
              f[ks][8 * c + 0] = bflo(x.x); f[ks][8 * c + 1] = bfhi(x.x); f[ks][8 * c + 2] = bflo(x.y); f[ks][8 * c + 3] = bfhi(x.y);
              f[ks][8 * c + 4] = bflo(x.z); f[ks][8 * c + 5] = bfhi(x.z); f[ks][8 * c + 6] = bflo(x.w); f[ks][8 * c + 7] = bfhi(x.w); }
      float ss = 0.f;
#pragma unroll
      for (int ks = 0; ks < 3; ++ks)
#pragma unroll
          for (int i = 0; i < 32; ++i) ss += f[ks][i] * f[ks][i];
      { auto rr = __builtin_amdgcn_permlane32_swap(__float_as_uint(ss), __float_as_uint(ss), false, false); ss = __uint_as_float(rr[0]) + __uint_as_float(rr[1]); }
      const float* psr = ps + (size_t)(tok0 + wid * QBLK + r32) * 20; const f32x4 s0 = *(const f32x4*)psr, s1 = *(const f32x4*)(psr + 4);
      const float rq = __builtin_amdgcn_rsqf((((s0[0] + s0[1]) + (s0[2] + s0[3])) + ((s1[0] + s1[1]) + (s1[2] + s1[3]))) * (1.f / 512.f) + EPS);
      const float rs = __builtin_amdgcn_rsqf(ss * (rq * rq) * (1.f / 192.f) + EPS) * rq * 0.32267250623034593f;
#pragma unroll
      for (int ks = 0; ks < 3; ++ks)
#pragma unroll
          for (int c = 0; c < 8; ++c) { const f32x4 g = *(const f32x4*)(qgain + 64 * ks + 32 * hi + 4 * c);
              f[ks][4 * c] *= rs * g.x; f[ks][4 * c + 1] *= rs * g.y; f[ks][4 * c + 2] *= rs * g.z; f[ks][4 * c + 3] *= rs * g.w; }
      if (lat) { const int t = tok0 + wid * QBLK + r32, pos = hi ? (t & 63) : ((t >> 6) & 255);
#pragma unroll
          for (int c = 0; c < 4; ++c) { const f32x4 cs = *(const f32x4*)(rtab + pos * 16 + 4 * c), sn = *(const f32x4*)(rtab + 4096 + pos * 16 + 4 * c);
#pragma unroll
              for (int i = 0; i < 4; ++i) { const float x1 = f[2][4 * c + i], x2 = f[2][16 + 4 * c + i]; f[2][4 * c + i] = x1 * cs[i] - x2 * sn[i]; f[2][16 + 4 * c + i] = x2 * cs[i] + x1 * sn[i]; } } }
#pragma unroll
      for (int ks = 0; ks < 3; ++ks)
#pragma unroll
          for (int w = 0; w < 8; ++w) { int x = 0; x = __builtin_amdgcn_cvt_pk_fp8_f32(f[ks][4 * w], f[ks][4 * w + 1], x, false); x = __builtin_amdgcn_cvt_pk_fp8_f32(f[ks][4 * w + 2], f[ks][4 * w + 3], x, true); q8[ks][w] = x; } }
    f32x16 pA0, pA1, pB0, pB1, bias = {}; v8i pa = {}; const int NT = seq / KVBLK;
    v8i ones = {0x38383838, 0x38383838, 0x38383838, 0x38383838, 0x38383838, 0x38383838, 0x38383838, 0x38383838};
    asm volatile("" : "+v"(ones));
    int sl = 0;
#define SLOT(k) ((sl + (k)) >= 5 ? (sl + (k)) - 5 : (sl + (k)))
#define KS_(k) (lds + SLOT(k) * MSLOT + klane)
#define VS_(k) (lds + SLOT(k) * MSLOT + vlane)
    if (2 < NT) DMA_TILE(2, 2);
    WAIT_BAR0();
    qkt8(pA0, pA1, bias, lds + klane, q8); sm8_a<true>(pA0, pA1, bias, o, al_l, r32, hi);
#define DSTEP(DMA_STMTS) do { \
        qkt8(pB0, pB1, bias, KS_(1), q8); \
        DMA_STMTS                                                  \
        sm8_b(pA0, pA1, pa); \
        pv8(o, VS_(0), pa, ones); sm8_a<false>(pB0, pB1, bias, o, al_l, r32, hi); \
        qkt8(pA0, pA1, bias, KS_(2), q8); sm8_b(pB0, pB1, pa); \
        pv8(o, VS_(1), pa, ones); sm8_a<false>(pA0, pA1, bias, o, al_l, r32, hi); \
        SBAR(); WAIT_BAR0(); \
        sl = SLOT(2); } while (0)
    int j = 1;
    for (; j + 3 < NT; j += 2) DSTEP(DMA_TILE(j + 2, SLOT(3)); DMA_TILE(j + 3, SLOT(4)););
    DSTEP(DMA_TILE(j + 2, SLOT(3)););
#undef DSTEP
    qkt8(pB0, pB1, bias, KS_(1), q8); sm8_b(pA0, pA1, pa);
    pv8(o, VS_(0), pa, ones); sm8_a<false>(pB0, pB1, bias, o, al_l, r32, hi);
    sm8_b(pB0, pB1, pa);
    pv8(o, VS_(1), pa, ones);
#undef SLOT
#undef KS_
#undef VS_
    float rli[16];
#pragma unroll
    for (int r = 0; r < 16; ++r) rli[r] = __builtin_amdgcn_rcpf(o[4][r]);
    bf16* Ow = Ob + (size_t)(wid * QBLK) * 2048;
#pragma unroll
    for (int r = 0; r < 16; ++r) { const int orow = crow(r, hi);
#pragma unroll
        for (int d0 = 0; d0 < 4; ++d0) Ow[(size_t)orow * 2048 + d0 * 32 + r32] = (bf16)(cvtpk_v(o[d0][r] * rli[r] * MLA_ALPHA, 0.f) & 0xffffu); }
    WAIT_BAR0();
#undef DMA_TILE
#undef ROT
}

constexpr int NSLOT_B = 32768, N_V = 0, N_K = 16384, N_BIAS = 124928;
__device__ __forceinline__ void na_unit(const bf16* __restrict__ QKV, int h, int rb, const float* __restrict__ rpb_h, bf16* __restrict__ Ob, LAS char* lds) {
    const int tid = ltid(), lane = tid & 63, r32 = lane & 31, hi = lane >> 5; const int wid = __builtin_amdgcn_readfirstlane(tid >> 6);
    LAS float* wsx = (LAS float*)(lds + M_WS) + wid * 64; LAS float* li_l = wsx; LAS float* al_l = wsx + 32;
    LAS float* btab = (LAS float*)(lds + N_BIAS) + 128;
    constexpr float C = 0.08838834764831845f * LOG2E;
    for (int i = tid; i < 15 * 31; i += 512) btab[i] = rpb_h[i] * LOG2E;
    if (tid < 64) btab[600 + tid] = 0.f;
    const int qrow = rb * 4 + (wid >> 1), qcol = (wid & 1) * 32 + r32;
    const int rs = min(max(qrow - 4, 0), 248), cs = min(max(qcol - 8, 0), 48);
    const int lb = 15 - qcol + 4 * hi;
    const unsigned long long wmask = 0xFFFFull << cs;
    const int lm = (int)(unsigned)(wmask >> (4 * hi)), lb2 = (int)(unsigned)(wmask >> (32 + 4 * hi));
    const int lo = min(max(rb * 4 - 4, 0), 248), hr = min(max(rb * 4 + 3 - 4, 0), 248) + 7, cnt = hr - lo + 1;
    const int NT = (4 + cnt + 1) & ~1;
#define TKEY0(t) ((t) < 4 ? NL + 64 * (t) : 64 * min(lo + (t) - 4, hr))
#define TKR(t) ((t) < 4 ? -1 : ((t) - 4 < cnt ? lo + (t) - 4 : -1000))
    const bf16* Kh = QKV + 2048 + h * 128; const bf16* Vh = QKV + 4096 + h * 128;
    int k_off[2], v_off[2];
#pragma unroll
    for (int i = 0; i < 2; ++i) { const int p = 2 * wid + i;
        { const int row = 4 * p + (lane >> 4), lch = (lane & 15) ^ (row & 15); k_off[i] = row * 6144 + lch * 8; }
        { const int s = 2 * p + (lane >> 5), kk = (s >> 2) * 8 + ((lane & 31) >> 2), key = (kk & ~0xC) | ((kk & 4) << 1) | ((kk & 8) >> 1), col = (s & 3) * 32 + (lane & 3) * 8; v_off[i] = key * 6144 + col; } }
#define DMA_TILE(t, slot) do { const size_t kb_ = (size_t)TKEY0(t) * 6144; const unsigned sb_ = (unsigned)((slot) * NSLOT_B); \
    glds16(Vh + kb_ + v_off[0], sb_ + N_V + (2 * wid) * 1024); glds16(Vh + kb_ + v_off[1], sb_ + N_V + (2 * wid + 1) * 1024); \
    glds16(Kh + kb_ + k_off[0], sb_ + N_K + (2 * wid) * 1024); glds16(Kh + kb_ + k_off[1], sb_ + N_K + (2 * wid + 1) * 1024); } while (0)
    DMA_TILE(0, 0); DMA_TILE(1, 1);
    float m_reg = -1e30f, l_reg = 0; f32x16 o[4] = {}; bf16x8 qr[8];
    const bf16* Qw = QKV + (size_t)(rb * 256 + wid * QBLK + r32) * 6144 + h * 128 + hi * 8;
#pragma unroll
    for (int d0 = 0; d0 < 8; ++d0) qr[d0] = *(const bf16x8*)(Qw + d0 * 16);
    const int vbl = N_V + v_rd_base(lane);
    f32x16 pA0, pA1, pB0, pB1; float mnA, mnB, alA, alB; bf16x8 pa0, pa1, pa2, pa3;
    int s_prev = 0, s_cur = 1, s_next = 2;
#define ROT() do { const int t_ = s_prev; s_prev = s_cur; s_cur = s_next; s_next = t_; } while (0)
    WAIT_BAR0();
    qkt<0>(pA0, pA1, lds + N_K, lds, qr, r32, hi); partialSM_na(pA0, pA1, m_reg, mnA, alA, C, TKR(0), qrow, rs, lb, lm, lb2, btab);
    for (int j = 1; j + 1 < NT; j += 2) {
        DMA_TILE(j + 1, s_next);
        SBAR(); qkt<0>(pB0, pB1, lds + s_cur * NSLOT_B + N_K, lds, qr, r32, hi);
        finishSM(pA0, pA1, alA, l_reg, pa0, pa1, pa2, pa3); SBAR();
        pv_d0(o, vbl + s_prev * NSLOT_B, pa0, pa1, pa2, pa3); partialSM_na(pB0, pB1, m_reg, mnB, alB, C, TKR(j), qrow, rs, lb, lm, lb2, btab);
        RESC(alB);
        WAIT_BAR0(); ROT();
        DMA_TILE(j + 2, s_next);
        SBAR(); qkt<0>(pA0, pA1, lds + s_cur * NSLOT_B + N_K, lds, qr, r32, hi);
        finishSM(pB0, pB1, alB, l_reg, pa0, pa1, pa2, pa3); SBAR();
        pv_d0(o, vbl + s_prev * NSLOT_B, pa0, pa1, pa2, pa3); partialSM_na(pA0, pA1, m_reg, mnA, alA, C, TKR(j + 1), qrow, rs, lb, lm, lb2, btab);
        RESC(alA);
        WAIT_BAR0(); ROT();
    }
    SBAR(); qkt<0>(pB0, pB1, lds + s_cur * NSLOT_B + N_K, lds, qr, r32, hi);
    finishSM(pA0, pA1, alA, l_reg, pa0, pa1, pa2, pa3); SBAR();
    pv_d0(o, vbl + s_prev * NSLOT_B, pa0, pa1, pa2, pa3); partialSM_na(pB0, pB1, m_reg, mnB, alB, C, TKR(NT - 1), qrow, rs, lb, lm, lb2, btab);
    RESC(alB);
    finishSM(pB0, pB1, alB, l_reg, pa0, pa1, pa2, pa3); SBAR();
    pv_d0(o, vbl + s_cur * NSLOT_B, pa0, pa1, pa2, pa3);
    if (hi == 0) li_l[r32] = l_reg; asm volatile("s_waitcnt lgkmcnt(0)" ::: "memory");
    float rli[16];
#pragma unroll
    for (int r = 0; r < 16; ++r) rli[r] = __builtin_amdgcn_rcpf(li_l[crow(r, hi)]);
    bf16* Ow = Ob + (size_t)(rb * 256 + wid * QBLK) * 2048 + h * 128;
#pragma unroll
    for (int r = 0; r < 16; ++r) { const int orow = crow(r, hi);
#pragma unroll
        for (int d0 = 0; d0 < 4; ++d0) Ow[(size_t)orow * 2048 + d0 * 32 + r32] = (bf16)(cvtpk_v(o[d0][r] * rli[r], 0.f) & 0xffffu); }
    WAIT_BAR0();
#undef DMA_TILE
#undef ROT
#undef TKEY0
#undef TKR
}
#undef RESC
}
namespace thin {
__device__ __constant__ float ROPE_INV[16] = {1.0f, 0.5623413251903491f, 0.31622776601683794f, 0.1778279410038923f, 0.1f, 0.05623413251903491f, 0.03162277660168379f, 0.01778279410038923f,
                                              0.01f, 0.005623413251903491f, 0.0031622776601683794f, 0.001778279410038923f, 0.001f, 0.0005623413251903491f, 0.00031622776601683794f, 0.0001778279410038923f};

__device__ __forceinline__ void tr_tile(const float* __restrict__ src, int ld_src, bf16* __restrict__ dst, int ld_dst, LAS float* T, const float* __restrict__ kgain = nullptr) {
    const int tid = ltid(), kr = tid >> 4, c4 = tid & 15;
    f32x4 v[4];
#pragma unroll
    for (int i = 0; i < 4; ++i) v[i] = *(const f32x4*)(src + (size_t)(kr + 32 * i) * ld_src + c4 * 4);
    if (kgain) {
#pragma unroll
        for (int i = 0; i < 4; ++i) v[i] = v[i] * kgain[kr + 32 * i]; }
    __syncthreads();
#pragma unroll
    for (int i = 0; i < 4; ++i) {
#pragma unroll
        for (int j = 0; j < 4; ++j) T[(c4 * 4 + j) * 129 + kr + 32 * i] = v[i][j]; }
    __syncthreads();
    const int n = tid >> 3, kc = (tid & 7) * 16; const LAS float* s = T + n * 129 + kc;
    u32x4 w0, w1;
    w0.x = cvtpk(s[0], s[1]); w0.y = cvtpk(s[2], s[3]); w0.z = cvtpk(s[4], s[5]); w0.w = cvtpk(s[6], s[7]);
    w1.x = cvtpk(s[8], s[9]); w1.y = cvtpk(s[10], s[11]); w1.z = cvtpk(s[12], s[13]); w1.w = cvtpk(s[14], s[15]);
    bf16* d = dst + (size_t)n * ld_dst + kc;
    *(u32x4*)d = w0; *(u32x4*)(d + 8) = w1;
}
__device__ __forceinline__ void tr_job(const float* src, int K, int N, bf16* dst, int t, LAS float* T, const float* kgain = nullptr) {
    const int nkt = K / 128, nt = t / nkt, kt = t - nt * nkt;
    tr_tile(src + (size_t)(kt * 128) * N + nt * 64, N, dst + (size_t)(nt * 64) * K + kt * 128, K, T, kgain ? kgain + kt * 128 : nullptr);
}

struct In {
    const float *x, *c, *ctx, *c_ctx, *ada_w, *ada_b, *norm_mix, *norm_ffn, *mla_w_in, *mla_q_a_gain, *mla_kv_a_gain, *mla_w_qb, *mla_w_kvb, *mla_q_gain, *mla_k_gain, *mla_w_o,
                *na_w_qkv, *na_q_gain, *na_k_gain, *na_rpb, *na_w_o, *router_w, *moe_w_gate, *moe_w_up, *moe_w_down;
};

constexpr int TL_GU = 16 * 2 * 352, TL_D = 16 * 352, TL_QKV = 96 * 16, TL_WO1 = 32 * 16;
constexpr int TL_E0 = TL_GU, TL_E1 = TL_E0 + TL_D, TL_E2 = TL_E1 + TL_QKV, TL_E3 = TL_E2 + TL_WO1, TL_E4 = TL_E3 + TL_GU, TL_ALL = TL_E4 + TL_D;
constexpr int LIM_MOE0 = TL_E1, LIM_NA = TL_E3, LIM_GU1 = TL_E4, LIM_ALL = TL_ALL;
__device__ __forceinline__ void late_tile(const In& in, unsigned char* ws, int t, LAS float* T) {
    int l = 0;
    if (t >= TL_E3) { t -= TL_E3; l = 1; }
    else if (t >= TL_E1) { t -= TL_E1;
        if (t < TL_QKV) tr_job(in.na_w_qkv, 2048, 6144, (bf16*)(ws + WS_WQKV_T), t, T);
        else tr_job(in.na_w_o, 2048, 2048, (bf16*)(ws + WS_WO1_T), t - TL_QKV, T);
        return; }
    if (t < TL_GU) {
        const int e = t / 704, r = t - e * 704, which = r / 352, tt = r - which * 352, nt = tt >> 4, kt = tt & 15, le = l * 16 + e;
        const float* src = (which ? in.moe_w_up : in.moe_w_gate) + (size_t)le * 2048 * FF;
        const int n0 = nt * 64, drow = (n0 >> 7) * 256 + which * 128 + (n0 & 127);
        bf16* dst = (bf16*)(ws + WS_WGU_T) + (size_t)le * 2816 * 2048;
        tr_tile(src + (size_t)(kt * 128) * FF + n0, FF, dst + (size_t)drow * 2048 + kt * 128, 2048, T);
    } else {
        t -= TL_GU; const int e = t / 352, tt = t - e * 352, le = l * 16 + e;
        tr_job(in.moe_w_down + (size_t)le * FF * 2048, FF, 2048, (bf16*)(ws + WS_WD_T) + (size_t)le * 2048 * FF, tt, T); }
}
__device__ __forceinline__ void late_work(const In& in, unsigned char* ws, LAS unsigned char* lds, int G, int phase, int limit) {
    const int tid = ltid();
    LAS float* T = (LAS float*)lds; LAS int* sh = (LAS int*)(lds + 40960);
    unsigned* work = (unsigned*)(ws + WS_CTL) + CW_WORK; unsigned* done = (unsigned*)(ws + WS_CTL) + CW_DONE + 64 * (phase < 0 ? 0 : phase);
    __syncthreads();
    if (phase >= 0 && tid == 0) __hip_atomic_fetch_add(done, 1u, __ATOMIC_RELAXED, __HIP_MEMORY_SCOPE_AGENT);
    for (;;) {
        if (tid == 0) { int t = -1;
            bool go = true;
            if (phase >= 0) go = __hip_atomic_load(done, __ATOMIC_RELAXED, __HIP_MEMORY_SCOPE_AGENT) < (unsigned)G;
            if (go) t = (int)__hip_atomic_fetch_add(work, 1u, __ATOMIC_RELAXED, __HIP_MEMORY_SCOPE_AGENT);
            sh[0] = t; }
        __syncthreads();
        const int t = sh[0];
        if (t < 0 || t >= TL_ALL) break;
        late_tile(in, ws, t, T);
        __syncthreads();
        if (phase < 0 && t >= limit) break;
    }
    __syncthreads();
}

__device__ __forceinline__ void phase_prologue(const In& in, unsigned char* ws, LAS unsigned char* lds, int G, int bid) {
    const int tid = ltid();
    {
        LAS float* sl = (LAS float*)lds; LAS float* sc_ = sl + 2048; LAS float* red = sc_ + 2048;
        for (int i = tid; i < 2048; i += 512) { const float a = in.c[i], b = in.c_ctx[i]; sl[i] = a / (1.f + __expf(-a)); sc_[i] = b / (1.f + __expf(-b)); }
        __syncthreads();
        float* mod = (float*)(ws + WS_MOD);
        for (int item = bid; item < 256; item += G) {
            const int cg = item * 96, l = cg / 12288, n0 = cg - l * 12288;
            if (tid < 384) {
                const int rl = tid / 24, c4 = tid - rl * 24;
                const float* wp = in.ada_w + ((size_t)l * 2048 + rl) * 12288 + n0 + c4 * 4;
                f32x4 al = {0.f, 0.f, 0.f, 0.f}, ac = {0.f, 0.f, 0.f, 0.f};
#pragma unroll 8
                for (int i = 0; i < 128; ++i) { const f32x4 w = *(const f32x4*)(wp + (size_t)(16 * i) * 12288); const float a = sl[rl + 16 * i], b = sc_[rl + 16 * i]; al += w * a; ac += w * b; }
                *(LAS f32x4*)(red + rl * 96 + c4 * 4) = al; *(LAS f32x4*)(red + 1536 + rl * 96 + c4 * 4) = ac;
            }
            __syncthreads();
            if (tid < 192) { const int v = tid / 96, j = tid - v * 96; float s = in.ada_b[l * 12288 + n0 + j];
#pragma unroll
                for (int k = 0; k < 16; ++k) s += red[v * 1536 + k * 96 + j];
                mod[(size_t)(l * 2 + v) * 12288 + n0 + j] = s; }
            __syncthreads();
        }
    }
    if (bid == 0) { float* gt = (float*)(ws + WS_MODP);
        for (int i = tid; i < 4096; i += 512) { const int pos = i >> 4, j = i & 15; float s, c; sincosf((float)pos * ROPE_INV[j], &s, &c); gt[i] = c; gt[4096 + i] = s; } }
    LAS float* T = (LAS float*)lds;
    constexpr int T_WIN = 17 * 16, T_QB = 48 * 4, T_KVB = 64 * 4, T_WO = 32 * 16;
    constexpr int T_ALL = T_WIN + T_QB + T_KVB + T_WO;
    bf16* win_t = (bf16*)(ws + WS_WIN_T);
    for (size_t i = (size_t)bid * 512 + tid; i < (size_t)(WIN_NP - WIN_N) * 2048 / 8; i += (size_t)G * 512) ((u32x4*)(win_t + (size_t)WIN_N * 2048))[i] = (u32x4){0u, 0u, 0u, 0u};
    for (int t0 = bid; t0 < T_ALL; t0 += G) {
        int t = t0;
        if (t < T_WIN) { tr_job(in.mla_w_in, 2048, WIN_N, win_t, t, T); continue; } t -= T_WIN;
        if (t < T_QB) { tr_job(in.mla_w_qb, 512, 3072, (bf16*)(ws + WS_WQB_T), t, T, in.mla_q_a_gain); continue; } t -= T_QB;
        if (t < T_KVB) { tr_job(in.mla_w_kvb, 512, 4096, (bf16*)(ws + WS_WKVB_T), t, T, in.mla_kv_a_gain); continue; } t -= T_KVB;
        tr_job(in.mla_w_o, 2048, 2048, (bf16*)(ws + WS_WO0_T), t, T);
    }
}
__device__ __forceinline__ const float* modv(const unsigned char* ws, int l, int v, int chunk) { return (const float*)(ws + WS_MOD) + (size_t)(l * 2 + v) * 12288 + chunk * 2048; }

__device__ __forceinline__ void norm_mod_row(f32x4 (&v)[8], const float* gain, const float* sh, const float* sc, int lane) {
    float ss = 0.f;
#pragma unroll
    for (int j = 0; j < 8; ++j) ss += (v[j].x * v[j].x + v[j].y * v[j].y) + (v[j].z * v[j].z + v[j].w * v[j].w);
    const float rs = __builtin_amdgcn_rsqf(wave_sum(ss) * (1.f / 2048.f) + EPS);
#pragma unroll
    for (int j = 0; j < 8; ++j) { const int c = 4 * (lane + 64 * j); const f32x4 g = *(const f32x4*)(gain + c), a = *(const f32x4*)(sc + c), b = *(const f32x4*)(sh + c);
        v[j] = v[j] * rs * g * (a + 1.f) + b; }
}
__device__ __forceinline__ void stage_mod_lds(LAS float* ga, LAS float* sb, const float* gain, const float* sh, const float* sc, int tid) {
    *(LAS f32x4*)(ga + 4 * tid) = *(const f32x4*)(gain + 4 * tid) * (*(const f32x4*)(sc + 4 * tid) + 1.f); *(LAS f32x4*)(sb + 4 * tid) = *(const f32x4*)(sh + 4 * tid);
}
__device__ __forceinline__ void norm_mod_row_lds(f32x4 (&v)[8], const LAS float* ga, const LAS float* sb, int lane) {
    float ss = 0.f;
#pragma unroll
    for (int j = 0; j < 8; ++j) ss += (v[j].x * v[j].x + v[j].y * v[j].y) + (v[j].z * v[j].z + v[j].w * v[j].w);
    const float rs = __builtin_amdgcn_rsqf(wave_sum(ss) * (1.f / 2048.f) + EPS);
#pragma unroll
    for (int j = 0; j < 8; ++j) { const int c = 4 * (lane + 64 * j); v[j] = v[j] * rs * *(const LAS f32x4*)(ga + c) + *(const LAS f32x4*)(sb + c); }
}
__device__ __forceinline__ f32x4 bf4(const u32x2 w) { return (f32x4){bflo(w.x), bfhi(w.x), bflo(w.y), bfhi(w.y)}; }
__device__ __forceinline__ void store_row_bf16(bf16* orow, const f32x4 (&v)[8], int lane) {
#pragma unroll
    for (int j = 0; j < 8; ++j) { u32x2 w; w.x = cvtpk(v[j].x, v[j].y); w.y = cvtpk(v[j].z, v[j].w); *(u32x2*)(orow + 4 * (lane + 64 * j)) = w; }
}
__device__ __forceinline__ void phase_norm_in(const In& in, unsigned char* ws, LAS unsigned char* lds, int G, int bid) {
    const int lane = ltid() & 63, gw = bid * 8 + (ltid() >> 6), NGW = G * 8;
    bf16* hb = (bf16*)(ws + WS_HB);
    LAS float* mv = (LAS float*)lds;
    stage_mod_lds(mv, mv + 2048, in.norm_mix, modv(ws, 0, 0, 0), modv(ws, 0, 0, 1), ltid());
    stage_mod_lds(mv + 4096, mv + 6144, in.norm_mix, modv(ws, 0, 1, 0), modv(ws, 0, 1, 1), ltid());
    __syncthreads();
    f32x4 a[8], nx[8];
#define NI_LOAD(dst, rw) do { const float* xr_ = ((rw) >= NL) ? in.ctx + (size_t)((rw) - NL) * 2048 : in.x + (size_t)(rw) * 2048; \
    _Pragma("unroll") for (int j = 0; j < 8; ++j) dst[j] = *(const f32x4*)(xr_ + 4 * (lane + 64 * j)); } while (0)
    if (gw < NTOK) NI_LOAD(a, gw);
    for (int row = gw; row < NTOK; row += NGW) {
        const int v = row >= NL;
        if (row + NGW < NTOK) NI_LOAD(nx, row + NGW);
        norm_mod_row_lds(a, mv + v * 4096, mv + v * 4096 + 2048, lane);
        store_row_bf16(hb + (size_t)row * 2048, a, lane);
#pragma unroll
        for (int j = 0; j < 8; ++j) a[j] = nx[j];
    }
#undef NI_LOAD
    __syncthreads();
}
__device__ __forceinline__ void phase_rownorm_a(const In& in, unsigned char* ws, int G, int bid) {
    const int lane = ltid() & 63, gw = bid * 8 + (ltid() >> 6), NGW = G * 8;
    const bf16* ab = (const bf16*)(ws + WS_AB); bf16* qn = (bf16*)(ws + WS_QN); bf16* kvn = (bf16*)(ws + WS_KVN);
    float gq[8], gk[8];
#pragma unroll
    for (int i = 0; i < 8; ++i) { gq[i] = in.mla_q_a_gain[lane * 8 + i]; gk[i] = in.mla_kv_a_gain[lane * 8 + i]; }
    u32x4 qn_, kn_;
    if (gw < NTOK) { qn_ = *(const u32x4*)(ab + (size_t)gw * WIN_NP + lane * 8); kn_ = *(const u32x4*)(ab + (size_t)gw * WIN_NP + 512 + lane * 8); }
    for (int row = gw; row < NTOK; row += NGW) {
        const u32x4 q = qn_, k = kn_;
        if (row + NGW < NTOK) { qn_ = *(const u32x4*)(ab + (size_t)(row + NGW) * WIN_NP + lane * 8); kn_ = *(const u32x4*)(ab + (size_t)(row + NGW) * WIN_NP + 512 + lane * 8); }
        float qf[8] = {bflo(q.x), bfhi(q.x), bflo(q.y), bfhi(q.y), bflo(q.z), bfhi(q.z), bflo(q.w), bfhi(q.w)};
        float kf[8] = {bflo(k.x), bfhi(k.x), bflo(k.y), bfhi(k.y), bflo(k.z), bfhi(k.z), bflo(k.w), bfhi(k.w)};
        float sq = 0.f, sk = 0.f;
#pragma unroll
        for (int i = 0; i < 8; ++i) { sq += qf[i] * qf[i]; sk += kf[i] * kf[i]; }
        const float rq = __builtin_amdgcn_rsqf(wave_sum(sq) * (1.f / 512.f) + EPS), rk = __builtin_amdgcn_rsqf(wave_sum(sk) * (1.f / 512.f) + EPS);
        u32x4 wq, wk;
        wq.x = cvtpk(qf[0] * rq * gq[0], qf[1] * rq * gq[1]); wq.y = cvtpk(qf[2] * rq * gq[2], qf[3] * rq * gq[3]); wq.z = cvtpk(qf[4] * rq * gq[4], qf[5] * rq * gq[5]); wq.w = cvtpk(qf[6] * rq * gq[6], qf[7] * rq * gq[7]);
        wk.x = cvtpk(kf[0] * rk * gk[0], kf[1] * rk * gk[1]); wk.y = cvtpk(kf[2] * rk * gk[2], kf[3] * rk * gk[3]); wk.z = cvtpk(kf[4] * rk * gk[4], kf[5] * rk * gk[5]); wk.w = cvtpk(kf[6] * rk * gk[6], kf[7] * rk * gk[7]);
        *(u32x4*)(qn + (size_t)row * 512 + lane * 8) = wq; *(u32x4*)(kvn + (size_t)row * 512 + lane * 8) = wk;
    }
}
__device__ __forceinline__ void unpack8(const u32x4 q, float (&f)[8]) { f[0] = bflo(q.x); f[1] = bfhi(q.x); f[2] = bflo(q.y); f[3] = bfhi(q.y); f[4] = bflo(q.z); f[5] = bfhi(q.z); f[6] = bflo(q.w); f[7] = bfhi(q.w); }
__device__ __forceinline__ u32x4 pack8(const float (&f)[8]) { u32x4 w; w.x = cvtpk(f[0], f[1]); w.y = cvtpk(f[2], f[3]); w.z = cvtpk(f[4], f[5]); w.w = cvtpk(f[6], f[7]); return w; }
__device__ __forceinline__ u32x2 pack8_fp8(const float (&f)[8]) { int w0 = 0, w1 = 0;
    w0 = __builtin_amdgcn_cvt_pk_fp8_f32(f[0], f[1], w0, false); w0 = __builtin_amdgcn_cvt_pk_fp8_f32(f[2], f[3], w0, true);
    w1 = __builtin_amdgcn_cvt_pk_fp8_f32(f[4], f[5], w1, false); w1 = __builtin_amdgcn_cvt_pk_fp8_f32(f[6], f[7], w1, true);
    u32x2 r; r.x = (unsigned)w0; r.y = (unsigned)w1; return r; }
__device__ __forceinline__ float sumsq8(const u32x4 q) { float f[8]; unpack8(q, f); float s = 0.f;
#pragma unroll
    for (int i = 0; i < 8; ++i) s += f[i] * f[i];
    return s; }

__device__ __forceinline__ void rope64(float (&pe)[64], const LAS float* ct, const LAS float* st, int row, int col) {
#pragma unroll
    for (int j = 0; j < 16; ++j) { const float c = ct[row * 16 + j], s = st[row * 16 + j]; const float x1 = pe[j], x2 = pe[16 + j]; pe[j] = x1 * c - x2 * s; pe[16 + j] = x2 * c + x1 * s; }
#pragma unroll
    for (int j = 0; j < 16; ++j) { const float c = ct[col * 16 + j], s = st[col * 16 + j]; const float x1 = pe[32 + j], x2 = pe[48 + j]; pe[32 + j] = x1 * c - x2 * s; pe[48 + j] = x2 * c + x1 * s; }
}
__device__ __forceinline__ void phase_headnorm_rope(const In& in, unsigned char* ws, LAS unsigned char* lds, int G, int bid) {
    const int tid = ltid();
    bf16* kvraw = (bf16*)(ws + WS_KVRAW);
    __syncthreads();
    {
        const int lane = tid & 63, wid = tid >> 6, c = lane & 15, q = lane >> 4;
        LAS unsigned* img = (LAS unsigned*)(lds + 36864) + wid * 2048;
        unsigned char* vtb = ws + WS_KPE;
        for (int it = bid * 8 + wid; it < NH * (NTOK / 64); it += G * 8) {
            const int h = it / (NTOK / 64), T = it - h * (NTOK / 64);
            const bf16* vp = kvraw + (size_t)(T * 64) * 4096 + h * 256 + 128 + c * 8;
#pragma unroll
            for (int m = 0; m < 4; ++m) { const int gi = 4 * m + q;
                const int sd = 8 * (gi & 1) + 4 * (gi >> 3) + ((gi & 7) >> 1);
                float f0[8], f1[8], f2[8], f3[8];
                unpack8(*(const u32x4*)(vp + (size_t)(4 * gi) * 4096), f0); unpack8(*(const u32x4*)(vp + (size_t)(4 * gi + 1) * 4096), f1);
                unpack8(*(const u32x4*)(vp + (size_t)(4 * gi + 2) * 4096), f2); unpack8(*(const u32x4*)(vp + (size_t)(4 * gi + 3) * 4096), f3);
#pragma unroll
                for (int i = 0; i < 8; ++i) { int w = 0; w = __builtin_amdgcn_cvt_pk_fp8_f32(f0[i], f1[i], w, false); w = __builtin_amdgcn_cvt_pk_fp8_f32(f2[i], f3[i], w, true);
                    img[(c * 8 + i) * 16 + sd] = (unsigned)w; } }
            asm volatile("s_waitcnt lgkmcnt(0)" ::: "memory");
            u32x4* dst = (u32x4*)(vtb + (size_t)it * 8192);
#pragma unroll
            for (int k = 0; k < 8; ++k) dst[k * 64 + lane] = *(const LAS u32x4*)(img + (k * 64 + lane) * 4);
            asm volatile("s_waitcnt lgkmcnt(0)" ::: "memory");
        }
    }
}
__device__ __forceinline__ void phase_na_headnorm(const In& in, unsigned char* ws, int G, int bid) {
    bf16* qkv = (bf16*)(ws + WS_QKV1);
    const int tid = ltid(), lane = tid & 63, c = lane & 15, gw = bid * 8 + (tid >> 6), NGW = G * 8;
    const f32x4 gq0 = *(const f32x4*)(in.na_q_gain + c * 8), gq1 = *(const f32x4*)(in.na_q_gain + c * 8 + 4), gk0 = *(const f32x4*)(in.na_k_gain + c * 8), gk1 = *(const f32x4*)(in.na_k_gain + c * 8 + 4);
    constexpr int NIT = NTOK * 32 / 4;
    for (int pp = gw; pp < NIT; pp += 4 * NGW) {
        bf16* qp[4]; u32x4 raw[4]; bool isk[4], act[4];
#pragma unroll
        for (int u = 0; u < 4; ++u) { const int pi = pp + u * NGW; act[u] = pi < NIT; const int p = (act[u] ? pi : pp) * 4 + (lane >> 4), t = p >> 5, hh = p & 31; isk[u] = (hh >> 4) != 0;
            qp[u] = qkv + (size_t)t * 6144 + hh * 128 + c * 8; raw[u] = *(const u32x4*)qp[u]; }
#pragma unroll
        for (int u = 0; u < 4; ++u) {
            float f[8]; unpack8(raw[u], f);
            float ss = 0.f;
#pragma unroll
            for (int i = 0; i < 8; ++i) ss += f[i] * f[i];
#pragma unroll
            for (int o = 1; o < 16; o <<= 1) ss += __shfl_xor(ss, o);
            const float rs = __builtin_amdgcn_rsqf(ss * (1.f / 128.f) + EPS);
            const f32x4 g0 = isk[u] ? gk0 : gq0, g1 = isk[u] ? gk1 : gq1;
            f[0] *= rs * g0.x; f[1] *= rs * g0.y; f[2] *= rs * g0.z; f[3] *= rs * g0.w; f[4] *= rs * g1.x; f[5] *= rs * g1.y; f[6] *= rs * g1.z; f[7] *= rs * g1.w;
            if (act[u]) *(u32x4*)qp[u] = pack8(f);
        }
    }
}
typedef float f32x2v __attribute__((ext_vector_type(2)));
__device__ __forceinline__ void router_finish(const float (&lg)[16], int lane, float* aff, int row, bool valid) {
    float v8[8], v4[4], v2[2], v1;
    { const bool up = (lane & 32) != 0;
#pragma unroll
      for (int i = 0; i < 8; ++i) { const float snd = up ? lg[i] : lg[8 + i], kp = up ? lg[8 + i] : lg[i]; v8[i] = kp + __shfl_xor(snd, 32); } }
    { const bool up = (lane & 16) != 0;
#pragma unroll
      for (int i = 0; i < 4; ++i) { const float snd = up ? v8[i] : v8[4 + i], kp = up ? v8[4 + i] : v8[i]; v4[i] = kp + __shfl_xor(snd, 16); } }
    { const bool up = (lane & 8) != 0;
#pragma unroll
      for (int i = 0; i < 2; ++i) { const float snd = up ? v4[i] : v4[2 + i], kp = up ? v4[2 + i] : v4[i]; v2[i] = kp + __shfl_xor(snd, 8); } }
    { const bool up = (lane & 4) != 0; const float snd = up ? v2[0] : v2[1], kp = up ? v2[1] : v2[0]; v1 = kp + __shfl_xor(snd, 4); }
    v1 += __shfl_xor(v1, 2); v1 += __shfl_xor(v1, 1);
    float mx = v1;
#pragma unroll
    for (int o = 4; o < 64; o <<= 1) mx = fmaxf(mx, __shfl_xor(mx, o));
    const float ex = __expf(v1 - mx);
    float den = ex;
#pragma unroll
    for (int o = 4; o < 64; o <<= 1) den += __shfl_xor(den, o);
    if (valid && (lane & 3) == 0) { const int e = ((lane >> 5) & 1) * 8 + ((lane >> 4) & 1) * 4 + ((lane >> 3) & 1) * 2 + ((lane >> 2) & 1); aff[(size_t)e * NTOK + row] = ex / den; }
}
__device__ __forceinline__ void phase_router(const In& in, unsigned char* ws, LAS unsigned char* lds, int G, int bid, int l, int nrows) {
    const int tid = ltid(), lane = tid & 63, gw = bid * 8 + (tid >> 6), NGW = G * 8;
    LAS float* rwT = (LAS float*)lds;
    const float* rw = in.router_w + (size_t)l * 2048 * 16;
    for (int i = tid; i < 2048 * 16; i += 512) rwT[(i & 15) * 2048 + (i >> 4)] = rw[i];
    LAS float* mv = (LAS float*)(lds + 131072);
    stage_mod_lds(mv, mv + 2048, in.norm_ffn + l * 2048, modv(ws, l, 0, 3), modv(ws, l, 0, 4), tid);
    __syncthreads();
    const bf16* x1 = (const bf16*)(ws + WS_X1); bf16* hb = (bf16*)(ws + WS_HB); float* aff = (float*)(ws + WS_AFF);
    { const int nlat = nrows < NL ? nrows : NL;
      u32x2 c0[8], c1[8], n0[8], n1[8];
#define RT_LOAD(dst, rw_) do { _Pragma("unroll") for (int j = 0; j < 8; ++j) dst[j] = *(const u32x2*)(x1 + (size_t)(rw_) * 2048 + 4 * (lane + 64 * j)); } while (0)
      if (gw < nlat) { RT_LOAD(c0, gw); RT_LOAD(c1, (gw + NGW < nlat ? gw + NGW : gw)); }
      for (int row = gw; row < nlat; row += 2 * NGW) {
        const bool two = row + NGW < nlat; const int rowb = two ? row + NGW : row;
        const int rn = row + 2 * NGW;
        __builtin_amdgcn_sched_barrier(0);
        if (rn < nlat) { RT_LOAD(n0, rn); RT_LOAD(n1, (rn + NGW < nlat ? rn + NGW : rn)); }
        __builtin_amdgcn_sched_barrier(0);
        f32x4 a0[8], a1[8];
        float ss0 = 0.f, ss1 = 0.f;
#pragma unroll
        for (int j = 0; j < 8; ++j) { a0[j] = bf4(c0[j]); a1[j] = bf4(c1[j]);
            ss0 += (a0[j].x * a0[j].x + a0[j].y * a0[j].y) + (a0[j].z * a0[j].z + a0[j].w * a0[j].w); ss1 += (a1[j].x * a1[j].x + a1[j].y * a1[j].y) + (a1[j].z * a1[j].z + a1[j].w * a1[j].w); }
        const float rs0 = __builtin_amdgcn_rsqf(wave_sum(ss0) * (1.f / 2048.f) + EPS), rs1 = __builtin_amdgcn_rsqf(wave_sum(ss1) * (1.f / 2048.f) + EPS);
#pragma unroll
        for (int j = 0; j < 8; ++j) { const int c = 4 * (lane + 64 * j); const f32x4 g = *(const LAS f32x4*)(mv + c), sb = *(const LAS f32x4*)(mv + 2048 + c);
            a0[j] = a0[j] * rs0 * g + sb; a1[j] = a1[j] * rs1 * g + sb; }
        store_row_bf16(hb + (size_t)row * 2048, a0, lane);
        store_row_bf16(hb + (size_t)rowb * 2048, a1, lane);
        __builtin_amdgcn_sched_barrier(0);
        float lg0[16], lg1[16];
        unsigned wbase = (unsigned)(size_t)(rwT + 4 * lane); asm volatile("" : "+v"(wbase));
#pragma unroll
        for (int e = 0; e < 16; ++e) { f32x2v s0 = {0.f, 0.f}, s1 = {0.f, 0.f};
#pragma unroll
            for (int j = 0; j < 8; ++j) { const f32x4 w = *(const LAS f32x4*)(wbase + (e * 2048 + 256 * j) * 4);
                const f32x2v wl = {w.x, w.y}, wh = {w.z, w.w};
                s0 = __builtin_elementwise_fma((f32x2v){a0[j].x, a0[j].y}, wl, s0); s0 = __builtin_elementwise_fma((f32x2v){a0[j].z, a0[j].w}, wh, s0);
                s1 = __builtin_elementwise_fma((f32x2v){a1[j].x, a1[j].y}, wl, s1); s1 = __builtin_elementwise_fma((f32x2v){a1[j].z, a1[j].w}, wh, s1); }
            float t0 = s0.x + s0.y, t1 = s1.x + s1.y; asm volatile("" : "+v"(t0), "+v"(t1)); lg0[e] = t0; lg1[e] = t1; }
        router_finish(lg0, lane, aff, row, true);
        router_finish(lg1, lane, aff, rowb, two);
#pragma unroll
        for (int j = 0; j < 8; ++j) { c0[j] = n0[j]; c1[j] = n1[j]; }
      }
#undef RT_LOAD
    }
    for (int row = NL + gw; row < nrows; row += NGW) {
        f32x4 a[8];
#pragma unroll
        for (int j = 0; j < 8; ++j) a[j] = bf4(*(const u32x2*)(x1 + (size_t)row * 2048 + 4 * (lane + 64 * j)));
        norm_mod_row(a, in.norm_ffn + l * 2048, modv(ws, l, 1, 3), modv(ws, l, 1, 4), lane);
        store_row_bf16(hb + (size_t)row * 2048, a, lane);
        float lg[16];
        unsigned wbase = (unsigned)(size_t)(rwT + 4 * lane); asm volatile("" : "+v"(wbase));
#pragma unroll
        for (int e = 0; e < 16; ++e) { float s = 0.f;
#pragma unroll
            for (int j = 0; j < 8; ++j) { const f32x4 w = *(const LAS f32x4*)(wbase + (e * 2048 + 256 * j) * 4); s += (a[j].x * w.x + a[j].y * w.y) + (a[j].z * w.z + a[j].w * w.w); }
            lg[e] = s; __builtin_amdgcn_sched_barrier(0); }
        router_finish(lg, lane, aff, row, true);
    }
    __syncthreads();
}
__device__ __forceinline__ int block_sum_i(int v, LAS int* red, int tid) {
    v = wave_sum_i(v);
    __syncthreads();
    if ((tid & 63) == 0) red[tid >> 6] = v;
    __syncthreads();
    int s = 0;
#pragma unroll
    for (int w = 0; w < 8; ++w) s += red[w];
    return s;
}
__device__ __forceinline__ void phase_topk(unsigned char* ws, LAS unsigned char* lds, int G, int bid, int nprob) {
    const int tid = ltid(), lane = tid & 63, wid = tid >> 6;
    LAS int* red = (LAS int*)lds; LAS int* scan = red + 16;
    const float* aff = (const float*)(ws + WS_AFF); int* idx = (int*)(ws + WS_IDX); float* gate = (float*)(ws + WS_GATE); int* slot = (int*)(ws + WS_SLOT);
    for (int pb = bid; pb < nprob; pb += G) {
        const int e = pb & 15, isctx = pb >> 4;
        const int n = isctx ? NC : NL, k = isctx ? CAPC : CAPL, tok0 = isctx ? NL : 0, slot0 = isctx ? CAPL : 0;
        const int per = n / 512;
        unsigned key[32];
        const float* ap = aff + (size_t)e * NTOK + tok0;
        if (!isctx) {
#pragma unroll
            for (int j = 0; j < 8; ++j) { const u32x4 q = *(const u32x4*)(ap + tid * 32 + j * 4); key[j * 4] = q.x; key[j * 4 + 1] = q.y; key[j * 4 + 2] = q.z; key[j * 4 + 3] = q.w; }
        } else {
#pragma unroll
            for (int j = 0; j < 32; ++j) key[j] = 0u;
            if (tid < NC) key[0] = __float_as_uint(ap[tid]);
        }
        (void)per;
        unsigned lo = 0u, hi = 0x7f800000u;
        while (hi - lo > 1u) {
            const unsigned mid = lo + ((hi - lo) >> 1);
            int c = 32;
#pragma unroll
            for (int j = 0; j < 32; ++j) c += ((int)key[j] - (int)mid) >> 31;
            c = block_sum_i(c, red, tid);
            if (c >= k) lo = mid; else hi = mid;
        }
        const unsigned T = lo;
        int cg = 32, ce = 32;
#pragma unroll
        for (int j = 0; j < 32; ++j) { cg += ((int)key[j] - (int)(T + 1u)) >> 31; ce += ((int)key[j] - (int)T) >> 31; }
        ce -= cg;
        if (isctx && tid >= NC) { cg = 0; ce = 0; }
        int sg = cg, se = ce;
#pragma unroll
        for (int o = 1; o < 64; o <<= 1) { const int a = __shfl_up(sg, o), b = __shfl_up(se, o); if (lane >= o) { sg += a; se += b; } }
        __syncthreads();
        if (lane == 63) { scan[wid] = sg; scan[8 + wid] = se; }
        __syncthreads();
        int bg = 0, be = 0, totg = 0;
#pragma unroll
        for (int w = 0; w < 8; ++w) { const int a = scan[w], b = scan[8 + w]; if (w < wid) { bg += a; be += b; } totg += a; }
        const int need_eq = k - totg;
        int g_before = bg + sg - cg, e_before = be + se - ce;
        const int nmine = isctx ? (tid < NC ? 1 : 0) : 32;
#pragma unroll
        for (int j = 0; j < 32; ++j) {
            if (j < nmine) {
                const int i = isctx ? tid : tid * 32 + j;
                const bool gt = key[j] > T, eq = key[j] == T;
                const bool sel = gt || (eq && e_before < need_eq);
                const int s = g_before + min(e_before, need_eq);
                if (sel) { idx[e * EROWS + slot0 + s] = tok0 + i; gate[e * EROWS + slot0 + s] = __uint_as_float(key[j]); }
                slot[(size_t)(tok0 + i) * 16 + e] = sel ? slot0 + s : -1;
                g_before += gt ? 1 : 0; e_before += eq ? 1 : 0;
            }
        }
        if (isctx) { for (int s = CAPL + CAPC + tid; s < EROWS; s += 512) { idx[e * EROWS + s] = -1; gate[e * EROWS + s] = 0.f; } }
        __syncthreads();
    }
}
__device__ __forceinline__ void phase_gather(unsigned char* ws, int G, int bid, int rows_per_e) {
    const int lane = ltid() & 63, gw = bid * 8 + (ltid() >> 6), NGW = G * 8;
    const bf16* hb = (const bf16*)(ws + WS_HB); bf16* xs = (bf16*)(ws + WS_XS); const int* idx = (const int*)(ws + WS_IDX);
    for (int r = gw; r < NE * rows_per_e; r += NGW) {
        const int e = r / rows_per_e, s = r - e * rows_per_e; const int t = idx[e * EROWS + s];
        u32x4 v[4];
#pragma unroll
        for (int j = 0; j < 4; ++j) v[j] = (t >= 0) ? *(const u32x4*)(hb + (size_t)t * 2048 + (lane + 64 * j) * 8) : (u32x4){0u, 0u, 0u, 0u};
#pragma unroll
        for (int j = 0; j < 4; ++j) *(u32x4*)(xs + ((size_t)e * EROWS + s) * 2048 + (lane + 64 * j) * 8) = v[j];
    }
}
__device__ __forceinline__ void phase_combine(const In& in, unsigned char* ws, LAS unsigned char* lds, float* out, int G, int bid, int l, int nrows) {
    const int tid = ltid(), lane = tid & 63, gw = bid * 8 + (tid >> 6), NGW = G * 8;
    bf16* x1 = (bf16*)(ws + WS_X1); const bf16* yb = (const bf16*)(ws + WS_YB); const int* slot = (const int*)(ws + WS_SLOT); bf16* hb = (bf16*)(ws + WS_HB);
    LAS float* mv = (LAS float*)lds;
    for (int v = 0; v < (nrows > NL ? 2 : 1); ++v) {
        *(LAS f32x4*)(mv + v * 6144 + 4 * tid) = *(const f32x4*)(modv(ws, l, v, 5) + 4 * tid);
        if (l == 0) stage_mod_lds(mv + v * 6144 + 2048, mv + v * 6144 + 4096, in.norm_mix + 2048, modv(ws, 1, v, 0), modv(ws, 1, v, 1), tid); }
    __syncthreads();
    int nslot = (gw < nrows) ? slot[(size_t)gw * 16 + (lane & 15)] : -1;
    for (int row = gw; row < nrows; row += NGW) {
        const LAS float* mvv = mv + (row >= NL ? 6144 : 0);
        const int myslot = nslot;
        f32x4 a[8];
#pragma unroll
        for (int j = 0; j < 8; ++j) a[j] = bf4(*(const u32x2*)(x1 + (size_t)row * 2048 + 4 * (lane + 64 * j)));
        if (row + NGW < nrows) nslot = slot[(size_t)(row + NGW) * 16 + (lane & 15)];
        f32x4 acc[8];
#pragma unroll
        for (int j = 0; j < 8; ++j) acc[j] = (f32x4){0.f, 0.f, 0.f, 0.f};
        unsigned m = (unsigned)__ballot(myslot >= 0) & 0xffffu;
        while (m) {
            const int e0 = __builtin_ctz(m); m &= m - 1u;
            const bool two = m != 0u; const int e1 = two ? __builtin_ctz(m) : e0; if (two) m &= m - 1u;
            const bf16* y0 = yb + ((size_t)e0 * EROWS + __shfl(myslot, e0)) * 2048; const bf16* y1 = yb + ((size_t)e1 * EROWS + __shfl(myslot, e1)) * 2048;
            u32x2 w0[8], w1[8];
#pragma unroll
            for (int j = 0; j < 8; ++j) w0[j] = *(const u32x2*)(y0 + 4 * (lane + 64 * j));
            if (two) {
#pragma unroll
                for (int j = 0; j < 8; ++j) w1[j] = *(const u32x2*)(y1 + 4 * (lane + 64 * j)); }
#pragma unroll
            for (int j = 0; j < 8; ++j) { acc[j].x += bflo(w0[j].x); acc[j].y += bfhi(w0[j].x); acc[j].z += bflo(w0[j].y); acc[j].w += bfhi(w0[j].y); }
            if (two) {
#pragma unroll
                for (int j = 0; j < 8; ++j) { acc[j].x += bflo(w1[j].x); acc[j].y += bfhi(w1[j].x); acc[j].z += bflo(w1[j].y); acc[j].w += bfhi(w1[j].y); } }
        }
#pragma unroll
        for (int j = 0; j < 8; ++j) a[j] = a[j] + *(const LAS f32x4*)(mvv + 4 * (lane + 64 * j)) * acc[j];
        if (l == 0) {
            store_row_bf16(x1 + (size_t)row * 2048, a, lane);
            norm_mod_row_lds(a, mvv + 2048, mvv + 4096, lane);
            store_row_bf16(hb + (size_t)row * 2048, a, lane);
        } else {
#pragma unroll
            for (int j = 0; j < 8; ++j) *(f32x4*)(out + (size_t)row * 2048 + 4 * (lane + 64 * j)) = a[j];
        }
    }
    __syncthreads();
}
}
#define XB_TMO      128
#define XB_XCNT(j)  (256  + 64 * (j))
#define XB_XSUB(j)  (1280 + 64 * (j))
#define XB_XGEN(j)  (2304 + 64 * (j))
#define XB_TOP      3328
#define XB_TOPGEN   3392
#define XCD_BAR_WORDS 3456
#define XB_SPIN_CAP (1u << 22)

__device__ __forceinline__ unsigned xb_ld(unsigned* p)              { return __hip_atomic_load(p, __ATOMIC_RELAXED, __HIP_MEMORY_SCOPE_AGENT); }
__device__ __forceinline__ unsigned xb_add(unsigned* p, unsigned v) { return __hip_atomic_fetch_add(p, v, __ATOMIC_RELAXED, __HIP_MEMORY_SCOPE_AGENT); }
__device__ __forceinline__ unsigned xb_xcc_id() { return (unsigned)__builtin_amdgcn_s_getreg((3 << 11) | 20) & 0xFu; }
#define XB_SPIN(cond, bar) do { unsigned _sp = 0; while (cond) { __builtin_amdgcn_s_sleep(1); \
    if ((++_sp & 255u) == 0u) { if (xb_ld(&(bar)[XB_TMO])) break; if (_sp > XB_SPIN_CAP) { atomicAdd(&(bar)[XB_TMO], 1u); break; } } } } while (0)

struct XcdBarrier { unsigned* bar; unsigned x; volatile LAS unsigned* st; };

__device__ __forceinline__ XcdBarrier xcd_barrier_post(unsigned* bar, volatile LAS unsigned* st) {
    XcdBarrier b; b.bar = bar; b.x = xb_xcc_id(); b.st = st;
    if (threadIdx.x == 0) (void)xb_add(&bar[XB_XCNT(b.x)], 1u);
    return b;
}
__device__ __forceinline__ void xcd_barrier_complete(unsigned* bar, unsigned x, unsigned& nloc, unsigned& nx) {
    const unsigned G = gridDim.x * gridDim.y * gridDim.z;
    unsigned sum, cnt, mine, sp = 0u;
    for (;;) {
        sum = 0u; cnt = 0u; mine = 0u;
#pragma unroll
        for (unsigned j = 0; j < 16; ++j) { const unsigned c = xb_ld(&bar[XB_XCNT(j)]); sum += c; cnt += (c > 0u) ? 1u : 0u; mine = (j == x) ? c : mine; }
        if (sum == G) break;
        __builtin_amdgcn_s_sleep(1);
        if ((++sp & 255u) == 0u) { if (xb_ld(&bar[XB_TMO])) break; if (sp > XB_SPIN_CAP) { atomicAdd(&bar[XB_TMO], 1u); break; } }
    }
    nloc = mine > 0u ? mine : 1u; nx = cnt > 0u ? cnt : 1u;
}
__device__ __forceinline__ void xcd_barrier(const XcdBarrier& b) {
    asm volatile("s_waitcnt vmcnt(0)" ::: "memory");
    __syncthreads();
    if (threadIdx.x == 0) {
        unsigned* bar = b.bar;
        __builtin_amdgcn_s_waitcnt(0);
        unsigned nloc = b.st[0], nx = b.st[1];
        if (nloc == 0u) { xcd_barrier_complete(bar, b.x, nloc, nx); b.st[0] = nloc; b.st[1] = nx; }
        const unsigned old = xb_add(&bar[XB_XSUB(b.x)], 1u);
        const unsigned gen = old / nloc;
        if (old + 1u == (gen + 1u) * nloc) {
            __builtin_amdgcn_fence(__ATOMIC_RELEASE, "agent");
            asm volatile("s_waitcnt vmcnt(0)" ::: "memory");
            const unsigned og = xb_add(&bar[XB_TOP], 1u);
            const unsigned tg = og / nx;
            if (og + 1u == (tg + 1u) * nx) xb_add(&bar[XB_TOPGEN], 1u);
            else XB_SPIN(xb_ld(&bar[XB_TOPGEN]) == tg, bar);
            __builtin_amdgcn_fence(__ATOMIC_ACQUIRE, "agent");
            xb_add(&bar[XB_XGEN(b.x)], 1u);
            asm volatile("s_waitcnt vmcnt(0)" ::: "memory");
        } else {
            XB_SPIN(xb_ld(&bar[XB_XGEN(b.x)]) == gen, bar);
            __builtin_amdgcn_fence(__ATOMIC_ACQUIRE, "agent");
            asm volatile("s_waitcnt vmcnt(0)" ::: "memory");
        }
    }
    __syncthreads();
}

#ifndef MK_PER_PHASE
#define MK_PER_PHASE 0
#endif
constexpr int NPHASE = 25;
constexpr int LDS_BYTES = 148480;
constexpr int MISC_OFF = 147456 + 64;

struct Args { thin::In in; float* out; unsigned char* ws; int ph_lo, ph_hi; };
#define CAS __attribute__((address_space(4)))
typedef const CAS Args* ArgsP;
__device__ __forceinline__ ArgsP opaque(ArgsP p) { asm volatile("" : "+s"(p)); return p; }
__device__ __forceinline__ thin::In load_in(ArgsP A) { thin::In r;
    r.x = A->in.x; r.c = A->in.c; r.ctx = A->in.ctx; r.c_ctx = A->in.c_ctx; r.ada_w = A->in.ada_w; r.ada_b = A->in.ada_b; r.norm_mix = A->in.norm_mix; r.norm_ffn = A->in.norm_ffn;
    r.mla_w_in = A->in.mla_w_in; r.mla_q_a_gain = A->in.mla_q_a_gain; r.mla_kv_a_gain = A->in.mla_kv_a_gain; r.mla_w_qb = A->in.mla_w_qb; r.mla_w_kvb = A->in.mla_w_kvb;
    r.mla_q_gain = A->in.mla_q_gain; r.mla_k_gain = A->in.mla_k_gain; r.mla_w_o = A->in.mla_w_o; r.na_w_qkv = A->in.na_w_qkv; r.na_q_gain = A->in.na_q_gain; r.na_k_gain = A->in.na_k_gain;
    r.na_rpb = A->in.na_rpb; r.na_w_o = A->in.na_w_o; r.router_w = A->in.router_w; r.moe_w_gate = A->in.moe_w_gate; r.moe_w_up = A->in.moe_w_up; r.moe_w_down = A->in.moe_w_down; return r; }

__global__ void __launch_bounds__(512, 2) fwd_kernel(Args args) {
    extern __shared__ __attribute__((aligned(16))) unsigned char lds_raw[];
    LAS unsigned char* lds = (LAS unsigned char*)lds_raw;
    const int tid = threadIdx.x, G = gridDim.x, bid = blockIdx.x;
    ArgsP ap = (ArgsP)__builtin_amdgcn_kernarg_segment_ptr();
    volatile LAS unsigned* MISC = (volatile LAS unsigned*)(lds + MISC_OFF);
    if (tid < 32) MISC[tid] = 0u;
    __syncthreads();
    XcdBarrier bar; bar.bar = (unsigned*)(ap->ws + WS_CTL) + CW_BAR; bar.x = 0; bar.st = MISC + 8;
    if (!MK_PER_PHASE) bar = xcd_barrier_post((unsigned*)(ap->ws + WS_CTL) + CW_BAR, MISC + 8);
    const int lo = ap->ph_lo, hi = ap->ph_hi;
#ifndef DBG_ONLY
#define DBG_ONLY -1
#endif
#ifndef DBG_MASK
#define DBG_MASK 0xFFFFFFFFu
#endif
#ifndef REPMASK
#define REPMASK 0u
#endif
#define RP(k) for (int rep_ = 0; rep_ < 1 + (int)((REPMASK >> (k)) & 1u); ++rep_)
#define EN(k) ((DBG_ONLY < 0 || DBG_ONLY == (k)) && ((DBG_MASK >> (k)) & 1u))
#define IN(k) ({ int lo_ = lo, hi_ = hi; asm volatile("" : "+s"(lo_), "+s"(hi_)); (lo_ <= (k) && (k) < hi_); })
#define SEAM(k) do { if (IN(k) && IN((k) + 1)) xcd_barrier(bar); else __syncthreads(); } while (0)
#define PH_ARGS() ArgsP A_ = opaque(ap); const thin::In in = load_in(A_); unsigned char* const ws = A_->ws; (void)in; (void)ws

    if (EN(0) && IN(0)) { PH_ARGS(); RP(0) thin::phase_prologue(in, ws, lds, G, bid); } SEAM(0);
    if (EN(2) && IN(2)) { PH_ARGS(); RP(2) thin::phase_norm_in(in, ws, lds, G, bid); } SEAM(2);
    if (EN(3) && IN(3)) { PH_ARGS(); RP(3) {
        pg8::Gemm g{(const bf16*)(ws + WS_HB), (const bf16*)(ws + WS_WIN_T), NTOK, WIN_NP, 2048}; pg8::StaticOrder S; S.init(NTOK, WIN_NP, G, bid);
        pg8::EpiWin E{(bf16*)(ws + WS_AB), (float*)(ws + WS_PS), (float*)(ws + WS_KPER), in.mla_k_gain, (const float*)(ws + WS_MODP)};
        pg8::gemm_phase<pg8::EpiWin, pg8::StaticOrder, true, true>(lds, g, S, E);
    } thin::late_work(in, ws, lds, G, 3, 0); } SEAM(3);
    if (EN(5) && IN(5)) { PH_ARGS(); RP(5) {
        { pg8::Gemm g{(const bf16*)(ws + WS_AB), (const bf16*)(ws + WS_WQB_T), NTOK, 3072, 512, WIN_NP}; pg8::StaticOrder S; S.init(NTOK, 3072, G, bid);
          pg8::EpiBf16P E{(bf16*)(ws + WS_QRAW), 3072};
          pg8::gemm_phase<pg8::EpiBf16P, pg8::StaticOrder, true, true>(lds, g, S, E); }
        __syncthreads();
        { pg8::Gemm g{(const bf16*)(ws + WS_AB) + 512, (const bf16*)(ws + WS_WKVB_T), NTOK, 4096, 512, WIN_NP}; pg8::StaticOrder S; S.init(NTOK, 4096, G, (bid + 28) % G);
          pg8::EpiKv E{(bf16*)(ws + WS_KVRAW), in.mla_k_gain, (const float*)(ws + WS_KPER), (const float*)(ws + WS_PS), (LAS float*)(lds + 131072), ws + WS_KPE};
          pg8::gemm_phase<pg8::EpiKv, pg8::StaticOrder, true, true>(lds, g, S, E); }
    } thin::late_work(in, ws, lds, G, 5, 0); } SEAM(5);
    if (EN(7) && IN(7)) { PH_ARGS(); RP(7) {
        const unsigned char* q8 = ws + WS_QRAW; const unsigned char* k8 = ws + WS_KVRAW; const unsigned char* vt = ws + WS_KPE; bf16* ob = (bf16*)(ws + WS_OB);
        const int nun = (G == 256) ? 5 : 0;
        for (int i = 0; i < nun; ++i) {
            const int x = bid & 7, rr = bid >> 3;
            int h, qb; bool isctx = false;
            if (i < 4) { h = 2 * x + (i >> 1); qb = rr * 2 + (i & 1); }
            else { if (rr >= 2) break; h = 2 * x + rr; qb = 0; isctx = true; }
            __syncthreads();
            if (!isctx) att::mla_unit(q8 + (size_t)(qb * 256) * 6144 + h * 384, k8 + h * 512, vt + (size_t)h * (NTOK / 64) * 8192, ob + (size_t)(qb * 256) * 2048 + h * 128, NTOK, (LAS char*)lds, in.mla_q_gain, (const float*)(ws + WS_MODP), (const float*)(ws + WS_PS), qb * 256, true);
            else att::mla_unit(q8 + (size_t)NL * 6144 + h * 384, k8 + (size_t)NL * 8192 + h * 512, vt + ((size_t)h * (NTOK / 64) + NL / 64) * 8192, ob + (size_t)NL * 2048 + h * 128, NC, (LAS char*)lds, in.mla_q_gain, (const float*)(ws + WS_MODP), (const float*)(ws + WS_PS), NL, false);
        }
        if (G != 256)
        for (int u = bid; u < 1040; u += G) {
            __syncthreads();
            if (u < 1024) { const int h = u >> 6, qb = u & 63;
                att::mla_unit(q8 + (size_t)(qb * 256) * 6144 + h * 384, k8 + h * 512, vt + (size_t)h * (NTOK / 64) * 8192, ob + (size_t)(qb * 256) * 2048 + h * 128, NTOK, (LAS char*)lds, in.mla_q_gain, (const float*)(ws + WS_MODP), (const float*)(ws + WS_PS), qb * 256, true);
            } else { const int h = u - 1024;
                att::mla_unit(q8 + (size_t)NL * 6144 + h * 384, k8 + (size_t)NL * 8192 + h * 512, vt + ((size_t)h * (NTOK / 64) + NL / 64) * 8192, ob + (size_t)NL * 2048 + h * 128, NC, (LAS char*)lds, in.mla_q_gain, (const float*)(ws + WS_MODP), (const float*)(ws + WS_PS), NL, false); }
        }
    } thin::late_work(in, ws, lds, G, 7, 0); } SEAM(7);
    if (EN(8) && IN(8)) { PH_ARGS(); RP(8) {
        pg8::Gemm g{(const bf16*)(ws + WS_OB), (const bf16*)(ws + WS_WO0_T), NTOK, 2048, 2048}; pg8::StaticOrder S; S.init(NTOK, 2048, G, bid);
        pg8::EpiResB<false> E{(bf16*)(ws + WS_X1), in.x, in.ctx, thin::modv(ws, 0, 0, 2), thin::modv(ws, 0, 1, 2)};
        pg8::gemm_phase<pg8::EpiResB<false>, pg8::StaticOrder, true, true>(lds, g, S, E);
    } thin::late_work(in, ws, lds, G, 8, 0); } SEAM(8);
#define MOE_PHASES(L, PB, PC) \
    if (EN(9) && IN(PB + 0)) { PH_ARGS(); RP(9) thin::phase_router(in, ws, lds, G, bid, L, L ? NL : NTOK); } SEAM(PB + 0); \
    if (EN(10) && IN(PB + 1)) { PH_ARGS(); RP(10) thin::phase_topk(ws, lds, G, bid, L ? 16 : 32); thin::late_work(in, ws, lds, G, PB + 1, 0); thin::late_work(in, ws, lds, G, -1, L ? thin::LIM_GU1 : thin::LIM_MOE0); } SEAM(PB + 1); \
    if (EN(12) && IN(PB + 3)) { PH_ARGS(); RP(12) { \
        pg8::Gemm g{(const bf16*)(ws + WS_HB), (const bf16*)(ws + WS_WGU_T) + (size_t)L * WGU_L, NE * EROWS, NE * 2816, 2048}; \
        pg8::GroupedOrder S; S.init(L ? 8 : 9, 11, G, bid); \
        pg8::EpiSwiGLU E{(bf16*)(ws + WS_HID)}; \
        pg8::gemm_phase_gather<pg8::EpiSwiGLU, pg8::GroupedOrder, true, true>(lds, g, (const int*)(ws + WS_IDX), S, E);     \
    } thin::late_work(in, ws, lds, G, PB + 3, 0); if (L == 1) thin::late_work(in, ws, lds, G, -1, thin::LIM_ALL); } SEAM(PB + 3);     \
    if (EN(13) && IN(PB + 4)) { PH_ARGS(); RP(13) { \
        pg8::Gemm g{(const bf16*)(ws + WS_HID), (const bf16*)(ws + WS_WD_T) + (size_t)L * WD_L, NE * EROWS, NE * 2048, FF}; \
        pg8::GroupedOrder S; S.init(L ? 8 : 9, 8, G, bid); \
        pg8::EpiDown E{(bf16*)(ws + WS_YB), (const float*)(ws + WS_GATE)}; \
        pg8::gemm_phase<pg8::EpiDown, pg8::GroupedOrder, true, true>(lds, g, S, E); \
    } if (L == 0) thin::late_work(in, ws, lds, G, PB + 4, 0); } SEAM(PB + 4); \
    if (EN(14) && IN(PC)) { PH_ARGS(); RP(14) thin::phase_combine(in, ws, lds, A_->out, G, bid, L, L ? NL : NTOK); if (L == 0) thin::late_work(in, ws, lds, G, -1, thin::LIM_NA); }

    MOE_PHASES(0, 9, 14)
    SEAM(14);
    if (EN(15) && IN(15)) { PH_ARGS(); RP(15) {
        pg8::Gemm g{(const bf16*)(ws + WS_HB), (const bf16*)(ws + WS_WQKV_T), NTOK, 6144, 2048}; pg8::StaticOrder S; S.init(NTOK, 6144, G, bid);
        pg8::EpiQkvNorm E{(bf16*)(ws + WS_QKV1), in.na_q_gain, in.na_k_gain, (LAS float*)(lds + 131072)};
        pg8::gemm_phase<pg8::EpiQkvNorm, pg8::StaticOrder, true, true>(lds, g, S, E);
    } thin::late_work(in, ws, lds, G, 15, 0); } SEAM(15);
    if (EN(17) && IN(17)) { PH_ARGS(); RP(17) {
        for (int u = bid; u < 1024; u += G) { const int h = u >> 6, rb = u & 63;
            __syncthreads();
            att::na_unit((const bf16*)(ws + WS_QKV1), h, rb, in.na_rpb + h * 465, (bf16*)(ws + WS_OB), (LAS char*)lds); }
    } thin::late_work(in, ws, lds, G, 17, 0); } SEAM(17);
    if (EN(18) && IN(18)) { PH_ARGS(); RP(18) {
        pg8::Gemm g{(const bf16*)(ws + WS_OB), (const bf16*)(ws + WS_WO1_T), NL, 2048, 2048}; pg8::StaticOrder S; S.init(NL, 2048, G, bid);
        pg8::EpiResB<true> E{(bf16*)(ws + WS_X1), ws + WS_X1, ws + WS_X1, thin::modv(ws, 1, 0, 2), thin::modv(ws, 1, 0, 2)};
        pg8::gemm_phase<pg8::EpiResB<true>, pg8::StaticOrder, true, true>(lds, g, S, E);
    } thin::late_work(in, ws, lds, G, 18, 0); } SEAM(18);
    MOE_PHASES(1, 19, 24)
#undef MOE_PHASES
#undef IN
#undef SEAM
}

extern "C" void kernel_launch(void* const* d_in, const int* in_sizes, int n_in, void* d_out, int out_size, void* d_ws, size_t ws_size, hipStream_t stream) {
    static int grid = 0;
    if (grid == 0) {
        if (n_in != 25 || in_sizes[0] != NL * DM || out_size != NL * DM || ws_size < WS_END) {
            fprintf(stderr, "kernel_launch: unexpected problem: n_in %d in0 %d out %d ws %zu (need %zu)\n", n_in, n_in > 0 ? in_sizes[0] : -1, out_size, ws_size, (size_t)WS_END); grid = -1; return; }
        int dev = 0, cus = 0, per_cu = 0;
        if (hipGetDevice(&dev) != hipSuccess || hipDeviceGetAttribute(&cus, hipDeviceAttributeMultiprocessorCount, dev) != hipSuccess) { grid = -1; return; }
        if (hipFuncSetAttribute((const void*)fwd_kernel, hipFuncAttributeMaxDynamicSharedMemorySize, LDS_BYTES) != hipSuccess) { fprintf(stderr, "kernel_launch: hipFuncSetAttribute failed\n"); grid = -1; return; }
        if (hipOccupancyMaxActiveBlocksPerMultiprocessor(&per_cu, (const void*)fwd_kernel, 512, LDS_BYTES) != hipSuccess || per_cu < 1)
            fprintf(stderr, "kernel_launch: note: occupancy query reports %d workgroups per CU\n", per_cu);
        (void)hipGetLastError();
        grid = cus;
    }
    if (grid < 0) return;
    if (hipMemsetAsync((char*)d_ws + WS_CTL, 0, CTL_ZERO_BYTES, stream) != hipSuccess) { fprintf(stderr, "kernel_launch: memset failed\n"); return; }
    Args a{};
    const float** ip = (const float**)&a.in;
    for (int i = 0; i < 25; ++i) ip[i] = (const float*)d_in[i];
    a.out = (float*)d_out; a.ws = (unsigned char*)d_ws;
#if MK_PER_PHASE
    for (int p = 0; p < NPHASE; ++p) { a.ph_lo = p; a.ph_hi = p + 1;
        hipLaunchKernelGGL(fwd_kernel, dim3(grid), dim3(512), LDS_BYTES, stream, a); }
#else
    a.ph_lo = 0; a.ph_hi = NPHASE;
    hipLaunchKernelGGL(fwd_kernel, dim3(grid), dim3(512), LDS_BYTES, stream, a);
#endif
    const hipError_t le = hipPeekAtLastError();
    if (le != hipSuccess) fprintf(stderr, "kernel_launch: launch failed: %s\n", hipGetErrorName(le));
}
```

```cpp
#include <hip/hip_runtime.h>
#include <cstdio>
#include <cstdint>

#define GAS __attribute__((address_space(1)))
#define LAS __attribute__((address_space(3)))
typedef unsigned short bf16;
typedef short bf16x8 __attribute__((ext_vector_type(8)));
typedef short s16x4 __attribute__((ext_vector_type(4)));
typedef float f32x2 __attribute__((ext_vector_type(2)));
typedef float f32x4 __attribute__((ext_vector_type(4)));
typedef float f32x16 __attribute__((ext_vector_type(16)));
typedef unsigned u32x4 __attribute__((ext_vector_type(4)));
typedef unsigned u32x2 __attribute__((ext_vector_type(2)));

constexpr int NL = 16384, NC = 256, NTOK = NL + NC, DM = 2048, NH = 16;
constexpr int QLORA = 512, KVLORA = 512, ROPE_D = 64, NOPE_D = 128, QKH = 192, VD = 128;
constexpr int WIN_N = 1088, WIN_NP = 1280;
constexpr int NE = 16, FF = 1408, CAPL = 2048, CAPC = 32, EROWS = 2304;
constexpr float EPS = 1e-6f;
constexpr float LOG2E = 1.4426950408889634f;

constexpr size_t MiB = (size_t)1 << 20;
constexpr size_t WS_CTL = 0, CTL_ZERO_BYTES = 1 * MiB;
constexpr size_t WS_MODP = 1 * MiB;
static_assert((size_t)NTOK * 64 * 4 + 64 * 1024 <= 4608 * 1024 && 4608 * 1024 + (size_t)NTOK * 20 * 4 <= 6 * MiB, "small tables");
constexpr size_t WS_KPER = WS_MODP + 64 * 1024;
constexpr size_t WS_PS = WS_MODP + 4608 * 1024;
constexpr size_t WS_MOD = 7 * MiB;
constexpr size_t WS_AFF = 8 * MiB;
constexpr size_t WS_IDX = 8 * MiB + 1280 * 1024;
constexpr size_t WS_GATE = WS_IDX + 256 * 1024;
constexpr size_t WS_SLOT = 10 * MiB;
constexpr size_t WS_WIN_T = 12 * MiB, WS_WQB_T = 17 * MiB, WS_WKVB_T = 20 * MiB, WS_WO0_T = 24 * MiB, WS_WQKV_T = 32 * MiB, WS_WO1_T = 56 * MiB;
constexpr size_t WS_WGU_T = 64 * MiB;
constexpr size_t WS_WD_T = 416 * MiB;
constexpr size_t WS_HB = 592 * MiB;
constexpr size_t WS_X1 = 657 * MiB;
constexpr size_t WS_R = 787 * MiB;
constexpr size_t WS_AB = WS_R, WS_QN = WS_R + 41 * MiB, WS_KVN = WS_R + 58 * MiB, WS_QRAW = WS_R + 75 * MiB, WS_KVRAW = WS_R + 173 * MiB, WS_KPE = WS_R + 303 * MiB, WS_OB = WS_R + 336 * MiB;
constexpr size_t WS_QKV1 = WS_R;
constexpr size_t WS_XS = WS_R, WS_HID = WS_R + 144 * MiB, WS_YB = WS_R + 243 * MiB;
constexpr size_t WS_END = WS_R + 401 * MiB;
static_assert((size_t)NTOK * WIN_NP * 2 <= 41 * MiB && (size_t)NTOK * 512 * 2 <= 17 * MiB && (size_t)NTOK * 3072 * 2 <= 98 * MiB && (size_t)NTOK * 4096 * 2 <= 130 * MiB && (size_t)NTOK * 1024 * 2 <= 33 * MiB && (size_t)NTOK * 2048 * 2 <= 65 * MiB, "region A");
static_assert((size_t)NE * EROWS * 2048 * 2 <= 144 * MiB && (size_t)NE * EROWS * FF * 2 <= 99 * MiB && (size_t)NTOK * 6144 * 2 <= 195 * MiB, "region B");
constexpr size_t WGU_L = (size_t)NE * 2816 * 2048, WD_L = (size_t)NE * 2048 * FF;

constexpr int CW_BAR = 4096;
constexpr int CW_WORK = 128;
constexpr int CW_DONE = 256;
constexpr int CW_KMAX = 64;

__device__ __forceinline__ unsigned cvtpk(float lo, float hi) { unsigned r; asm("v_cvt_pk_bf16_f32 %0, %1, %2" : "=v"(r) : "v"(lo), "v"(hi)); return r; }
__device__ __forceinline__ float bflo(unsigned u) { return __uint_as_float(u << 16); }
__device__ __forceinline__ float bfhi(unsigned u) { return __uint_as_float(u & 0xffff0000u); }
__device__ __forceinline__ float wave_sum(float v) {
#pragma unroll
    for (int o = 1; o < 64; o <<= 1) v += __shfl_xor(v, o);
    return v;
}
__device__ __forceinline__ int wave_sum_i(int v) {
#pragma unroll
    for (int o = 1; o < 64; o <<= 1) v += __shfl_xor(v, o);
    return v;
}
__device__ __forceinline__ int ltid() { int t = threadIdx.x; asm volatile("" : "+v"(t)); return t; }
namespace pg8 {
#define PG8_LAS __attribute__((address_space(3)))
typedef unsigned short bf16_t;
typedef short bf16x8 __attribute__((ext_vector_type(8)));
typedef float f32x4 __attribute__((ext_vector_type(4)));
typedef unsigned u32x4 __attribute__((ext_vector_type(4)));
constexpr int BM = 256, BK = 64, HALF = 128, HTB = HALF * BK * 2  , STAGE_BYTES = 8 * HTB, NXCD = 8, WGM = 8;

__host__ __device__ __forceinline__ int lds_byte(int r, int c) { const int st = (r >> 4) * 2 + (c >> 5), rr = r & 15, cc = c & 31, ob = rr * 64 + cc * 2; return st * 1024 + (ob ^ (((ob >> 9) & 1) << 5)); }
__host__ __device__ __forceinline__ void stage_rc(int b, int& R, int& C) { const int st = b / 1024, sb = b % 1024, swz = sb ^ (((sb >> 9) & 1) << 5); R = (st >> 1) * 16 + swz / 64; C = (st & 1) * 32 + (swz % 64) / 2; }
__host__ __device__ __forceinline__ int perm32(int rho) { const int n = rho >> 4, i = rho & 15; return 8 * (i >> 2) + 4 * n + (i & 3); }

struct Unit { int pm, pn; };
struct Gemm { const bf16_t* A; const bf16_t* Bt; int M, N, K; int lda = 0; };

struct StaticOrder {
    int nM, nN, nwg, G, c;
    __host__ __device__ void init(int M, int N, int G_, int c_) { nM = M / BM; nN = N / BM; nwg = nM * nN; G = G_; c = c_; }
    __host__ __device__ bool next(int i, Unit& u) const {
        const long L = (long)i * G + c; if (L >= nwg) return false;
        int wgid = (int)L; { const int q = nwg / NXCD, r = nwg % NXCD, xcd = wgid % NXCD, off = wgid / NXCD; wgid = (xcd < r ? xcd * (q + 1) : r * (q + 1) + (xcd - r) * q) + off; }
        const int nig = WGM * nN, gid = wgid / nig, fm = gid * WGM, gsz = (nM - fm) < WGM ? (nM - fm) : WGM;
        u.pm = fm + ((wgid % nig) % gsz); u.pn = (wgid % nig) / gsz; return true;
    }
    __device__ __forceinline__ void a_ready(const Unit&) const {}
    __device__ __forceinline__ void done(const Unit&) const {}
};

__device__ __forceinline__ unsigned cvt_pk_bf16(float lo, float hi) { unsigned r; asm volatile("v_cvt_pk_bf16_f32 %0, %1, %2" : "=v"(r) : "v"(lo), "v"(hi)); return r; }
typedef float f32x2 __attribute__((ext_vector_type(2)));
template <class Epi, class Sched, bool ALIGN_EPI = false, bool SP2 = false>
__device__ __forceinline__ void gemm_phase(PG8_LAS unsigned char* lds, const Gemm g, const Sched& S, const Epi& E) {
    const int tid = ltid(), wid = __builtin_amdgcn_readfirstlane(tid >> 6), lane = tid & 63, wr = wid >> 2, wc = wid & 3, fr = lane & 15, fq = lane >> 4;
    const int K = g.K, nt = K / BK, lda = g.lda ? g.lda : K;
    unsigned voffA[2], voffB[2];
#pragma unroll
    for (int i = 0; i < 2; ++i) { int R, C; stage_rc(tid * 16 + i * 8192, R, C); const int Rb = Epi::PERM ? ((R & ~31) + perm32(R & 31)) : R;
        voffA[i] = (unsigned)(R * lda + C) * 2u; voffB[i] = (unsigned)(Rb * K + C) * 2u; }
    const size_t kstep = (size_t)(BK * 2);
    const size_t hstep = (size_t)HALF * K * 2;
    const size_t tstep = 2 * hstep;
    const size_t hstepA = (size_t)HALF * lda * 2, tstepA = 2 * hstepA;
    const unsigned ldsw = (unsigned)wid * 1024u;
    const int aoff = lds_byte(wr * 64 + fr, fq * 8), boff = lds_byte(wc * 32 + fr, fq * 8);
#define PG8_SA(b, h) (((b) * 2 + (h)) * HTB)
#define PG8_SB(b, h) ((4 + (b) * 2 + (h)) * HTB)
#define PG8_STAGE(bufoff, gbase, voff) do { _Pragma("unroll") for (int _i = 0; _i < 2; ++_i) \
        __builtin_amdgcn_global_load_lds((const unsigned*)((const char*)(gbase) + (voff)[_i]), (PG8_LAS unsigned*)(lds + (bufoff) + ldsw + _i * 8192), 16, 0, 0); } while (0)
#define PG8_LDA(dst, b, h) do { _Pragma("unroll") for (int m = 0; m < 4; ++m) _Pragma("unroll") for (int k = 0; k < 2; ++k) dst[m][k] = *(const PG8_LAS bf16x8*)(lds + PG8_SA(b, h) + aoff + m * 2048 + k * 1024); } while (0)
#define PG8_LDB(dst, b, h) do { _Pragma("unroll") for (int n = 0; n < 2; ++n) _Pragma("unroll") for (int k = 0; k < 2; ++k) dst[n][k] = *(const PG8_LAS bf16x8*)(lds + PG8_SB(b, h) + boff + n * 2048 + k * 1024); } while (0)
#define PG8_MMA(ai, bj, At, Bt) do { __builtin_amdgcn_s_setprio(1); _Pragma("unroll") for (int m = 0; m < 4; ++m) _Pragma("unroll") for (int n = 0; n < 2; ++n) _Pragma("unroll") for (int k = 0; k < 2; ++k) \
        acc[ai][bj][m][n] = __builtin_amdgcn_mfma_f32_16x16x32_bf16(Bt[n][k], At[m][k], acc[ai][bj][m][n], 0, 0, 0); __builtin_amdgcn_s_setprio(0); } while (0)
#define PG8_WAIT_V(n) asm volatile("s_waitcnt vmcnt(" #n ")" ::: "memory")
#define PG8_WAIT_L(n) asm volatile("s_waitcnt lgkmcnt(" #n ")" ::: "memory")
#define PG8_BAR __builtin_amdgcn_s_barrier()
#define PG8_SCHED __builtin_amdgcn_sched_barrier(0)
    Unit cur, nxt; int ui = 0;
    if (!S.next(0, cur)) return;
    f32x4 acc[2][2][4][2];
#pragma unroll
    for (int a = 0; a < 2; ++a)
#pragma unroll
        for (int b = 0; b < 2; ++b)
#pragma unroll
            for (int m = 0; m < 4; ++m)
#pragma unroll
                for (int n = 0; n < 2; ++n) acc[a][b][m][n] = (f32x4){0.f, 0.f, 0.f, 0.f};
    bf16x8 At[4][2], B0[2][2], B1[2][2];
    const char* cA = (const char*)g.A + (size_t)cur.pm * tstepA; const char* cB = (const char*)g.Bt + (size_t)cur.pn * tstep;
    S.a_ready(cur);
    if constexpr (SP2) {
        PG8_STAGE(PG8_SB(0, 0), cB, voffB); PG8_STAGE(PG8_SB(0, 1), cB + hstep, voffB); PG8_STAGE(PG8_SA(0, 0), cA, voffA); PG8_STAGE(PG8_SA(0, 1), cA + hstepA, voffA);
        if (wr == 1) PG8_BAR;
        PG8_WAIT_V(2); PG8_BAR;
        PG8_STAGE(PG8_SB(1, 0), cB + kstep, voffB); PG8_STAGE(PG8_SA(1, 0), cA + kstep, voffA); PG8_STAGE(PG8_SB(1, 1), cB + hstep + kstep, voffB);
        PG8_WAIT_V(6); PG8_BAR;
    } else {
        PG8_STAGE(PG8_SB(0, 0), cB, voffB); PG8_STAGE(PG8_SA(0, 0), cA, voffA); PG8_STAGE(PG8_SB(0, 1), cB + hstep, voffB); PG8_STAGE(PG8_SA(0, 1), cA + hstepA, voffA);
        if (wr == 1) PG8_BAR;
        PG8_WAIT_V(4); PG8_BAR;
        PG8_STAGE(PG8_SB(1, 0), cB + kstep, voffB); PG8_STAGE(PG8_SA(1, 0), cA + kstep, voffA); PG8_STAGE(PG8_SB(1, 1), cB + hstep + kstep, voffB);
        PG8_WAIT_V(6); PG8_BAR;
    }
    for (;;) {
        const bool has_next = S.next(ui + 1, nxt);
        const char* nA = has_next ? (const char*)g.A + (size_t)nxt.pm * tstepA : cA; const char* nB = has_next ? (const char*)g.Bt + (size_t)nxt.pn * tstep : cB;
        for (int t = 0; t < nt; t += 2) {
            const bool last = (t == nt - 2);
            const char* a1 = cA + (size_t)(t + 1) * kstep;
            const char* a2 = last ? nA : cA + (size_t)(t + 2) * kstep; const char* b2 = last ? nB : cB + (size_t)(t + 2) * kstep;
            const char* a3 = a2 + kstep; const char* b3 = b2 + kstep;
            if (last && has_next) S.a_ready(nxt);
            if constexpr (SP2) {
            PG8_LDB(B0, 0, 0); PG8_LDB(B1, 0, 1); PG8_SCHED; PG8_LDA(At, 0, 0); PG8_STAGE(PG8_SA(1, 1), a1 + hstepA, voffA);
            PG8_WAIT_V(8); PG8_WAIT_L(0); PG8_BAR; PG8_MMA(0, 0, At, B0); PG8_MMA(0, 1, At, B1); PG8_BAR; PG8_SCHED;
            PG8_LDA(At, 0, 1); PG8_STAGE(PG8_SB(0, 0), b2, voffB); PG8_STAGE(PG8_SB(0, 1), b2 + hstep, voffB); PG8_STAGE(PG8_SA(0, 0), a2, voffA);
            PG8_WAIT_V(8); PG8_WAIT_L(0); PG8_BAR; PG8_MMA(1, 0, At, B0); PG8_MMA(1, 1, At, B1); PG8_BAR; PG8_SCHED;
            PG8_LDB(B0, 1, 0); PG8_LDB(B1, 1, 1); PG8_SCHED; PG8_LDA(At, 1, 0); PG8_STAGE(PG8_SA(0, 1), a2 + hstepA, voffA);
            PG8_WAIT_V(8); PG8_WAIT_L(0); PG8_BAR; PG8_MMA(0, 0, At, B0); PG8_MMA(0, 1, At, B1); PG8_BAR; PG8_SCHED;
            PG8_LDA(At, 1, 1); PG8_STAGE(PG8_SB(1, 0), b3, voffB); PG8_STAGE(PG8_SB(1, 1), b3 + hstep, voffB); PG8_STAGE(PG8_SA(1, 0), a3, voffA);
            PG8_WAIT_V(8); PG8_WAIT_L(0); PG8_BAR; PG8_MMA(1, 0, At, B0); PG8_MMA(1, 1, At, B1); PG8_BAR; PG8_SCHED;
            } else {
            PG8_LDB(B0, 0, 0); PG8_SCHED; PG8_LDA(At, 0, 0); PG8_STAGE(PG8_SA(1, 1), a1 + hstepA, voffA);
            PG8_WAIT_L(8); PG8_BAR; PG8_WAIT_L(0); PG8_MMA(0, 0, At, B0); PG8_BAR; PG8_SCHED;
            PG8_LDB(B1, 0, 1); PG8_STAGE(PG8_SB(0, 0), b2, voffB);
            PG8_BAR; PG8_WAIT_L(0); PG8_MMA(0, 1, At, B1); PG8_BAR;
            PG8_LDA(At, 0, 1); PG8_STAGE(PG8_SA(0, 0), a2, voffA);
            PG8_BAR; PG8_WAIT_L(0); PG8_MMA(1, 0, At, B0); PG8_BAR; PG8_SCHED;
            PG8_STAGE(PG8_SB(0, 1), b2 + hstep, voffB);
            PG8_WAIT_V(6); PG8_BAR; PG8_MMA(1, 1, At, B1); PG8_BAR;
            PG8_LDB(B0, 1, 0); PG8_SCHED; PG8_LDA(At, 1, 0); PG8_STAGE(PG8_SA(0, 1), a2 + hstepA, voffA);
            PG8_WAIT_L(8); PG8_BAR; PG8_WAIT_L(0); PG8_MMA(0, 0, At, B0); PG8_BAR; PG8_SCHED;
            PG8_LDB(B1, 1, 1); PG8_STAGE(PG8_SB(1, 0), b3, voffB);
            PG8_BAR; PG8_WAIT_L(0); PG8_MMA(0, 1, At, B1); PG8_BAR;
            PG8_LDA(At, 1, 1); PG8_STAGE(PG8_SA(1, 0), a3, voffA);
            PG8_BAR; PG8_WAIT_L(0); PG8_MMA(1, 0, At, B0); PG8_BAR; PG8_SCHED;
            PG8_STAGE(PG8_SB(1, 1), b3 + hstep, voffB);
            PG8_WAIT_V(6); PG8_BAR; PG8_MMA(1, 1, At, B1); PG8_BAR;
            }
        }
        if constexpr (ALIGN_EPI) { if (wr == 0) PG8_BAR; }
        if constexpr (!Epi::AFTER_DRAIN) { E(acc, cur, wr, wc, fr, fq); S.done(cur); }
        if (!has_next) break;
#pragma unroll
        for (int a = 0; a < 2; ++a)
#pragma unroll
            for (int b = 0; b < 2; ++b)
#pragma unroll
                for (int m = 0; m < 4; ++m)
#pragma unroll
                    for (int n = 0; n < 2; ++n) acc[a][b][m][n] = (f32x4){0.f, 0.f, 0.f, 0.f};
        cur = nxt; cA = nA; cB = nB; ++ui;
        if constexpr (ALIGN_EPI) { if (wr == 1) PG8_BAR; }
    }
    PG8_WAIT_V(0);
    if constexpr (!ALIGN_EPI) { if (wr == 0) PG8_BAR; }
    PG8_BAR;
    if constexpr (Epi::AFTER_DRAIN) { E.fused(acc, cur, wr, wc, fr, fq, lds, wid, lane); S.done(cur); }
#undef PG8_SA
#undef PG8_SB
#undef PG8_STAGE
#undef PG8_LDA
#undef PG8_LDB
#undef PG8_MMA
#undef PG8_WAIT_V
#undef PG8_WAIT_L
#undef PG8_BAR
#undef PG8_SCHED
}
template <class Epi, class Sched, bool ALIGN_EPI = false, bool SP2 = false>
__device__ __forceinline__ void gemm_phase_gather(PG8_LAS unsigned char* lds, const Gemm g, const int* __restrict__ rowidx, const Sched& S, const Epi& E) {
    static_assert(SP2, "gather variant: SP2 loop only");
    const int tid = ltid(), wid = __builtin_amdgcn_readfirstlane(tid >> 6), lane = tid & 63, wr = wid >> 2, wc = wid & 3, fr = lane & 15, fq = lane >> 4;
    const int K = g.K, nt = K / BK;
    unsigned voffA[2], voffB[2];
#pragma unroll
    for (int i = 0; i < 2; ++i) { int R, C; stage_rc(tid * 16 + i * 8192, R, C); const int Rb = Epi::PERM ? ((R & ~31) + perm32(R & 31)) : R;
        voffA[i] = (unsigned)(R * K + C) * 2u; voffB[i] = (unsigned)(Rb * K + C) * 2u; }
    const size_t kstep = (size_t)(BK * 2);
    const size_t hstep = (size_t)HALF * K * 2;
    const size_t tstep = 2 * hstep;
    const unsigned ldsw = (unsigned)wid * 1024u;
    const int aoff = lds_byte(wr * 64 + fr, fq * 8), boff = lds_byte(wc * 32 + fr, fq * 8);
#define PG8_SA(b, h) (((b) * 2 + (h)) * HTB)
#define PG8_SB(b, h) ((4 + (b) * 2 + (h)) * HTB)
#define PG8_STAGE(bufoff, gbase, voff) do { _Pragma("unroll") for (int _i = 0; _i < 2; ++_i) \
        __builtin_amdgcn_global_load_lds((const unsigned*)((const char*)(gbase) + (voff)[_i]), (PG8_LAS unsigned*)(lds + (bufoff) + ldsw + _i * 8192), 16, 0, 0); } while (0)
#define PG8_LDA(dst, b, h) do { _Pragma("unroll") for (int m = 0; m < 4; ++m) _Pragma("unroll") for (int k = 0; k < 2; ++k) dst[m][k] = *(const PG8_LAS bf16x8*)(lds + PG8_SA(b, h) + aoff + m * 2048 + k * 1024); } while (0)
#define PG8_LDB(dst, b, h) do { _Pragma("unroll") for (int n = 0; n < 2; ++n) _Pragma("unroll") for (int k = 0; k < 2; ++k) dst[n][k] = *(const PG8_LAS bf16x8*)(lds + PG8_SB(b, h) + boff + n * 2048 + k * 1024); } while (0)
#define PG8_MMA(ai, bj, At, Bt) do { __builtin_amdgcn_s_setprio(1); _Pragma("unroll") for (int m = 0; m < 4; ++m) _Pragma("unroll") for (int n = 0; n < 2; ++n) _Pragma("unroll") for (int k = 0; k < 2; ++k) \
        acc[ai][bj][m][n] = __builtin_amdgcn_mfma_f32_16x16x32_bf16(Bt[n][k], At[m][k], acc[ai][bj][m][n], 0, 0, 0); __builtin_amdgcn_s_setprio(0); } while (0)
#define PG8_WAIT_V(n) asm volatile("s_waitcnt vmcnt(" #n ")" ::: "memory")
#define PG8_WAIT_L(n) asm volatile("s_waitcnt lgkmcnt(" #n ")" ::: "memory")
#define PG8_BAR __builtin_amdgcn_s_barrier()
#define PG8_SCHED __builtin_amdgcn_sched_barrier(0)
    Unit cur, nxt; int ui = 0;
    if (!S.next(0, cur)) return;
    int RA[2], CA[2];
#pragma unroll
    for (int i = 0; i < 2; ++i) stage_rc(tid * 16 + i * 8192, RA[i], CA[i]);
    unsigned vA0[2], vA1[2], nvA0[2], nvA1[2];
#define PG8_GOFF(u, d0, d1) do { _Pragma("unroll") for (int i = 0; i < 2; ++i) { \
        int t0_ = rowidx[(u).pm * BM + RA[i]], t1_ = rowidx[(u).pm * BM + HALF + RA[i]]; t0_ = t0_ < 0 ? 0 : t0_; t1_ = t1_ < 0 ? 0 : t1_; \
        d0[i] = (unsigned)(t0_ * K + CA[i]) * 2u; d1[i] = (unsigned)(t1_ * K + CA[i]) * 2u; } } while (0)
    PG8_GOFF(cur, vA0, vA1);
    f32x4 acc[2][2][4][2];
#pragma unroll
    for (int a = 0; a < 2; ++a)
#pragma unroll
        for (int b = 0; b < 2; ++b)
#pragma unroll
            for (int m = 0; m < 4; ++m)
#pragma unroll
                for (int n = 0; n < 2; ++n) acc[a][b][m][n] = (f32x4){0.f, 0.f, 0.f, 0.f};
    bf16x8 At[4][2], B0[2][2], B1[2][2];
    const char* cA = (const char*)g.A; const char* cB = (const char*)g.Bt + (size_t)cur.pn * tstep;
    S.a_ready(cur);
    if constexpr (SP2) {
        PG8_STAGE(PG8_SB(0, 0), cB, voffB); PG8_STAGE(PG8_SB(0, 1), cB + hstep, voffB); PG8_STAGE(PG8_SA(0, 0), cA, vA0); PG8_STAGE(PG8_SA(0, 1), cA, vA1);
        if (wr == 1) PG8_BAR;
        PG8_WAIT_V(2); PG8_BAR;
        PG8_STAGE(PG8_SB(1, 0), cB + kstep, voffB); PG8_STAGE(PG8_SA(1, 0), cA + kstep, vA0); PG8_STAGE(PG8_SB(1, 1), cB + hstep + kstep, voffB);
        PG8_WAIT_V(6); PG8_BAR;
    } else {
        PG8_STAGE(PG8_SB(0, 0), cB, voffB); PG8_STAGE(PG8_SA(0, 0), cA, voffA); PG8_STAGE(PG8_SB(0, 1), cB + hstep, voffB); PG8_STAGE(PG8_SA(0, 1), cA + hstep, voffA);
        if (wr == 1) PG8_BAR;
        PG8_WAIT_V(4); PG8_BAR;
        PG8_STAGE(PG8_SB(1, 0), cB + kstep, voffB); PG8_STAGE(PG8_SA(1, 0), cA + kstep, voffA); PG8_STAGE(PG8_SB(1, 1), cB + hstep + kstep, voffB);
        PG8_WAIT_V(6); PG8_BAR;
    }
    for (;;) {
        const bool has_next = S.next(ui + 1, nxt);
        if (has_next) PG8_GOFF(nxt, nvA0, nvA1); else { nvA0[0] = vA0[0]; nvA0[1] = vA0[1]; nvA1[0] = vA1[0]; nvA1[1] = vA1[1]; }
        const char* nA = cA; const char* nB = has_next ? (const char*)g.Bt + (size_t)nxt.pn * tstep : cB;
        for (int t = 0; t < nt; t += 2) {
            const bool last = (t == nt - 2);
            const char* a1 = cA + (size_t)(t + 1) * kstep;
            const char* a2 = last ? nA : cA + (size_t)(t + 2) * kstep; const char* b2 = last ? nB : cB + (size_t)(t + 2) * kstep;
            const char* a3 = a2 + kstep; const char* b3 = b2 + kstep;
            unsigned wA0[2], wA1[2]; wA0[0] = last ? nvA0[0] : vA0[0]; wA0[1] = last ? nvA0[1] : vA0[1]; wA1[0] = last ? nvA1[0] : vA1[0]; wA1[1] = last ? nvA1[1] : vA1[1];
            if (last && has_next) S.a_ready(nxt);
            if constexpr (SP2) {
            PG8_LDB(B0, 0, 0); PG8_LDB(B1, 0, 1); PG8_SCHED; PG8_LDA(At, 0, 0); PG8_STAGE(PG8_SA(1, 1), a1, vA1);
            PG8_WAIT_V(8); PG8_WAIT_L(0); PG8_BAR; PG8_MMA(0, 0, At, B0); PG8_MMA(0, 1, At, B1); PG8_BAR; PG8_SCHED;
            PG8_LDA(At, 0, 1); PG8_STAGE(PG8_SB(0, 0), b2, voffB); PG8_STAGE(PG8_SB(0, 1), b2 + hstep, voffB); PG8_STAGE(PG8_SA(0, 0), a2, wA0);
            PG8_WAIT_V(8); PG8_WAIT_L(0); PG8_BAR; PG8_MMA(1, 0, At, B0); PG8_MMA(1, 1, At, B1); PG8_BAR; PG8_SCHED;
            PG8_LDB(B0, 1, 0); PG8_LDB(B1, 1, 1); PG8_SCHED; PG8_LDA(At, 1, 0); PG8_STAGE(PG8_SA(0, 1), a2, wA1);
            PG8_WAIT_V(8); PG8_WAIT_L(0); PG8_BAR; PG8_MMA(0, 0, At, B0); PG8_MMA(0, 1, At, B1); PG8_BAR; PG8_SCHED;
            PG8_LDA(At, 1, 1); PG8_STAGE(PG8_SB(1, 0), b3, voffB); PG8_STAGE(PG8_SB(1, 1), b3 + hstep, voffB); PG8_STAGE(PG8_SA(1, 0), a3, wA0);
            PG8_WAIT_V(8); PG8_WAIT_L(0); PG8_BAR; PG8_MMA(1, 0, At, B0); PG8_MMA(1, 1, At, B1); PG8_BAR; PG8_SCHED;
            } else {
            PG8_LDB(B0, 0, 0); PG8_SCHED; PG8_LDA(At, 0, 0); PG8_STAGE(PG8_SA(1, 1), a1 + hstep, voffA);
            PG8_WAIT_L(8); PG8_BAR; PG8_WAIT_L(0); PG8_MMA(0, 0, At, B0); PG8_BAR; PG8_SCHED;
            PG8_LDB(B1, 0, 1); PG8_STAGE(PG8_SB(0, 0), b2, voffB);
            PG8_BAR; PG8_WAIT_L(0); PG8_MMA(0, 1, At, B1); PG8_BAR;
            PG8_LDA(At, 0, 1); PG8_STAGE(PG8_SA(0, 0), a2, voffA);
            PG8_BAR; PG8_WAIT_L(0); PG8_MMA(1, 0, At, B0); PG8_BAR; PG8_SCHED;
            PG8_STAGE(PG8_SB(0, 1), b2 + hstep, voffB);
            PG8_WAIT_V(6); PG8_BAR; PG8_MMA(1, 1, At, B1); PG8_BAR;
            PG8_LDB(B0, 1, 0); PG8_SCHED; PG8_LDA(At, 1, 0); PG8_STAGE(PG8_SA(0, 1), a2 + hstep, voffA);
            PG8_WAIT_L(8); PG8_BAR; PG8_WAIT_L(0); PG8_MMA(0, 0, At, B0); PG8_BAR; PG8_SCHED;
            PG8_LDB(B1, 1, 1); PG8_STAGE(PG8_SB(1, 0), b3, voffB);
            PG8_BAR; PG8_WAIT_L(0); PG8_MMA(0, 1, At, B1); PG8_BAR;
            PG8_LDA(At, 1, 1); PG8_STAGE(PG8_SA(1, 0), a3, voffA);
            PG8_BAR; PG8_WAIT_L(0); PG8_MMA(1, 0, At, B0); PG8_BAR; PG8_SCHED;
            PG8_STAGE(PG8_SB(1, 1), b3 + hstep, voffB);
            PG8_WAIT_V(6); PG8_BAR; PG8_MMA(1, 1, At, B1); PG8_BAR;
            }
        }
        if constexpr (ALIGN_EPI) { if (wr == 0) PG8_BAR; }
        if constexpr (!Epi::AFTER_DRAIN) { E(acc, cur, wr, wc, fr, fq); S.done(cur); }
        if (!has_next) break;
#pragma unroll
        for (int a = 0; a < 2; ++a)
#pragma unroll
            for (int b = 0; b < 2; ++b)
#pragma unroll
                for (int m = 0; m < 4; ++m)
#pragma unroll
                    for (int n = 0; n < 2; ++n) acc[a][b][m][n] = (f32x4){0.f, 0.f, 0.f, 0.f};
        cur = nxt; cA = nA; cB = nB; ++ui; vA0[0] = nvA0[0]; vA0[1] = nvA0[1]; vA1[0] = nvA1[0]; vA1[1] = nvA1[1];
        if constexpr (ALIGN_EPI) { if (wr == 1) PG8_BAR; }
    }
    PG8_WAIT_V(0);
    if constexpr (!ALIGN_EPI) { if (wr == 0) PG8_BAR; }
    PG8_BAR;
    if constexpr (Epi::AFTER_DRAIN) { E.fused(acc, cur, wr, wc, fr, fq, lds, wid, lane); S.done(cur); }
#undef PG8_GOFF
#undef PG8_SA
#undef PG8_SB
#undef PG8_STAGE
#undef PG8_LDA
#undef PG8_LDB
#undef PG8_MMA
#undef PG8_WAIT_V
#undef PG8_WAIT_L
#undef PG8_BAR
#undef PG8_SCHED
}
}
namespace pg8 {
struct EpiBf16P {
    static constexpr bool PERM = true, AFTER_DRAIN = false;
    bf16_t* O; int ldc;
    __device__ __forceinline__ void operator()(const f32x4 (&acc)[2][2][4][2], const Unit& u, int wr, int wc, int fr, int fq) const {
        const int row0 = u.pm * BM + wr * 64 + fr, col0 = u.pn * BM + wc * 32 + 8 * fq;
#pragma unroll
        for (int ai = 0; ai < 2; ++ai)
#pragma unroll
            for (int m = 0; m < 4; ++m) { bf16_t* rowp = O + (size_t)(row0 + ai * HALF + m * 16) * ldc + col0;
#pragma unroll
                for (int bj = 0; bj < 2; ++bj) { const f32x4 v0 = acc[ai][bj][m][0], v1 = acc[ai][bj][m][1];
                    u32x4 w; w.x = cvt_pk_bf16(v0[0], v0[1]); w.y = cvt_pk_bf16(v0[2], v0[3]); w.z = cvt_pk_bf16(v1[0], v1[1]); w.w = cvt_pk_bf16(v1[2], v1[3]);
                    *(u32x4*)(rowp + bj * HALF) = w; } }
    }
};
struct EpiWin {
    static constexpr bool PERM = true, AFTER_DRAIN = false;
    bf16_t* O; float* ps; float* kper; const float* gk; const float* rtab;
    __device__ __forceinline__ void operator()(const f32x4 (&acc)[2][2][4][2], const Unit& u, int wr, int wc, int fr, int fq) const {
        const int row0 = u.pm * BM + wr * 64 + fr, col0 = u.pn * BM + wc * 32 + 8 * fq;
#pragma unroll
        for (int ai = 0; ai < 2; ++ai)
#pragma unroll
            for (int m = 0; m < 4; ++m) { const int row = row0 + ai * HALF + m * 16; bf16_t* rowp = O + (size_t)row * 1280 + col0;
                float s = 0.f;
#pragma unroll
                for (int bj = 0; bj < 2; ++bj) { const f32x4 v0 = acc[ai][bj][m][0], v1 = acc[ai][bj][m][1];
                    s += ((v0[0] * v0[0] + v0[1] * v0[1]) + (v0[2] * v0[2] + v0[3] * v0[3])) + ((v1[0] * v1[0] + v1[1] * v1[1]) + (v1[2] * v1[2] + v1[3] * v1[3]));
                    u32x4 w; w.x = cvt_pk_bf16(v0[0], v0[1]); w.y = cvt_pk_bf16(v0[2], v0[3]); w.z = cvt_pk_bf16(v1[0], v1[1]); w.w = cvt_pk_bf16(v1[2], v1[3]);
                    *(u32x4*)(rowp + bj * HALF) = w; }
                s += __shfl_xor(s, 16); s += __shfl_xor(s, 32);
                if (fq == 0) ps[(size_t)row * 20 + u.pn * 4 + wc] = s; }
        if (u.pn == 4 && wc < 2) {
            const int D0 = wc * 32 + 8 * fq, jt = 8 * (fq & 1); const bool second = (fq & 2) != 0;
            const f32x4 g0 = *(const f32x4*)(gk + 128 + D0), g1 = *(const f32x4*)(gk + 128 + D0 + 4);
#pragma unroll
            for (int ai = 0; ai < 2; ++ai)
#pragma unroll
                for (int m = 0; m < 4; ++m) { const int row = row0 + ai * HALF + m * 16;
                    f32x4 x0 = acc[ai][0][m][0] * g0, x1 = acc[ai][0][m][1] * g1;
                    f32x4 p0, p1;
#pragma unroll
                    for (int i = 0; i < 4; ++i) { p0[i] = __shfl_xor(x0[i], 32); p1[i] = __shfl_xor(x1[i], 32); }
                    if (row < 16384) { const int pos = wc ? (row & 63) : ((row >> 6) & 255);
                        const f32x4 c0 = *(const f32x4*)(rtab + pos * 16 + jt), c1 = *(const f32x4*)(rtab + pos * 16 + jt + 4), s0 = *(const f32x4*)(rtab + 4096 + pos * 16 + jt), s1 = *(const f32x4*)(rtab + 4096 + pos * 16 + jt + 4);
                        x0 = second ? (x0 * c0 + p0 * s0) : (x0 * c0 - p0 * s0); x1 = second ? (x1 * c1 + p1 * s1) : (x1 * c1 - p1 * s1); }
                    *(f32x4*)(kper + (size_t)row * 64 + D0) = x0; *(f32x4*)(kper + (size_t)row * 64 + D0 + 4) = x1; }
        }
    }
};
struct EpiQkvNorm {
    static constexpr bool PERM = true, AFTER_DRAIN = false;
    bf16_t* O; const float* gq; const float* gk; PG8_LAS float* part;
    __device__ __forceinline__ void operator()(const f32x4 (&acc_in)[2][2][4][2], const Unit& u, int wr, int wc, int fr, int fq) const {
        const int row0 = u.pm * BM + wr * 64 + fr, col0 = u.pn * BM + wc * 32 + 8 * fq;
        f32x4 acc[2][2][4][2];
#pragma unroll
        for (int ai = 0; ai < 2; ++ai)
#pragma unroll
            for (int bj = 0; bj < 2; ++bj)
#pragma unroll
                for (int m = 0; m < 4; ++m) { acc[ai][bj][m][0] = acc_in[ai][bj][m][0]; acc[ai][bj][m][1] = acc_in[ai][bj][m][1]; }
        if (u.pn < 16) {
            const float* gp = (u.pn < 8 ? gq : gk) + wc * 32 + 8 * fq;
            const f32x4 g0 = *(const f32x4*)gp, g1 = *(const f32x4*)(gp + 4);
#pragma unroll
            for (int ai = 0; ai < 2; ++ai)
#pragma unroll
                for (int bj = 0; bj < 2; ++bj)
#pragma unroll
                    for (int m = 0; m < 4; ++m) { const f32x4 v0 = acc[ai][bj][m][0], v1 = acc[ai][bj][m][1];
                        float s = ((v0[0] * v0[0] + v0[1] * v0[1]) + (v0[2] * v0[2] + v0[3] * v0[3])) + ((v1[0] * v1[0] + v1[1] * v1[1]) + (v1[2] * v1[2] + v1[3] * v1[3]));
                        s += __shfl_xor(s, 16); s += __shfl_xor(s, 32);
                        if (fq == 0) part[((ai * HALF + wr * 64 + m * 16 + fr) * 2 + bj) * 4 + wc] = s; }
            asm volatile("s_waitcnt lgkmcnt(0)" ::: "memory"); __builtin_amdgcn_s_barrier();
#pragma unroll
            for (int ai = 0; ai < 2; ++ai)
#pragma unroll
                for (int bj = 0; bj < 2; ++bj)
#pragma unroll
                    for (int m = 0; m < 4; ++m) { const f32x4 p = *(const PG8_LAS f32x4*)(part + ((ai * HALF + wr * 64 + m * 16 + fr) * 2 + bj) * 4);
                        const float rs = __builtin_amdgcn_rsqf(((p[0] + p[1]) + (p[2] + p[3])) * (1.f / 128.f) + 1e-6f);
                        acc[ai][bj][m][0] = acc[ai][bj][m][0] * rs * g0; acc[ai][bj][m][1] = acc[ai][bj][m][1] * rs * g1; }
            asm volatile("s_waitcnt lgkmcnt(0)" ::: "memory"); __builtin_amdgcn_s_barrier();
        }
#pragma unroll
        for (int ai = 0; ai < 2; ++ai)
#pragma unroll
            for (int m = 0; m < 4; ++m) { bf16_t* rowp = O + (size_t)(row0 + ai * HALF + m * 16) * 6144 + col0;
#pragma unroll
                for (int bj = 0; bj < 2; ++bj) { const f32x4 v0 = acc[ai][bj][m][0], v1 = acc[ai][bj][m][1];
                    u32x4 w; w.x = cvt_pk_bf16(v0[0], v0[1]); w.y = cvt_pk_bf16(v0[2], v0[3]); w.z = cvt_pk_bf16(v1[0], v1[1]); w.w = cvt_pk_bf16(v1[2], v1[3]);
                    *(u32x4*)(rowp + bj * HALF) = w; } }
    }
};
struct EpiKv {
    static constexpr bool PERM = true, AFTER_DRAIN = false;
    bf16_t* O; const float* gk; const float* kper; const float* ps; PG8_LAS float* part; unsigned char* vt;
    __device__ __forceinline__ void operator()(const f32x4 (&acc)[2][2][4][2], const Unit& u, int wr, int wc, int fr, int fq) const {
        const int row0 = u.pm * BM + wr * 64 + fr, h = u.pn;
        const f32x4 g0 = *(const f32x4*)(gk + wc * 32 + 8 * fq), g1 = *(const f32x4*)(gk + wc * 32 + 8 * fq + 4);
#pragma unroll
        for (int ai = 0; ai < 2; ++ai)
#pragma unroll
            for (int m = 0; m < 4; ++m) { const f32x4 v0 = acc[ai][0][m][0], v1 = acc[ai][0][m][1];
                float s = ((v0[0] * v0[0] + v0[1] * v0[1]) + (v0[2] * v0[2] + v0[3] * v0[3])) + ((v1[0] * v1[0] + v1[1] * v1[1]) + (v1[2] * v1[2] + v1[3] * v1[3]));
                s += __shfl_xor(s, 16); s += __shfl_xor(s, 32);
                if (fq == 0) part[(ai * HALF + wr * 64 + m * 16 + fr) * 4 + wc] = s; }
        asm volatile("s_waitcnt lgkmcnt(0)" ::: "memory"); __builtin_amdgcn_s_barrier();
        float rkv_[2][4];
#pragma unroll
        for (int ai = 0; ai < 2; ++ai)
#pragma unroll
            for (int m = 0; m < 4; ++m) { const int row = row0 + ai * HALF + m * 16;
                const f32x4 p = *(const PG8_LAS f32x4*)(part + (ai * HALF + wr * 64 + m * 16 + fr) * 4);
                const f32x4 q2 = *(const f32x4*)(ps + (size_t)row * 20 + 8), q3 = *(const f32x4*)(ps + (size_t)row * 20 + 12), q4 = *(const f32x4*)(ps + (size_t)row * 20 + 16);
                const float rkv = __builtin_amdgcn_rsqf((((q2[0] + q2[1]) + (q2[2] + q2[3])) + ((q3[0] + q3[1]) + (q3[2] + q3[3]))) * (1.f / 512.f) + 1e-6f);
                rkv_[ai][m] = rkv;
                const float rs = __builtin_amdgcn_rsqf((((p[0] + p[1]) + (p[2] + p[3])) * (rkv * rkv) + ((q4[0] + q4[1]) + (q4[2] + q4[3]))) * (1.f / 192.f) + 1e-6f) * 0.32267250623034593f;
                const float rsn = rs * rkv;
                unsigned char* slot = (unsigned char*)O + (size_t)row * 8192 + h * 512;
                const f32x4 v0 = acc[ai][0][m][0] * rsn * g0, v1 = acc[ai][0][m][1] * rsn * g1;
                int w0 = 0, w1 = 0;
                w0 = __builtin_amdgcn_cvt_pk_fp8_f32(v0[0], v0[1], w0, false); w0 = __builtin_amdgcn_cvt_pk_fp8_f32(v0[2], v0[3], w0, true);
                w1 = __builtin_amdgcn_cvt_pk_fp8_f32(v1[0], v1[1], w1, false); w1 = __builtin_amdgcn_cvt_pk_fp8_f32(v1[2], v1[3], w1, true);
                u32x2 kw; kw.x = (unsigned)w0; kw.y = (unsigned)w1; *(u32x2*)(slot + wc * 32 + 8 * fq) = kw;
                const f32x4 r4 = *(const f32x4*)(kper + (size_t)row * 64 + wc * 16 + 4 * fq) * rs;
                int w2 = 0; w2 = __builtin_amdgcn_cvt_pk_fp8_f32(r4[0], r4[1], w2, false); w2 = __builtin_amdgcn_cvt_pk_fp8_f32(r4[2], r4[3], w2, true);
                *(unsigned*)(slot + 128 + wc * 16 + 4 * fq) = (unsigned)w2;
            }
        asm volatile("s_waitcnt lgkmcnt(0)" ::: "memory"); __builtin_amdgcn_s_barrier();
        const int mq = fr & 3, aq = fr >> 2;
        const unsigned sel01 = (unsigned)mq | ((unsigned)(4 + mq) << 8);
        const int sd = 8 * (aq & 1) + 4 * (mq >> 1) + 2 * (mq & 1) + (aq >> 1);
#pragma unroll
        for (int ai = 0; ai < 2; ++ai) {
            unsigned char* tile = vt + ((size_t)h * (16640 / 64) + (size_t)(u.pm * 4 + ai * 2 + wr)) * 8192 + (size_t)(wc * 32 + 8 * fq) * 64 + 4 * sd;
#pragma unroll
            for (int j = 0; j < 8; ++j) {
                int L = 0;
                L = __builtin_amdgcn_cvt_pk_fp8_f32(acc[ai][1][0][j >> 2][j & 3] * rkv_[ai][0], acc[ai][1][1][j >> 2][j & 3] * rkv_[ai][1], L, false);
                L = __builtin_amdgcn_cvt_pk_fp8_f32(acc[ai][1][2][j >> 2][j & 3] * rkv_[ai][2], acc[ai][1][3][j >> 2][j & 3] * rkv_[ai][3], L, true);
                const unsigned x0 = (unsigned)__builtin_amdgcn_mov_dpp(L, 0x00, 0xf, 0xf, false), x1 = (unsigned)__builtin_amdgcn_mov_dpp(L, 0x55, 0xf, 0xf, false);
                const unsigned x2 = (unsigned)__builtin_amdgcn_mov_dpp(L, 0xAA, 0xf, 0xf, false), x3 = (unsigned)__builtin_amdgcn_mov_dpp(L, 0xFF, 0xf, 0xf, false);
                const unsigned t01 = __builtin_amdgcn_perm(x1, x0, sel01), t23 = __builtin_amdgcn_perm(x3, x2, sel01);
                *(unsigned*)(tile + j * 64) = __builtin_amdgcn_perm(t23, t01, 0x05040100u);
            }
        }
    }
};
struct EpiRes {
    static constexpr bool PERM = false, AFTER_DRAIN = false;
    float* out; const float* res_lat; const float* res_ctx; const float* g_lat; const float* g_ctx;
    __device__ __forceinline__ void operator()(const f32x4 (&acc)[2][2][4][2], const Unit& u, int wr, int wc, int fr, int fq) const {
        const bool isctx = (u.pm >= 64);
        const int row0 = u.pm * BM + wr * 64 + fr, col0 = u.pn * BM + wc * 32 + 4 * fq;
        const float* res = isctx ? res_ctx : res_lat; const float* gv = isctx ? g_ctx : g_lat; const int rsub = isctx ? 16384 : 0;
        f32x4 g4[2][2];
#pragma unroll
        for (int bj = 0; bj < 2; ++bj)
#pragma unroll
            for (int n = 0; n < 2; ++n) g4[bj][n] = *(const f32x4*)(gv + col0 + bj * HALF + n * 16);
#pragma unroll
        for (int ai = 0; ai < 2; ++ai)
#pragma unroll
            for (int m = 0; m < 4; ++m) { const int row = row0 + ai * HALF + m * 16; float* op = out + (size_t)row * 2048 + col0; const float* rp = res + (size_t)(row - rsub) * 2048 + col0;
#pragma unroll
                for (int bj = 0; bj < 2; ++bj)
#pragma unroll
                    for (int n = 0; n < 2; ++n) { const f32x4 r = *(const f32x4*)(rp + bj * HALF + n * 16); *(f32x4*)(op + bj * HALF + n * 16) = r + g4[bj][n] * acc[ai][bj][m][n]; } }
    }
};
template <bool RESB>
struct EpiResB {
    static constexpr bool PERM = true, AFTER_DRAIN = false;
    bf16_t* out; const void* res_lat; const void* res_ctx; const float* g_lat; const float* g_ctx;
    __device__ __forceinline__ void operator()(const f32x4 (&acc)[2][2][4][2], const Unit& u, int wr, int wc, int fr, int fq) const {
        const bool isctx = (u.pm >= 64);
        const int row0 = u.pm * BM + wr * 64 + fr, col0 = u.pn * BM + wc * 32 + 8 * fq;
        const void* res = isctx ? res_ctx : res_lat; const float* gv = isctx ? g_ctx : g_lat; const int rsub = (!RESB && isctx) ? 16384 : 0;
        f32x4 g4[2][2];
#pragma unroll
        for (int bj = 0; bj < 2; ++bj)
#pragma unroll
            for (int n = 0; n < 2; ++n) g4[bj][n] = *(const f32x4*)(gv + col0 + bj * HALF + n * 4);
#pragma unroll
        for (int ai = 0; ai < 2; ++ai)
#pragma unroll
            for (int m = 0; m < 4; ++m) { const int row = row0 + ai * HALF + m * 16; bf16_t* op = out + (size_t)row * 2048 + col0;
#pragma unroll
                for (int bj = 0; bj < 2; ++bj) { f32x4 r0, r1;
                    if constexpr (RESB) { const u32x4 w = *(const u32x4*)((const bf16_t*)res + (size_t)row * 2048 + col0 + bj * HALF);
                        r0 = (f32x4){__uint_as_float(w.x << 16), __uint_as_float(w.x & 0xffff0000u), __uint_as_float(w.y << 16), __uint_as_float(w.y & 0xffff0000u)};
                        r1 = (f32x4){__uint_as_float(w.z << 16), __uint_as_float(w.z & 0xffff0000u), __uint_as_float(w.w << 16), __uint_as_float(w.w & 0xffff0000u)}; }
                    else { const float* rp = (const float*)res + (size_t)(row - rsub) * 2048 + col0 + bj * HALF; r0 = *(const f32x4*)rp; r1 = *(const f32x4*)(rp + 4); }
                    const f32x4 v0 = r0 + g4[bj][0] * acc[ai][bj][m][0], v1 = r1 + g4[bj][1] * acc[ai][bj][m][1];
                    u32x4 w; w.x = cvt_pk_bf16(v0[0], v0[1]); w.y = cvt_pk_bf16(v0[2], v0[3]); w.z = cvt_pk_bf16(v1[0], v1[1]); w.w = cvt_pk_bf16(v1[2], v1[3]);
                    *(u32x4*)(op + bj * HALF) = w; } }
    }
};
struct EpiSwiGLU {
    static constexpr bool PERM = true, AFTER_DRAIN = false;
    bf16_t* H;
    __device__ __forceinline__ void operator()(const f32x4 (&acc)[2][2][4][2], const Unit& u, int wr, int wc, int fr, int fq) const {
        const int e = u.pm / 9, nl = u.pn - e * 11;
        const int row0 = u.pm * BM + wr * 64 + fr, col0 = nl * 128 + wc * 32 + 8 * fq;
#pragma unroll
        for (int ai = 0; ai < 2; ++ai)
#pragma unroll
            for (int m = 0; m < 4; ++m) { bf16_t* rowp = H + (size_t)(row0 + ai * HALF + m * 16) * 1408 + col0;
                float hv[8];
#pragma unroll
                for (int n = 0; n < 2; ++n)
#pragma unroll
                    for (int i = 0; i < 4; ++i) { const float g = acc[ai][0][m][n][i], up = acc[ai][1][m][n][i];
                        const float s = g * __builtin_amdgcn_rcpf(1.f + __builtin_amdgcn_exp2f(-1.4426950408889634f * g)); hv[n * 4 + i] = s * up; }
                u32x4 w; w.x = cvt_pk_bf16(hv[0], hv[1]); w.y = cvt_pk_bf16(hv[2], hv[3]); w.z = cvt_pk_bf16(hv[4], hv[5]); w.w = cvt_pk_bf16(hv[6], hv[7]);
                *(u32x4*)rowp = w; }
    }
};
struct EpiDown {
    static constexpr bool PERM = true, AFTER_DRAIN = false;
    bf16_t* Y; const float* gate;
    __device__ __forceinline__ void operator()(const f32x4 (&acc)[2][2][4][2], const Unit& u, int wr, int wc, int fr, int fq) const {
        const int e = u.pm / 9, nl = u.pn - e * 8;
        const int row0 = u.pm * BM + wr * 64 + fr, col0 = nl * BM + wc * 32 + 8 * fq;
#pragma unroll
        for (int ai = 0; ai < 2; ++ai)
#pragma unroll
            for (int m = 0; m < 4; ++m) { const int row = row0 + ai * HALF + m * 16; const float gt = gate[row]; bf16_t* rowp = Y + (size_t)row * 2048 + col0;
#pragma unroll
                for (int bj = 0; bj < 2; ++bj) { const f32x4 v0 = acc[ai][bj][m][0] * gt, v1 = acc[ai][bj][m][1] * gt;
                    u32x4 w; w.x = cvt_pk_bf16(v0[0], v0[1]); w.y = cvt_pk_bf16(v0[2], v0[3]); w.z = cvt_pk_bf16(v1[0], v1[1]); w.w = cvt_pk_bf16(v1[2], v1[3]);
                    *(u32x4*)(rowp + bj * HALF) = w; } }
    }
};
struct GroupedOrder {
    int tm, tn, total, G, c;
    __device__ void init(int tm_, int tn_, int G_, int c_) { tm = tm_; tn = tn_; total = NE_ * tm_ * tn_; G = G_; c = c_; }
    static constexpr int NE_ = 16;
    __device__ bool next(int i, Unit& u) const {
        int L = i * G + c; if (L >= total) return false;
        if ((total & 7) == 0) L = (L & 7) * (total >> 3) + (L >> 3);
        const int per = tm * tn, e = L / per, r = L - e * per, pml = r / tn, pnl = r - pml * tn;
        u.pm = e * 9 + pml; u.pn = e * tn + pnl; return true;
    }
    __device__ __forceinline__ void a_ready(const Unit&) const {}
    __device__ __forceinline__ void done(const Unit&) const {}
};
}
namespace att {
constexpr int NW = 8, QBLK = 32, KVBLK = 64;
constexpr int SHM_V = 16384, SHM_KN = 16384, SHM_KP = 8192;
constexpr int OFF_V = 0, OFF_KN = 32768, OFF_KP = 65536, OFF_WS = 81920, OFF_BIAS = 83968;
constexpr int ATT_LDS = OFF_BIAS + 4096;
constexpr float THR = 8.f;
#define KSWZ(row, colB) ((row) * 256 + ((colB) ^ (((row) & 15) << 4)))
#define KPSWZ(row, colB) ((row) * 128 + ((colB) ^ ((((row) >> 1) & 7) << 4)))
#define SBAR() __builtin_amdgcn_sched_barrier(0)
__device__ __forceinline__ int crow(int r, int hi) { return (r & 3) + 8 * (r >> 2) + 4 * hi; }
__device__ __forceinline__ unsigned cvtpk_v(float lo, float hi) { unsigned r; asm volatile("v_cvt_pk_bf16_f32 %0, %1, %2" : "=v"(r) : "v"(lo), "v"(hi)); return r; }

template <int DUMMY = 0>
__device__ __forceinline__ void partialSM(f32x16& p0, f32x16& p1, float& m_reg, float& mn, float& alpha, const float C, const float thr_raw) {
    float pmax = p0[0];
#pragma unroll
    for (int r = 1; r < 16; ++r) pmax = fmaxf(pmax, p0[r]);
#pragma unroll
    for (int r = 0; r < 16; ++r) pmax = fmaxf(pmax, p1[r]);
    { auto rr = __builtin_amdgcn_permlane32_swap(__float_as_uint(pmax), __float_as_uint(pmax), false, false);
      pmax = fmaxf(__uint_as_float(rr[0]), __uint_as_float(rr[1])); }
    if (__builtin_expect(__all(pmax - m_reg <= thr_raw), 1)) { mn = m_reg; alpha = 1.f; }
    else { mn = fmaxf(m_reg, pmax); alpha = __builtin_amdgcn_exp2f((m_reg - mn) * C); m_reg = mn; }
    const float mnC = -mn * C;
#pragma unroll
    for (int r = 0; r < 16; ++r) p0[r] = fmaf(p0[r], C, mnC);
#pragma unroll
    for (int r = 0; r < 16; ++r) p1[r] = fmaf(p1[r], C, mnC);
#pragma unroll
    for (int r = 0; r < 16; ++r) p0[r] = __builtin_amdgcn_exp2f(p0[r]);
}
__device__ __forceinline__ void sm_static(f32x16& p0, f32x16& p1, const float C, const float negm) {
#pragma unroll
    for (int r = 0; r < 16; ++r) p0[r] = fmaf(p0[r], C, negm);
#pragma unroll
    for (int r = 0; r < 16; ++r) p1[r] = fmaf(p1[r], C, negm);
#pragma unroll
    for (int r = 0; r < 16; ++r) p0[r] = __builtin_amdgcn_exp2f(p0[r]);
}
__device__ __forceinline__ void partialSM_na(f32x16& p0, f32x16& p1, float& m_reg, float& mn, float& alpha, const float C, int kr, int qrow, int rs, int lb, int lm, int lb2, const LAS float* btab) {
    const bool isctx = (kr == -1), rowok = (kr >= rs) && (kr < rs + 8);
    const int vm0 = isctx ? -1 : (rowok ? lm : 0), vm1 = isctx ? -1 : (rowok ? lb2 : 0);
    const LAS float* brow = (isctx || !rowok) ? (btab + 600) : (btab + (kr - qrow + 7) * 31 + lb);
    constexpr unsigned NEGB = 0xff61b1e6u;
#define NA_GRP(P, VM, R0, KOFF) do { _Pragma("unroll") for (int r = R0; r < R0 + 8; ++r) { const int kc0 = (r & 3) + 8 * (r >> 2); \
        const unsigned v_ = (unsigned)__builtin_amdgcn_sbfe(VM, kc0, 1);     \
        unsigned bm_; asm("v_bfi_b32 %0, %1, %2, %3" : "=v"(bm_) : "v"(v_), "v"(brow[kc0 + KOFF]), "v"(NEGB));       \
        P[r] = fmaf(P[r], C, __uint_as_float(bm_)); } SBAR(); } while (0)
    NA_GRP(p0, vm0, 0, 0); NA_GRP(p0, vm0, 8, 0); NA_GRP(p1, vm1, 0, 32); NA_GRP(p1, vm1, 8, 32);
#undef NA_GRP
    float pmax = p0[0];
#pragma unroll
    for (int r = 1; r < 16; ++r) pmax = fmaxf(pmax, p0[r]);
#pragma unroll
    for (int r = 0; r < 16; ++r) pmax = fmaxf(pmax, p1[r]);
    { auto rr = __builtin_amdgcn_permlane32_swap(__float_as_uint(pmax), __float_as_uint(pmax), false, false);
      pmax = fmaxf(__uint_as_float(rr[0]), __uint_as_float(rr[1])); }
    if (__builtin_expect(__all(pmax - m_reg <= THR * LOG2E), 1)) { mn = m_reg; alpha = 1.f; }
    else { mn = fmaxf(m_reg, pmax); alpha = __builtin_amdgcn_exp2f(m_reg - mn); m_reg = mn; }
    p0 = p0 - mn; p1 = p1 - mn;
#pragma unroll
    for (int r = 0; r < 16; ++r) p0[r] = __builtin_amdgcn_exp2f(p0[r]);
}
__device__ __forceinline__ void finishSM(f32x16& p0, f32x16& p1, float alpha, float& l_reg, bf16x8& pa0, bf16x8& pa1, bf16x8& pa2, bf16x8& pa3) {
#pragma unroll
    for (int r = 0; r < 16; ++r) p1[r] = __builtin_amdgcn_exp2f(p1[r]);
    f32x2 ps2 = {0.f, 0.f};
#pragma unroll
    for (int r = 0; r < 16; r += 2) { ps2 += (f32x2){p0[r], p0[r + 1]}; ps2 += (f32x2){p1[r], p1[r + 1]}; }
    float ps = ps2.x + ps2.y;
    { auto rr = __builtin_amdgcn_permlane32_swap(__float_as_uint(ps), __float_as_uint(ps), false, false);
      ps = __uint_as_float(rr[0]) + __uint_as_float(rr[1]); }
    l_reg = l_reg * alpha + ps;
#define PK4(P, BASE, OUT) do { unsigned a0 = cvtpk_v(P[BASE + 0], P[BASE + 1]), a1 = cvtpk_v(P[BASE + 2], P[BASE + 3]);   \
    unsigned b0 = cvtpk_v(P[BASE + 4], P[BASE + 5]), b1 = cvtpk_v(P[BASE + 6], P[BASE + 7]);                              \
    auto r0 = __builtin_amdgcn_permlane32_swap(a0, b0, false, false); auto r1 = __builtin_amdgcn_permlane32_swap(a1, b1, false, false); \
    u32x4 w = {r0[0], r1[0], r0[1], r1[1]}; OUT = __builtin_bit_cast(bf16x8, w); } while (0)
    PK4(p0, 0, pa0); PK4(p0, 8, pa1); PK4(p1, 0, pa2); PK4(p1, 8, pa3);
#undef PK4
}
#ifndef ATT_PRIO
#define ATT_PRIO 0
#endif
template <int NPE>
__device__ __forceinline__ void qkt(f32x16& p0, f32x16& p1, const LAS char* Kn, const LAS char* Kp, const bf16x8* qr, int r32, int hi) {
    p0 = f32x16{}; p1 = f32x16{};
#if ATT_PRIO
    __builtin_amdgcn_s_setprio(1);
#endif
#pragma unroll
    for (int d0 = 0; d0 < 8; ++d0) { const int cb = (d0 * 16 + hi * 8) * 2;
        const bf16x8 b0 = *(const LAS bf16x8*)(Kn + KSWZ(r32, cb));
        const bf16x8 b1 = *(const LAS bf16x8*)(Kn + KSWZ(32 + r32, cb));
        p0 = __builtin_amdgcn_mfma_f32_32x32x16_bf16(b0, qr[d0], p0, 0, 0, 0);
        p1 = __builtin_amdgcn_mfma_f32_32x32x16_bf16(b1, qr[d0], p1, 0, 0, 0); }
#pragma unroll
    for (int d0 = 0; d0 < NPE; ++d0) { const int cb = (d0 * 16 + hi * 8) * 2;
        const bf16x8 b0 = *(const LAS bf16x8*)(Kp + KPSWZ(r32, cb));
        const bf16x8 b1 = *(const LAS bf16x8*)(Kp + KPSWZ(32 + r32, cb));
        p0 = __builtin_amdgcn_mfma_f32_32x32x16_bf16(b0, qr[8 + d0], p0, 0, 0, 0);
        p1 = __builtin_amdgcn_mfma_f32_32x32x16_bf16(b1, qr[8 + d0], p1, 0, 0, 0); }
#if ATT_PRIO
    __builtin_amdgcn_s_setprio(0);
#endif
}
__device__ __forceinline__ int v_st(int k, int c) { const int kk = (k & ~0xC) | ((k & 4) << 1) | ((k & 8) >> 1); return ((kk >> 3) * 4 + (c >> 5)) * 512 + ((kk & 7) * 32 + (c & 31)) * 2; }
__device__ __forceinline__ int v_rd_base(int lane) { return ((lane & 3) << 3) | (((lane >> 2) & 3) << 6) | (((lane >> 4) & 1) << 5) | (((lane >> 5) & 1) << 8); }
constexpr int v_rd_off(int d0, int ks, int half) { return d0 * 512 + ks * 4096 + half * 2048; }
typedef short v4i16_t __attribute__((ext_vector_type(4)));
#ifndef PV_ASM
#define PV_ASM 0
#endif
#if PV_ASM
template <int OFF> __device__ __forceinline__ s16x4 tr_read(int vb) {
    s16x4 r; asm volatile("ds_read_b64_tr_b16 %0, %1 offset:%2" : "=&v"(r) : "v"(vb), "i"(OFF) : "memory"); return r;
}
#else
template <int OFF> __device__ __forceinline__ s16x4 tr_read(int vb) {
    return __builtin_bit_cast(s16x4, __builtin_amdgcn_ds_read_tr16_b64_v4i16((LAS v4i16_t*)(unsigned)(vb + OFF)));
}
#endif
template <int D0> __device__ __forceinline__ void pv_one(f32x16& od, int vb, bf16x8 pa0, bf16x8 pa1, bf16x8 pa2, bf16x8 pa3) {
    const s16x4 l0 = tr_read<v_rd_off(D0, 0, 0)>(vb), h0 = tr_read<v_rd_off(D0, 0, 1)>(vb), l1 = tr_read<v_rd_off(D0, 1, 0)>(vb), h1 = tr_read<v_rd_off(D0, 1, 1)>(vb);
    const s16x4 l2 = tr_read<v_rd_off(D0, 2, 0)>(vb), h2 = tr_read<v_rd_off(D0, 2, 1)>(vb), l3 = tr_read<v_rd_off(D0, 3, 0)>(vb), h3 = tr_read<v_rd_off(D0, 3, 1)>(vb);
#if PV_ASM
    asm volatile("s_waitcnt lgkmcnt(0)" ::: "memory"); SBAR();
#endif
#define PK(L, H) (bf16x8){L[0], L[1], L[2], L[3], H[0], H[1], H[2], H[3]}
#if ATT_PRIO
    __builtin_amdgcn_s_setprio(1);
#endif
    od = __builtin_amdgcn_mfma_f32_32x32x16_bf16(pa0, PK(l0, h0), od, 0, 0, 0);
    od = __builtin_amdgcn_mfma_f32_32x32x16_bf16(pa1, PK(l1, h1), od, 0, 0, 0);
    od = __builtin_amdgcn_mfma_f32_32x32x16_bf16(pa2, PK(l2, h2), od, 0, 0, 0);
    od = __builtin_amdgcn_mfma_f32_32x32x16_bf16(pa3, PK(l3, h3), od, 0, 0, 0);
#if ATT_PRIO
    __builtin_amdgcn_s_setprio(0);
#endif
#undef PK
}
__device__ __forceinline__ void pv_d0(f32x16* o, int vb, bf16x8 pa0, bf16x8 pa1, bf16x8 pa2, bf16x8 pa3) {
    pv_one<0>(o[0], vb, pa0, pa1, pa2, pa3); pv_one<1>(o[1], vb, pa0, pa1, pa2, pa3); pv_one<2>(o[2], vb, pa0, pa1, pa2, pa3); pv_one<3>(o[3], vb, pa0, pa1, pa2, pa3);
}

#define RESC(a) do { if (__any((a) < 1.f)) { if (hi == 0) al_l[r32] = (a); asm volatile("s_waitcnt lgkmcnt(0)" ::: "memory"); \
    _Pragma("unroll") for (int d = 0; d < 4; ++d) _Pragma("unroll") for (int r = 0; r < 16; ++r) o[d][r] *= al_l[crow(r, hi)]; } } while (0)

typedef int v8i __attribute__((ext_vector_type(8)));
constexpr int KPITCH = 208, VPITCH = 80, MSLOT = 23552, M_KN = 0, M_VT = 13312, M_WS = 122880;
static_assert(64 * KPITCH == M_VT && M_VT + 128 * VPITCH == MSLOT && 5 * MSLOT <= M_WS, "MLA slot layout");
__device__ __forceinline__ void glds16(const void* gsrc, unsigned lds_dst) { unsigned keep;
    asm volatile("s_mov_b32 %0, m0\n\ts_mov_b32 m0, %2\n\ts_nop 0\n\tglobal_load_lds_dwordx4 %1, off\n\ts_mov_b32 m0, %0" : "=&s"(keep) : "v"(gsrc), "s"(lds_dst) : "memory"); }
__device__ __forceinline__ void glds16s(const void* sbase, unsigned voff, unsigned lds_dst) { unsigned keep;
    asm volatile("s_mov_b32 %0, m0\n\ts_mov_b32 m0, %3\n\ts_nop 0\n\tglobal_load_lds_dwordx4 %1, %2\n\ts_mov_b32 m0, %0" : "=&s"(keep) : "v"(voff), "s"(sbase), "s"(lds_dst) : "memory"); }
#define WAIT_BAR0() asm volatile("s_waitcnt vmcnt(0) lgkmcnt(0)\n\ts_barrier" ::: "memory")
__device__ __forceinline__ void qkt8(f32x16& p0, f32x16& p1, const f32x16& bias, const LAS char* Kl, const v8i* q8) {
#pragma unroll
    for (int ks = 0; ks < 3; ++ks) {
        const u32x4 a0 = *(const LAS u32x4*)(Kl + 64 * ks), a1 = *(const LAS u32x4*)(Kl + 64 * ks + 16);
        const u32x4 b0 = *(const LAS u32x4*)(Kl + 32 * KPITCH + 64 * ks), b1 = *(const LAS u32x4*)(Kl + 32 * KPITCH + 64 * ks + 16);
        const v8i ka = {(int)a0.x, (int)a0.y, (int)a0.z, (int)a0.w, (int)a1.x, (int)a1.y, (int)a1.z, (int)a1.w};
        const v8i kb = {(int)b0.x, (int)b0.y, (int)b0.z, (int)b0.w, (int)b1.x, (int)b1.y, (int)b1.z, (int)b1.w};
        p0 = __builtin_amdgcn_mfma_scale_f32_32x32x64_f8f6f4(ka, q8[ks], ks ? p0 : bias, 0, 0, 0, 0, 0, 0);
        p1 = __builtin_amdgcn_mfma_scale_f32_32x32x64_f8f6f4(kb, q8[ks], ks ? p1 : bias, 0, 0, 0, 0, 0, 0); }
}
__device__ __forceinline__ float vmax2(float a, float b) { float d; asm("v_max_f32 %0, %1, %2" : "=v"(d) : "v"(a), "v"(b)); return d; }
template <bool FIRST>
__device__ __forceinline__ void sm8_a(f32x16& p0, f32x16& p1, f32x16& bias, f32x16* o, LAS float* al_l, int r32, int hi) {
    float xm = __builtin_fmaxf(__builtin_fmaxf(p0[0], p0[1]), p1[0]), xn = __builtin_fmaxf(__builtin_fmaxf(p0[2], p0[3]), p1[1]);
    xm = __builtin_fmaxf(__builtin_fmaxf(xm, p1[2]), p1[3]);
#pragma unroll
    for (int r = 4; r < 16; r += 4) { xm = __builtin_fmaxf(__builtin_fmaxf(xm, p0[r]), p0[r + 1]); xn = __builtin_fmaxf(__builtin_fmaxf(xn, p0[r + 2]), p0[r + 3]);
        xm = __builtin_fmaxf(__builtin_fmaxf(xm, p1[r]), p1[r + 1]); xn = __builtin_fmaxf(__builtin_fmaxf(xn, p1[r + 2]), p1[r + 3]); }
    xm = __builtin_fmaxf(xm, xn);
    { auto rr = __builtin_amdgcn_permlane32_swap(__float_as_uint(xm), __float_as_uint(xm), false, false);
      xm = vmax2(__uint_as_float(rr[0]), __uint_as_float(rr[1])); }
    if (FIRST || !__builtin_expect(__all(xm <= 8.5f), 1)) {
        const float dl = FIRST ? xm - 7.f : fmaxf(xm - 7.f, 0.f);
#pragma unroll
        for (int r = 0; r < 16; ++r) { bias[r] -= dl; p0[r] -= dl; p1[r] -= dl; }
        if (!FIRST) {
            if (hi == 0) al_l[r32] = __builtin_amdgcn_exp2f(-dl);
            asm volatile("s_waitcnt lgkmcnt(0)" ::: "memory");
#pragma unroll
            for (int d = 0; d < 5; ++d)
#pragma unroll
                for (int r = 0; r < 16; ++r) o[d][r] *= al_l[crow(r, hi)];
        }
    }
    asm volatile("" : "+v"(bias));
}
__device__ __forceinline__ void sm8_b(f32x16& p0, f32x16& p1, v8i& pa) {
#pragma unroll
    for (int r = 0; r < 16; ++r) p0[r] = __builtin_amdgcn_exp2f(p0[r]);
#pragma unroll
    for (int r = 0; r < 16; ++r) p1[r] = __builtin_amdgcn_exp2f(p1[r]);
#pragma unroll
    for (int w = 0; w < 4; ++w) { int x = pa[w]; x = __builtin_amdgcn_cvt_pk_fp8_f32(p0[4 * w], p0[4 * w + 1], x, false); x = __builtin_amdgcn_cvt_pk_fp8_f32(p0[4 * w + 2], p0[4 * w + 3], x, true); pa[w] = x; }
#pragma unroll
    for (int w = 0; w < 4; ++w) { int x = pa[4 + w]; x = __builtin_amdgcn_cvt_pk_fp8_f32(p1[4 * w], p1[4 * w + 1], x, false); x = __builtin_amdgcn_cvt_pk_fp8_f32(p1[4 * w + 2], p1[4 * w + 3], x, true); pa[4 + w] = x; }
}
__device__ __forceinline__ void pv8(f32x16* o, const LAS char* Vl, const v8i pa, const v8i ones) {
#pragma unroll
    for (int d0 = 0; d0 < 4; ++d0) { const LAS char* row = Vl + 32 * d0 * VPITCH;
        const u32x4 b0 = *(const LAS u32x4*)(row), b1 = *(const LAS u32x4*)(row + 16);
        const v8i vb = {(int)b0.x, (int)b0.y, (int)b0.z, (int)b0.w, (int)b1.x, (int)b1.y, (int)b1.z, (int)b1.w};
        o[d0] = __builtin_amdgcn_mfma_scale_f32_32x32x64_f8f6f4(pa, vb, o[d0], 0, 0, 0, 0, 0, 0); }
    o[4] = __builtin_amdgcn_mfma_scale_f32_32x32x64_f8f6f4(pa, ones, o[4], 0, 0, 0, 0, 0, 0);
}
#ifndef MLA_ALPHA
#define MLA_ALPHA 1.0f
#endif
__device__ __forceinline__ void mla_unit(const unsigned char* __restrict__ Q8, const unsigned char* __restrict__ K8, const unsigned char* __restrict__ Vt, bf16* __restrict__ Ob, int seq, LAS char* lds,
                                         const float* __restrict__ qgain, const float* __restrict__ rtab, const float* __restrict__ ps, int tok0, bool lat) {
    const int tid = ltid(), lane = tid & 63, r32 = lane & 31, hi = lane >> 5; const int wid = __builtin_amdgcn_readfirstlane(tid >> 6);
    LAS float* wsx = (LAS float*)(lds + M_WS) + wid * 64; LAS float* al_l = wsx + 32;
    unsigned d_off[3]; bool d_isk[3]; unsigned d_dst[3];
#pragma unroll
    for (int i = 0; i < 3; ++i) { int P = 3 * wid + i; if (P > 22) P = 22; d_isk[i] = P < 13; d_dst[i] = P * 1024;
        if (P < 13) { const int g = 64 * P + lane, row = g / 13, ch = g - 13 * row; d_off[i] = row * 8192 + (ch < 12 ? ch : 0) * 16; }
        else { const int g = 64 * (P - 13) + lane, d = g / 5, ch = g - 5 * d; d_off[i] = d * 64 + (ch < 4 ? ch : 0) * 16; } }
#define DMA_TILE(t, slot) do { const unsigned sb_ = (unsigned)((slot) * MSLOT); const unsigned char* kb_ = K8 + (size_t)(t) * 64 * 8192; const unsigned char* vb_ = Vt + (size_t)(t) * 8192; \
    glds16s(d_isk[0] ? kb_ : vb_, d_off[0], sb_ + d_dst[0]); glds16s(d_isk[1] ? kb_ : vb_, d_off[1], sb_ + d_dst[1]); glds16s(d_isk[2] ? kb_ : vb_, d_off[2], sb_ + d_dst[2]); } while (0)
    const int klane = r32 * KPITCH + hi * 32, vlane = M_VT + r32 * VPITCH + hi * 32;
    DMA_TILE(0, 0); DMA_TILE(1, 1);
    f32x16 o[5] = {}; v8i q8[3];
    { const unsigned char* Qw = Q8 + (size_t)(wid * QBLK + r32) * 6144 + hi * 64;
      float f[3][32];
#pragma unroll
      for (int ks = 0; ks < 3; ++ks)
#pragma unroll
          for (int c = 0; c < 4; ++c) { const u32x4 x = *(const u32x4*)(Qw + 128 * ks + 16 * c);
              f[ks][8 * c + 0] = bflo(x.x); f[ks][8 * c + 1] = bfhi(x.x); f[ks][8 * c + 2] = bflo(x.y); f[ks][8 * c + 3] = bfhi(x.y);
              f[ks][8 * c + 4] = bflo(x.z); f[ks][8 * c + 5] = bfhi(x.z); f[ks][8 * c + 6] = bflo(x.w); f[ks][8 * c + 7] = bfhi(x.w); }
      float ss = 0.f;
#pragma unroll
      for (int ks = 0; ks < 3; ++ks)
#pragma unroll
          for (int i = 0; i < 32; ++i) ss += f[ks][i] * f[ks][i];
      { auto rr = __builtin_amdgcn_permlane32_swap(__float_as_uint(ss), __float_as_uint(ss), false, false); ss = __uint_as_float(rr[0]) + __uint_as_float(rr[1]); }
      const float* psr = ps + (size_t)(tok0 + wid * QBLK + r32) * 20; const f32x4 s0 = *(const f32x4*)psr, s1 = *(const f32x4*)(psr + 4);
      const float rq = __builtin_amdgcn_rsqf((((s0[0] + s0[1]) + (s0[2] + s0[3])) + ((s1[0] + s1[1]) + (s1[2] + s1[3]))) * (1.f / 512.f) + EPS);
      const float rs = __builtin_amdgcn_rsqf(ss * (rq * rq) * (1.f / 192.f) + EPS) * rq * 0.32267250623034593f;
#pragma unroll
      for (int ks = 0; ks < 3; ++ks)
#pragma unroll
          for (int c = 0; c < 8; ++c) { const f32x4 g = *(const f32x4*)(qgain + 64 * ks + 32 * hi + 4 * c);
              f[ks][4 * c] *= rs * g.x; f[ks][4 * c + 1] *= rs * g.y; f[ks][4 * c + 2] *= rs * g.z; f[ks][4 * c + 3] *= rs * g.w; }
      if (lat) { const int t = tok0 + wid * QBLK + r32, pos = hi ? (t & 63) : ((t >> 6) & 255);
#pragma unroll
          for (int c = 0; c < 4; ++c) { const f32x4 cs = *(const f32x4*)(rtab + pos * 16 + 4 * c), sn = *(const f32x4*)(rtab + 4096 + pos * 16 + 4 * c);
#pragma unroll
              for (int i = 0; i < 4; ++i) { const float x1 = f[2][4 * c + i], x2 = f[2][16 + 4 * c + i]; f[2][4 * c + i] = x1 * cs[i] - x2 * sn[i]; f[2][16 + 4 * c + i] = x2 * cs[i] + x1 * sn[i]; } } }
#pragma unroll
      for (int ks = 0; ks < 3; ++ks)
#pragma unroll
          for (int w = 0; w < 8; ++w) { int x = 0; x = __builtin_amdgcn_cvt_pk_fp8_f32(f[ks][4 * w], f[ks][4 * w + 1], x, false); x = __builtin_amdgcn_cvt_pk_fp8_f32(f[ks][4 * w + 2], f[ks][4 * w + 3], x, true); q8[ks][w] = x; } }
    f32x16 pA0, pA1, pB0, pB1, bias = {}; v8i pa = {}; const int NT = seq / KVBLK;
    v8i ones = {0x38383838, 0x38383838, 0x38383838, 0x38383838, 0x38383838, 0x38383838, 0x38383838, 0x38383838};
    asm volatile("" : "+v"(ones));
    int sl = 0;
#define SLOT(k) ((sl + (k)) >= 5 ? (sl + (k)) - 5 : (sl + (k)))
#define KS_(k) (lds + SLOT(k) * MSLOT + klane)
#define VS_(k) (lds + SLOT(k) * MSLOT + vlane)
    if (2 < NT) DMA_TILE(2, 2);
    WAIT_BAR0();
    qkt8(pA0, pA1, bias, lds + klane, q8); sm8_a<true>(pA0, pA1, bias, o, al_l, r32, hi);
#define DSTEP(DMA_STMTS) do { \
        qkt8(pB0, pB1, bias, KS_(1), q8); \
        DMA_STMTS                                                  \
        sm8_b(pA0, pA1, pa); \
        pv8(o, VS_(0), pa, ones); sm8_a<false>(pB0, pB1, bias, o, al_l, r32, hi); \
        qkt8(pA0, pA1, bias, KS_(2), q8); sm8_b(pB0, pB1, pa); \
        pv8(o, VS_(1), pa, ones); sm8_a<false>(pA0, pA1, bias, o, al_l, r32, hi); \
        SBAR(); WAIT_BAR0(); \
        sl = SLOT(2); } while (0)
    int j = 1;
    for (; j + 3 < NT; j += 2) DSTEP(DMA_TILE(j + 2, SLOT(3)); DMA_TILE(j + 3, SLOT(4)););
    DSTEP(DMA_TILE(j + 2, SLOT(3)););
#undef DSTEP
    qkt8(pB0, pB1, bias, KS_(1), q8); sm8_b(pA0, pA1, pa);
    pv8(o, VS_(0), pa, ones); sm8_a<false>(pB0, pB1, bias, o, al_l, r32, hi);
    sm8_b(pB0, pB1, pa);
    pv8(o, VS_(1), pa, ones);
#undef SLOT
#undef KS_
#undef VS_
    float rli[16];
#pragma unroll
    for (int r = 0; r < 16; ++r) rli[r] = __builtin_amdgcn_rcpf(o[4][r]);
    bf16* Ow = Ob + (size_t)(wid * QBLK) * 2048;
#pragma unroll
    for (int r = 0; r < 16; ++r) { const int orow = crow(r, hi);
#pragma unroll
        for (int d0 = 0; d0 < 4; ++d0) Ow[(size_t)orow * 2048 + d0 * 32 + r32] = (bf16)(cvtpk_v(o[d0][r] * rli[r] * MLA_ALPHA, 0.f) & 0xffffu); }
    WAIT_BAR0();
#undef DMA_TILE
#undef ROT
}

constexpr int NSLOT_B = 32768, N_V = 0, N_K = 16384, N_BIAS = 124928;
__device__ __forceinline__ void na_unit(const bf16* __restrict__ QKV, int h, int rb, const float* __restrict__ rpb_h, bf16* __restrict__ Ob, LAS char* lds) {
    const int tid = ltid(), lane = tid & 63, r32 = lane & 31, hi = lane >> 5; const int wid = __builtin_amdgcn_readfirstlane(tid >> 6);
    LAS float* wsx = (LAS float*)(lds + M_WS) + wid * 64; LAS float* li_l = wsx; LAS float* al_l = wsx + 32;
    LAS float* btab = (LAS float*)(lds + N_BIAS) + 128;
    constexpr float C = 0.08838834764831845f * LOG2E;
    for (int i = tid; i < 15 * 31; i += 512) btab[i] = rpb_h[i] * LOG2E;
    if (tid < 64) btab[600 + tid] = 0.f;
    const int qrow = rb * 4 + (wid >> 1), qcol = (wid & 1) * 32 + r32;
    const int rs = min(max(qrow - 4, 0), 248), cs = min(max(qcol - 8, 0), 48);
    const int lb = 15 - qcol + 4 * hi;
    const unsigned long long wmask = 0xFFFFull << cs;
    const int lm = (int)(unsigned)(wmask >> (4 * hi)), lb2 = (int)(unsigned)(wmask >> (32 + 4 * hi));
    const int lo = min(max(rb * 4 - 4, 0), 248), hr = min(max(rb * 4 + 3 - 4, 0), 248) + 7, cnt = hr - lo + 1;
    const int NT = (4 + cnt + 1) & ~1;
#define TKEY0(t) ((t) < 4 ? NL + 64 * (t) : 64 * min(lo + (t) - 4, hr))
#define TKR(t) ((t) < 4 ? -1 : ((t) - 4 < cnt ? lo + (t) - 4 : -1000))
    const bf16* Kh = QKV + 2048 + h * 128; const bf16* Vh = QKV + 4096 + h * 128;
    int k_off[2], v_off[2];
#pragma unroll
    for (int i = 0; i < 2; ++i) { const int p = 2 * wid + i;
        { const int row = 4 * p + (lane >> 4), lch = (lane & 15) ^ (row & 15); k_off[i] = row * 6144 + lch * 8; }
        { const int s = 2 * p + (lane >> 5), kk = (s >> 2) * 8 + ((lane & 31) >> 2), key = (kk & ~0xC) | ((kk & 4) << 1) | ((kk & 8) >> 1), col = (s & 3) * 32 + (lane & 3) * 8; v_off[i] = key * 6144 + col; } }
#define DMA_TILE(t, slot) do { const size_t kb_ = (size_t)TKEY0(t) * 6144; const unsigned sb_ = (unsigned)((slot) * NSLOT_B); \
    glds16(Vh + kb_ + v_off[0], sb_ + N_V + (2 * wid) * 1024); glds16(Vh + kb_ + v_off[1], sb_ + N_V + (2 * wid + 1) * 1024); \
    glds16(Kh + kb_ + k_off[0], sb_ + N_K + (2 * wid) * 1024); glds16(Kh + kb_ + k_off[1], sb_ + N_K + (2 * wid + 1) * 1024); } while (0)
    DMA_TILE(0, 0); DMA_TILE(1, 1);
    float m_reg = -1e30f, l_reg = 0; f32x16 o[4] = {}; bf16x8 qr[8];
    const bf16* Qw = QKV + (size_t)(rb * 256 + wid * QBLK + r32) * 6144 + h * 128 + hi * 8;
#pragma unroll
    for (int d0 = 0; d0 < 8; ++d0) qr[d0] = *(const bf16x8*)(Qw + d0 * 16);
    const int vbl = N_V + v_rd_base(lane);
    f32x16 pA0, pA1, pB0, pB1; float mnA, mnB, alA, alB; bf16x8 pa0, pa1, pa2, pa3;
    int s_prev = 0, s_cur = 1, s_next = 2;
#define ROT() do { const int t_ = s_prev; s_prev = s_cur; s_cur = s_next; s_next = t_; } while (0)
    WAIT_BAR0();
    qkt<0>(pA0, pA1, lds + N_K, lds, qr, r32, hi); partialSM_na(pA0, pA1, m_reg, mnA, alA, C, TKR(0), qrow, rs, lb, lm, lb2, btab);
    for (int j = 1; j + 1 < NT; j += 2) {
        DMA_TILE(j + 1, s_next);
        SBAR(); qkt<0>(pB0, pB1, lds + s_cur * NSLOT_B + N_K, lds, qr, r32, hi);
        finishSM(pA0, pA1, alA, l_reg, pa0, pa1, pa2, pa3); SBAR();
        pv_d0(o, vbl + s_prev * NSLOT_B, pa0, pa1, pa2, pa3); partialSM_na(pB0, pB1, m_reg, mnB, alB, C, TKR(j), qrow, rs, lb, lm, lb2, btab);
        RESC(alB);
        WAIT_BAR0(); ROT();
        DMA_TILE(j + 2, s_next);
        SBAR(); qkt<0>(pA0, pA1, lds + s_cur * NSLOT_B + N_K, lds, qr, r32, hi);
        finishSM(pB0, pB1, alB, l_reg, pa0, pa1, pa2, pa3); SBAR();
        pv_d0(o, vbl + s_prev * NSLOT_B, pa0, pa1, pa2, pa3); partialSM_na(pA0, pA1, m_reg, mnA, alA, C, TKR(j + 1), qrow, rs, lb, lm, lb2, btab);
        RESC(alA);
        WAIT_BAR0(); ROT();
    }
    SBAR(); qkt<0>(pB0, pB1, lds + s_cur * NSLOT_B + N_K, lds, qr, r32, hi);
    finishSM(pA0, pA1, alA, l_reg, pa0, pa1, pa2, pa3); SBAR();
    pv_d0(o, vbl + s_prev * NSLOT_B, pa0, pa1, pa2, pa3); partialSM_na(pB0, pB1, m_reg, mnB, alB, C, TKR(NT - 1), qrow, rs, lb, lm, lb2, btab);
    RESC(alB);
    finishSM(pB0, pB1, alB, l_reg, pa0, pa1, pa2, pa3); SBAR();
    pv_d0(o, vbl + s_cur * NSLOT_B, pa0, pa1, pa2, pa3);
    if (hi == 0) li_l[r32] = l_reg; asm volatile("s_waitcnt lgkmcnt(0)" ::: "memory");
    float rli[16];
#pragma unroll
    for (int r = 0; r < 16; ++r) rli[r] = __builtin_amdgcn_rcpf(li_l[crow(r, hi)]);
    bf16* Ow = Ob + (size_t)(rb * 256 + wid * QBLK) * 2048 + h * 128;
#pragma unroll
    for (int r = 0; r < 16; ++r) { const int orow = crow(r, hi);
#pragma unroll
        for (int d0 = 0; d0 < 4; ++d0) Ow[(size_t)orow * 2048 + d0 * 32 + r32] = (bf16)(cvtpk_v(o[d0][r] * rli[r], 0.f) & 0xffffu); }
    WAIT_BAR0();
#undef DMA_TILE
#undef ROT
#undef TKEY0
#undef TKR
}
#undef RESC
}
namespace thin {
__device__ __constant__ float ROPE_INV[16] = {1.0f, 0.5623413251903491f, 0.31622776601683794f, 0.1778279410038923f, 0.1f, 0.05623413251903491f, 0.03162277660168379f, 0.01778279410038923f,
                                              0.01f, 0.005623413251903491f, 0.0031622776601683794f, 0.001778279410038923f, 0.001f, 0.0005623413251903491f, 0.00031622776601683794f, 0.0001778279410038923f};

__device__ __forceinline__ void tr_tile(const float* __restrict__ src, int ld_src, bf16* __restrict__ dst, int ld_dst, LAS float* T, const float* __restrict__ kgain = nullptr) {
    const int tid = ltid(), kr = tid >> 4, c4 = tid & 15;
    f32x4 v[4];
#pragma unroll
    for (int i = 0; i < 4; ++i) v[i] = *(const f32x4*)(src + (size_t)(kr + 32 * i) * ld_src + c4 * 4);
    if (kgain) {
#pragma unroll
        for (int i = 0; i < 4; ++i) v[i] = v[i] * kgain[kr + 32 * i]; }
    __syncthreads();
#pragma unroll
    for (int i = 0; i < 4; ++i) {
#pragma unroll
        for (int j = 0; j < 4; ++j) T[(c4 * 4 + j) * 129 + kr + 32 * i] = v[i][j]; }
    __syncthreads();
    const int n = tid >> 3, kc = (tid & 7) * 16; const LAS float* s = T + n * 129 + kc;
    u32x4 w0, w1;
    w0.x = cvtpk(s[0], s[1]); w0.y = cvtpk(s[2], s[3]); w0.z = cvtpk(s[4], s[5]); w0.w = cvtpk(s[6], s[7]);
    w1.x = cvtpk(s[8], s[9]); w1.y = cvtpk(s[10], s[11]); w1.z = cvtpk(s[12], s[13]); w1.w = cvtpk(s[14], s[15]);
    bf16* d = dst + (size_t)n * ld_dst + kc;
    *(u32x4*)d = w0; *(u32x4*)(d + 8) = w1;
}
__device__ __forceinline__ void tr_job(const float* src, int K, int N, bf16* dst, int t, LAS float* T, const float* kgain = nullptr) {
    const int nkt = K / 128, nt = t / nkt, kt = t - nt * nkt;
    tr_tile(src + (size_t)(kt * 128) * N + nt * 64, N, dst + (size_t)(nt * 64) * K + kt * 128, K, T, kgain ? kgain + kt * 128 : nullptr);
}

struct In {
    const float *x, *c, *ctx, *c_ctx, *ada_w, *ada_b, *norm_mix, *norm_ffn, *mla_w_in, *mla_q_a_gain, *mla_kv_a_gain, *mla_w_qb, *mla_w_kvb, *mla_q_gain, *mla_k_gain, *mla_w_o,
                *na_w_qkv, *na_q_gain, *na_k_gain, *na_rpb, *na_w_o, *router_w, *moe_w_gate, *moe_w_up, *moe_w_down;
};

constexpr int TL_GU = 16 * 2 * 352, TL_D = 16 * 352, TL_QKV = 96 * 16, TL_WO1 = 32 * 16;
constexpr int TL_E0 = TL_GU, TL_E1 = TL_E0 + TL_D, TL_E2 = TL_E1 + TL_QKV, TL_E3 = TL_E2 + TL_WO1, TL_E4 = TL_E3 + TL_GU, TL_ALL = TL_E4 + TL_D;
constexpr int LIM_MOE0 = TL_E1, LIM_NA = TL_E3, LIM_GU1 = TL_E4, LIM_ALL = TL_ALL;
__device__ __forceinline__ void late_tile(const In& in, unsigned char* ws, int t, LAS float* T) {
    int l = 0;
    if (t >= TL_E3) { t -= TL_E3; l = 1; }
    else if (t >= TL_E1) { t -= TL_E1;
        if (t < TL_QKV) tr_job(in.na_w_qkv, 2048, 6144, (bf16*)(ws + WS_WQKV_T), t, T);
        else tr_job(in.na_w_o, 2048, 2048, (bf16*)(ws + WS_WO1_T), t - TL_QKV, T);
        return; }
    if (t < TL_GU) {
        const int e = t / 704, r = t - e * 704, which = r / 352, tt = r - which * 352, nt = tt >> 4, kt = tt & 15, le = l * 16 + e;
        const float* src = (which ? in.moe_w_up : in.moe_w_gate) + (size_t)le * 2048 * FF;
        const int n0 = nt * 64, drow = (n0 >> 7) * 256 + which * 128 + (n0 & 127);
        bf16* dst = (bf16*)(ws + WS_WGU_T) + (size_t)le * 2816 * 2048;
        tr_tile(src + (size_t)(kt * 128) * FF + n0, FF, dst + (size_t)drow * 2048 + kt * 128, 2048, T);
    } else {
        t -= TL_GU; const int e = t / 352, tt = t - e * 352, le = l * 16 + e;
        tr_job(in.moe_w_down + (size_t)le * FF * 2048, FF, 2048, (bf16*)(ws + WS_WD_T) + (size_t)le * 2048 * FF, tt, T); }
}
__device__ __forceinline__ void late_work(const In& in, unsigned char* ws, LAS unsigned char* lds, int G, int phase, int limit) {
    const int tid = ltid();
    LAS float* T = (LAS float*)lds; LAS int* sh = (LAS int*)(lds + 40960);
    unsigned* work = (unsigned*)(ws + WS_CTL) + CW_WORK; unsigned* done = (unsigned*)(ws + WS_CTL) + CW_DONE + 64 * (phase < 0 ? 0 : phase);
    __syncthreads();
    if (phase >= 0 && tid == 0) __hip_atomic_fetch_add(done, 1u, __ATOMIC_RELAXED, __HIP_MEMORY_SCOPE_AGENT);
    for (;;) {
        if (tid == 0) { int t = -1;
            bool go = true;
            if (phase >= 0) go = __hip_atomic_load(done, __ATOMIC_RELAXED, __HIP_MEMORY_SCOPE_AGENT) < (unsigned)G;
            if (go) t = (int)__hip_atomic_fetch_add(work, 1u, __ATOMIC_RELAXED, __HIP_MEMORY_SCOPE_AGENT);
            sh[0] = t; }
        __syncthreads();
        const int t = sh[0];
        if (t < 0 || t >= TL_ALL) break;
        late_tile(in, ws, t, T);
        __syncthreads();
        if (phase < 0 && t >= limit) break;
    }
    __syncthreads();
}

__device__ __forceinline__ void phase_prologue(const In& in, unsigned char* ws, LAS unsigned char* lds, int G, int bid) {
    const int tid = ltid();
    {
        LAS float* sl = (LAS float*)lds; LAS float* sc_ = sl + 2048; LAS float* red = sc_ + 2048;
        for (int i = tid; i < 2048; i += 512) { const float a = in.c[i], b = in.c_ctx[i]; sl[i] = a / (1.f + __expf(-a)); sc_[i] = b / (1.f + __expf(-b)); }
        __syncthreads();
        float* mod = (float*)(ws + WS_MOD);
        for (int item = bid; item < 256; item += G) {
            const int cg = item * 96, l = cg / 12288, n0 = cg - l * 12288;
            if (tid < 384) {
                const int rl = tid / 24, c4 = tid - rl * 24;
                const float* wp = in.ada_w + ((size_t)l * 2048 + rl) * 12288 + n0 + c4 * 4;
                f32x4 al = {0.f, 0.f, 0.f, 0.f}, ac = {0.f, 0.f, 0.f, 0.f};
#pragma unroll 8
                for (int i = 0; i < 128; ++i) { const f32x4 w = *(const f32x4*)(wp + (size_t)(16 * i) * 12288); const float a = sl[rl + 16 * i], b = sc_[rl + 16 * i]; al += w * a; ac += w * b; }
                *(LAS f32x4*)(red + rl * 96 + c4 * 4) = al; *(LAS f32x4*)(red + 1536 + rl * 96 + c4 * 4) = ac;
            }
            __syncthreads();
            if (tid < 192) { const int v = tid / 96, j = tid - v * 96; float s = in.ada_b[l * 12288 + n0 + j];
#pragma unroll
                for (int k = 0; k < 16; ++k) s += red[v * 1536 + k * 96 + j];
                mod[(size_t)(l * 2 + v) * 12288 + n0 + j] = s; }
            __syncthreads();
        }
    }
    if (bid == 0) { float* gt = (float*)(ws + WS_MODP);
        for (int i = tid; i < 4096; i += 512) { const int pos = i >> 4, j = i & 15; float s, c; sincosf((float)pos * ROPE_INV[j], &s, &c); gt[i] = c; gt[4096 + i] = s; } }
    LAS float* T = (LAS float*)lds;
    constexpr int T_WIN = 17 * 16, T_QB = 48 * 4, T_KVB = 64 * 4, T_WO = 32 * 16;
    constexpr int T_ALL = T_WIN + T_QB + T_KVB + T_WO;
    bf16* win_t = (bf16*)(ws + WS_WIN_T);
    for (size_t i = (size_t)bid * 512 + tid; i < (size_t)(WIN_NP - WIN_N) * 2048 / 8; i += (size_t)G * 512) ((u32x4*)(win_t + (size_t)WIN_N * 2048))[i] = (u32x4){0u, 0u, 0u, 0u};
    for (int t0 = bid; t0 < T_ALL; t0 += G) {
        int t = t0;
        if (t < T_WIN) { tr_job(in.mla_w_in, 2048, WIN_N, win_t, t, T); continue; } t -= T_WIN;
        if (t < T_QB) { tr_job(in.mla_w_qb, 512, 3072, (bf16*)(ws + WS_WQB_T), t, T, in.mla_q_a_gain); continue; } t -= T_QB;
        if (t < T_KVB) { tr_job(in.mla_w_kvb, 512, 4096, (bf16*)(ws + WS_WKVB_T), t, T, in.mla_kv_a_gain); continue; } t -= T_KVB;
        tr_job(in.mla_w_o, 2048, 2048, (bf16*)(ws + WS_WO0_T), t, T);
    }
}
__device__ __forceinline__ const float* modv(const unsigned char* ws, int l, int v, int chunk) { return (const float*)(ws + WS_MOD) + (size_t)(l * 2 + v) * 12288 + chunk * 2048; }

__device__ __forceinline__ void norm_mod_row(f32x4 (&v)[8], const float* gain, const float* sh, const float* sc, int lane) {
    float ss = 0.f;
#pragma unroll
    for (int j = 0; j < 8; ++j) ss += (v[j].x * v[j].x + v[j].y * v[j].y) + (v[j].z * v[j].z + v[j].w * v[j].w);
    const float rs = __builtin_amdgcn_rsqf(wave_sum(ss) * (1.f / 2048.f) + EPS);
#pragma unroll
    for (int j = 0; j < 8; ++j) { const int c = 4 * (lane + 64 * j); const f32x4 g = *(const f32x4*)(gain + c), a = *(const f32x4*)(sc + c), b = *(const f32x4*)(sh + c);
        v[j] = v[j] * rs * g * (a + 1.f) + b; }
}
__device__ __forceinline__ void stage_mod_lds(LAS float* ga, LAS float* sb, const float* gain, const float* sh, const float* sc, int tid) {
    *(LAS f32x4*)(ga + 4 * tid) = *(const f32x4*)(gain + 4 * tid) * (*(const f32x4*)(sc + 4 * tid) + 1.f); *(LAS f32x4*)(sb + 4 * tid) = *(const f32x4*)(sh + 4 * tid);
}
__device__ __forceinline__ void norm_mod_row_lds(f32x4 (&v)[8], const LAS float* ga, const LAS float* sb, int lane) {
    float ss = 0.f;
#pragma unroll
    for (int j = 0; j < 8; ++j) ss += (v[j].x * v[j].x + v[j].y * v[j].y) + (v[j].z * v[j].z + v[j].w * v[j].w);
    const float rs = __builtin_amdgcn_rsqf(wave_sum(ss) * (1.f / 2048.f) + EPS);
#pragma unroll
    for (int j = 0; j < 8; ++j) { const int c = 4 * (lane + 64 * j); v[j] = v[j] * rs * *(const LAS f32x4*)(ga + c) + *(const LAS f32x4*)(sb + c); }
}
__device__ __forceinline__ f32x4 bf4(const u32x2 w) { return (f32x4){bflo(w.x), bfhi(w.x), bflo(w.y), bfhi(w.y)}; }
__device__ __forceinline__ void store_row_bf16(bf16* orow, const f32x4 (&v)[8], int lane) {
#pragma unroll
    for (int j = 0; j < 8; ++j) { u32x2 w; w.x = cvtpk(v[j].x, v[j].y); w.y = cvtpk(v[j].z, v[j].w); *(u32x2*)(orow + 4 * (lane + 64 * j)) = w; }
}
__device__ __forceinline__ void phase_norm_in(const In& in, unsigned char* ws, LAS unsigned char* lds, int G, int bid) {
    const int lane = ltid() & 63, gw = bid * 8 + (ltid() >> 6), NGW = G * 8;
    bf16* hb = (bf16*)(ws + WS_HB);
    LAS float* mv = (LAS float*)lds;
    stage_mod_lds(mv, mv + 2048, in.norm_mix, modv(ws, 0, 0, 0), modv(ws, 0, 0, 1), ltid());
    stage_mod_lds(mv + 4096, mv + 6144, in.norm_mix, modv(ws, 0, 1, 0), modv(ws, 0, 1, 1), ltid());
    __syncthreads();
    f32x4 a[8], nx[8];
#define NI_LOAD(dst, rw) do { const float* xr_ = ((rw) >= NL) ? in.ctx + (size_t)((rw) - NL) * 2048 : in.x + (size_t)(rw) * 2048; \
    _Pragma("unroll") for (int j = 0; j < 8; ++j) dst[j] = *(const f32x4*)(xr_ + 4 * (lane + 64 * j)); } while (0)
    if (gw < NTOK) NI_LOAD(a, gw);
    for (int row = gw; row < NTOK; row += NGW) {
        const int v = row >= NL;
        if (row + NGW < NTOK) NI_LOAD(nx, row + NGW);
        norm_mod_row_lds(a, mv + v * 4096, mv + v * 4096 + 2048, lane);
        store_row_bf16(hb + (size_t)row * 2048, a, lane);
#pragma unroll
        for (int j = 0; j < 8; ++j) a[j] = nx[j];
    }
#undef NI_LOAD
    __syncthreads();
}
__device__ __forceinline__ void phase_rownorm_a(const In& in, unsigned char* ws, int G, int bid) {
    const int lane = ltid() & 63, gw = bid * 8 + (ltid() >> 6), NGW = G * 8;
    const bf16* ab = (const bf16*)(ws + WS_AB); bf16* qn = (bf16*)(ws + WS_QN); bf16* kvn = (bf16*)(ws + WS_KVN);
    float gq[8], gk[8];
#pragma unroll
    for (int i = 0; i < 8; ++i) { gq[i] = in.mla_q_a_gain[lane * 8 + i]; gk[i] = in.mla_kv_a_gain[lane * 8 + i]; }
    u32x4 qn_, kn_;
    if (gw < NTOK) { qn_ = *(const u32x4*)(ab + (size_t)gw * WIN_NP + lane * 8); kn_ = *(const u32x4*)(ab + (size_t)gw * WIN_NP + 512 + lane * 8); }
    for (int row = gw; row < NTOK; row += NGW) {
        const u32x4 q = qn_, k = kn_;
        if (row + NGW < NTOK) { qn_ = *(const u32x4*)(ab + (size_t)(row + NGW) * WIN_NP + lane * 8); kn_ = *(const u32x4*)(ab + (size_t)(row + NGW) * WIN_NP + 512 + lane * 8); }
        float qf[8] = {bflo(q.x), bfhi(q.x), bflo(q.y), bfhi(q.y), bflo(q.z), bfhi(q.z), bflo(q.w), bfhi(q.w)};
        float kf[8] = {bflo(k.x), bfhi(k.x), bflo(k.y), bfhi(k.y), bflo(k.z), bfhi(k.z), bflo(k.w), bfhi(k.w)};
        float sq = 0.f, sk = 0.f;
#pragma unroll
        for (int i = 0; i < 8; ++i) { sq += qf[i] * qf[i]; sk += kf[i] * kf[i]; }
        const float rq = __builtin_amdgcn_rsqf(wave_sum(sq) * (1.f / 512.f) + EPS), rk = __builtin_amdgcn_rsqf(wave_sum(sk) * (1.f / 512.f) + EPS);
        u32x4 wq, wk;
        wq.x = cvtpk(qf[0] * rq * gq[0], qf[1] * rq * gq[1]); wq.y = cvtpk(qf[2] * rq * gq[2], qf[3] * rq * gq[3]); wq.z = cvtpk(qf[4] * rq * gq[4], qf[5] * rq * gq[5]); wq.w = cvtpk(qf[6] * rq * gq[6], qf[7] * rq * gq[7]);
        wk.x = cvtpk(kf[0] * rk * gk[0], kf[1] * rk * gk[1]); wk.y = cvtpk(kf[2] * rk * gk[2], kf[3] * rk * gk[3]); wk.z = cvtpk(kf[4] * rk * gk[4], kf[5] * rk * gk[5]); wk.w = cvtpk(kf[6] * rk * gk[6], kf[7] * rk * gk[7]);
        *(u32x4*)(qn + (size_t)row * 512 + lane * 8) = wq; *(u32x4*)(kvn + (size_t)row * 512 + lane * 8) = wk;
    }
}
__device__ __forceinline__ void unpack8(const u32x4 q, float (&f)[8]) { f[0] = bflo(q.x); f[1] = bfhi(q.x); f[2] = bflo(q.y); f[3] = bfhi(q.y); f[4] = bflo(q.z); f[5] = bfhi(q.z); f[6] = bflo(q.w); f[7] = bfhi(q.w); }
__device__ __forceinline__ u32x4 pack8(const float (&f)[8]) { u32x4 w; w.x = cvtpk(f[0], f[1]); w.y = cvtpk(f[2], f[3]); w.z = cvtpk(f[4], f[5]); w.w = cvtpk(f[6], f[7]); return w; }
__device__ __forceinline__ u32x2 pack8_fp8(const float (&f)[8]) { int w0 = 0, w1 = 0;
    w0 = __builtin_amdgcn_cvt_pk_fp8_f32(f[0], f[1], w0, false); w0 = __builtin_amdgcn_cvt_pk_fp8_f32(f[2], f[3], w0, true);
    w1 = __builtin_amdgcn_cvt_pk_fp8_f32(f[4], f[5], w1, false); w1 = __builtin_amdgcn_cvt_pk_fp8_f32(f[6], f[7], w1, true);
    u32x2 r; r.x = (unsigned)w0; r.y = (unsigned)w1; return r; }
__device__ __forceinline__ float sumsq8(const u32x4 q) { float f[8]; unpack8(q, f); float s = 0.f;
#pragma unroll
    for (int i = 0; i < 8; ++i) s += f[i] * f[i];
    return s; }

__device__ __forceinline__ void rope64(float (&pe)[64], const LAS float* ct, const LAS float* st, int row, int col) {
#pragma unroll
    for (int j = 0; j < 16; ++j) { const float c = ct[row * 16 + j], s = st[row * 16 + j]; const float x1 = pe[j], x2 = pe[16 + j]; pe[j] = x1 * c - x2 * s; pe[16 + j] = x2 * c + x1 * s; }
#pragma unroll
    for (int j = 0; j < 16; ++j) { const float c = ct[col * 16 + j], s = st[col * 16 + j]; const float x1 = pe[32 + j], x2 = pe[48 + j]; pe[32 + j] = x1 * c - x2 * s; pe[48 + j] = x2 * c + x1 * s; }
}
__device__ __forceinline__ void phase_headnorm_rope(const In& in, unsigned char* ws, LAS unsigned char* lds, int G, int bid) {
    const int tid = ltid();
    bf16* kvraw = (bf16*)(ws + WS_KVRAW);
    __syncthreads();
    {
        const int lane = tid & 63, wid = tid >> 6, c = lane & 15, q = lane >> 4;
        LAS unsigned* img = (LAS unsigned*)(lds + 36864) + wid * 2048;
        unsigned char* vtb = ws + WS_KPE;
        for (int it = bid * 8 + wid; it < NH * (NTOK / 64); it += G * 8) {
            const int h = it / (NTOK / 64), T = it - h * (NTOK / 64);
            const bf16* vp = kvraw + (size_t)(T * 64) * 4096 + h * 256 + 128 + c * 8;
#pragma unroll
            for (int m = 0; m < 4; ++m) { const int gi = 4 * m + q;
                const int sd = 8 * (gi & 1) + 4 * (gi >> 3) + ((gi & 7) >> 1);
                float f0[8], f1[8], f2[8], f3[8];
                unpack8(*(const u32x4*)(vp + (size_t)(4 * gi) * 4096), f0); unpack8(*(const u32x4*)(vp + (size_t)(4 * gi + 1) * 4096), f1);
                unpack8(*(const u32x4*)(vp + (size_t)(4 * gi + 2) * 4096), f2); unpack8(*(const u32x4*)(vp + (size_t)(4 * gi + 3) * 4096), f3);
#pragma unroll
                for (int i = 0; i < 8; ++i) { int w = 0; w = __builtin_amdgcn_cvt_pk_fp8_f32(f0[i], f1[i], w, false); w = __builtin_amdgcn_cvt_pk_fp8_f32(f2[i], f3[i], w, true);
                    img[(c * 8 + i) * 16 + sd] = (unsigned)w; } }
            asm volatile("s_waitcnt lgkmcnt(0)" ::: "memory");
            u32x4* dst = (u32x4*)(vtb + (size_t)it * 8192);
#pragma unroll
            for (int k = 0; k < 8; ++k) dst[k * 64 + lane] = *(const LAS u32x4*)(img + (k * 64 + lane) * 4);
            asm volatile("s_waitcnt lgkmcnt(0)" ::: "memory");
        }
    }
}
__device__ __forceinline__ void phase_na_headnorm(const In& in, unsigned char* ws, int G, int bid) {
    bf16* qkv = (bf16*)(ws + WS_QKV1);
    const int tid = ltid(), lane = tid & 63, c = lane & 15, gw = bid * 8 + (tid >> 6), NGW = G * 8;
    const f32x4 gq0 = *(const f32x4*)(in.na_q_gain + c * 8), gq1 = *(const f32x4*)(in.na_q_gain + c * 8 + 4), gk0 = *(const f32x4*)(in.na_k_gain + c * 8), gk1 = *(const f32x4*)(in.na_k_gain + c * 8 + 4);
    constexpr int NIT = NTOK * 32 / 4;
    for (int pp = gw; pp < NIT; pp += 4 * NGW) {
        bf16* qp[4]; u32x4 raw[4]; bool isk[4], act[4];
#pragma unroll
        for (int u = 0; u < 4; ++u) { const int pi = pp + u * NGW; act[u] = pi < NIT; const int p = (act[u] ? pi : pp) * 4 + (lane >> 4), t = p >> 5, hh = p & 31; isk[u] = (hh >> 4) != 0;
            qp[u] = qkv + (size_t)t * 6144 + hh * 128 + c * 8; raw[u] = *(const u32x4*)qp[u]; }
#pragma unroll
        for (int u = 0; u < 4; ++u) {
            float f[8]; unpack8(raw[u], f);
            float ss = 0.f;
#pragma unroll
            for (int i = 0; i < 8; ++i) ss += f[i] * f[i];
#pragma unroll
            for (int o = 1; o < 16; o <<= 1) ss += __shfl_xor(ss, o);
            const float rs = __builtin_amdgcn_rsqf(ss * (1.f / 128.f) + EPS);
            const f32x4 g0 = isk[u] ? gk0 : gq0, g1 = isk[u] ? gk1 : gq1;
            f[0] *= rs * g0.x; f[1] *= rs * g0.y; f[2] *= rs * g0.z; f[3] *= rs * g0.w; f[4] *= rs * g1.x; f[5] *= rs * g1.y; f[6] *= rs * g1.z; f[7] *= rs * g1.w;
            if (act[u]) *(u32x4*)qp[u] = pack8(f);
        }
    }
}
typedef float f32x2v __attribute__((ext_vector_type(2)));
__device__ __forceinline__ void router_finish(const float (&lg)[16], int lane, float* aff, int row, bool valid) {
    float v8[8], v4[4], v2[2], v1;
    { const bool up = (lane & 32) != 0;
#pragma unroll
      for (int i = 0; i < 8; ++i) { const float snd = up ? lg[i] : lg[8 + i], kp = up ? lg[8 + i] : lg[i]; v8[i] = kp + __shfl_xor(snd, 32); } }
    { const bool up = (lane & 16) != 0;
#pragma unroll
      for (int i = 0; i < 4; ++i) { const float snd = up ? v8[i] : v8[4 + i], kp = up ? v8[4 + i] : v8[i]; v4[i] = kp + __shfl_xor(snd, 16); } }
    { const bool up = (lane & 8) != 0;
#pragma unroll
      for (int i = 0; i < 2; ++i) { const float snd = up ? v4[i] : v4[2 + i], kp = up ? v4[2 + i] : v4[i]; v2[i] = kp + __shfl_xor(snd, 8); } }
    { const bool up = (lane & 4) != 0; const float snd = up ? v2[0] : v2[1], kp = up ? v2[1] : v2[0]; v1 = kp + __shfl_xor(snd, 4); }
    v1 += __shfl_xor(v1, 2); v1 += __shfl_xor(v1, 1);
    float mx = v1;
#pragma unroll
    for (int o = 4; o < 64; o <<= 1) mx = fmaxf(mx, __shfl_xor(mx, o));
    const float ex = __expf(v1 - mx);
    float den = ex;
#pragma unroll
    for (int o = 4; o < 64; o <<= 1) den += __shfl_xor(den, o);
    if (valid && (lane & 3) == 0) { const int e = ((lane >> 5) & 1) * 8 + ((lane >> 4) & 1) * 4 + ((lane >> 3) & 1) * 2 + ((lane >> 2) & 1); aff[(size_t)e * NTOK + row] = ex / den; }
}
__device__ __forceinline__ void phase_router(const In& in, unsigned char* ws, LAS unsigned char* lds, int G, int bid, int l, int nrows) {
    const int tid = ltid(), lane = tid & 63, gw = bid * 8 + (tid >> 6), NGW = G * 8;
    LAS float* rwT = (LAS float*)lds;
    const float* rw = in.router_w + (size_t)l * 2048 * 16;
    { u32x4 t[16];
#pragma unroll
      for (int it = 0; it < 16; ++it) t[it] = *(const u32x4*)(rw + 4 * (tid + 512 * it));
#pragma unroll
      for (int it = 0; it < 16; ++it) { const int i4 = tid + 512 * it, k = i4 >> 2, e0 = 4 * (i4 & 3); LAS unsigned* d = (LAS unsigned*)rwT + e0 * 2048 + k;
          d[0] = t[it].x; d[2048] = t[it].y; d[4096] = t[it].z; d[6144] = t[it].w; } }
    LAS float* mv = (LAS float*)(lds + 131072);
    stage_mod_lds(mv, mv + 2048, in.norm_ffn + l * 2048, modv(ws, l, 0, 3), modv(ws, l, 0, 4), tid);
    __syncthreads();
    const bf16* x1 = (const bf16*)(ws + WS_X1); bf16* hb = (bf16*)(ws + WS_HB); float* aff = (float*)(ws + WS_AFF);
    { const int nlat = nrows < NL ? nrows : NL;
      u32x2 c0[8], c1[8], n0[8], n1[8];
#define RT_LOAD(dst, rw_) do { _Pragma("unroll") for (int j = 0; j < 8; ++j) dst[j] = *(const u32x2*)(x1 + (size_t)(rw_) * 2048 + 4 * (lane + 64 * j)); } while (0)
      if (gw < nlat) { RT_LOAD(c0, gw); RT_LOAD(c1, (gw + NGW < nlat ? gw + NGW : gw)); }
      for (int row = gw; row < nlat; row += 2 * NGW) {
        const bool two = row + NGW < nlat; const int rowb = two ? row + NGW : row;
        const int rn = row + 2 * NGW;
        __builtin_amdgcn_sched_barrier(0);
        if (rn < nlat) { RT_LOAD(n0, rn); RT_LOAD(n1, (rn + NGW < nlat ? rn + NGW : rn)); }
        __builtin_amdgcn_sched_barrier(0);
        f32x4 a0[8], a1[8];
        float ss0 = 0.f, ss1 = 0.f;
#pragma unroll
        for (int j = 0; j < 8; ++j) { a0[j] = bf4(c0[j]); a1[j] = bf4(c1[j]);
            ss0 += (a0[j].x * a0[j].x + a0[j].y * a0[j].y) + (a0[j].z * a0[j].z + a0[j].w * a0[j].w); ss1 += (a1[j].x * a1[j].x + a1[j].y * a1[j].y) + (a1[j].z * a1[j].z + a1[j].w * a1[j].w); }
        const float rs0 = __builtin_amdgcn_rsqf(wave_sum(ss0) * (1.f / 2048.f) + EPS), rs1 = __builtin_amdgcn_rsqf(wave_sum(ss1) * (1.f / 2048.f) + EPS);
#pragma unroll
        for (int j = 0; j < 8; ++j) { const int c = 4 * (lane + 64 * j); const f32x4 g = *(const LAS f32x4*)(mv + c), sb = *(const LAS f32x4*)(mv + 2048 + c);
            a0[j] = a0[j] * rs0 * g + sb; a1[j] = a1[j] * rs1 * g + sb; }
        store_row_bf16(hb + (size_t)row * 2048, a0, lane);
        store_row_bf16(hb + (size_t)rowb * 2048, a1, lane);
        __builtin_amdgcn_sched_barrier(0);
        float lg0[16], lg1[16];
        unsigned wbase = (unsigned)(size_t)(rwT + 4 * lane); asm volatile("" : "+v"(wbase));
        f32x4 wq[2][8];
#pragma unroll
        for (int j = 0; j < 8; ++j) wq[0][j] = *(const LAS f32x4*)(wbase + (256 * j) * 4);
#pragma unroll
        for (int e = 0; e < 16; ++e) { f32x2v s0 = {0.f, 0.f}, s1 = {0.f, 0.f};
            if (e < 15) {
#pragma unroll
                for (int j = 0; j < 8; ++j) wq[(e + 1) & 1][j] = *(const LAS f32x4*)(wbase + ((e + 1) * 2048 + 256 * j) * 4); }
            __builtin_amdgcn_sched_barrier(0);
#pragma unroll
            for (int j = 0; j < 8; ++j) { const f32x4 w = wq[e & 1][j];
                const f32x2v wl = {w.x, w.y}, wh = {w.z, w.w};
                s0 = __builtin_elementwise_fma((f32x2v){a0[j].x, a0[j].y}, wl, s0); s0 = __builtin_elementwise_fma((f32x2v){a0[j].z, a0[j].w}, wh, s0);
                s1 = __builtin_elementwise_fma((f32x2v){a1[j].x, a1[j].y}, wl, s1); s1 = __builtin_elementwise_fma((f32x2v){a1[j].z, a1[j].w}, wh, s1); }
            float t0 = s0.x + s0.y, t1 = s1.x + s1.y; asm volatile("" : "+v"(t0), "+v"(t1)); lg0[e] = t0; lg1[e] = t1; }
        router_finish(lg0, lane, aff, row, true);
        router_finish(lg1, lane, aff, rowb, two);
#pragma unroll
        for (int j = 0; j < 8; ++j) { c0[j] = n0[j]; c1[j] = n1[j]; }
      }
#undef RT_LOAD
    }
    for (int row = NL + gw; row < nrows; row += NGW) {
        f32x4 a[8];
#pragma unroll
        for (int j = 0; j < 8; ++j) a[j] = bf4(*(const u32x2*)(x1 + (size_t)row * 2048 + 4 * (lane + 64 * j)));
        norm_mod_row(a, in.norm_ffn + l * 2048, modv(ws, l, 1, 3), modv(ws, l, 1, 4), lane);
        store_row_bf16(hb + (size_t)row * 2048, a, lane);
        float lg[16];
        unsigned wbase = (unsigned)(size_t)(rwT + 4 * lane); asm volatile("" : "+v"(wbase));
#pragma unroll
        for (int e = 0; e < 16; ++e) { float s = 0.f;
#pragma unroll
            for (int j = 0; j < 8; ++j) { const f32x4 w = *(const LAS f32x4*)(wbase + (e * 2048 + 256 * j) * 4); s += (a[j].x * w.x + a[j].y * w.y) + (a[j].z * w.z + a[j].w * w.w); }
            lg[e] = s; __builtin_amdgcn_sched_barrier(0); }
        router_finish(lg, lane, aff, row, true);
    }
    __syncthreads();
}
__device__ __forceinline__ int block_sum_i(int v, LAS int* red, int tid) {
    v = wave_sum_i(v);
    __syncthreads();
    if ((tid & 63) == 0) red[tid >> 6] = v;
    __syncthreads();
    int s = 0;
#pragma unroll
    for (int w = 0; w < 8; ++w) s += red[w];
    return s;
}
__device__ __forceinline__ void phase_topk(unsigned char* ws, LAS unsigned char* lds, int G, int bid, int nprob) {
    const int tid = ltid(), lane = tid & 63, wid = tid >> 6;
    LAS int* red = (LAS int*)lds; LAS int* scan = red + 16;
    const float* aff = (const float*)(ws + WS_AFF); int* idx = (int*)(ws + WS_IDX); float* gate = (float*)(ws + WS_GATE); int* slot = (int*)(ws + WS_SLOT);
    for (int pb = bid; pb < nprob; pb += G) {
        const int e = pb & 15, isctx = pb >> 4;
        const int n = isctx ? NC : NL, k = isctx ? CAPC : CAPL, tok0 = isctx ? NL : 0, slot0 = isctx ? CAPL : 0;
        const int per = n / 512;
        unsigned key[32];
        const float* ap = aff + (size_t)e * NTOK + tok0;
        if (!isctx) {
#pragma unroll
            for (int j = 0; j < 8; ++j) { const u32x4 q = *(const u32x4*)(ap + tid * 32 + j * 4); key[j * 4] = q.x; key[j * 4 + 1] = q.y; key[j * 4 + 2] = q.z; key[j * 4 + 3] = q.w; }
        } else {
#pragma unroll
            for (int j = 0; j < 32; ++j) key[j] = 0u;
            if (tid < NC) key[0] = __float_as_uint(ap[tid]);
        }
        (void)per;
        unsigned lo = 0u, hi = 0x7f800000u;
        while (hi - lo > 1u) {
            const unsigned mid = lo + ((hi - lo) >> 1);
            int c = 32;
#pragma unroll
            for (int j = 0; j < 32; ++j) c += ((int)key[j] - (int)mid) >> 31;
            c = block_sum_i(c, red, tid);
            if (c >= k) lo = mid; else hi = mid;
        }
        const unsigned T = lo;
        int cg = 32, ce = 32;
#pragma unroll
        for (int j = 0; j < 32; ++j) { cg += ((int)key[j] - (int)(T + 1u)) >> 31; ce += ((int)key[j] - (int)T) >> 31; }
        ce -= cg;
        if (isctx && tid >= NC) { cg = 0; ce = 0; }
        int sg = cg, se = ce;
#pragma unroll
        for (int o = 1; o < 64; o <<= 1) { const int a = __shfl_up(sg, o), b = __shfl_up(se, o); if (lane >= o) { sg += a; se += b; } }
        __syncthreads();
        if (lane == 63) { scan[wid] = sg; scan[8 + wid] = se; }
        __syncthreads();
        int bg = 0, be = 0, totg = 0;
#pragma unroll
        for (int w = 0; w < 8; ++w) { const int a = scan[w], b = scan[8 + w]; if (w < wid) { bg += a; be += b; } totg += a; }
        const int need_eq = k - totg;
        int g_before = bg + sg - cg, e_before = be + se - ce;
        const int nmine = isctx ? (tid < NC ? 1 : 0) : 32;
#pragma unroll
        for (int j = 0; j < 32; ++j) {
            if (j < nmine) {
                const int i = isctx ? tid : tid * 32 + j;
                const bool gt = key[j] > T, eq = key[j] == T;
                const bool sel = gt || (eq && e_before < need_eq);
                const int s = g_before + min(e_before, need_eq);
                if (sel) { idx[e * EROWS + slot0 + s] = tok0 + i; gate[e * EROWS + slot0 + s] = __uint_as_float(key[j]); }
                slot[(size_t)(tok0 + i) * 16 + e] = sel ? slot0 + s : -1;
                g_before += gt ? 1 : 0; e_before += eq ? 1 : 0;
            }
        }
        if (isctx) { for (int s = CAPL + CAPC + tid; s < EROWS; s += 512) { idx[e * EROWS + s] = -1; gate[e * EROWS + s] = 0.f; } }
        __syncthreads();
    }
}
__device__ __forceinline__ void phase_gather(unsigned char* ws, int G, int bid, int rows_per_e) {
    const int lane = ltid() & 63, gw = bid * 8 + (ltid() >> 6), NGW = G * 8;
    const bf16* hb = (const bf16*)(ws + WS_HB); bf16* xs = (bf16*)(ws + WS_XS); const int* idx = (const int*)(ws + WS_IDX);
    for (int r = gw; r < NE * rows_per_e; r += NGW) {
        const int e = r / rows_per_e, s = r - e * rows_per_e; const int t = idx[e * EROWS + s];
        u32x4 v[4];
#pragma unroll
        for (int j = 0; j < 4; ++j) v[j] = (t >= 0) ? *(const u32x4*)(hb + (size_t)t * 2048 + (lane + 64 * j) * 8) : (u32x4){0u, 0u, 0u, 0u};
#pragma unroll
        for (int j = 0; j < 4; ++j) *(u32x4*)(xs + ((size_t)e * EROWS + s) * 2048 + (lane + 64 * j) * 8) = v[j];
    }
}
__device__ __forceinline__ void phase_combine(const In& in, unsigned char* ws, LAS unsigned char* lds, float* out, int G, int bid, int l, int nrows) {
    const int tid = ltid(), lane = tid & 63, gw = bid * 8 + (tid >> 6), NGW = G * 8;
    bf16* x1 = (bf16*)(ws + WS_X1); const bf16* yb = (const bf16*)(ws + WS_YB); const int* slot = (const int*)(ws + WS_SLOT); bf16* hb = (bf16*)(ws + WS_HB);
    LAS float* mv = (LAS float*)lds;
    for (int v = 0; v < (nrows > NL ? 2 : 1); ++v) {
        *(LAS f32x4*)(mv + v * 6144 + 4 * tid) = *(const f32x4*)(modv(ws, l, v, 5) + 4 * tid);
        if (l == 0) stage_mod_lds(mv + v * 6144 + 2048, mv + v * 6144 + 4096, in.norm_mix + 2048, modv(ws, 1, v, 0), modv(ws, 1, v, 1), tid); }
    __syncthreads();
    int nslot = (gw < nrows) ? slot[(size_t)gw * 16 + (lane & 15)] : -1;
    for (int row = gw; row < nrows; row += NGW) {
        const LAS float* mvv = mv + (row >= NL ? 6144 : 0);
        const int myslot = nslot;
        f32x4 a[8];
#pragma unroll
        for (int j = 0; j < 8; ++j) a[j] = bf4(*(const u32x2*)(x1 + (size_t)row * 2048 + 4 * (lane + 64 * j)));
        if (row + NGW < nrows) nslot = slot[(size_t)(row + NGW) * 16 + (lane & 15)];
        f32x4 acc[8];
#pragma unroll
        for (int j = 0; j < 8; ++j) acc[j] = (f32x4){0.f, 0.f, 0.f, 0.f};
        unsigned m = (unsigned)__ballot(myslot >= 0) & 0xffffu;
        while (m) {
            const int e0 = __builtin_ctz(m); m &= m - 1u;
            const bool two = m != 0u; const int e1 = two ? __builtin_ctz(m) : e0; if (two) m &= m - 1u;
            const bf16* y0 = yb + ((size_t)e0 * EROWS + __shfl(myslot, e0)) * 2048; const bf16* y1 = yb + ((size_t)e1 * EROWS + __shfl(myslot, e1)) * 2048;
            u32x2 w0[8], w1[8];
#pragma unroll
            for (int j = 0; j < 8; ++j) w0[j] = *(const u32x2*)(y0 + 4 * (lane + 64 * j));
            if (two) {
#pragma unroll
                for (int j = 0; j < 8; ++j) w1[j] = *(const u32x2*)(y1 + 4 * (lane + 64 * j)); }
#pragma unroll
            for (int j = 0; j < 8; ++j) { acc[j].x += bflo(w0[j].x); acc[j].y += bfhi(w0[j].x); acc[j].z += bflo(w0[j].y); acc[j].w += bfhi(w0[j].y); }
            if (two) {
#pragma unroll
                for (int j = 0; j < 8; ++j) { acc[j].x += bflo(w1[j].x); acc[j].y += bfhi(w1[j].x); acc[j].z += bflo(w1[j].y); acc[j].w += bfhi(w1[j].y); } }
        }
#pragma unroll
        for (int j = 0; j < 8; ++j) a[j] = a[j] + *(const LAS f32x4*)(mvv + 4 * (lane + 64 * j)) * acc[j];
        if (l == 0) {
            store_row_bf16(x1 + (size_t)row * 2048, a, lane);
            norm_mod_row_lds(a, mvv + 2048, mvv + 4096, lane);
            store_row_bf16(hb + (size_t)row * 2048, a, lane);
        } else {
#pragma unroll
            for (int j = 0; j < 8; ++j) *(f32x4*)(out + (size_t)row * 2048 + 4 * (lane + 64 * j)) = a[j];
        }
    }
    __syncthreads();
}
}
#define XB_TMO      128
#define XB_XCNT(j)  (256  + 64 * (j))
#define XB_XSUB(j)  (1280 + 64 * (j))
#define XB_XGEN(j)  (2304 + 64 * (j))
#define XB_TOP      3328
#define XB_TOPGEN   3392
#define XCD_BAR_WORDS 3456
#define XB_SPIN_CAP (1u << 22)

__device__ __forceinline__ unsigned xb_ld(unsigned* p)              { return __hip_atomic_load(p, __ATOMIC_RELAXED, __HIP_MEMORY_SCOPE_AGENT); }
__device__ __forceinline__ unsigned xb_add(unsigned* p, unsigned v) { return __hip_atomic_fetch_add(p, v, __ATOMIC_RELAXED, __HIP_MEMORY_SCOPE_AGENT); }
__device__ __forceinline__ unsigned xb_xcc_id() { return (unsigned)__builtin_amdgcn_s_getreg((3 << 11) | 20) & 0xFu; }
#define XB_SPIN(cond, bar) do { unsigned _sp = 0; while (cond) { __builtin_amdgcn_s_sleep(1); \
    if ((++_sp & 255u) == 0u) { if (xb_ld(&(bar)[XB_TMO])) break; if (_sp > XB_SPIN_CAP) { atomicAdd(&(bar)[XB_TMO], 1u); break; } } } } while (0)

struct XcdBarrier { unsigned* bar; unsigned x; volatile LAS unsigned* st; };

__device__ __forceinline__ XcdBarrier xcd_barrier_post(unsigned* bar, volatile LAS unsigned* st) {
    XcdBarrier b; b.bar = bar; b.x = xb_xcc_id(); b.st = st;
    if (threadIdx.x == 0) (void)xb_add(&bar[XB_XCNT(b.x)], 1u);
    return b;
}
__device__ __forceinline__ void xcd_barrier_complete(unsigned* bar, unsigned x, unsigned& nloc, unsigned& nx) {
    const unsigned G = gridDim.x * gridDim.y * gridDim.z;
    unsigned sum, cnt, mine, sp = 0u;
    for (;;) {
        sum = 0u; cnt = 0u; mine = 0u;
#pragma unroll
        for (unsigned j = 0; j < 16; ++j) { const unsigned c = xb_ld(&bar[XB_XCNT(j)]); sum += c; cnt += (c > 0u) ? 1u : 0u; mine = (j == x) ? c : mine; }
        if (sum == G) break;
        __builtin_amdgcn_s_sleep(1);
        if ((++sp & 255u) == 0u) { if (xb_ld(&bar[XB_TMO])) break; if (sp > XB_SPIN_CAP) { atomicAdd(&bar[XB_TMO], 1u); break; } }
    }
    nloc = mine > 0u ? mine : 1u; nx = cnt > 0u ? cnt : 1u;
}
__device__ __forceinline__ void xcd_barrier(const XcdBarrier& b) {
    asm volatile("s_waitcnt vmcnt(0)" ::: "memory");
    __syncthreads();
    if (threadIdx.x == 0) {
        unsigned* bar = b.bar;
        __builtin_amdgcn_s_waitcnt(0);
        unsigned nloc = b.st[0], nx = b.st[1];
        if (nloc == 0u) { xcd_barrier_complete(bar, b.x, nloc, nx); b.st[0] = nloc; b.st[1] = nx; }
        const unsigned old = xb_add(&bar[XB_XSUB(b.x)], 1u);
        const unsigned gen = old / nloc;
        if (old + 1u == (gen + 1u) * nloc) {
            __builtin_amdgcn_fence(__ATOMIC_RELEASE, "agent");
            asm volatile("s_waitcnt vmcnt(0)" ::: "memory");
            const unsigned og = xb_add(&bar[XB_TOP], 1u);
            const unsigned tg = og / nx;
            if (og + 1u == (tg + 1u) * nx) xb_add(&bar[XB_TOPGEN], 1u);
            else XB_SPIN(xb_ld(&bar[XB_TOPGEN]) == tg, bar);
            __builtin_amdgcn_fence(__ATOMIC_ACQUIRE, "agent");
            xb_add(&bar[XB_XGEN(b.x)], 1u);
            asm volatile("s_waitcnt vmcnt(0)" ::: "memory");
        } else {
            XB_SPIN(xb_ld(&bar[XB_XGEN(b.x)]) == gen, bar);
            __builtin_amdgcn_fence(__ATOMIC_ACQUIRE, "agent");
            asm volatile("s_waitcnt vmcnt(0)" ::: "memory");
        }
    }
    __syncthreads();
}

#ifndef MK_PER_PHASE
#define MK_PER_PHASE 0
#endif
constexpr int NPHASE = 25;
constexpr int LDS_BYTES = 148480;
constexpr int MISC_OFF = 147456 + 64;

struct Args { thin::In in; float* out; unsigned char* ws; int ph_lo, ph_hi; };
#define CAS __attribute__((address_space(4)))
typedef const CAS Args* ArgsP;
__device__ __forceinline__ ArgsP opaque(ArgsP p) { asm volatile("" : "+s"(p)); return p; }
__device__ __forceinline__ thin::In load_in(ArgsP A) { thin::In r;
    r.x = A->in.x; r.c = A->in.c; r.ctx = A->in.ctx; r.c_ctx = A->in.c_ctx; r.ada_w = A->in.ada_w; r.ada_b = A->in.ada_b; r.norm_mix = A->in.norm_mix; r.norm_ffn = A->in.norm_ffn;
    r.mla_w_in = A->in.mla_w_in; r.mla_q_a_gain = A->in.mla_q_a_gain; r.mla_kv_a_gain = A->in.mla_kv_a_gain; r.mla_w_qb = A->in.mla_w_qb; r.mla_w_kvb = A->in.mla_w_kvb;
    r.mla_q_gain = A->in.mla_q_gain; r.mla_k_gain = A->in.mla_k_gain; r.mla_w_o = A->in.mla_w_o; r.na_w_qkv = A->in.na_w_qkv; r.na_q_gain = A->in.na_q_gain; r.na_k_gain = A->in.na_k_gain;
    r.na_rpb = A->in.na_rpb; r.na_w_o = A->in.na_w_o; r.router_w = A->in.router_w; r.moe_w_gate = A->in.moe_w_gate; r.moe_w_up = A->in.moe_w_up; r.moe_w_down = A->in.moe_w_down; return r; }

__global__ void __launch_bounds__(512, 2) fwd_kernel(Args args) {
    extern __shared__ __attribute__((aligned(16))) unsigned char lds_raw[];
    LAS unsigned char* lds = (LAS unsigned char*)lds_raw;
    const int tid = threadIdx.x, G = gridDim.x, bid = blockIdx.x;
    ArgsP ap = (ArgsP)__builtin_amdgcn_kernarg_segment_ptr();
    volatile LAS unsigned* MISC = (volatile LAS unsigned*)(lds + MISC_OFF);
    if (tid < 32) MISC[tid] = 0u;
    __syncthreads();
    XcdBarrier bar; bar.bar = (unsigned*)(ap->ws + WS_CTL) + CW_BAR; bar.x = 0; bar.st = MISC + 8;
    if (!MK_PER_PHASE) bar = xcd_barrier_post((unsigned*)(ap->ws + WS_CTL) + CW_BAR, MISC + 8);
    const int lo = ap->ph_lo, hi = ap->ph_hi;
#ifndef DBG_ONLY
#define DBG_ONLY -1
#endif
#ifndef DBG_MASK
#define DBG_MASK 0xFFFFFFFFu
#endif
#ifndef REPMASK
#define REPMASK 0u
#endif
#define RP(k) for (int rep_ = 0; rep_ < 1 + (int)((REPMASK >> (k)) & 1u); ++rep_)
#define EN(k) ((DBG_ONLY < 0 || DBG_ONLY == (k)) && ((DBG_MASK >> (k)) & 1u))
#define IN(k) ({ int lo_ = lo, hi_ = hi; asm volatile("" : "+s"(lo_), "+s"(hi_)); (lo_ <= (k) && (k) < hi_); })
#define SEAM(k) do { if (IN(k) && IN((k) + 1)) xcd_barrier(bar); else __syncthreads(); } while (0)
#define PH_ARGS() ArgsP A_ = opaque(ap); const thin::In in = load_in(A_); unsigned char* const ws = A_->ws; (void)in; (void)ws

    if (EN(0) && IN(0)) { PH_ARGS(); RP(0) thin::phase_prologue(in, ws, lds, G, bid); } SEAM(0);
    if (EN(2) && IN(2)) { PH_ARGS(); RP(2) thin::phase_norm_in(in, ws, lds, G, bid); } SEAM(2);
    if (EN(3) && IN(3)) { PH_ARGS(); RP(3) {
        pg8::Gemm g{(const bf16*)(ws + WS_HB), (const bf16*)(ws + WS_WIN_T), NTOK, WIN_NP, 2048}; pg8::StaticOrder S; S.init(NTOK, WIN_NP, G, bid);
        pg8::EpiWin E{(bf16*)(ws + WS_AB), (float*)(ws + WS_PS), (float*)(ws + WS_KPER), in.mla_k_gain, (const float*)(ws + WS_MODP)};
        pg8::gemm_phase<pg8::EpiWin, pg8::StaticOrder, true, true>(lds, g, S, E);
    } thin::late_work(in, ws, lds, G, 3, 0); } SEAM(3);
    if (EN(5) && IN(5)) { PH_ARGS(); RP(5) {
        { pg8::Gemm g{(const bf16*)(ws + WS_AB), (const bf16*)(ws + WS_WQB_T), NTOK, 3072, 512, WIN_NP}; pg8::StaticOrder S; S.init(NTOK, 3072, G, bid);
          pg8::EpiBf16P E{(bf16*)(ws + WS_QRAW), 3072};
          pg8::gemm_phase<pg8::EpiBf16P, pg8::StaticOrder, true, true>(lds, g, S, E); }
        __syncthreads();
        { pg8::Gemm g{(const bf16*)(ws + WS_AB) + 512, (const bf16*)(ws + WS_WKVB_T), NTOK, 4096, 512, WIN_NP}; pg8::StaticOrder S; S.init(NTOK, 4096, G, (bid + 28) % G);
          pg8::EpiKv E{(bf16*)(ws + WS_KVRAW), in.mla_k_gain, (const float*)(ws + WS_KPER), (const float*)(ws + WS_PS), (LAS float*)(lds + 131072), ws + WS_KPE};
          pg8::gemm_phase<pg8::EpiKv, pg8::StaticOrder, true, true>(lds, g, S, E); }
    } thin::late_work(in, ws, lds, G, 5, 0); } SEAM(5);
    if (EN(7) && IN(7)) { PH_ARGS(); RP(7) {
        const unsigned char* q8 = ws + WS_QRAW; const unsigned char* k8 = ws + WS_KVRAW; const unsigned char* vt = ws + WS_KPE; bf16* ob = (bf16*)(ws + WS_OB);
        const int nun = (G == 256) ? 5 : 0;
        for (int i = 0; i < nun; ++i) {
            const int x = bid & 7, rr = bid >> 3;
            int h, qb; bool isctx = false;
            if (i < 4) { h = 2 * x + (i >> 1); qb = rr * 2 + (i & 1); }
            else { if (rr >= 2) break; h = 2 * x + rr; qb = 0; isctx = true; }
            __syncthreads();
            if (!isctx) att::mla_unit(q8 + (size_t)(qb * 256) * 6144 + h * 384, k8 + h * 512, vt + (size_t)h * (NTOK / 64) * 8192, ob + (size_t)(qb * 256) * 2048 + h * 128, NTOK, (LAS char*)lds, in.mla_q_gain, (const float*)(ws + WS_MODP), (const float*)(ws + WS_PS), qb * 256, true);
            else att::mla_unit(q8 + (size_t)NL * 6144 + h * 384, k8 + (size_t)NL * 8192 + h * 512, vt + ((size_t)h * (NTOK / 64) + NL / 64) * 8192, ob + (size_t)NL * 2048 + h * 128, NC, (LAS char*)lds, in.mla_q_gain, (const float*)(ws + WS_MODP), (const float*)(ws + WS_PS), NL, false);
        }
        if (G != 256)
        for (int u = bid; u < 1040; u += G) {
            __syncthreads();
            if (u < 1024) { const int h = u >> 6, qb = u & 63;
                att::mla_unit(q8 + (size_t)(qb * 256) * 6144 + h * 384, k8 + h * 512, vt + (size_t)h * (NTOK / 64) * 8192, ob + (size_t)(qb * 256) * 2048 + h * 128, NTOK, (LAS char*)lds, in.mla_q_gain, (const float*)(ws + WS_MODP), (const float*)(ws + WS_PS), qb * 256, true);
            } else { const int h = u - 1024;
                att::mla_unit(q8 + (size_t)NL * 6144 + h * 384, k8 + (size_t)NL * 8192 + h * 512, vt + ((size_t)h * (NTOK / 64) + NL / 64) * 8192, ob + (size_t)NL * 2048 + h * 128, NC, (LAS char*)lds, in.mla_q_gain, (const float*)(ws + WS_MODP), (const float*)(ws + WS_PS), NL, false); }
        }
    } thin::late_work(in, ws, lds, G, 7, 0); } SEAM(7);
    if (EN(8) && IN(8)) { PH_ARGS(); RP(8) {
        pg8::Gemm g{(const bf16*)(ws + WS_OB), (const bf16*)(ws + WS_WO0_T), NTOK, 2048, 2048}; pg8::StaticOrder S; S.init(NTOK, 2048, G, bid);
        pg8::EpiResB<false> E{(bf16*)(ws + WS_X1), in.x, in.ctx, thin::modv(ws, 0, 0, 2), thin::modv(ws, 0, 1, 2)};
        pg8::gemm_phase<pg8::EpiResB<false>, pg8::StaticOrder, true, true>(lds, g, S, E);
    } thin::late_work(in, ws, lds, G, 8, 0); } SEAM(8);
#define MOE_PHASES(L, PB, PC) \
    if (EN(9) && IN(PB + 0)) { PH_ARGS(); RP(9) thin::phase_router(in, ws, lds, G, bid, L, L ? NL : NTOK); } SEAM(PB + 0); \
    if (EN(10) && IN(PB + 1)) { PH_ARGS(); RP(10) thin::phase_topk(ws, lds, G, bid, L ? 16 : 32); thin::late_work(in, ws, lds, G, PB + 1, 0); thin::late_work(in, ws, lds, G, -1, L ? thin::LIM_GU1 : thin::LIM_MOE0); } SEAM(PB + 1); \
    if (EN(12) && IN(PB + 3)) { PH_ARGS(); RP(12) { \
        pg8::Gemm g{(const bf16*)(ws + WS_HB), (const bf16*)(ws + WS_WGU_T) + (size_t)L * WGU_L, NE * EROWS, NE * 2816, 2048}; \
        pg8::GroupedOrder S; S.init(L ? 8 : 9, 11, G, bid); \
        pg8::EpiSwiGLU E{(bf16*)(ws + WS_HID)}; \
        pg8::gemm_phase_gather<pg8::EpiSwiGLU, pg8::GroupedOrder, true, true>(lds, g, (const int*)(ws + WS_IDX), S, E);     \
    } thin::late_work(in, ws, lds, G, PB + 3, 0); if (L == 1) thin::late_work(in, ws, lds, G, -1, thin::LIM_ALL); } SEAM(PB + 3);     \
    if (EN(13) && IN(PB + 4)) { PH_ARGS(); RP(13) { \
        pg8::Gemm g{(const bf16*)(ws + WS_HID), (const bf16*)(ws + WS_WD_T) + (size_t)L * WD_L, NE * EROWS, NE * 2048, FF}; \
        pg8::GroupedOrder S; S.init(L ? 8 : 9, 8, G, bid); \
        pg8::EpiDown E{(bf16*)(ws + WS_YB), (const float*)(ws + WS_GATE)}; \
        pg8::gemm_phase<pg8::EpiDown, pg8::GroupedOrder, true, true>(lds, g, S, E); \
    } if (L == 0) thin::late_work(in, ws, lds, G, PB + 4, 0); } SEAM(PB + 4); \
    if (EN(14) && IN(PC)) { PH_ARGS(); RP(14) thin::phase_combine(in, ws, lds, A_->out, G, bid, L, L ? NL : NTOK); if (L == 0) thin::late_work(in, ws, lds, G, -1, thin::LIM_NA); }

    MOE_PHASES(0, 9, 14)
    SEAM(14);
    if (EN(15) && IN(15)) { PH_ARGS(); RP(15) {
        pg8::Gemm g{(const bf16*)(ws + WS_HB), (const bf16*)(ws + WS_WQKV_T), NTOK, 6144, 2048}; pg8::StaticOrder S; S.init(NTOK, 6144, G, bid);
        pg8::EpiQkvNorm E{(bf16*)(ws + WS_QKV1), in.na_q_gain, in.na_k_gain, (LAS float*)(lds + 131072)};
        pg8::gemm_phase<pg8::EpiQkvNorm, pg8::StaticOrder, true, true>(lds, g, S, E);
    } thin::late_work(in, ws, lds, G, 15, 0); } SEAM(15);
    if (EN(17) && IN(17)) { PH_ARGS(); RP(17) {
        for (int u = bid; u < 1024; u += G) { const int h = u >> 6, rb = u & 63;
            __syncthreads();
            att::na_unit((const bf16*)(ws + WS_QKV1), h, rb, in.na_rpb + h * 465, (bf16*)(ws + WS_OB), (LAS char*)lds); }
    } thin::late_work(in, ws, lds, G, 17, 0); } SEAM(17);
    if (EN(18) && IN(18)) { PH_ARGS(); RP(18) {
        pg8::Gemm g{(const bf16*)(ws + WS_OB), (const bf16*)(ws + WS_WO1_T), NL, 2048, 2048}; pg8::StaticOrder S; S.init(NL, 2048, G, bid);
        pg8::EpiResB<true> E{(bf16*)(ws + WS_X1), ws + WS_X1, ws + WS_X1, thin::modv(ws, 1, 0, 2), thin::modv(ws, 1, 0, 2)};
        pg8::gemm_phase<pg8::EpiResB<true>, pg8::StaticOrder, true, true>(lds, g, S, E);
    } thin::late_work(in, ws, lds, G, 18, 0); } SEAM(18);
    MOE_PHASES(1, 19, 24)
#undef MOE_PHASES
#undef IN
#undef SEAM
}

extern "C" void kernel_launch(void* const* d_in, const int* in_sizes, int n_in, void* d_out, int out_size, void* d_ws, size_t ws_size, hipStream_t stream) {
    static int grid = 0;
    if (grid == 0) {
        if (n_in != 25 || in_sizes[0] != NL * DM || out_size != NL * DM || ws_size < WS_END) {
            fprintf(stderr, "kernel_launch: unexpected problem: n_in %d in0 %d out %d ws %zu (need %zu)\n", n_in, n_in > 0 ? in_sizes[0] : -1, out_size, ws_size, (size_t)WS_END); grid = -1; return; }
        int dev = 0, cus = 0, per_cu = 0;
        if (hipGetDevice(&dev) != hipSuccess || hipDeviceGetAttribute(&cus, hipDeviceAttributeMultiprocessorCount, dev) != hipSuccess) { grid = -1; return; }
        if (hipFuncSetAttribute((const void*)fwd_kernel, hipFuncAttributeMaxDynamicSharedMemorySize, LDS_BYTES) != hipSuccess) { fprintf(stderr, "kernel_launch: hipFuncSetAttribute failed\n"); grid = -1; return; }
        if (hipOccupancyMaxActiveBlocksPerMultiprocessor(&per_cu, (const void*)fwd_kernel, 512, LDS_BYTES) != hipSuccess || per_cu < 1)
            fprintf(stderr, "kernel_launch: note: occupancy query reports %d workgroups per CU\n", per_cu);
        (void)hipGetLastError();
        grid = cus;
    }
    if (grid < 0) return;
    if (hipMemsetAsync((char*)d_ws + WS_CTL, 0, CTL_ZERO_BYTES, stream) != hipSuccess) { fprintf(stderr, "kernel_launch: memset failed\n"); return; }
    Args a{};
    const float** ip = (const float**)&a.in;
    for (int i = 0; i < 25; ++i) ip[i] = (const float*)d_in[i];
    a.out = (float*)d_out; a.ws = (unsigned char*)d_ws;
#if MK_PER_PHASE
    for (int p = 0; p < NPHASE; ++p) { a.ph_lo = p; a.ph_hi = p + 1;
        hipLaunchKernelGGL(fwd_kernel, dim3(grid), dim3(512), LDS_BYTES, stream, a); }
#else
    a.ph_lo = 0; a.ph_hi = NPHASE;
    hipLaunchKernelGGL(fwd_kernel, dim3(grid), dim3(512), LDS_BYTES, stream, a);
#endif
    const hipError_t le = hipPeekAtLastError();
    if (le != hipSuccess) fprintf(stderr, "kernel_launch: launch failed: %s\n", hipGetErrorName(le));
}
```

```cpp
#include <hip/hip_runtime.h>
#include <cstdio>
#include <cstdint>

#define GAS __attribute__((address_space(1)))
#define LAS __attribute__((address_space(3)))
typedef unsigned short bf16;
typedef short bf16x8 __attribute__((ext_vector_type(8)));
typedef short s16x4 __attribute__((ext_vector_type(4)));
typedef float f32x2 __attribute__((ext_vector_type(2)));
typedef float f32x4 __attribute__((ext_vector_type(4)));
typedef float f32x16 __attribute__((ext_vector_type(16)));
typedef unsigned u32x4 __attribute__((ext_vector_type(4)));
typedef unsigned u32x2 __attribute__((ext_vector_type(2)));

constexpr int NL = 16384, NC = 256, NTOK = NL + NC, DM = 2048, NH = 16;
constexpr int QLORA = 512, KVLORA = 512, ROPE_D = 64, NOPE_D = 128, QKH = 192, VD = 128;
constexpr int WIN_N = 1088, WIN_NP = 1280;
constexpr int NE = 16, FF = 1408, CAPL = 2048, CAPC = 32, EROWS = 2304;
constexpr float EPS = 1e-6f;
constexpr float LOG2E = 1.4426950408889634f;

constexpr size_t MiB = (size_t)1 << 20;
constexpr size_t WS_CTL = 0, CTL_ZERO_BYTES = 1 * MiB;
constexpr size_t WS_MODP = 1 * MiB;
static_assert((size_t)NTOK * 64 * 4 + 64 * 1024 <= 4608 * 1024 && 4608 * 1024 + (size_t)NTOK * 20 * 4 <= 6 * MiB, "small tables");
constexpr size_t WS_KPER = WS_MODP + 64 * 1024;
constexpr size_t WS_PS = WS_MODP + 4608 * 1024;
constexpr size_t WS_MOD = 7 * MiB;
constexpr size_t WS_AFF = 8 * MiB;
constexpr size_t WS_IDX = 8 * MiB + 1280 * 1024;
constexpr size_t WS_GATE = WS_IDX + 256 * 1024;
constexpr size_t WS_SLOT = 10 * MiB;
constexpr size_t WS_WIN_T = 12 * MiB, WS_WQB_T = 17 * MiB, WS_WKVB_T = 20 * MiB, WS_WO0_T = 24 * MiB, WS_WQKV_T = 32 * MiB, WS_WO1_T = 56 * MiB;
constexpr size_t WS_WGU_T = 64 * MiB;
constexpr size_t WS_WD_T = 416 * MiB;
constexpr size_t WS_HB = 592 * MiB;
constexpr size_t WS_X1 = 657 * MiB;
constexpr size_t WS_R = 787 * MiB;
constexpr size_t WS_AB = WS_R, WS_QN = WS_R + 41 * MiB, WS_KVN = WS_R + 58 * MiB, WS_QRAW = WS_R + 75 * MiB, WS_KVRAW = WS_R + 173 * MiB, WS_KPE = WS_R + 303 * MiB, WS_OB = WS_R + 336 * MiB;
constexpr size_t WS_QKV1 = WS_R;
constexpr size_t WS_XS = WS_R, WS_HID = WS_R + 144 * MiB, WS_YB = WS_R + 243 * MiB;
constexpr size_t WS_END = WS_R + 401 * MiB;
static_assert((size_t)NTOK * WIN_NP * 2 <= 41 * MiB && (size_t)NTOK * 512 * 2 <= 17 * MiB && (size_t)NTOK * 3072 * 2 <= 98 * MiB && (size_t)NTOK * 4096 * 2 <= 130 * MiB && (size_t)NTOK * 1024 * 2 <= 33 * MiB && (size_t)NTOK * 2048 * 2 <= 65 * MiB, "region A");
static_assert((size_t)NE * EROWS * 2048 * 2 <= 144 * MiB && (size_t)NE * EROWS * FF * 2 <= 99 * MiB && (size_t)NTOK * 6144 * 2 <= 195 * MiB, "region B");
constexpr size_t WGU_L = (size_t)NE * 2816 * 2048, WD_L = (size_t)NE * 2048 * FF;

constexpr int CW_BAR = 4096;
constexpr int CW_WORK = 128;
constexpr int CW_DONE = 256;
constexpr int CW_KMAX = 64;

__device__ __forceinline__ unsigned cvtpk(float lo, float hi) { unsigned r; asm("v_cvt_pk_bf16_f32 %0, %1, %2" : "=v"(r) : "v"(lo), "v"(hi)); return r; }
__device__ __forceinline__ float bflo(unsigned u) { return __uint_as_float(u << 16); }
__device__ __forceinline__ float bfhi(unsigned u) { return __uint_as_float(u & 0xffff0000u); }
__device__ __forceinline__ float wave_sum(float v) {
#pragma unroll
    for (int o = 1; o < 64; o <<= 1) v += __shfl_xor(v, o);
    return v;
}
__device__ __forceinline__ int wave_sum_i(int v) {
#pragma unroll
    for (int o = 1; o < 64; o <<= 1) v += __shfl_xor(v, o);
    return v;
}
__device__ __forceinline__ int ltid() { int t = threadIdx.x; asm volatile("" : "+v"(t)); return t; }
namespace pg8 {
#define PG8_LAS __attribute__((address_space(3)))
typedef unsigned short bf16_t;
typedef short bf16x8 __attribute__((ext_vector_type(8)));
typedef float f32x4 __attribute__((ext_vector_type(4)));
typedef unsigned u32x4 __attribute__((ext_vector_type(4)));
constexpr int BM = 256, BK = 64, HALF = 128, HTB = HALF * BK * 2  , STAGE_BYTES = 8 * HTB, NXCD = 8, WGM = 8;

__host__ __device__ __forceinline__ int lds_byte(int r, int c) { const int st = (r >> 4) * 2 + (c >> 5), rr = r & 15, cc = c & 31, ob = rr * 64 + cc * 2; return st * 1024 + (ob ^ (((ob >> 9) & 1) << 5)); }
__host__ __device__ __forceinline__ void stage_rc(int b, int& R, int& C) { const int st = b / 1024, sb = b % 1024, swz = sb ^ (((sb >> 9) & 1) << 5); R = (st >> 1) * 16 + swz / 64; C = (st & 1) * 32 + (swz % 64) / 2; }
__host__ __device__ __forceinline__ int perm32(int rho) { const int n = rho >> 4, i = rho & 15; return 8 * (i >> 2) + 4 * n + (i & 3); }

struct Unit { int pm, pn; };
struct Gemm { const bf16_t* A; const bf16_t* Bt; int M, N, K; int lda = 0; };

struct StaticOrder {
    int nM, nN, nwg, G, c;
    __host__ __device__ void init(int M, int N, int G_, int c_) { nM = M / BM; nN = N / BM; nwg = nM * nN; G = G_; c = c_; }
    __host__ __device__ bool next(int i, Unit& u) const {
        const long L = (long)i * G + c; if (L >= nwg) return false;
        int wgid = (int)L; { const int q = nwg / NXCD, r = nwg % NXCD, xcd = wgid % NXCD, off = wgid / NXCD; wgid = (xcd < r ? xcd * (q + 1) : r * (q + 1) + (xcd - r) * q) + off; }
        const int nig = WGM * nN, gid = wgid / nig, fm = gid * WGM, gsz = (nM - fm) < WGM ? (nM - fm) : WGM;
        u.pm = fm + ((wgid % nig) % gsz); u.pn = (wgid % nig) / gsz; return true;
    }
    __device__ __forceinline__ void a_ready(const Unit&) const {}
    __device__ __forceinline__ void done(const Unit&) const {}
};

__device__ __forceinline__ unsigned cvt_pk_bf16(float lo, float hi) { unsigned r; asm volatile("v_cvt_pk_bf16_f32 %0, %1, %2" : "=v"(r) : "v"(lo), "v"(hi)); return r; }
typedef float f32x2 __attribute__((ext_vector_type(2)));
template <class Epi, class Sched, bool ALIGN_EPI = false, bool SP2 = false>
__device__ __forceinline__ void gemm_phase(PG8_LAS unsigned char* lds, const Gemm g, const Sched& S, const Epi& E) {
    const int tid = ltid(), wid = __builtin_amdgcn_readfirstlane(tid >> 6), lane = tid & 63, wr = wid >> 2, wc = wid & 3, fr = lane & 15, fq = lane >> 4;
    const int K = g.K, nt = K / BK, lda = g.lda ? g.lda : K;
    unsigned voffA[2], voffB[2];
#pragma unroll
    for (int i = 0; i < 2; ++i) { int R, C; stage_rc(tid * 16 + i * 8192, R, C); const int Rb = Epi::PERM ? ((R & ~31) + perm32(R & 31)) : R;
        voffA[i] = (unsigned)(R * lda + C) * 2u; voffB[i] = (unsigned)(Rb * K + C) * 2u; }
    const size_t kstep = (size_t)(BK * 2);
    const size_t hstep = (size_t)HALF * K * 2;
    const size_t tstep = 2 * hstep;
    const size_t hstepA = (size_t)HALF * lda * 2, tstepA = 2 * hstepA;
    const unsigned ldsw = (unsigned)wid * 1024u;
    const int aoff = lds_byte(wr * 64 + fr, fq * 8), boff = lds_byte(wc * 32 + fr, fq * 8);
#define PG8_SA(b, h) (((b) * 2 + (h)) * HTB)
#define PG8_SB(b, h) ((4 + (b) * 2 + (h)) * HTB)
#define PG8_STAGE(bufoff, gbase, voff) do { _Pragma("unroll") for (int _i = 0; _i < 2; ++_i) \
        __builtin_amdgcn_global_load_lds((const unsigned*)((const char*)(gbase) + (voff)[_i]), (PG8_LAS unsigned*)(lds + (bufoff) + ldsw + _i * 8192), 16, 0, 0); } while (0)
#define PG8_LDA(dst, b, h) do { _Pragma("unroll") for (int m = 0; m < 4; ++m) _Pragma("unroll") for (int k = 0; k < 2; ++k) dst[m][k] = *(const PG8_LAS bf16x8*)(lds + PG8_SA(b, h) + aoff + m * 2048 + k * 1024); } while (0)
#define PG8_LDB(dst, b, h) do { _Pragma("unroll") for (int n = 0; n < 2; ++n) _Pragma("unroll") for (int k = 0; k < 2; ++k) dst[n][k] = *(const PG8_LAS bf16x8*)(lds + PG8_SB(b, h) + boff + n * 2048 + k * 1024); } while (0)
#define PG8_MMA(ai, bj, At, Bt) do { __builtin_amdgcn_s_setprio(1); _Pragma("unroll") for (int m = 0; m < 4; ++m) _Pragma("unroll") for (int n = 0; n < 2; ++n) _Pragma("unroll") for (int k = 0; k < 2; ++k) \
        acc[ai][bj][m][n] = __builtin_amdgcn_mfma_f32_16x16x32_bf16(Bt[n][k], At[m][k], acc[ai][bj][m][n], 0, 0, 0); __builtin_amdgcn_s_setprio(0); } while (0)
#define PG8_WAIT_V(n) asm volatile("s_waitcnt vmcnt(" #n ")" ::: "memory")
#define PG8_WAIT_L(n) asm volatile("s_waitcnt lgkmcnt(" #n ")" ::: "memory")
#define PG8_BAR __builtin_amdgcn_s_barrier()
#define PG8_SCHED __builtin_amdgcn_sched_barrier(0)
    Unit cur, nxt; int ui = 0;
    if (!S.next(0, cur)) return;
    f32x4 acc[2][2][4][2];
#pragma unroll
    for (int a = 0; a < 2; ++a)
#pragma unroll
        for (int b = 0; b < 2; ++b)
#pragma unroll
            for (int m = 0; m < 4; ++m)
#pragma unroll
                for (int n = 0; n < 2; ++n) acc[a][b][m][n] = (f32x4){0.f, 0.f, 0.f, 0.f};
    bf16x8 At[4][2], B0[2][2], B1[2][2];
    const char* cA = (const char*)g.A + (size_t)cur.pm * tstepA; const char* cB = (const char*)g.Bt + (size_t)cur.pn * tstep;
    S.a_ready(cur);
    if constexpr (SP2) {
        PG8_STAGE(PG8_SB(0, 0), cB, voffB); PG8_STAGE(PG8_SB(0, 1), cB + hstep, voffB); PG8_STAGE(PG8_SA(0, 0), cA, voffA); PG8_STAGE(PG8_SA(0, 1), cA + hstepA, voffA);
        if (wr == 1) PG8_BAR;
        PG8_WAIT_V(2); PG8_BAR;
        PG8_STAGE(PG8_SB(1, 0), cB + kstep, voffB); PG8_STAGE(PG8_SA(1, 0), cA + kstep, voffA); PG8_STAGE(PG8_SB(1, 1), cB + hstep + kstep, voffB);
        PG8_WAIT_V(6); PG8_BAR;
    } else {
        PG8_STAGE(PG8_SB(0, 0), cB, voffB); PG8_STAGE(PG8_SA(0, 0), cA, voffA); PG8_STAGE(PG8_SB(0, 1), cB + hstep, voffB); PG8_STAGE(PG8_SA(0, 1), cA + hstepA, voffA);
        if (wr == 1) PG8_BAR;
        PG8_WAIT_V(4); PG8_BAR;
        PG8_STAGE(PG8_SB(1, 0), cB + kstep, voffB); PG8_STAGE(PG8_SA(1, 0), cA + kstep, voffA); PG8_STAGE(PG8_SB(1, 1), cB + hstep + kstep, voffB);
        PG8_WAIT_V(6); PG8_BAR;
    }
    for (;;) {
        const bool has_next = S.next(ui + 1, nxt);
        const char* nA = has_next ? (const char*)g.A + (size_t)nxt.pm * tstepA : cA; const char* nB = has_next ? (const char*)g.Bt + (size_t)nxt.pn * tstep : cB;
        for (int t = 0; t < nt; t += 2) {
            const bool last = (t == nt - 2);
            const char* a1 = cA + (size_t)(t + 1) * kstep;
            const char* a2 = last ? nA : cA + (size_t)(t + 2) * kstep; const char* b2 = last ? nB : cB + (size_t)(t + 2) * kstep;
            const char* a3 = a2 + kstep; const char* b3 = b2 + kstep;
            if (last && has_next) S.a_ready(nxt);
            if constexpr (SP2) {
            PG8_LDB(B0, 0, 0); PG8_LDB(B1, 0, 1); PG8_SCHED; PG8_LDA(At, 0, 0); PG8_STAGE(PG8_SA(1, 1), a1 + hstepA, voffA);
            PG8_WAIT_V(8); PG8_WAIT_L(0); PG8_BAR; PG8_MMA(0, 0, At, B0); PG8_MMA(0, 1, At, B1); PG8_BAR; PG8_SCHED;
            PG8_LDA(At, 0, 1); PG8_STAGE(PG8_SB(0, 0), b2, voffB); PG8_STAGE(PG8_SB(0, 1), b2 + hstep, voffB); PG8_STAGE(PG8_SA(0, 0), a2, voffA);
            PG8_WAIT_V(8); PG8_WAIT_L(0); PG8_BAR; PG8_MMA(1, 0, At, B0); PG8_MMA(1, 1, At, B1); PG8_BAR; PG8_SCHED;
            PG8_LDB(B0, 1, 0); PG8_LDB(B1, 1, 1); PG8_SCHED; PG8_LDA(At, 1, 0); PG8_STAGE(PG8_SA(0, 1), a2 + hstepA, voffA);
            PG8_WAIT_V(8); PG8_WAIT_L(0); PG8_BAR; PG8_MMA(0, 0, At, B0); PG8_MMA(0, 1, At, B1); PG8_BAR; PG8_SCHED;
            PG8_LDA(At, 1, 1); PG8_STAGE(PG8_SB(1, 0), b3, voffB); PG8_STAGE(PG8_SB(1, 1), b3 + hstep, voffB); PG8_STAGE(PG8_SA(1, 0), a3, voffA);
            PG8_WAIT_V(8); PG8_WAIT_L(0); PG8_BAR; PG8_MMA(1, 0, At, B0); PG8_MMA(1, 1, At, B1); PG8_BAR; PG8_SCHED;
            } else {
            PG8_LDB(B0, 0, 0); PG8_SCHED; PG8_LDA(At, 0, 0); PG8_STAGE(PG8_SA(1, 1), a1 + hstepA, voffA);
            PG8_WAIT_L(8); PG8_BAR; PG8_WAIT_L(0); PG8_MMA(0, 0, At, B0); PG8_BAR; PG8_SCHED;
            PG8_LDB(B1, 0, 1); PG8_STAGE(PG8_SB(0, 0), b2, voffB);
            PG8_BAR; PG8_WAIT_L(0); PG8_MMA(0, 1, At, B1); PG8_BAR;
            PG8_LDA(At, 0, 1); PG8_STAGE(PG8_SA(0, 0), a2, voffA);
            PG8_BAR; PG8_WAIT_L(0); PG8_MMA(1, 0, At, B0); PG8_BAR; PG8_SCHED;
            PG8_STAGE(PG8_SB(0, 1), b2 + hstep, voffB);
            PG8_WAIT_V(6); PG8_BAR; PG8_MMA(1, 1, At, B1); PG8_BAR;
            PG8_LDB(B0, 1, 0); PG8_SCHED; PG8_LDA(At, 1, 0); PG8_STAGE(PG8_SA(0, 1), a2 + hstepA, voffA);
            PG8_WAIT_L(8); PG8_BAR; PG8_WAIT_L(0); PG8_MMA(0, 0, At, B0); PG8_BAR; PG8_SCHED;
            PG8_LDB(B1, 1, 1); PG8_STAGE(PG8_SB(1, 0), b3, voffB);
            PG8_BAR; PG8_WAIT_L(0); PG8_MMA(0, 1, At, B1); PG8_BAR;
            PG8_LDA(At, 1, 1); PG8_STAGE(PG8_SA(1, 0), a3, voffA);
            PG8_BAR; PG8_WAIT_L(0); PG8_MMA(1, 0, At, B0); PG8_BAR; PG8_SCHED;
            PG8_STAGE(PG8_SB(1, 1), b3 + hstep, voffB);
            PG8_WAIT_V(6); PG8_BAR; PG8_MMA(1, 1, At, B1); PG8_BAR;
            }
        }
        if constexpr (ALIGN_EPI) { if (wr == 0) PG8_BAR; }
        if constexpr (!Epi::AFTER_DRAIN) { E(acc, cur, wr, wc, fr, fq); S.done(cur); }
        if (!has_next) break;
#pragma unroll
        for (int a = 0; a < 2; ++a)
#pragma unroll
            for (int b = 0; b < 2; ++b)
#pragma unroll
                for (int m = 0; m < 4; ++m)
#pragma unroll
                    for (int n = 0; n < 2; ++n) acc[a][b][m][n] = (f32x4){0.f, 0.f, 0.f, 0.f};
        cur = nxt; cA = nA; cB = nB; ++ui;
        if constexpr (ALIGN_EPI) { if (wr == 1) PG8_BAR; }
    }
    PG8_WAIT_V(0);
    if constexpr (!ALIGN_EPI) { if (wr == 0) PG8_BAR; }
    PG8_BAR;
    if constexpr (Epi::AFTER_DRAIN) { E.fused(acc, cur, wr, wc, fr, fq, lds, wid, lane); S.done(cur); }
#undef PG8_SA
#undef PG8_SB
#undef PG8_STAGE
#undef PG8_LDA
#undef PG8_LDB
#undef PG8_MMA
#undef PG8_WAIT_V
#undef PG8_WAIT_L
#undef PG8_BAR
#undef PG8_SCHED
}
template <class Epi, class Sched, bool ALIGN_EPI = false, bool SP2 = false>
__device__ __forceinline__ void gemm_phase_gather(PG8_LAS unsigned char* lds, const Gemm g, const int* __restrict__ rowidx, const Sched& S, const Epi& E) {
    static_assert(SP2, "gather variant: SP2 loop only");
    const int tid = ltid(), wid = __builtin_amdgcn_readfirstlane(tid >> 6), lane = tid & 63, wr = wid >> 2, wc = wid & 3, fr = lane & 15, fq = lane >> 4;
    const int K = g.K, nt = K / BK;
    unsigned voffA[2], voffB[2];
#pragma unroll
    for (int i = 0; i < 2; ++i) { int R, C; stage_rc(tid * 16 + i * 8192, R, C); const int Rb = Epi::PERM ? ((R & ~31) + perm32(R & 31)) : R;
        voffA[i] = (unsigned)(R * K + C) * 2u; voffB[i] = (unsigned)(Rb * K + C) * 2u; }
    const size_t kstep = (size_t)(BK * 2);
    const size_t hstep = (size_t)HALF * K * 2;
    const size_t tstep = 2 * hstep;
    const unsigned ldsw = (unsigned)wid * 1024u;
    const int aoff = lds_byte(wr * 64 + fr, fq * 8), boff = lds_byte(wc * 32 + fr, fq * 8);
#define PG8_SA(b, h) (((b) * 2 + (h)) * HTB)
#define PG8_SB(b, h) ((4 + (b) * 2 + (h)) * HTB)
#define PG8_STAGE(bufoff, gbase, voff) do { _Pragma("unroll") for (int _i = 0; _i < 2; ++_i) \
        __builtin_amdgcn_global_load_lds((const unsigned*)((const char*)(gbase) + (voff)[_i]), (PG8_LAS unsigned*)(lds + (bufoff) + ldsw + _i * 8192), 16, 0, 0); } while (0)
#define PG8_LDA(dst, b, h) do { _Pragma("unroll") for (int m = 0; m < 4; ++m) _Pragma("unroll") for (int k = 0; k < 2; ++k) dst[m][k] = *(const PG8_LAS bf16x8*)(lds + PG8_SA(b, h) + aoff + m * 2048 + k * 1024); } while (0)
#define PG8_LDB(dst, b, h) do { _Pragma("unroll") for (int n = 0; n < 2; ++n) _Pragma("unroll") for (int k = 0; k < 2; ++k) dst[n][k] = *(const PG8_LAS bf16x8*)(lds + PG8_SB(b, h) + boff + n * 2048 + k * 1024); } while (0)
#define PG8_MMA(ai, bj, At, Bt) do { __builtin_amdgcn_s_setprio(1); _Pragma("unroll") for (int m = 0; m < 4; ++m) _Pragma("unroll") for (int n = 0; n < 2; ++n) _Pragma("unroll") for (int k = 0; k < 2; ++k) \
        acc[ai][bj][m][n] = __builtin_amdgcn_mfma_f32_16x16x32_bf16(Bt[n][k], At[m][k], acc[ai][bj][m][n], 0, 0, 0); __builtin_amdgcn_s_setprio(0); } while (0)
#define PG8_WAIT_V(n) asm volatile("s_waitcnt vmcnt(" #n ")" ::: "memory")
#define PG8_WAIT_L(n) asm volatile("s_waitcnt lgkmcnt(" #n ")" ::: "memory")
#define PG8_BAR __builtin_amdgcn_s_barrier()
#define PG8_SCHED __builtin_amdgcn_sched_barrier(0)
    Unit cur, nxt; int ui = 0;
    if (!S.next(0, cur)) return;
    int RA[2], CA[2];
#pragma unroll
    for (int i = 0; i < 2; ++i) stage_rc(tid * 16 + i * 8192, RA[i], CA[i]);
    unsigned vA0[2], vA1[2], nvA0[2], nvA1[2];
#define PG8_GOFF(u, d0, d1) do { _Pragma("unroll") for (int i = 0; i < 2; ++i) { \
        int t0_ = rowidx[(u).pm * BM + RA[i]], t1_ = rowidx[(u).pm * BM + HALF + RA[i]]; t0_ = t0_ < 0 ? 0 : t0_; t1_ = t1_ < 0 ? 0 : t1_; \
        d0[i] = (unsigned)(t0_ * K + CA[i]) * 2u; d1[i] = (unsigned)(t1_ * K + CA[i]) * 2u; } } while (0)
    PG8_GOFF(cur, vA0, vA1);
    f32x4 acc[2][2][4][2];
#pragma unroll
    for (int a = 0; a < 2; ++a)
#pragma unroll
        for (int b = 0; b < 2; ++b)
#pragma unroll
            for (int m = 0; m < 4; ++m)
#pragma unroll
                for (int n = 0; n < 2; ++n) acc[a][b][m][n] = (f32x4){0.f, 0.f, 0.f, 0.f};
    bf16x8 At[4][2], B0[2][2], B1[2][2];
    const char* cA = (const char*)g.A; const char* cB = (const char*)g.Bt + (size_t)cur.pn * tstep;
    S.a_ready(cur);
    if constexpr (SP2) {
        PG8_STAGE(PG8_SB(0, 0), cB, voffB); PG8_STAGE(PG8_SB(0, 1), cB + hstep, voffB); PG8_STAGE(PG8_SA(0, 0), cA, vA0); PG8_STAGE(PG8_SA(0, 1), cA, vA1);
        if (wr == 1) PG8_BAR;
        PG8_WAIT_V(2); PG8_BAR;
        PG8_STAGE(PG8_SB(1, 0), cB + kstep, voffB); PG8_STAGE(PG8_SA(1, 0), cA + kstep, vA0); PG8_STAGE(PG8_SB(1, 1), cB + hstep + kstep, voffB);
        PG8_WAIT_V(6); PG8_BAR;
    } else {
        PG8_STAGE(PG8_SB(0, 0), cB, voffB); PG8_STAGE(PG8_SA(0, 0), cA, voffA); PG8_STAGE(PG8_SB(0, 1), cB + hstep, voffB); PG8_STAGE(PG8_SA(0, 1), cA + hstep, voffA);
        if (wr == 1) PG8_BAR;
        PG8_WAIT_V(4); PG8_BAR;
        PG8_STAGE(PG8_SB(1, 0), cB + kstep, voffB); PG8_STAGE(PG8_SA(1, 0), cA + kstep, voffA); PG8_STAGE(PG8_SB(1, 1), cB + hstep + kstep, voffB);
        PG8_WAIT_V(6); PG8_BAR;
    }
    for (;;) {
        const bool has_next = S.next(ui + 1, nxt);
        if (has_next) PG8_GOFF(nxt, nvA0, nvA1); else { nvA0[0] = vA0[0]; nvA0[1] = vA0[1]; nvA1[0] = vA1[0]; nvA1[1] = vA1[1]; }
        const char* nA = cA; const char* nB = has_next ? (const char*)g.Bt + (size_t)nxt.pn * tstep : cB;
        for (int t = 0; t < nt; t += 2) {
            const bool last = (t == nt - 2);
            const char* a1 = cA + (size_t)(t + 1) * kstep;
            const char* a2 = last ? nA : cA + (size_t)(t + 2) * kstep; const char* b2 = last ? nB : cB + (size_t)(t + 2) * kstep;
            const char* a3 = a2 + kstep; const char* b3 = b2 + kstep;
            unsigned wA0[2], wA1[2]; wA0[0] = last ? nvA0[0] : vA0[0]; wA0[1] = last ? nvA0[1] : vA0[1]; wA1[0] = last ? nvA1[0] : vA1[0]; wA1[1] = last ? nvA1[1] : vA1[1];
            if (last && has_next) S.a_ready(nxt);
            if constexpr (SP2) {
            PG8_LDB(B0, 0, 0); PG8_LDB(B1, 0, 1); PG8_SCHED; PG8_LDA(At, 0, 0); PG8_STAGE(PG8_SA(1, 1), a1, vA1);
            PG8_WAIT_V(8); PG8_WAIT_L(0); PG8_BAR; PG8_MMA(0, 0, At, B0); PG8_MMA(0, 1, At, B1); PG8_BAR; PG8_SCHED;
            PG8_LDA(At, 0, 1); PG8_STAGE(PG8_SB(0, 0), b2, voffB); PG8_STAGE(PG8_SB(0, 1), b2 + hstep, voffB); PG8_STAGE(PG8_SA(0, 0), a2, wA0);
            PG8_WAIT_V(8); PG8_WAIT_L(0); PG8_BAR; PG8_MMA(1, 0, At, B0); PG8_MMA(1, 1, At, B1); PG8_BAR; PG8_SCHED;
            PG8_LDB(B0, 1, 0); PG8_LDB(B1, 1, 1); PG8_SCHED; PG8_LDA(At, 1, 0); PG8_STAGE(PG8_SA(0, 1), a2, wA1);
            PG8_WAIT_V(8); PG8_WAIT_L(0); PG8_BAR; PG8_MMA(0, 0, At, B0); PG8_MMA(0, 1, At, B1); PG8_BAR; PG8_SCHED;
            PG8_LDA(At, 1, 1); PG8_STAGE(PG8_SB(1, 0), b3, voffB); PG8_STAGE(PG8_SB(1, 1), b3 + hstep, voffB); PG8_STAGE(PG8_SA(1, 0), a3, wA0);
            PG8_WAIT_V(8); PG8_WAIT_L(0); PG8_BAR; PG8_MMA(1, 0, At, B0); PG8_MMA(1, 1, At, B1); PG8_BAR; PG8_SCHED;
            } else {
            PG8_LDB(B0, 0, 0); PG8_SCHED; PG8_LDA(At, 0, 0); PG8_STAGE(PG8_SA(1, 1), a1 + hstep, voffA);
            PG8_WAIT_L(8); PG8_BAR; PG8_WAIT_L(0); PG8_MMA(0, 0, At, B0); PG8_BAR; PG8_SCHED;
            PG8_LDB(B1, 0, 1); PG8_STAGE(PG8_SB(0, 0), b2, voffB);
            PG8_BAR; PG8_WAIT_L(0); PG8_MMA(0, 1, At, B1); PG8_BAR;
            PG8_LDA(At, 0, 1); PG8_STAGE(PG8_SA(0, 0), a2, voffA);
            PG8_BAR; PG8_WAIT_L(0); PG8_MMA(1, 0, At, B0); PG8_BAR; PG8_SCHED;
            PG8_STAGE(PG8_SB(0, 1), b2 + hstep, voffB);
            PG8_WAIT_V(6); PG8_BAR; PG8_MMA(1, 1, At, B1); PG8_BAR;
            PG8_LDB(B0, 1, 0); PG8_SCHED; PG8_LDA(At, 1, 0); PG8_STAGE(PG8_SA(0, 1), a2 + hstep, voffA);
            PG8_WAIT_L(8); PG8_BAR; PG8_WAIT_L(0); PG8_MMA(0, 0, At, B0); PG8_BAR; PG8_SCHED;
            PG8_LDB(B1, 1, 1); PG8_STAGE(PG8_SB(1, 0), b3, voffB);
            PG8_BAR; PG8_WAIT_L(0); PG8_MMA(0, 1, At, B1); PG8_BAR;
            PG8_LDA(At, 1, 1); PG8_STAGE(PG8_SA(1, 0), a3, voffA);
            PG8_BAR; PG8_WAIT_L(0); PG8_MMA(1, 0, At, B0); PG8_BAR; PG8_SCHED;
            PG8_STAGE(PG8_SB(1, 1), b3 + hstep, voffB);
            PG8_WAIT_V(6); PG8_BAR; PG8_MMA(1, 1, At, B1); PG8_BAR;
            }
        }
        if constexpr (ALIGN_EPI) { if (wr == 0) PG8_BAR; }
        if constexpr (!Epi::AFTER_DRAIN) { E(acc, cur, wr, wc, fr, fq); S.done(cur); }
        if (!has_next) break;
#pragma unroll
        for (int a = 0; a < 2; ++a)
#pragma unroll
            for (int b = 0; b < 2; ++b)
#pragma unroll
                for (int m = 0; m < 4; ++m)
#pragma unroll
                    for (int n = 0; n < 2; ++n) acc[a][b][m][n] = (f32x4){0.f, 0.f, 0.f, 0.f};
        cur = nxt; cA = nA; cB = nB; ++ui; vA0[0] = nvA0[0]; vA0[1] = nvA0[1]; vA1[0] = nvA1[0]; vA1[1] = nvA1[1];
        if constexpr (ALIGN_EPI) { if (wr == 1) PG8_BAR; }
    }
    PG8_WAIT_V(0);
    if constexpr (!ALIGN_EPI) { if (wr == 0) PG8_BAR; }
    PG8_BAR;
    if constexpr (Epi::AFTER_DRAIN) { E.fused(acc, cur, wr, wc, fr, fq, lds, wid, lane); S.done(cur); }
#undef PG8_GOFF
#undef PG8_SA
#undef PG8_SB
#undef PG8_STAGE
#undef PG8_LDA
#undef PG8_LDB
#undef PG8_MMA
#undef PG8_WAIT_V
#undef PG8_WAIT_L
#undef PG8_BAR
#undef PG8_SCHED
}
}
namespace pg8 {
struct EpiBf16P {
    static constexpr bool PERM = true, AFTER_DRAIN = false;
    bf16_t* O; int ldc;
    __device__ __forceinline__ void operator()(const f32x4 (&acc)[2][2][4][2], const Unit& u, int wr, int wc, int fr, int fq) const {
        const int row0 = u.pm * BM + wr * 64 + fr, col0 = u.pn * BM + wc * 32 + 8 * fq;
#pragma unroll
        for (int ai = 0; ai < 2; ++ai)
#pragma unroll
            for (int m = 0; m < 4; ++m) { bf16_t* rowp = O + (size_t)(row0 + ai * HALF + m * 16) * ldc + col0;
#pragma unroll
                for (int bj = 0; bj < 2; ++bj) { const f32x4 v0 = acc[ai][bj][m][0], v1 = acc[ai][bj][m][1];
                    u32x4 w; w.x = cvt_pk_bf16(v0[0], v0[1]); w.y = cvt_pk_bf16(v0[2], v0[3]); w.z = cvt_pk_bf16(v1[0], v1[1]); w.w = cvt_pk_bf16(v1[2], v1[3]);
                    *(u32x4*)(rowp + bj * HALF) = w; } }
    }
};
struct EpiWin {
    static constexpr bool PERM = true, AFTER_DRAIN = false;
    bf16_t* O; float* ps; float* kper; const float* gk; const float* rtab;
    __device__ __forceinline__ void operator()(const f32x4 (&acc)[2][2][4][2], const Unit& u, int wr, int wc, int fr, int fq) const {
        const int row0 = u.pm * BM + wr * 64 + fr, col0 = u.pn * BM + wc * 32 + 8 * fq;
#pragma unroll
        for (int ai = 0; ai < 2; ++ai)
#pragma unroll
            for (int m = 0; m < 4; ++m) { const int row = row0 + ai * HALF + m * 16; bf16_t* rowp = O + (size_t)row * 1280 + col0;
                float s = 0.f;
#pragma unroll
                for (int bj = 0; bj < 2; ++bj) { const f32x4 v0 = acc[ai][bj][m][0], v1 = acc[ai][bj][m][1];
                    s += ((v0[0] * v0[0] + v0[1] * v0[1]) + (v0[2] * v0[2] + v0[3] * v0[3])) + ((v1[0] * v1[0] + v1[1] * v1[1]) + (v1[2] * v1[2] + v1[3] * v1[3]));
                    u32x4 w; w.x = cvt_pk_bf16(v0[0], v0[1]); w.y = cvt_pk_bf16(v0[2], v0[3]); w.z = cvt_pk_bf16(v1[0], v1[1]); w.w = cvt_pk_bf16(v1[2], v1[3]);
                    *(u32x4*)(rowp + bj * HALF) = w; }
                s += __shfl_xor(s, 16); s += __shfl_xor(s, 32);
                if (fq == 0) ps[(size_t)row * 20 + u.pn * 4 + wc] = s; }
        if (u.pn == 4 && wc < 2) {
            const int D0 = wc * 32 + 8 * fq, jt = 8 * (fq & 1); const bool second = (fq & 2) != 0;
            const f32x4 g0 = *(const f32x4*)(gk + 128 + D0), g1 = *(const f32x4*)(gk + 128 + D0 + 4);
#pragma unroll
            for (int ai = 0; ai < 2; ++ai)
#pragma unroll
                for (int m = 0; m < 4; ++m) { const int row = row0 + ai * HALF + m * 16;
                    f32x4 x0 = acc[ai][0][m][0] * g0, x1 = acc[ai][0][m][1] * g1;
                    f32x4 p0, p1;
#pragma unroll
                    for (int i = 0; i < 4; ++i) { p0[i] = __shfl_xor(x0[i], 32); p1[i] = __shfl_xor(x1[i], 32); }
                    if (row < 16384) { const int pos = wc ? (row & 63) : ((row >> 6) & 255);
                        const f32x4 c0 = *(const f32x4*)(rtab + pos * 16 + jt), c1 = *(const f32x4*)(rtab + pos * 16 + jt + 4), s0 = *(const f32x4*)(rtab + 4096 + pos * 16 + jt), s1 = *(const f32x4*)(rtab + 4096 + pos * 16 + jt + 4);
                        x0 = second ? (x0 * c0 + p0 * s0) : (x0 * c0 - p0 * s0); x1 = second ? (x1 * c1 + p1 * s1) : (x1 * c1 - p1 * s1); }
                    *(f32x4*)(kper + (size_t)row * 64 + D0) = x0; *(f32x4*)(kper + (size_t)row * 64 + D0 + 4) = x1; }
        }
    }
};
struct EpiQkvNorm {
    static constexpr bool PERM = true, AFTER_DRAIN = false;
    bf16_t* O; const float* gq; const float* gk; PG8_LAS float* part;
    __device__ __forceinline__ void operator()(const f32x4 (&acc_in)[2][2][4][2], const Unit& u, int wr, int wc, int fr, int fq) const {
        const int row0 = u.pm * BM + wr * 64 + fr, col0 = u.pn * BM + wc * 32 + 8 * fq;
        f32x4 acc[2][2][4][2];
#pragma unroll
        for (int ai = 0; ai < 2; ++ai)
#pragma unroll
            for (int bj = 0; bj < 2; ++bj)
#pragma unroll
                for (int m = 0; m < 4; ++m) { acc[ai][bj][m][0] = acc_in[ai][bj][m][0]; acc[ai][bj][m][1] = acc_in[ai][bj][m][1]; }
        if (u.pn < 16) {
            const float* gp = (u.pn < 8 ? gq : gk) + wc * 32 + 8 * fq;
            const f32x4 g0 = *(const f32x4*)gp, g1 = *(const f32x4*)(gp + 4);
#pragma unroll
            for (int ai = 0; ai < 2; ++ai)
#pragma unroll
                for (int bj = 0; bj < 2; ++bj)
#pragma unroll
                    for (int m = 0; m < 4; ++m) { const f32x4 v0 = acc[ai][bj][m][0], v1 = acc[ai][bj][m][1];
                        float s = ((v0[0] * v0[0] + v0[1] * v0[1]) + (v0[2] * v0[2] + v0[3] * v0[3])) + ((v1[0] * v1[0] + v1[1] * v1[1]) + (v1[2] * v1[2] + v1[3] * v1[3]));
                        s += __shfl_xor(s, 16); s += __shfl_xor(s, 32);
                        if (fq == 0) part[((ai * HALF + wr * 64 + m * 16 + fr) * 2 + bj) * 4 + wc] = s; }
            asm volatile("s_waitcnt lgkmcnt(0)" ::: "memory"); __builtin_amdgcn_s_barrier();
#pragma unroll
            for (int ai = 0; ai < 2; ++ai)
#pragma unroll
                for (int bj = 0; bj < 2; ++bj)
#pragma unroll
                    for (int m = 0; m < 4; ++m) { const f32x4 p = *(const PG8_LAS f32x4*)(part + ((ai * HALF + wr * 64 + m * 16 + fr) * 2 + bj) * 4);
                        const float rs = __builtin_amdgcn_rsqf(((p[0] + p[1]) + (p[2] + p[3])) * (1.f / 128.f) + 1e-6f);
                        acc[ai][bj][m][0] = acc[ai][bj][m][0] * rs * g0; acc[ai][bj][m][1] = acc[ai][bj][m][1] * rs * g1; }
            asm volatile("s_waitcnt lgkmcnt(0)" ::: "memory"); __builtin_amdgcn_s_barrier();
        }
#pragma unroll
        for (int ai = 0; ai < 2; ++ai)
#pragma unroll
            for (int m = 0; m < 4; ++m) { bf16_t* rowp = O + (size_t)(row0 + ai * HALF + m * 16) * 6144 + col0;
#pragma unroll
                for (int bj = 0; bj < 2; ++bj) { const f32x4 v0 = acc[ai][bj][m][0], v1 = acc[ai][bj][m][1];
                    u32x4 w; w.x = cvt_pk_bf16(v0[0], v0[1]); w.y = cvt_pk_bf16(v0[2], v0[3]); w.z = cvt_pk_bf16(v1[0], v1[1]); w.w = cvt_pk_bf16(v1[2], v1[3]);
                    *(u32x4*)(rowp + bj * HALF) = w; } }
    }
};
struct EpiKv {
    static constexpr bool PERM = true, AFTER_DRAIN = false;
    bf16_t* O; const float* gk; const float* kper; const float* ps; PG8_LAS float* part; unsigned char* vt;
    __device__ __forceinline__ void operator()(const f32x4 (&acc)[2][2][4][2], const Unit& u, int wr, int wc, int fr, int fq) const {
        const int row0 = u.pm * BM + wr * 64 + fr, h = u.pn;
        const f32x4 g0 = *(const f32x4*)(gk + wc * 32 + 8 * fq), g1 = *(const f32x4*)(gk + wc * 32 + 8 * fq + 4);
#pragma unroll
        for (int ai = 0; ai < 2; ++ai)
#pragma unroll
            for (int m = 0; m < 4; ++m) { const f32x4 v0 = acc[ai][0][m][0], v1 = acc[ai][0][m][1];
                float s = ((v0[0] * v0[0] + v0[1] * v0[1]) + (v0[2] * v0[2] + v0[3] * v0[3])) + ((v1[0] * v1[0] + v1[1] * v1[1]) + (v1[2] * v1[2] + v1[3] * v1[3]));
                s += __shfl_xor(s, 16); s += __shfl_xor(s, 32);
                if (fq == 0) part[(ai * HALF + wr * 64 + m * 16 + fr) * 4 + wc] = s; }
        asm volatile("s_waitcnt lgkmcnt(0)" ::: "memory"); __builtin_amdgcn_s_barrier();
        float rkv_[2][4];
#pragma unroll
        for (int ai = 0; ai < 2; ++ai)
#pragma unroll
            for (int m = 0; m < 4; ++m) { const int row = row0 + ai * HALF + m * 16;
                const f32x4 p = *(const PG8_LAS f32x4*)(part + (ai * HALF + wr * 64 + m * 16 + fr) * 4);
                const f32x4 q2 = *(const f32x4*)(ps + (size_t)row * 20 + 8), q3 = *(const f32x4*)(ps + (size_t)row * 20 + 12), q4 = *(const f32x4*)(ps + (size_t)row * 20 + 16);
                const float rkv = __builtin_amdgcn_rsqf((((q2[0] + q2[1]) + (q2[2] + q2[3])) + ((q3[0] + q3[1]) + (q3[2] + q3[3]))) * (1.f / 512.f) + 1e-6f);
                rkv_[ai][m] = rkv;
                const float rs = __builtin_amdgcn_rsqf((((p[0] + p[1]) + (p[2] + p[3])) * (rkv * rkv) + ((q4[0] + q4[1]) + (q4[2] + q4[3]))) * (1.f / 192.f) + 1e-6f) * 0.32267250623034593f;
                const float rsn = rs * rkv;
                unsigned char* slot = (unsigned char*)O + (size_t)row * 8192 + h * 512;
                const f32x4 v0 = acc[ai][0][m][0] * rsn * g0, v1 = acc[ai][0][m][1] * rsn * g1;
                int w0 = 0, w1 = 0;
                w0 = __builtin_amdgcn_cvt_pk_fp8_f32(v0[0], v0[1], w0, false); w0 = __builtin_amdgcn_cvt_pk_fp8_f32(v0[2], v0[3], w0, true);
                w1 = __builtin_amdgcn_cvt_pk_fp8_f32(v1[0], v1[1], w1, false); w1 = __builtin_amdgcn_cvt_pk_fp8_f32(v1[2], v1[3], w1, true);
                u32x2 kw; kw.x = (unsigned)w0; kw.y = (unsigned)w1; *(u32x2*)(slot + wc * 32 + 8 * fq) = kw;
                const f32x4 r4 = *(const f32x4*)(kper + (size_t)row * 64 + wc * 16 + 4 * fq) * rs;
                int w2 = 0; w2 = __builtin_amdgcn_cvt_pk_fp8_f32(r4[0], r4[1], w2, false); w2 = __builtin_amdgcn_cvt_pk_fp8_f32(r4[2], r4[3], w2, true);
                *(unsigned*)(slot + 128 + wc * 16 + 4 * fq) = (unsigned)w2;
            }
        asm volatile("s_waitcnt lgkmcnt(0)" ::: "memory"); __builtin_amdgcn_s_barrier();
        const int mq = fr & 3, aq = fr >> 2;
        const unsigned sel01 = (unsigned)mq | ((unsigned)(4 + mq) << 8);
        const int sd = 8 * (aq & 1) + 4 * (mq >> 1) + 2 * (mq & 1) + (aq >> 1);
#pragma unroll
        for (int ai = 0; ai < 2; ++ai) {
            unsigned char* tile = vt + ((size_t)h * (16640 / 64) + (size_t)(u.pm * 4 + ai * 2 + wr)) * 8192 + (size_t)(wc * 32 + 8 * fq) * 64 + 4 * sd;
#pragma unroll
            for (int j = 0; j < 8; ++j) {
                int L = 0;
                L = __builtin_amdgcn_cvt_pk_fp8_f32(acc[ai][1][0][j >> 2][j & 3] * rkv_[ai][0], acc[ai][1][1][j >> 2][j & 3] * rkv_[ai][1], L, false);
                L = __builtin_amdgcn_cvt_pk_fp8_f32(acc[ai][1][2][j >> 2][j & 3] * rkv_[ai][2], acc[ai][1][3][j >> 2][j & 3] * rkv_[ai][3], L, true);
                const unsigned x0 = (unsigned)__builtin_amdgcn_mov_dpp(L, 0x00, 0xf, 0xf, false), x1 = (unsigned)__builtin_amdgcn_mov_dpp(L, 0x55, 0xf, 0xf, false);
                const unsigned x2 = (unsigned)__builtin_amdgcn_mov_dpp(L, 0xAA, 0xf, 0xf, false), x3 = (unsigned)__builtin_amdgcn_mov_dpp(L, 0xFF, 0xf, 0xf, false);
                const unsigned t01 = __builtin_amdgcn_perm(x1, x0, sel01), t23 = __builtin_amdgcn_perm(x3, x2, sel01);
                *(unsigned*)(tile + j * 64) = __builtin_amdgcn_perm(t23, t01, 0x05040100u);
            }
        }
    }
};
struct EpiRes {
    static constexpr bool PERM = false, AFTER_DRAIN = false;
    float* out; const float* res_lat; const float* res_ctx; const float* g_lat; const float* g_ctx;
    __device__ __forceinline__ void operator()(const f32x4 (&acc)[2][2][4][2], const Unit& u, int wr, int wc, int fr, int fq) const {
        const bool isctx = (u.pm >= 64);
        const int row0 = u.pm * BM + wr * 64 + fr, col0 = u.pn * BM + wc * 32 + 4 * fq;
        const float* res = isctx ? res_ctx : res_lat; const float* gv = isctx ? g_ctx : g_lat; const int rsub = isctx ? 16384 : 0;
        f32x4 g4[2][2];
#pragma unroll
        for (int bj = 0; bj < 2; ++bj)
#pragma unroll
            for (int n = 0; n < 2; ++n) g4[bj][n] = *(const f32x4*)(gv + col0 + bj * HALF + n * 16);
#pragma unroll
        for (int ai = 0; ai < 2; ++ai)
#pragma unroll
            for (int m = 0; m < 4; ++m) { const int row = row0 + ai * HALF + m * 16; float* op = out + (size_t)row * 2048 + col0; const float* rp = res + (size_t)(row - rsub) * 2048 + col0;
#pragma unroll
                for (int bj = 0; bj < 2; ++bj)
#pragma unroll
                    for (int n = 0; n < 2; ++n) { const f32x4 r = *(const f32x4*)(rp + bj * HALF + n * 16); *(f32x4*)(op + bj * HALF + n * 16) = r + g4[bj][n] * acc[ai][bj][m][n]; } }
    }
};
template <bool RESB>
struct EpiResB {
    static constexpr bool PERM = true, AFTER_DRAIN = false;
    bf16_t* out; const void* res_lat; const void* res_ctx; const float* g_lat; const float* g_ctx;
    __device__ __forceinline__ void operator()(const f32x4 (&acc)[2][2][4][2], const Unit& u, int wr, int wc, int fr, int fq) const {
        const bool isctx = (u.pm >= 64);
        const int row0 = u.pm * BM + wr * 64 + fr, col0 = u.pn * BM + wc * 32 + 8 * fq;
        const void* res = isctx ? res_ctx : res_lat; const float* gv = isctx ? g_ctx : g_lat; const int rsub = (!RESB && isctx) ? 16384 : 0;
        f32x4 g4[2][2];
#pragma unroll
        for (int bj = 0; bj < 2; ++bj)
#pragma unroll
            for (int n = 0; n < 2; ++n) g4[bj][n] = *(const f32x4*)(gv + col0 + bj * HALF + n * 4);
#pragma unroll
        for (int ai = 0; ai < 2; ++ai)
#pragma unroll
            for (int m = 0; m < 4; ++m) { const int row = row0 + ai * HALF + m * 16; bf16_t* op = out + (size_t)row * 2048 + col0;
#pragma unroll
                for (int bj = 0; bj < 2; ++bj) { f32x4 r0, r1;
                    if constexpr (RESB) { const u32x4 w = *(const u32x4*)((const bf16_t*)res + (size_t)row * 2048 + col0 + bj * HALF);
                        r0 = (f32x4){__uint_as_float(w.x << 16), __uint_as_float(w.x & 0xffff0000u), __uint_as_float(w.y << 16), __uint_as_float(w.y & 0xffff0000u)};
                        r1 = (f32x4){__uint_as_float(w.z << 16), __uint_as_float(w.z & 0xffff0000u), __uint_as_float(w.w << 16), __uint_as_float(w.w & 0xffff0000u)}; }
                    else { const float* rp = (const float*)res + (size_t)(row - rsub) * 2048 + col0 + bj * HALF; r0 = *(const f32x4*)rp; r1 = *(const f32x4*)(rp + 4); }
                    const f32x4 v0 = r0 + g4[bj][0] * acc[ai][bj][m][0], v1 = r1 + g4[bj][1] * acc[ai][bj][m][1];
                    u32x4 w; w.x = cvt_pk_bf16(v0[0], v0[1]); w.y = cvt_pk_bf16(v0[2], v0[3]); w.z = cvt_pk_bf16(v1[0], v1[1]); w.w = cvt_pk_bf16(v1[2], v1[3]);
                    *(u32x4*)(op + bj * HALF) = w; } }
    }
};
struct EpiSwiGLU {
    static constexpr bool PERM = true, AFTER_DRAIN = false;
    bf16_t* H;
    __device__ __forceinline__ void operator()(const f32x4 (&acc)[2][2][4][2], const Unit& u, int wr, int wc, int fr, int fq) const {
        const int e = u.pm / 9, nl = u.pn - e * 11;
        const int row0 = u.pm * BM + wr * 64 + fr, col0 = nl * 128 + wc * 32 + 8 * fq;
#pragma unroll
        for (int ai = 0; ai < 2; ++ai)
#pragma unroll
            for (int m = 0; m < 4; ++m) { bf16_t* rowp = H + (size_t)(row0 + ai * HALF + m * 16) * 1408 + col0;
                float hv[8];
#pragma unroll
                for (int n = 0; n < 2; ++n)
#pragma unroll
                    for (int i = 0; i < 4; ++i) { const float g = acc[ai][0][m][n][i], up = acc[ai][1][m][n][i];
                        const float s = g * __builtin_amdgcn_rcpf(1.f + __builtin_amdgcn_exp2f(-1.4426950408889634f * g)); hv[n * 4 + i] = s * up; }
                u32x4 w; w.x = cvt_pk_bf16(hv[0], hv[1]); w.y = cvt_pk_bf16(hv[2], hv[3]); w.z = cvt_pk_bf16(hv[4], hv[5]); w.w = cvt_pk_bf16(hv[6], hv[7]);
                *(u32x4*)rowp = w; }
    }
};
struct EpiDown {
    static constexpr bool PERM = true, AFTER_DRAIN = false;
    bf16_t* Y; const float* gate;
    __device__ __forceinline__ void operator()(const f32x4 (&acc)[2][2][4][2], const Unit& u, int wr, int wc, int fr, int fq) const {
        const int e = u.pm / 9, nl = u.pn - e * 8;
        const int row0 = u.pm * BM + wr * 64 + fr, col0 = nl * BM + wc * 32 + 8 * fq;
#pragma unroll
        for (int ai = 0; ai < 2; ++ai)
#pragma unroll
            for (int m = 0; m < 4; ++m) { const int row = row0 + ai * HALF + m * 16; const float gt = gate[row]; bf16_t* rowp = Y + (size_t)row * 2048 + col0;
#pragma unroll
                for (int bj = 0; bj < 2; ++bj) { const f32x4 v0 = acc[ai][bj][m][0] * gt, v1 = acc[ai][bj][m][1] * gt;
                    u32x4 w; w.x = cvt_pk_bf16(v0[0], v0[1]); w.y = cvt_pk_bf16(v0[2], v0[3]); w.z = cvt_pk_bf16(v1[0], v1[1]); w.w = cvt_pk_bf16(v1[2], v1[3]);
                    *(u32x4*)(rowp + bj * HALF) = w; } }
    }
};
struct GroupedOrder {
    int tm, tn, total, G, c;
    __device__ void init(int tm_, int tn_, int G_, int c_) { tm = tm_; tn = tn_; total = NE_ * tm_ * tn_; G = G_; c = c_; }
    static constexpr int NE_ = 16;
    __device__ bool next(int i, Unit& u) const {
        int L = i * G + c; if (L >= total) return false;
        if ((total & 7) == 0) L = (L & 7) * (total >> 3) + (L >> 3);
        const int per = tm * tn, e = L / per, r = L - e * per, pml = r / tn, pnl = r - pml * tn;
        u.pm = e * 9 + pml; u.pn = e * tn + pnl; return true;
    }
    __device__ __forceinline__ void a_ready(const Unit&) const {}
    __device__ __forceinline__ void done(const Unit&) const {}
};
}
namespace att {
constexpr int NW = 8, QBLK = 32, KVBLK = 64;
constexpr int SHM_V = 16384, SHM_KN = 16384, SHM_KP = 8192;
constexpr int OFF_V = 0, OFF_KN = 32768, OFF_KP = 65536, OFF_WS = 81920, OFF_BIAS = 83968;
constexpr int ATT_LDS = OFF_BIAS + 4096;
constexpr float THR = 8.f;
#define KSWZ(row, colB) ((row) * 256 + ((colB) ^ (((row) & 15) << 4)))
#define KPSWZ(row, colB) ((row) * 128 + ((colB) ^ ((((row) >> 1) & 7) << 4)))
#define SBAR() __builtin_amdgcn_sched_barrier(0)
__device__ __forceinline__ int crow(int r, int hi) { return (r & 3) + 8 * (r >> 2) + 4 * hi; }
__device__ __forceinline__ unsigned cvtpk_v(float lo, float hi) { unsigned r; asm volatile("v_cvt_pk_bf16_f32 %0, %1, %2" : "=v"(r) : "v"(lo), "v"(hi)); return r; }

template <int DUMMY = 0>
__device__ __forceinline__ void partialSM(f32x16& p0, f32x16& p1, float& m_reg, float& mn, float& alpha, const float C, const float thr_raw) {
    float pmax = p0[0];
#pragma unroll
    for (int r = 1; r < 16; ++r) pmax = fmaxf(pmax, p0[r]);
#pragma unroll
    for (int r = 0; r < 16; ++r) pmax = fmaxf(pmax, p1[r]);
    { auto rr = __builtin_amdgcn_permlane32_swap(__float_as_uint(pmax), __float_as_uint(pmax), false, false);
      pmax = fmaxf(__uint_as_float(rr[0]), __uint_as_float(rr[1])); }
    if (__builtin_expect(__all(pmax - m_reg <= thr_raw), 1)) { mn = m_reg; alpha = 1.f; }
    else { mn = fmaxf(m_reg, pmax); alpha = __builtin_amdgcn_exp2f((m_reg - mn) * C); m_reg = mn; }
    const float mnC = -mn * C;
#pragma unroll
    for (int r = 0; r < 16; ++r) p0[r] = fmaf(p0[r], C, mnC);
#pragma unroll
    for (int r = 0; r < 16; ++r) p1[r] = fmaf(p1[r], C, mnC);
#pragma unroll
    for (int r = 0; r < 16; ++r) p0[r] = __builtin_amdgcn_exp2f(p0[r]);
}
__device__ __forceinline__ void sm_static(f32x16& p0, f32x16& p1, const float C, const float negm) {
#pragma unroll
    for (int r = 0; r < 16; ++r) p0[r] = fmaf(p0[r], C, negm);
#pragma unroll
    for (int r = 0; r < 16; ++r) p1[r] = fmaf(p1[r], C, negm);
#pragma unroll
    for (int r = 0; r < 16; ++r) p0[r] = __builtin_amdgcn_exp2f(p0[r]);
}
__device__ __forceinline__ void partialSM_na(f32x16& p0, f32x16& p1, float& m_reg, float& mn, float& alpha, const float C, int kr, int qrow, int rs, int lb, int lm, int lb2, const LAS float* btab) {
    const bool isctx = (kr == -1), rowok = (kr >= rs) && (kr < rs + 8);
    const int vm0 = isctx ? -1 : (rowok ? lm : 0), vm1 = isctx ? -1 : (rowok ? lb2 : 0);
    const LAS float* brow = (isctx || !rowok) ? (btab + 600) : (btab + (kr - qrow + 7) * 31 + lb);
    constexpr unsigned NEGB = 0xff61b1e6u;
#define NA_GRP(P, VM, R0, KOFF) do { _Pragma("unroll") for (int r = R0; r < R0 + 8; ++r) { const int kc0 = (r & 3) + 8 * (r >> 2); \
        const unsigned v_ = (unsigned)__builtin_amdgcn_sbfe(VM, kc0, 1);     \
        unsigned bm_; asm("v_bfi_b32 %0, %1, %2, %3" : "=v"(bm_) : "v"(v_), "v"(brow[kc0 + KOFF]), "v"(NEGB));       \
        P[r] = fmaf(P[r], C, __uint_as_float(bm_)); } SBAR(); } while (0)
    NA_GRP(p0, vm0, 0, 0); NA_GRP(p0, vm0, 8, 0); NA_GRP(p1, vm1, 0, 32); NA_GRP(p1, vm1, 8, 32);
#undef NA_GRP
    float pmax = p0[0];
#pragma unroll
    for (int r = 1; r < 16; ++r) pmax = fmaxf(pmax, p0[r]);
#pragma unroll
    for (int r = 0; r < 16; ++r) pmax = fmaxf(pmax, p1[r]);
    { auto rr = __builtin_amdgcn_permlane32_swap(__float_as_uint(pmax), __float_as_uint(pmax), false, false);
      pmax = fmaxf(__uint_as_float(rr[0]), __uint_as_float(rr[1])); }
    if (__builtin_expect(__all(pmax - m_reg <= THR * LOG2E), 1)) { mn = m_reg; alpha = 1.f; }
    else { mn = fmaxf(m_reg, pmax); alpha = __builtin_amdgcn_exp2f(m_reg - mn); m_reg = mn; }
    p0 = p0 - mn; p1 = p1 - mn;
#pragma unroll
    for (int r = 0; r < 16; ++r) p0[r] = __builtin_amdgcn_exp2f(p0[r]);
}
__device__ __forceinline__ void finishSM(f32x16& p0, f32x16& p1, float alpha, float& l_reg, bf16x8& pa0, bf16x8& pa1, bf16x8& pa2, bf16x8& pa3) {
#pragma unroll
    for (int r = 0; r < 16; ++r) p1[r] = __builtin_amdgcn_exp2f(p1[r]);
    f32x2 ps2 = {0.f, 0.f};
#pragma unroll
    for (int r = 0; r < 16; r += 2) { ps2 += (f32x2){p0[r], p0[r + 1]}; ps2 += (f32x2){p1[r], p1[r + 1]}; }
    float ps = ps2.x + ps2.y;
    { auto rr = __builtin_amdgcn_permlane32_swap(__float_as_uint(ps), __float_as_uint(ps), false, false);
      ps = __uint_as_float(rr[0]) + __uint_as_float(rr[1]); }
    l_reg = l_reg * alpha + ps;
#define PK4(P, BASE, OUT) do { unsigned a0 = cvtpk_v(P[BASE + 0], P[BASE + 1]), a1 = cvtpk_v(P[BASE + 2], P[BASE + 3]);   \
    unsigned b0 = cvtpk_v(P[BASE + 4], P[BASE + 5]), b1 = cvtpk_v(P[BASE + 6], P[BASE + 7]);                              \
    auto r0 = __builtin_amdgcn_permlane32_swap(a0, b0, false, false); auto r1 = __builtin_amdgcn_permlane32_swap(a1, b1, false, false); \
    u32x4 w = {r0[0], r1[0], r0[1], r1[1]}; OUT = __builtin_bit_cast(bf16x8, w); } while (0)
    PK4(p0, 0, pa0); PK4(p0, 8, pa1); PK4(p1, 0, pa2); PK4(p1, 8, pa3);
#undef PK4
}
#ifndef ATT_PRIO
#define ATT_PRIO 0
#endif
template <int NPE>
__device__ __forceinline__ void qkt(f32x16& p0, f32x16& p1, const LAS char* Kn, const LAS char* Kp, const bf16x8* qr, int r32, int hi) {
    p0 = f32x16{}; p1 = f32x16{};
#if ATT_PRIO
    __builtin_amdgcn_s_setprio(1);
#endif
#pragma unroll
    for (int d0 = 0; d0 < 8; ++d0) { const int cb = (d0 * 16 + hi * 8) * 2;
        const bf16x8 b0 = *(const LAS bf16x8*)(Kn + KSWZ(r32, cb));
        const bf16x8 b1 = *(const LAS bf16x8*)(Kn + KSWZ(32 + r32, cb));
        p0 = __builtin_amdgcn_mfma_f32_32x32x16_bf16(b0, qr[d0], p0, 0, 0, 0);
        p1 = __builtin_amdgcn_mfma_f32_32x32x16_bf16(b1, qr[d0], p1, 0, 0, 0); }
#pragma unroll
    for (int d0 = 0; d0 < NPE; ++d0) { const int cb = (d0 * 16 + hi * 8) * 2;
        const bf16x8 b0 = *(const LAS bf16x8*)(Kp + KPSWZ(r32, cb));
        const bf16x8 b1 = *(const LAS bf16x8*)(Kp + KPSWZ(32 + r32, cb));
        p0 = __builtin_amdgcn_mfma_f32_32x32x16_bf16(b0, qr[8 + d0], p0, 0, 0, 0);
        p1 = __builtin_amdgcn_mfma_f32_32x32x16_bf16(b1, qr[8 + d0], p1, 0, 0, 0); }
#if ATT_PRIO
    __builtin_amdgcn_s_setprio(0);
#endif
}
__device__ __forceinline__ int v_st(int k, int c) { const int kk = (k & ~0xC) | ((k & 4) << 1) | ((k & 8) >> 1); return ((kk >> 3) * 4 + (c >> 5)) * 512 + ((kk & 7) * 32 + (c & 31)) * 2; }
__device__ __forceinline__ int v_rd_base(int lane) { return ((lane & 3) << 3) | (((lane >> 2) & 3) << 6) | (((lane >> 4) & 1) << 5) | (((lane >> 5) & 1) << 8); }
constexpr int v_rd_off(int d0, int ks, int half) { return d0 * 512 + ks * 4096 + half * 2048; }
typedef short v4i16_t __attribute__((ext_vector_type(4)));
#ifndef PV_ASM
#define PV_ASM 0
#endif
#if PV_ASM
template <int OFF> __device__ __forceinline__ s16x4 tr_read(int vb) {
    s16x4 r; asm volatile("ds_read_b64_tr_b16 %0, %1 offset:%2" : "=&v"(r) : "v"(vb), "i"(OFF) : "memory"); return r;
}
#else
template <int OFF> __device__ __forceinline__ s16x4 tr_read(int vb) {
    return __builtin_bit_cast(s16x4, __builtin_amdgcn_ds_read_tr16_b64_v4i16((LAS v4i16_t*)(unsigned)(vb + OFF)));
}
#endif
template <int D0> __device__ __forceinline__ void pv_one(f32x16& od, int vb, bf16x8 pa0, bf16x8 pa1, bf16x8 pa2, bf16x8 pa3) {
    const s16x4 l0 = tr_read<v_rd_off(D0, 0, 0)>(vb), h0 = tr_read<v_rd_off(D0, 0, 1)>(vb), l1 = tr_read<v_rd_off(D0, 1, 0)>(vb), h1 = tr_read<v_rd_off(D0, 1, 1)>(vb);
    const s16x4 l2 = tr_read<v_rd_off(D0, 2, 0)>(vb), h2 = tr_read<v_rd_off(D0, 2, 1)>(vb), l3 = tr_read<v_rd_off(D0, 3, 0)>(vb), h3 = tr_read<v_rd_off(D0, 3, 1)>(vb);
#if PV_ASM
    asm volatile("s_waitcnt lgkmcnt(0)" ::: "memory"); SBAR();
#endif
#define PK(L, H) (bf16x8){L[0], L[1], L[2], L[3], H[0], H[1], H[2], H[3]}
#if ATT_PRIO
    __builtin_amdgcn_s_setprio(1);
#endif
    od = __builtin_amdgcn_mfma_f32_32x32x16_bf16(pa0, PK(l0, h0), od, 0, 0, 0);
    od = __builtin_amdgcn_mfma_f32_32x32x16_bf16(pa1, PK(l1, h1), od, 0, 0, 0);
    od = __builtin_amdgcn_mfma_f32_32x32x16_bf16(pa2, PK(l2, h2), od, 0, 0, 0);
    od = __builtin_amdgcn_mfma_f32_32x32x16_bf16(pa3, PK(l3, h3), od, 0, 0, 0);
#if ATT_PRIO
    __builtin_amdgcn_s_setprio(0);
#endif
#undef PK
}
__device__ __forceinline__ void pv_d0(f32x16* o, int vb, bf16x8 pa0, bf16x8 pa1, bf16x8 pa2, bf16x8 pa3) {
    pv_one<0>(o[0], vb, pa0, pa1, pa2, pa3); pv_one<1>(o[1], vb, pa0, pa1, pa2, pa3); pv_one<2>(o[2], vb, pa0, pa1, pa2, pa3); pv_one<3>(o[3], vb, pa0, pa1, pa2, pa3);
}

#define RESC(a) do { if (__any((a) < 1.f)) { if (hi == 0) al_l[r32] = (a); asm volatile("s_waitcnt lgkmcnt(0)" ::: "memory"); \
    _Pragma("unroll") for (int d = 0; d < 4; ++d) _Pragma("unroll") for (int r = 0; r < 16; ++r) o[d][r] *= al_l[crow(r, hi)]; } } while (0)

typedef int v8i __attribute__((ext_vector_type(8)));
constexpr int KPITCH = 208, VPITCH = 80, MSLOT = 23552, M_KN = 0, M_VT = 13312, M_WS = 122880;
static_assert(64 * KPITCH == M_VT && M_VT + 128 * VPITCH == MSLOT && 5 * MSLOT <= M_WS, "MLA slot layout");
__device__ __forceinline__ void glds16(const void* gsrc, unsigned lds_dst) { unsigned keep;
    asm volatile("s_mov_b32 %0, m0\n\ts_mov_b32 m0, %2\n\ts_nop 0\n\tglobal_load_lds_dwordx4 %1, off\n\ts_mov_b32 m0, %0" : "=&s"(keep) : "v"(gsrc), "s"(lds_dst) : "memory"); }
__device__ __forceinline__ void glds16s(const void* sbase, unsigned voff, unsigned lds_dst) { unsigned keep;
    asm volatile("s_mov_b32 %0, m0\n\ts_mov_b32 m0, %3\n\ts_nop 0\n\tglobal_load_lds_dwordx4 %1, %2\n\ts_mov_b32 m0, %0" : "=&s"(keep) : "v"(voff), "s"(sbase), "s"(lds_dst) : "memory"); }
#define WAIT_BAR0() asm volatile("s_waitcnt vmcnt(0) lgkmcnt(0)\n\ts_barrier" ::: "memory")
__device__ __forceinline__ void qkt8(f32x16& p0, f32x16& p1, const f32x16& bias, const LAS char* Kl, const v8i* q8) {
#pragma unroll
    for (int ks = 0; ks < 3; ++ks) {
        const u32x4 a0 = *(const LAS u32x4*)(Kl + 64 * ks), a1 = *(const LAS u32x4*)(Kl + 64 * ks + 16);
        const u32x4 b0 = *(const LAS u32x4*)(Kl + 32 * KPITCH + 64 * ks), b1 = *(const LAS u32x4*)(Kl + 32 * KPITCH + 64 * ks + 16);
        const v8i ka = {(int)a0.x, (int)a0.y, (int)a0.z, (int)a0.w, (int)a1.x, (int)a1.y, (int)a1.z, (int)a1.w};
        const v8i kb = {(int)b0.x, (int)b0.y, (int)b0.z, (int)b0.w, (int)b1.x, (int)b1.y, (int)b1.z, (int)b1.w};
        p0 = __builtin_amdgcn_mfma_scale_f32_32x32x64_f8f6f4(ka, q8[ks], ks ? p0 : bias, 0, 0, 0, 0, 0, 0);
        p1 = __builtin_amdgcn_mfma_scale_f32_32x32x64_f8f6f4(kb, q8[ks], ks ? p1 : bias, 0, 0, 0, 0, 0, 0); }
}
__device__ __forceinline__ float vmax2(float a, float b) { float d; asm("v_max_f32 %0, %1, %2" : "=v"(d) : "v"(a), "v"(b)); return d; }
template <bool FIRST>
__device__ __forceinline__ void sm8_a(f32x16& p0, f32x16& p1, f32x16& bias, f32x16* o, LAS float* al_l, int r32, int hi) {
    float xm = __builtin_fmaxf(__builtin_fmaxf(p0[0], p0[1]), p1[0]), xn = __builtin_fmaxf(__builtin_fmaxf(p0[2], p0[3]), p1[1]);
    xm = __builtin_fmaxf(__builtin_fmaxf(xm, p1[2]), p1[3]);
#pragma unroll
    for (int r = 4; r < 16; r += 4) { xm = __builtin_fmaxf(__builtin_fmaxf(xm, p0[r]), p0[r + 1]); xn = __builtin_fmaxf(__builtin_fmaxf(xn, p0[r + 2]), p0[r + 3]);
        xm = __builtin_fmaxf(__builtin_fmaxf(xm, p1[r]), p1[r + 1]); xn = __builtin_fmaxf(__builtin_fmaxf(xn, p1[r + 2]), p1[r + 3]); }
    xm = __builtin_fmaxf(xm, xn);
    { auto rr = __builtin_amdgcn_permlane32_swap(__float_as_uint(xm), __float_as_uint(xm), false, false);
      xm = vmax2(__uint_as_float(rr[0]), __uint_as_float(rr[1])); }
    if (FIRST || !__builtin_expect(__all(xm <= 8.5f), 1)) {
        const float dl = FIRST ? xm - 7.f : fmaxf(xm - 7.f, 0.f);
#pragma unroll
        for (int r = 0; r < 16; ++r) { bias[r] -= dl; p0[r] -= dl; p1[r] -= dl; }
        if (!FIRST) {
            if (hi == 0) al_l[r32] = __builtin_amdgcn_exp2f(-dl);
            asm volatile("s_waitcnt lgkmcnt(0)" ::: "memory");
#pragma unroll
            for (int d = 0; d < 5; ++d)
#pragma unroll
                for (int r = 0; r < 16; ++r) o[d][r] *= al_l[crow(r, hi)];
        }
    }
    asm volatile("" : "+v"(bias));
}
__device__ __forceinline__ void sm8_b(f32x16& p0, f32x16& p1, v8i& pa) {
#pragma unroll
    for (int r = 0; r < 16; ++r) p0[r] = __builtin_amdgcn_exp2f(p0[r]);
#pragma unroll
    for (int r = 0; r < 16; ++r) p1[r] = __builtin_amdgcn_exp2f(p1[r]);
#pragma unroll
    for (int w = 0; w < 4; ++w) { int x = pa[w]; x = __builtin_amdgcn_cvt_pk_fp8_f32(p0[4 * w], p0[4 * w + 1], x, false); x = __builtin_amdgcn_cvt_pk_fp8_f32(p0[4 * w + 2], p0[4 * w + 3], x, true); pa[w] = x; }
#pragma unroll
    for (int w = 0; w < 4; ++w) { int x = pa[4 + w]; x = __builtin_amdgcn_cvt_pk_fp8_f32(p1[4 * w], p1[4 * w + 1], x, false); x = __builtin_amdgcn_cvt_pk_fp8_f32(p1[4 * w + 2], p1[4 * w + 3], x, true); pa[4 + w] = x; }
}
__device__ __forceinline__ void pv8(f32x16* o, const LAS char* Vl, const v8i pa, const v8i ones) {
#pragma unroll
    for (int d0 = 0; d0 < 4; ++d0) { const LAS char* row = Vl + 32 * d0 * VPITCH;
        const u32x4 b0 = *(const LAS u32x4*)(row), b1 = *(const LAS u32x4*)(row + 16);
        const v8i vb = {(int)b0.x, (int)b0.y, (int)b0.z, (int)b0.w, (int)b1.x, (int)b1.y, (int)b1.z, (int)b1.w};
        o[d0] = __builtin_amdgcn_mfma_scale_f32_32x32x64_f8f6f4(pa, vb, o[d0], 0, 0, 0, 0, 0, 0); }
    o[4] = __builtin_amdgcn_mfma_scale_f32_32x32x64_f8f6f4(pa, ones, o[4], 0, 0, 0, 0, 0, 0);
}
#ifndef MLA_ALPHA
#define MLA_ALPHA 1.0f
#endif
__device__ __forceinline__ void mla_unit(const unsigned char* __restrict__ Q8, const unsigned char* __restrict__ K8, const unsigned char* __restrict__ Vt, bf16* __restrict__ Ob, int seq, LAS char* lds,
                                         const float* __restrict__ qgain, const float* __restrict__ rtab, const float* __restrict__ ps, int tok0, bool lat) {
    const int tid = ltid(), lane = tid & 63, r32 = lane & 31, hi = lane >> 5; const int wid = __builtin_amdgcn_readfirstlane(tid >> 6);
    LAS float* wsx = (LAS float*)(lds + M_WS) + wid * 64; LAS float* al_l = wsx + 32;
    unsigned d_off[3]; bool d_isk[3]; unsigned d_dst[3];
#pragma unroll
    for (int i = 0; i < 3; ++i) { int P = 3 * wid + i; if (P > 22) P = 22; d_isk[i] = P < 13; d_dst[i] = P * 1024;
        if (P < 13) { const int g = 64 * P + lane, row = g / 13, ch = g - 13 * row; d_off[i] = row * 8192 + (ch < 12 ? ch : 0) * 16; }
        else { const int g = 64 * (P - 13) + lane, d = g / 5, ch = g - 5 * d; d_off[i] = d * 64 + (ch < 4 ? ch : 0) * 16; } }
#define DMA_TILE(t, slot) do { const unsigned sb_ = (unsigned)((slot) * MSLOT); const unsigned char* kb_ = K8 + (size_t)(t) * 64 * 8192; const unsigned char* vb_ = Vt + (size_t)(t) * 8192; \
    glds16s(d_isk[0] ? kb_ : vb_, d_off[0], sb_ + d_dst[0]); glds16s(d_isk[1] ? kb_ : vb_, d_off[1], sb_ + d_dst[1]); glds16s(d_isk[2] ? kb_ : vb_, d_off[2], sb_ + d_dst[2]); } while (0)
    const int klane = r32 * KPITCH + hi * 32, vlane = M_VT + r32 * VPITCH + hi * 32;
    DMA_TILE(0, 0); DMA_TILE(1, 1);
    f32x16 o[5] = {}; v8i q8[3];
    { const unsigned char* Qw = Q8 + (size_t)(wid * QBLK + r32) * 6144 + hi * 64;
      float f[3][32];
#pragma unroll
      for (int ks = 0; ks < 3; ++ks)
#pragma unroll
          for (int c = 0; c < 4; ++c) { const u32x4 x = *(const u32x4*)(Qw + 128 * ks + 16 * c);
              f[ks][8 * c + 0] = bflo(x.x); f[ks][8 * c + 1] = bfhi(x.x); f[ks][8 * c + 2] = bflo(x.y); f[ks][8 * c + 3] = bfhi(x.y);
              f[ks][8 * c + 4] = bflo(x.z); f[ks][8 * c + 5] = bfhi(x.z); f[ks][8 * c + 6] = bflo(x.w); f[ks][8 * c + 7] = bfhi(x.w); }
      float ss = 0.f;
#pragma unroll
      for (int ks = 0; ks < 3; ++ks)
#pragma unroll
          for (int i = 0; i < 32; ++i) ss += f[ks][i] * f[ks][i];
      { auto rr = __builtin_amdgcn_permlane32_swap(__float_as_uint(ss), __float_as_uint(ss), false, false); ss = __uint_as_float(rr[0]) + __uint_as_float(rr[1]); }
      const float* psr = ps + (size_t)(tok0 + wid * QBLK + r32) * 20; const f32x4 s0 = *(const f32x4*)psr, s1 = *(const f32x4*)(psr + 4);
      const float rq = __builtin_amdgcn_rsqf((((s0[0] + s0[1]) + (s0[2] + s0[3])) + ((s1[0] + s1[1]) + (s1[2] + s1[3]))) * (1.f / 512.f) + EPS);
      const float rs = __builtin_amdgcn_rsqf(ss * (rq * rq) * (1.f / 192.f) + EPS) * rq * 0.32267250623034593f;
#pragma unroll
      for (int ks = 0; ks < 3; ++ks)
#pragma unroll
          for (int c = 0; c < 8; ++c) { const f32x4 g = *(const f32x4*)(qgain + 64 * ks + 32 * hi + 4 * c);
              f[ks][4 * c] *= rs * g.x; f[ks][4 * c + 1] *= rs * g.y; f[ks][4 * c + 2] *= rs * g.z; f[ks][4 * c + 3] *= rs * g.w; }
      if (lat) { const int t = tok0 + wid * QBLK + r32, pos = hi ? (t & 63) : ((t >> 6) & 255);
#pragma unroll
          for (int c = 0; c < 4; ++c) { const f32x4 cs = *(const f32x4*)(rtab + pos * 16 + 4 * c), sn = *(const f32x4*)(rtab + 4096 + pos * 16 + 4 * c);
#pragma unroll
              for (int i = 0; i < 4; ++i) { const float x1 = f[2][4 * c + i], x2 = f[2][16 + 4 * c + i]; f[2][4 * c + i] = x1 * cs[i] - x2 * sn[i]; f[2][16 + 4 * c + i] = x2 * cs[i] + x1 * sn[i]; } } }
#pragma unroll
      for (int ks = 0; ks < 3; ++ks)
#pragma unroll
          for (int w = 0; w < 8; ++w) { int x = 0; x = __builtin_amdgcn_cvt_pk_fp8_f32(f[ks][4 * w], f[ks][4 * w + 1], x, false); x = __builtin_amdgcn_cvt_pk_fp8_f32(f[ks][4 * w + 2], f[ks][4 * w + 3], x, true); q8[ks][w] = x; } }
    f32x16 pA0, pA1, pB0, pB1, bias = {}; v8i pa = {}; const int NT = seq / KVBLK;
    v8i ones = {0x38383838, 0x38383838, 0x38383838, 0x38383838, 0x38383838, 0x38383838, 0x38383838, 0x38383838};
    asm volatile("" : "+v"(ones));
    int sl = 0;
#define SLOT(k) ((sl + (k)) >= 5 ? (sl + (k)) - 5 : (sl + (k)))
#define KS_(k) (lds + SLOT(k) * MSLOT + klane)
#define VS_(k) (lds + SLOT(k) * MSLOT + vlane)
    if (2 < NT) DMA_TILE(2, 2);
    WAIT_BAR0();
    qkt8(pA0, pA1, bias, lds + klane, q8); sm8_a<true>(pA0, pA1, bias, o, al_l, r32, hi);
#define DSTEP(DMA_STMTS) do { \
        qkt8(pB0, pB1, bias, KS_(1), q8); \
        DMA_STMTS                                                  \
        sm8_b(pA0, pA1, pa); \
        pv8(o, VS_(0), pa, ones); sm8_a<false>(pB0, pB1, bias, o, al_l, r32, hi); \
        qkt8(pA0, pA1, bias, KS_(2), q8); sm8_b(pB0, pB1, pa); \
        pv8(o, VS_(1), pa, ones); sm8_a<false>(pA0, pA1, bias, o, al_l, r32, hi); \
        SBAR(); WAIT_BAR0(); \
        sl = SLOT(2); } while (0)
    int j = 1;
    for (; j + 3 < NT; j += 2) DSTEP(DMA_TILE(j + 2, SLOT(3)); DMA_TILE(j + 3, SLOT(4)););
    DSTEP(DMA_TILE(j + 2, SLOT(3)););
#undef DSTEP
    qkt8(pB0, pB1, bias, KS_(1), q8); sm8_b(pA0, pA1, pa);
    pv8(o, VS_(0), pa, ones); sm8_a<false>(pB0, pB1, bias, o, al_l, r32, hi);
    sm8_b(pB0, pB1, pa);
    pv8(o, VS_(1), pa, ones);
#undef SLOT
#undef KS_
#undef VS_
    float rli[16];
#pragma unroll
    for (int r = 0; r < 16; ++r) rli[r] = __builtin_amdgcn_rcpf(o[4][r]);
    bf16* Ow = Ob + (size_t)(wid * QBLK) * 2048;
#pragma unroll
    for (int r = 0; r < 16; ++r) { const int orow = crow(r, hi);
#pragma unroll
        for (int d0 = 0; d0 < 4; ++d0) Ow[(size_t)orow * 2048 + d0 * 32 + r32] = (bf16)(cvtpk_v(o[d0][r] * rli[r] * MLA_ALPHA, 0.f) & 0xffffu); }
    WAIT_BAR0();
#undef DMA_TILE
#undef ROT
}

constexpr int NSLOT_B = 32768, N_V = 0, N_K = 16384, N_BIAS = 124928;
__device__ __forceinline__ void na_unit(const bf16* __restrict__ QKV, int h, int rb, const float* __restrict__ rpb_h, bf16* __restrict__ Ob, LAS char* lds) {
    const int tid = ltid(), lane = tid & 63, r32 = lane & 31, hi = lane >> 5; const int wid = __builtin_amdgcn_readfirstlane(tid >> 6);
    LAS float* wsx = (LAS float*)(lds + M_WS) + wid * 64; LAS float* li_l = wsx; LAS float* al_l = wsx + 32;
    LAS float* btab = (LAS float*)(lds + N_BIAS) + 128;
    constexpr float C = 0.08838834764831845f * LOG2E;
    for (int i = tid; i < 15 * 31; i += 512) btab[i] = rpb_h[i] * LOG2E;
    if (tid < 64) btab[600 + tid] = 0.f;
    const int qrow = rb * 4 + (wid >> 1), qcol = (wid & 1) * 32 + r32;
    const int rs = min(max(qrow - 4, 0), 248), cs = min(max(qcol - 8, 0), 48);
    const int lb = 15 - qcol + 4 * hi;
    const unsigned long long wmask = 0xFFFFull << cs;
    const int lm = (int)(unsigned)(wmask >> (4 * hi)), lb2 = (int)(unsigned)(wmask >> (32 + 4 * hi));
    const int lo = min(max(rb * 4 - 4, 0), 248), hr = min(max(rb * 4 + 3 - 4, 0), 248) + 7, cnt = hr - lo + 1;
    const int NT = (4 + cnt + 1) & ~1;
#define TKEY0(t) ((t) < 4 ? NL + 64 * (t) : 64 * min(lo + (t) - 4, hr))
#define TKR(t) ((t) < 4 ? -1 : ((t) - 4 < cnt ? lo + (t) - 4 : -1000))
    const bf16* Kh = QKV + 2048 + h * 128; const bf16* Vh = QKV + 4096 + h * 128;
    int k_off[2], v_off[2];
#pragma unroll
    for (int i = 0; i < 2; ++i) { const int p = 2 * wid + i;
        { const int row = 4 * p + (lane >> 4), lch = (lane & 15) ^ (row & 15); k_off[i] = row * 6144 + lch * 8; }
        { const int s = 2 * p + (lane >> 5), kk = (s >> 2) * 8 + ((lane & 31) >> 2), key = (kk & ~0xC) | ((kk & 4) << 1) | ((kk & 8) >> 1), col = (s & 3) * 32 + (lane & 3) * 8; v_off[i] = key * 6144 + col; } }
#define DMA_TILE(t, slot) do { const size_t kb_ = (size_t)TKEY0(t) * 6144; const unsigned sb_ = (unsigned)((slot) * NSLOT_B); \
    glds16(Vh + kb_ + v_off[0], sb_ + N_V + (2 * wid) * 1024); glds16(Vh + kb_ + v_off[1], sb_ + N_V + (2 * wid + 1) * 1024); \
    glds16(Kh + kb_ + k_off[0], sb_ + N_K + (2 * wid) * 1024); glds16(Kh + kb_ + k_off[1], sb_ + N_K + (2 * wid + 1) * 1024); } while (0)
    DMA_TILE(0, 0); DMA_TILE(1, 1);
    float m_reg = -1e30f, l_reg = 0; f32x16 o[4] = {}; bf16x8 qr[8];
    const bf16* Qw = QKV + (size_t)(rb * 256 + wid * QBLK + r32) * 6144 + h * 128 + hi * 8;
#pragma unroll
    for (int d0 = 0; d0 < 8; ++d0) qr[d0] = *(const bf16x8*)(Qw + d0 * 16);
    const int vbl = N_V + v_rd_base(lane);
    f32x16 pA0, pA1, pB0, pB1; float mnA, mnB, alA, alB; bf16x8 pa0, pa1, pa2, pa3;
    int s_prev = 0, s_cur = 1, s_next = 2;
#define ROT() do { const int t_ = s_prev; s_prev = s_cur; s_cur = s_next; s_next = t_; } while (0)
    WAIT_BAR0();
    qkt<0>(pA0, pA1, lds + N_K, lds, qr, r32, hi); partialSM_na(pA0, pA1, m_reg, mnA, alA, C, TKR(0), qrow, rs, lb, lm, lb2, btab);
    for (int j = 1; j + 1 < NT; j += 2) {
        DMA_TILE(j + 1, s_next);
        SBAR(); qkt<0>(pB0, pB1, lds + s_cur * NSLOT_B + N_K, lds, qr, r32, hi);
        finishSM(pA0, pA1, alA, l_reg, pa0, pa1, pa2, pa3); SBAR();
        pv_d0(o, vbl + s_prev * NSLOT_B, pa0, pa1, pa2, pa3); partialSM_na(pB0, pB1, m_reg, mnB, alB, C, TKR(j), qrow, rs, lb, lm, lb2, btab);
        RESC(alB);
        WAIT_BAR0(); ROT();
        DMA_TILE(j + 2, s_next);
        SBAR(); qkt<0>(pA0, pA1, lds + s_cur * NSLOT_B + N_K, lds, qr, r32, hi);
        finishSM(pB0, pB1, alB, l_reg, pa0, pa1, pa2, pa3); SBAR();
        pv_d0(o, vbl + s_prev * NSLOT_B, pa0, pa1, pa2, pa3); partialSM_na(pA0, pA1, m_reg, mnA, alA, C, TKR(j + 1), qrow, rs, lb, lm, lb2, btab);
        RESC(alA);
        WAIT_BAR0(); ROT();
    }
    SBAR(); qkt<0>(pB0, pB1, lds + s_cur * NSLOT_B + N_K, lds, qr, r32, hi);
    finishSM(pA0, pA1, alA, l_reg, pa0, pa1, pa2, pa3); SBAR();
    pv_d0(o, vbl + s_prev * NSLOT_B, pa0, pa1, pa2, pa3); partialSM_na(pB0, pB1, m_reg, mnB, alB, C, TKR(NT - 1), qrow, rs, lb, lm, lb2, btab);
    RESC(alB);
    finishSM(pB0, pB1, alB, l_reg, pa0, pa1, pa2, pa3); SBAR();
    pv_d0(o, vbl + s_cur * NSLOT_B, pa0, pa1, pa2, pa3);
    if (hi == 0) li_l[r32] = l_reg; asm volatile("s_waitcnt lgkmcnt(0)" ::: "memory");
    float rli[16];
#pragma unroll
    for (int r = 0; r < 16; ++r) rli[r] = __builtin_amdgcn_rcpf(li_l[crow(r, hi)]);
    bf16* Ow = Ob + (size_t)(rb * 256 + wid * QBLK) * 2048 + h * 128;
#pragma unroll
    for (int r = 0; r < 16; ++r) { const int orow = crow(r, hi);
#pragma unroll
        for (int d0 = 0; d0 < 4; ++d0) Ow[(size_t)orow * 2048 + d0 * 32 + r32] = (bf16)(cvtpk_v(o[d0][r] * rli[r], 0.f) & 0xffffu); }
    WAIT_BAR0();
#undef DMA_TILE
#undef ROT
#undef TKEY0
#undef TKR
}
#undef RESC
}
namespace thin {
__device__ __constant__ float ROPE_INV[16] = {1.0f, 0.5623413251903491f, 0.31622776601683794f, 0.1778279410038923f, 0.1f, 0.05623413251903491f, 0.03162277660168379f, 0.01778279410038923f,
                                              0.01f, 0.005623413251903491f, 0.0031622776601683794f, 0.001778279410038923f, 0.001f, 0.0005623413251903491f, 0.00031622776601683794f, 0.0001778279410038923f};

__device__ __forceinline__ void tr_tile(const float* __restrict__ src, int ld_src, bf16* __restrict__ dst, int ld_dst, LAS float* T, const float* __restrict__ kgain = nullptr) {
    const int tid = ltid(), kr = tid >> 4, c4 = tid & 15;
    f32x4 v[4];
#pragma unroll
    for (int i = 0; i < 4; ++i) v[i] = *(const f32x4*)(src + (size_t)(kr + 32 * i) * ld_src + c4 * 4);
    if (kgain) {
#pragma unroll
        for (int i = 0; i < 4; ++i) v[i] = v[i] * kgain[kr + 32 * i]; }
    __syncthreads();
#pragma unroll
    for (int i = 0; i < 4; ++i) {
#pragma unroll
        for (int j = 0; j < 4; ++j) T[(c4 * 4 + j) * 129 + kr + 32 * i] = v[i][j]; }
    __syncthreads();
    const int n = tid >> 3, kc = (tid & 7) * 16; const LAS float* s = T + n * 129 + kc;
    u32x4 w0, w1;
    w0.x = cvtpk(s[0], s[1]); w0.y = cvtpk(s[2], s[3]); w0.z = cvtpk(s[4], s[5]); w0.w = cvtpk(s[6], s[7]);
    w1.x = cvtpk(s[8], s[9]); w1.y = cvtpk(s[10], s[11]); w1.z = cvtpk(s[12], s[13]); w1.w = cvtpk(s[14], s[15]);
    bf16* d = dst + (size_t)n * ld_dst + kc;
    *(u32x4*)d = w0; *(u32x4*)(d + 8) = w1;
}
__device__ __forceinline__ void tr_job(const float* src, int K, int N, bf16* dst, int t, LAS float* T, const float* kgain = nullptr) {
    const int nkt = K / 128, nt = t / nkt, kt = t - nt * nkt;
    tr_tile(src + (size_t)(kt * 128) * N + nt * 64, N, dst + (size_t)(nt * 64) * K + kt * 128, K, T, kgain ? kgain + kt * 128 : nullptr);
}

struct In {
    const float *x, *c, *ctx, *c_ctx, *ada_w, *ada_b, *norm_mix, *norm_ffn, *mla_w_in, *mla_q_a_gain, *mla_kv_a_gain, *mla_w_qb, *mla_w_kvb, *mla_q_gain, *mla_k_gain, *mla_w_o,
                *na_w_qkv, *na_q_gain, *na_k_gain, *na_rpb, *na_w_o, *router_w, *moe_w_gate, *moe_w_up, *moe_w_down;
};

constexpr int TL_GU = 16 * 2 * 352, TL_D = 16 * 352, TL_QKV = 96 * 16, TL_WO1 = 32 * 16;
constexpr int TL_E0 = TL_GU, TL_E1 = TL_E0 + TL_D, TL_E2 = TL_E1 + TL_QKV, TL_E3 = TL_E2 + TL_WO1, TL_E4 = TL_E3 + TL_GU, TL_ALL = TL_E4 + TL_D;
constexpr int LIM_MOE0 = TL_E1, LIM_NA = TL_E3, LIM_GU1 = TL_E4, LIM_ALL = TL_ALL;
__device__ __forceinline__ void late_tile(const In& in, unsigned char* ws, int t, LAS float* T) {
    int l = 0;
    if (t >= TL_E3) { t -= TL_E3; l = 1; }
    else if (t >= TL_E1) { t -= TL_E1;
        if (t < TL_QKV) tr_job(in.na_w_qkv, 2048, 6144, (bf16*)(ws + WS_WQKV_T), t, T);
        else tr_job(in.na_w_o, 2048, 2048, (bf16*)(ws + WS_WO1_T), t - TL_QKV, T);
        return; }
    if (t < TL_GU) {
        const int e = t / 704, r = t - e * 704, which = r / 352, tt = r - which * 352, nt = tt >> 4, kt = tt & 15, le = l * 16 + e;
        const float* src = (which ? in.moe_w_up : in.moe_w_gate) + (size_t)le * 2048 * FF;
        const int n0 = nt * 64, drow = (n0 >> 7) * 256 + which * 128 + (n0 & 127);
        bf16* dst = (bf16*)(ws + WS_WGU_T) + (size_t)le * 2816 * 2048;
        tr_tile(src + (size_t)(kt * 128) * FF + n0, FF, dst + (size_t)drow * 2048 + kt * 128, 2048, T);
    } else {
        t -= TL_GU; const int e = t / 352, tt = t - e * 352, le = l * 16 + e;
        tr_job(in.moe_w_down + (size_t)le * FF * 2048, FF, 2048, (bf16*)(ws + WS_WD_T) + (size_t)le * 2048 * FF, tt, T); }
}
__device__ __forceinline__ void late_work(const In& in, unsigned char* ws, LAS unsigned char* lds, int G, int phase, int limit) {
    const int tid = ltid();
    LAS float* T = (LAS float*)lds; LAS int* sh = (LAS int*)(lds + 40960);
    unsigned* work = (unsigned*)(ws + WS_CTL) + CW_WORK; unsigned* done = (unsigned*)(ws + WS_CTL) + CW_DONE + 64 * (phase < 0 ? 0 : phase);
    __syncthreads();
    if (phase >= 0 && tid == 0) __hip_atomic_fetch_add(done, 1u, __ATOMIC_RELAXED, __HIP_MEMORY_SCOPE_AGENT);
    for (;;) {
        if (tid == 0) { int t = -1;
            bool go = true;
            if (phase >= 0) go = __hip_atomic_load(done, __ATOMIC_RELAXED, __HIP_MEMORY_SCOPE_AGENT) < (unsigned)G;
            if (go) t = (int)__hip_atomic_fetch_add(work, 1u, __ATOMIC_RELAXED, __HIP_MEMORY_SCOPE_AGENT);
            sh[0] = t; }
        __syncthreads();
        const int t = sh[0];
        if (t < 0 || t >= TL_ALL) break;
        late_tile(in, ws, t, T);
        __syncthreads();
        if (phase < 0 && t >= limit) break;
    }
    __syncthreads();
}

__device__ __forceinline__ void phase_prologue(const In& in, unsigned char* ws, LAS unsigned char* lds, int G, int bid) {
    const int tid = ltid();
    {
        LAS float* sl = (LAS float*)lds; LAS float* sc_ = sl + 2048; LAS float* red = sc_ + 2048;
        for (int i = tid; i < 2048; i += 512) { const float a = in.c[i], b = in.c_ctx[i]; sl[i] = a / (1.f + __expf(-a)); sc_[i] = b / (1.f + __expf(-b)); }
        __syncthreads();
        float* mod = (float*)(ws + WS_MOD);
        for (int item = bid; item < 256; item += G) {
            const int cg = item * 96, l = cg / 12288, n0 = cg - l * 12288;
            if (tid < 384) {
                const int rl = tid / 24, c4 = tid - rl * 24;
                const float* wp = in.ada_w + ((size_t)l * 2048 + rl) * 12288 + n0 + c4 * 4;
                f32x4 al = {0.f, 0.f, 0.f, 0.f}, ac = {0.f, 0.f, 0.f, 0.f};
#pragma unroll 8
                for (int i = 0; i < 128; ++i) { const f32x4 w = *(const f32x4*)(wp + (size_t)(16 * i) * 12288); const float a = sl[rl + 16 * i], b = sc_[rl + 16 * i]; al += w * a; ac += w * b; }
                *(LAS f32x4*)(red + rl * 96 + c4 * 4) = al; *(LAS f32x4*)(red + 1536 + rl * 96 + c4 * 4) = ac;
            }
            __syncthreads();
            if (tid < 192) { const int v = tid / 96, j = tid - v * 96; float s = in.ada_b[l * 12288 + n0 + j];
#pragma unroll
                for (int k = 0; k < 16; ++k) s += red[v * 1536 + k * 96 + j];
                mod[(size_t)(l * 2 + v) * 12288 + n0 + j] = s; }
            __syncthreads();
        }
    }
    if (bid == 0) { float* gt = (float*)(ws + WS_MODP);
        for (int i = tid; i < 4096; i += 512) { const int pos = i >> 4, j = i & 15; float s, c; sincosf((float)pos * ROPE_INV[j], &s, &c); gt[i] = c; gt[4096 + i] = s; } }
    LAS float* T = (LAS float*)lds;
    constexpr int T_WIN = 17 * 16, T_QB = 48 * 4, T_KVB = 64 * 4, T_WO = 32 * 16;
    constexpr int T_ALL = T_WIN + T_QB + T_KVB + T_WO;
    bf16* win_t = (bf16*)(ws + WS_WIN_T);
    for (size_t i = (size_t)bid * 512 + tid; i < (size_t)(WIN_NP - WIN_N) * 2048 / 8; i += (size_t)G * 512) ((u32x4*)(win_t + (size_t)WIN_N * 2048))[i] = (u32x4){0u, 0u, 0u, 0u};
    for (int t0 = bid; t0 < T_ALL; t0 += G) {
        int t = t0;
        if (t < T_WIN) { tr_job(in.mla_w_in, 2048, WIN_N, win_t, t, T); continue; } t -= T_WIN;
        if (t < T_QB) { tr_job(in.mla_w_qb, 512, 3072, (bf16*)(ws + WS_WQB_T), t, T, in.mla_q_a_gain); continue; } t -= T_QB;
        if (t < T_KVB) { tr_job(in.mla_w_kvb, 512, 4096, (bf16*)(ws + WS_WKVB_T), t, T, in.mla_kv_a_gain); continue; } t -= T_KVB;
        tr_job(in.mla_w_o, 2048, 2048, (bf16*)(ws + WS_WO0_T), t, T);
    }
}
__device__ __forceinline__ const float* modv(const unsigned char* ws, int l, int v, int chunk) { return (const float*)(ws + WS_MOD) + (size_t)(l * 2 + v) * 12288 + chunk * 2048; }

__device__ __forceinline__ void norm_mod_row(f32x4 (&v)[8], const float* gain, const float* sh, const float* sc, int lane) {
    float ss = 0.f;
#pragma unroll
    for (int j = 0; j < 8; ++j) ss += (v[j].x * v[j].x + v[j].y * v[j].y) + (v[j].z * v[j].z + v[j].w * v[j].w);
    const float rs = __builtin_amdgcn_rsqf(wave_sum(ss) * (1.f / 2048.f) + EPS);
#pragma unroll
    for (int j = 0; j < 8; ++j) { const int c = 4 * (lane + 64 * j); const f32x4 g = *(const f32x4*)(gain + c), a = *(const f32x4*)(sc + c), b = *(const f32x4*)(sh + c);
        v[j] = v[j] * rs * g * (a + 1.f) + b; }
}
__device__ __forceinline__ void stage_mod_lds(LAS float* ga, LAS float* sb, const float* gain, const float* sh, const float* sc, int tid) {
    *(LAS f32x4*)(ga + 4 * tid) = *(const f32x4*)(gain + 4 * tid) * (*(const f32x4*)(sc + 4 * tid) + 1.f); *(LAS f32x4*)(sb + 4 * tid) = *(const f32x4*)(sh + 4 * tid);
}
__device__ __forceinline__ void norm_mod_row_lds(f32x4 (&v)[8], const LAS float* ga, const LAS float* sb, int lane) {
    float ss = 0.f;
#pragma unroll
    for (int j = 0; j < 8; ++j) ss += (v[j].x * v[j].x + v[j].y * v[j].y) + (v[j].z * v[j].z + v[j].w * v[j].w);
    const float rs = __builtin_amdgcn_rsqf(wave_sum(ss) * (1.f / 2048.f) + EPS);
#pragma unroll
    for (int j = 0; j < 8; ++j) { const int c = 4 * (lane + 64 * j); v[j] = v[j] * rs * *(const LAS f32x4*)(ga + c) + *(const LAS f32x4*)(sb + c); }
}
__device__ __forceinline__ f32x4 bf4(const u32x2 w) { return (f32x4){bflo(w.x), bfhi(w.x), bflo(w.y), bfhi(w.y)}; }
__device__ __forceinline__ void store_row_bf16(bf16* orow, const f32x4 (&v)[8], int lane) {
#pragma unroll
    for (int j = 0; j < 8; ++j) { u32x2 w; w.x = cvtpk(v[j].x, v[j].y); w.y = cvtpk(v[j].z, v[j].w); *(u32x2*)(orow + 4 * (lane + 64 * j)) = w; }
}
__device__ __forceinline__ void phase_norm_in(const In& in, unsigned char* ws, LAS unsigned char* lds, int G, int bid) {
    const int lane = ltid() & 63, gw = bid * 8 + (ltid() >> 6), NGW = G * 8;
    bf16* hb = (bf16*)(ws + WS_HB);
    LAS float* mv = (LAS float*)lds;
    stage_mod_lds(mv, mv + 2048, in.norm_mix, modv(ws, 0, 0, 0), modv(ws, 0, 0, 1), ltid());
    stage_mod_lds(mv + 4096, mv + 6144, in.norm_mix, modv(ws, 0, 1, 0), modv(ws, 0, 1, 1), ltid());
    __syncthreads();
    f32x4 a[8], nx[8];
#define NI_LOAD(dst, rw) do { const float* xr_ = ((rw) >= NL) ? in.ctx + (size_t)((rw) - NL) * 2048 : in.x + (size_t)(rw) * 2048; \
    _Pragma("unroll") for (int j = 0; j < 8; ++j) dst[j] = *(const f32x4*)(xr_ + 4 * (lane + 64 * j)); } while (0)
    if (gw < NTOK) NI_LOAD(a, gw);
    for (int row = gw; row < NTOK; row += NGW) {
        const int v = row >= NL;
        if (row + NGW < NTOK) NI_LOAD(nx, row + NGW);
        norm_mod_row_lds(a, mv + v * 4096, mv + v * 4096 + 2048, lane);
        store_row_bf16(hb + (size_t)row * 2048, a, lane);
#pragma unroll
        for (int j = 0; j < 8; ++j) a[j] = nx[j];
    }
#undef NI_LOAD
    __syncthreads();
}
__device__ __forceinline__ void phase_rownorm_a(const In& in, unsigned char* ws, int G, int bid) {
    const int lane = ltid() & 63, gw = bid * 8 + (ltid() >> 6), NGW = G * 8;
    const bf16* ab = (const bf16*)(ws + WS_AB); bf16* qn = (bf16*)(ws + WS_QN); bf16* kvn = (bf16*)(ws + WS_KVN);
    float gq[8], gk[8];
#pragma unroll
    for (int i = 0; i < 8; ++i) { gq[i] = in.mla_q_a_gain[lane * 8 + i]; gk[i] = in.mla_kv_a_gain[lane * 8 + i]; }
    u32x4 qn_, kn_;
    if (gw < NTOK) { qn_ = *(const u32x4*)(ab + (size_t)gw * WIN_NP + lane * 8); kn_ = *(const u32x4*)(ab + (size_t)gw * WIN_NP + 512 + lane * 8); }
    for (int row = gw; row < NTOK; row += NGW) {
        const u32x4 q = qn_, k = kn_;
        if (row + NGW < NTOK) { qn_ = *(const u32x4*)(ab + (size_t)(row + NGW) * WIN_NP + lane * 8); kn_ = *(const u32x4*)(ab + (size_t)(row + NGW) * WIN_NP + 512 + lane * 8); }
        float qf[8] = {bflo(q.x), bfhi(q.x), bflo(q.y), bfhi(q.y), bflo(q.z), bfhi(q.z), bflo(q.w), bfhi(q.w)};
        float kf[8] = {bflo(k.x), bfhi(k.x), bflo(k.y), bfhi(k.y), bflo(k.z), bfhi(k.z), bflo(k.w), bfhi(k.w)};
        float sq = 0.f, sk = 0.f;
#pragma unroll
        for (int i = 0; i < 8; ++i) { sq += qf[i] * qf[i]; sk += kf[i] * kf[i]; }
        const float rq = __builtin_amdgcn_rsqf(wave_sum(sq) * (1.f / 512.f) + EPS), rk = __builtin_amdgcn_rsqf(wave_sum(sk) * (1.f / 512.f) + EPS);
        u32x4 wq, wk;
        wq.x = cvtpk(qf[0] * rq * gq[0], qf[1] * rq * gq[1]); wq.y = cvtpk(qf[2] * rq * gq[2], qf[3] * rq * gq[3]); wq.z = cvtpk(qf[4] * rq * gq[4], qf[5] * rq * gq[5]); wq.w = cvtpk(qf[6] * rq * gq[6], qf[7] * rq * gq[7]);
        wk.x = cvtpk(kf[0] * rk * gk[0], kf[1] * rk * gk[1]); wk.y = cvtpk(kf[2] * rk * gk[2], kf[3] * rk * gk[3]); wk.z = cvtpk(kf[4] * rk * gk[4], kf[5] * rk * gk[5]); wk.w = cvtpk(kf[6] * rk * gk[6], kf[7] * rk * gk[7]);
        *(u32x4*)(qn + (size_t)row * 512 + lane * 8) = wq; *(u32x4*)(kvn + (size_t)row * 512 + lane * 8) = wk;
    }
}
__device__ __forceinline__ void unpack8(const u32x4 q, float (&f)[8]) { f[0] = bflo(q.x); f[1] = bfhi(q.x); f[2] = bflo(q.y); f[3] = bfhi(q.y); f[4] = bflo(q.z); f[5] = bfhi(q.z); f[6] = bflo(q.w); f[7] = bfhi(q.w); }
__device__ __forceinline__ u32x4 pack8(const float (&f)[8]) { u32x4 w; w.x = cvtpk(f[0], f[1]); w.y = cvtpk(f[2], f[3]); w.z = cvtpk(f[4], f[5]); w.w = cvtpk(f[6], f[7]); return w; }
__device__ __forceinline__ u32x2 pack8_fp8(const float (&f)[8]) { int w0 = 0, w1 = 0;
    w0 = __builtin_amdgcn_cvt_pk_fp8_f32(f[0], f[1], w0, false); w0 = __builtin_amdgcn_cvt_pk_fp8_f32(f[2], f[3], w0, true);
    w1 = __builtin_amdgcn_cvt_pk_fp8_f32(f[4], f[5], w1, false); w1 = __builtin_amdgcn_cvt_pk_fp8_f32(f[6], f[7], w1, true);
    u32x2 r; r.x = (unsigned)w0; r.y = (unsigned)w1; return r; }
__device__ __forceinline__ float sumsq8(const u32x4 q) { float f[8]; unpack8(q, f); float s = 0.f;
#pragma unroll
    for (int i = 0; i < 8; ++i) s += f[i] * f[i];
    return s; }

__device__ __forceinline__ void rope64(float (&pe)[64], const LAS float* ct, const LAS float* st, int row, int col) {
#pragma unroll
    for (int j = 0; j < 16; ++j) { const float c = ct[row * 16 + j], s = st[row * 16 + j]; const float x1 = pe[j], x2 = pe[16 + j]; pe[j] = x1 * c - x2 * s; pe[16 + j] = x2 * c + x1 * s; }
#pragma unroll
    for (int j = 0; j < 16; ++j) { const float c = ct[col * 16 + j], s = st[col * 16 + j]; const float x1 = pe[32 + j], x2 = pe[48 + j]; pe[32 + j] = x1 * c - x2 * s; pe[48 + j] = x2 * c + x1 * s; }
}
__device__ __forceinline__ void phase_headnorm_rope(const In& in, unsigned char* ws, LAS unsigned char* lds, int G, int bid) {
    const int tid = ltid();
    bf16* kvraw = (bf16*)(ws + WS_KVRAW);
    __syncthreads();
    {
        const int lane = tid & 63, wid = tid >> 6, c = lane & 15, q = lane >> 4;
        LAS unsigned* img = (LAS unsigned*)(lds + 36864) + wid * 2048;
        unsigned char* vtb = ws + WS_KPE;
        for (int it = bid * 8 + wid; it < NH * (NTOK / 64); it += G * 8) {
            const int h = it / (NTOK / 64), T = it - h * (NTOK / 64);
            const bf16* vp = kvraw + (size_t)(T * 64) * 4096 + h * 256 + 128 + c * 8;
#pragma unroll
            for (int m = 0; m < 4; ++m) { const int gi = 4 * m + q;
                const int sd = 8 * (gi & 1) + 4 * (gi >> 3) + ((gi & 7) >> 1);
                float f0[8], f1[8], f2[8], f3[8];
                unpack8(*(const u32x4*)(vp + (size_t)(4 * gi) * 4096), f0); unpack8(*(const u32x4*)(vp + (size_t)(4 * gi + 1) * 4096), f1);
                unpack8(*(const u32x4*)(vp + (size_t)(4 * gi + 2) * 4096), f2); unpack8(*(const u32x4*)(vp + (size_t)(4 * gi + 3) * 4096), f3);
#pragma unroll
                for (int i = 0; i < 8; ++i) { int w = 0; w = __builtin_amdgcn_cvt_pk_fp8_f32(f0[i], f1[i], w, false); w = __builtin_amdgcn_cvt_pk_fp8_f32(f2[i], f3[i], w, true);
                    img[(c * 8 + i) * 16 + sd] = (unsigned)w; } }
            asm volatile("s_waitcnt lgkmcnt(0)" ::: "memory");
            u32x4* dst = (u32x4*)(vtb + (size_t)it * 8192);
#pragma unroll
            for (int k = 0; k < 8; ++k) dst[k * 64 + lane] = *(const LAS u32x4*)(img + (k * 64 + lane) * 4);
            asm volatile("s_waitcnt lgkmcnt(0)" ::: "memory");
        }
    }
}
__device__ __forceinline__ void phase_na_headnorm(const In& in, unsigned char* ws, int G, int bid) {
    bf16* qkv = (bf16*)(ws + WS_QKV1);
    const int tid = ltid(), lane = tid & 63, c = lane & 15, gw = bid * 8 + (tid >> 6), NGW = G * 8;
    const f32x4 gq0 = *(const f32x4*)(in.na_q_gain + c * 8), gq1 = *(const f32x4*)(in.na_q_gain + c * 8 + 4), gk0 = *(const f32x4*)(in.na_k_gain + c * 8), gk1 = *(const f32x4*)(in.na_k_gain + c * 8 + 4);
    constexpr int NIT = NTOK * 32 / 4;
    for (int pp = gw; pp < NIT; pp += 4 * NGW) {
        bf16* qp[4]; u32x4 raw[4]; bool isk[4], act[4];
#pragma unroll
        for (int u = 0; u < 4; ++u) { const int pi = pp + u * NGW; act[u] = pi < NIT; const int p = (act[u] ? pi : pp) * 4 + (lane >> 4), t = p >> 5, hh = p & 31; isk[u] = (hh >> 4) != 0;
            qp[u] = qkv + (size_t)t * 6144 + hh * 128 + c * 8; raw[u] = *(const u32x4*)qp[u]; }
#pragma unroll
        for (int u = 0; u < 4; ++u) {
            float f[8]; unpack8(raw[u], f);
            float ss = 0.f;
#pragma unroll
            for (int i = 0; i < 8; ++i) ss += f[i] * f[i];
#pragma unroll
            for (int o = 1; o < 16; o <<= 1) ss += __shfl_xor(ss, o);
            const float rs = __builtin_amdgcn_rsqf(ss * (1.f / 128.f) + EPS);
            const f32x4 g0 = isk[u] ? gk0 : gq0, g1 = isk[u] ? gk1 : gq1;
            f[0] *= rs * g0.x; f[1] *= rs * g0.y; f[2] *= rs * g0.z; f[3] *= rs * g0.w; f[4] *= rs * g1.x; f[5] *= rs * g1.y; f[6] *= rs * g1.z; f[7] *= rs * g1.w;
            if (act[u]) *(u32x4*)qp[u] = pack8(f);
        }
    }
}
__device__ __forceinline__ void router_round(const f32x4 (&a0)[8], const f32x4 (&a1)[8], const bf16x8 (&wh)[8], const bf16x8 (&wl)[8], LAS unsigned char* S, float* aff, int row0, int row1, bool v0, bool v1, int lane, int wid) {
    __syncthreads();
    asm volatile("" : "+v"(lane));
#pragma unroll
    for (int r = 0; r < 2; ++r) { const int n = 2 * wid + r;
#pragma unroll
        for (int j = 0; j < 8; ++j) { const f32x4 a = r ? a1[j] : a0[j];
            u32x2 h, lo; h.x = cvtpk(a.x, a.y); h.y = cvtpk(a.z, a.w);
            lo.x = cvtpk(a.x - bflo(h.x), a.y - bfhi(h.x)); lo.y = cvtpk(a.z - bflo(h.y), a.w - bfhi(h.y));
            const int chunk = (lane + 64 * j) >> 1; const unsigned ad = (unsigned)(n * 4096 + ((chunk ^ n) << 4) + (lane & 1) * 8);
            *(LAS u32x2*)(S + ad) = h; *(LAS u32x2*)(S + 65536 + ad) = lo; } }
    __syncthreads();
    f32x4 acc = {0.f, 0.f, 0.f, 0.f};
    { const int n = lane & 15;
#pragma unroll
      for (int c = 0; c < 8; ++c) { const int q = 32 * wid + 4 * c + (lane >> 4); const unsigned ad = (unsigned)(n * 4096 + ((q ^ n) << 4));
          const bf16x8 bh = *(const LAS bf16x8*)(S + ad), bl = *(const LAS bf16x8*)(S + 65536 + ad);
          acc = __builtin_amdgcn_mfma_f32_16x16x32_bf16(wh[c], bh, acc, 0, 0, 0);
          acc = __builtin_amdgcn_mfma_f32_16x16x32_bf16(wh[c], bl, acc, 0, 0, 0);
          acc = __builtin_amdgcn_mfma_f32_16x16x32_bf16(wl[c], bh, acc, 0, 0, 0); } }
    __syncthreads();
    LAS float* P = (LAS float*)S;
    *(LAS f32x4*)(P + (wid * 16 + (lane & 15)) * 16 + 4 * (lane >> 4)) = acc;
    __syncthreads();
    { const int e = lane & 15, r = (lane >> 4) & 1, h = lane >> 5, n = 2 * wid + r;
      float v = 0.f;
#pragma unroll
      for (int w = 0; w < 4; ++w) v += P[((4 * h + w) * 16 + n) * 16 + e];
      v += __shfl_xor(v, 32);
      float mx = v;
#pragma unroll
      for (int o = 1; o < 16; o <<= 1) mx = fmaxf(mx, __shfl_xor(mx, o));
      const float ex = __expf(v - mx);
      float den = ex;
#pragma unroll
      for (int o = 1; o < 16; o <<= 1) den += __shfl_xor(den, o);
      if (h == 0 && (r ? v1 : v0)) aff[(size_t)e * NTOK + (r ? row1 : row0)] = ex / den; }
}
__device__ __forceinline__ void phase_router(const In& in, unsigned char* ws, LAS unsigned char* lds, int G, int bid, int l, int nrows) {
    const int tid = ltid(), lane = tid & 63, wid = __builtin_amdgcn_readfirstlane(tid >> 6), NGW = G * 8;
    LAS float* mv = (LAS float*)(lds + 131072);
    stage_mod_lds(mv, mv + 2048, in.norm_ffn + l * 2048, modv(ws, l, 0, 3), modv(ws, l, 0, 4), tid);
    bf16x8 wh[8], wl[8];
    { const float* rw = in.router_w + (size_t)l * 2048 * 16 + (size_t)(256 * wid + 8 * (lane >> 4)) * 16 + (lane & 15);
#pragma unroll
      for (int c = 0; c < 8; ++c) { float f[8];
#pragma unroll
          for (int i = 0; i < 8; ++i) f[i] = rw[(32 * c + i) * 16];
          u32x4 h, lo; h.x = cvtpk(f[0], f[1]); h.y = cvtpk(f[2], f[3]); h.z = cvtpk(f[4], f[5]); h.w = cvtpk(f[6], f[7]);
          lo.x = cvtpk(f[0] - bflo(h.x), f[1] - bfhi(h.x)); lo.y = cvtpk(f[2] - bflo(h.y), f[3] - bfhi(h.y)); lo.z = cvtpk(f[4] - bflo(h.z), f[5] - bfhi(h.z)); lo.w = cvtpk(f[6] - bflo(h.w), f[7] - bfhi(h.w));
          wh[c] = __builtin_bit_cast(bf16x8, h); wl[c] = __builtin_bit_cast(bf16x8, lo); } }
    __syncthreads();
    const bf16* x1 = (const bf16*)(ws + WS_X1); bf16* hb = (bf16*)(ws + WS_HB); float* aff = (float*)(ws + WS_AFF);
    { const int nlat = nrows < NL ? nrows : NL;
      u32x2 c0[8], c1[8];
#define RT_LOAD(dst, rw_) do { _Pragma("unroll") for (int j = 0; j < 8; ++j) dst[j] = *(const u32x2*)(x1 + (size_t)(rw_) * 2048 + 4 * (lane + 64 * j)); } while (0)
      const int rfirst = bid * 8 + wid;
      if (bid * 8 < nlat) { RT_LOAD(c0, rfirst); RT_LOAD(c1, (rfirst + NGW < nlat ? rfirst + NGW : rfirst)); }
      for (int base = bid * 8; base < nlat; base += 2 * NGW) {
        const int row = base + wid; const bool two = row + NGW < nlat; const int rowb = two ? row + NGW : row;
        const int rn = row + 2 * NGW;
        f32x4 a0[8], a1[8];
        float ss0 = 0.f, ss1 = 0.f;
#pragma unroll
        for (int j = 0; j < 8; ++j) { a0[j] = bf4(c0[j]); a1[j] = bf4(c1[j]);
            ss0 += (a0[j].x * a0[j].x + a0[j].y * a0[j].y) + (a0[j].z * a0[j].z + a0[j].w * a0[j].w); ss1 += (a1[j].x * a1[j].x + a1[j].y * a1[j].y) + (a1[j].z * a1[j].z + a1[j].w * a1[j].w); }
        __builtin_amdgcn_sched_barrier(0);
        if (base + 2 * NGW < nlat) { RT_LOAD(c0, rn); RT_LOAD(c1, (rn + NGW < nlat ? rn + NGW : rn)); }
        __builtin_amdgcn_sched_barrier(0);
        const float rs0 = __builtin_amdgcn_rsqf(wave_sum(ss0) * (1.f / 2048.f) + EPS), rs1 = __builtin_amdgcn_rsqf(wave_sum(ss1) * (1.f / 2048.f) + EPS);
#pragma unroll
        for (int j = 0; j < 8; ++j) { const int c = 4 * (lane + 64 * j); const f32x4 g = *(const LAS f32x4*)(mv + c), sb = *(const LAS f32x4*)(mv + 2048 + c);
            a0[j] = a0[j] * rs0 * g + sb; a1[j] = a1[j] * rs1 * g + sb; }
        store_row_bf16(hb + (size_t)row * 2048, a0, lane);
        store_row_bf16(hb + (size_t)rowb * 2048, a1, lane);
        router_round(a0, a1, wh, wl, lds, aff, row, rowb, true, two, lane, wid);
      }
#undef RT_LOAD
    }
    for (int base = NL + bid * 8; base < nrows; base += NGW) {
        const int row = base + wid;
        f32x4 a[8];
#pragma unroll
        for (int j = 0; j < 8; ++j) a[j] = bf4(*(const u32x2*)(x1 + (size_t)row * 2048 + 4 * (lane + 64 * j)));
        norm_mod_row(a, in.norm_ffn + l * 2048, modv(ws, l, 1, 3), modv(ws, l, 1, 4), lane);
        store_row_bf16(hb + (size_t)row * 2048, a, lane);
        router_round(a, a, wh, wl, lds, aff, row, row, true, false, lane, wid);
    }
    __syncthreads();
}
__device__ __forceinline__ int block_sum_i(int v, LAS int* red, int tid) {
    v = wave_sum_i(v);
    __syncthreads();
    if ((tid & 63) == 0) red[tid >> 6] = v;
    __syncthreads();
    int s = 0;
#pragma unroll
    for (int w = 0; w < 8; ++w) s += red[w];
    return s;
}
__device__ __forceinline__ void phase_topk(unsigned char* ws, LAS unsigned char* lds, int G, int bid, int nprob) {
    const int tid = ltid(), lane = tid & 63, wid = tid >> 6;
    LAS int* red = (LAS int*)lds; LAS int* scan = red + 16;
    const float* aff = (const float*)(ws + WS_AFF); int* idx = (int*)(ws + WS_IDX); float* gate = (float*)(ws + WS_GATE); int* slot = (int*)(ws + WS_SLOT);
    for (int pb = bid; pb < nprob; pb += G) {
        const int e = pb & 15, isctx = pb >> 4;
        const int n = isctx ? NC : NL, k = isctx ? CAPC : CAPL, tok0 = isctx ? NL : 0, slot0 = isctx ? CAPL : 0;
        const int per = n / 512;
        unsigned key[32];
        const float* ap = aff + (size_t)e * NTOK + tok0;
        if (!isctx) {
#pragma unroll
            for (int j = 0; j < 8; ++j) { const u32x4 q = *(const u32x4*)(ap + tid * 32 + j * 4); key[j * 4] = q.x; key[j * 4 + 1] = q.y; key[j * 4 + 2] = q.z; key[j * 4 + 3] = q.w; }
        } else {
#pragma unroll
            for (int j = 0; j < 32; ++j) key[j] = 0u;
            if (tid < NC) key[0] = __float_as_uint(ap[tid]);
        }
        (void)per;
        unsigned lo = 0u, hi = 0x7f800000u;
        while (hi - lo > 1u) {
            const unsigned mid = lo + ((hi - lo) >> 1);
            int c = 32;
#pragma unroll
            for (int j = 0; j < 32; ++j) c += ((int)key[j] - (int)mid) >> 31;
            c = block_sum_i(c, red, tid);
            if (c >= k) lo = mid; else hi = mid;
        }
        const unsigned T = lo;
        int cg = 32, ce = 32;
#pragma unroll
        for (int j = 0; j < 32; ++j) { cg += ((int)key[j] - (int)(T + 1u)) >> 31; ce += ((int)key[j] - (int)T) >> 31; }
        ce -= cg;
        if (isctx && tid >= NC) { cg = 0; ce = 0; }
        int sg = cg, se = ce;
#pragma unroll
        for (int o = 1; o < 64; o <<= 1) { const int a = __shfl_up(sg, o), b = __shfl_up(se, o); if (lane >= o) { sg += a; se += b; } }
        __syncthreads();
        if (lane == 63) { scan[wid] = sg; scan[8 + wid] = se; }
        __syncthreads();
        int bg = 0, be = 0, totg = 0;
#pragma unroll
        for (int w = 0; w < 8; ++w) { const int a = scan[w], b = scan[8 + w]; if (w < wid) { bg += a; be += b; } totg += a; }
        const int need_eq = k - totg;
        int g_before = bg + sg - cg, e_before = be + se - ce;
        const int nmine = isctx ? (tid < NC ? 1 : 0) : 32;
#pragma unroll
        for (int j = 0; j < 32; ++j) {
            if (j < nmine) {
                const int i = isctx ? tid : tid * 32 + j;
                const bool gt = key[j] > T, eq = key[j] == T;
                const bool sel = gt || (eq && e_before < need_eq);
                const int s = g_before + min(e_before, need_eq);
                if (sel) { idx[e * EROWS + slot0 + s] = tok0 + i; gate[e * EROWS + slot0 + s] = __uint_as_float(key[j]); }
                slot[(size_t)(tok0 + i) * 16 + e] = sel ? slot0 + s : -1;
                g_before += gt ? 1 : 0; e_before += eq ? 1 : 0;
            }
        }
        if (isctx) { for (int s = CAPL + CAPC + tid; s < EROWS; s += 512) { idx[e * EROWS + s] = -1; gate[e * EROWS + s] = 0.f; } }
        __syncthreads();
    }
}
__device__ __forceinline__ void phase_gather(unsigned char* ws, int G, int bid, int rows_per_e) {
    const int lane = ltid() & 63, gw = bid * 8 + (ltid() >> 6), NGW = G * 8;
    const bf16* hb = (const bf16*)(ws + WS_HB); bf16* xs = (bf16*)(ws + WS_XS); const int* idx = (const int*)(ws + WS_IDX);
    for (int r = gw; r < NE * rows_per_e; r += NGW) {
        const int e = r / rows_per_e, s = r - e * rows_per_e; const int t = idx[e * EROWS + s];
        u32x4 v[4];
#pragma unroll
        for (int j = 0; j < 4; ++j) v[j] = (t >= 0) ? *(const u32x4*)(hb + (size_t)t * 2048 + (lane + 64 * j) * 8) : (u32x4){0u, 0u, 0u, 0u};
#pragma unroll
        for (int j = 0; j < 4; ++j) *(u32x4*)(xs + ((size_t)e * EROWS + s) * 2048 + (lane + 64 * j) * 8) = v[j];
    }
}
__device__ __forceinline__ void phase_combine(const In& in, unsigned char* ws, LAS unsigned char* lds, float* out, int G, int bid, int l, int nrows) {
    const int tid = ltid(), lane = tid & 63, gw = bid * 8 + (tid >> 6), NGW = G * 8;
    bf16* x1 = (bf16*)(ws + WS_X1); const bf16* yb = (const bf16*)(ws + WS_YB); const int* slot = (const int*)(ws + WS_SLOT); bf16* hb = (bf16*)(ws + WS_HB);
    LAS float* mv = (LAS float*)lds;
    for (int v = 0; v < (nrows > NL ? 2 : 1); ++v) {
        *(LAS f32x4*)(mv + v * 6144 + 4 * tid) = *(const f32x4*)(modv(ws, l, v, 5) + 4 * tid);
        if (l == 0) stage_mod_lds(mv + v * 6144 + 2048, mv + v * 6144 + 4096, in.norm_mix + 2048, modv(ws, 1, v, 0), modv(ws, 1, v, 1), tid); }
    __syncthreads();
    int nslot = (gw < nrows) ? slot[(size_t)gw * 16 + (lane & 15)] : -1;
    for (int row = gw; row < nrows; row += NGW) {
        const LAS float* mvv = mv + (row >= NL ? 6144 : 0);
        const int myslot = nslot;
        f32x4 a[8];
#pragma unroll
        for (int j = 0; j < 8; ++j) a[j] = bf4(*(const u32x2*)(x1 + (size_t)row * 2048 + 4 * (lane + 64 * j)));
        if (row + NGW < nrows) nslot = slot[(size_t)(row + NGW) * 16 + (lane & 15)];
        f32x4 acc[8];
#pragma unroll
        for (int j = 0; j < 8; ++j) acc[j] = (f32x4){0.f, 0.f, 0.f, 0.f};
        unsigned m = (unsigned)__ballot(myslot >= 0) & 0xffffu;
        while (m) {
            const int e0 = __builtin_ctz(m); m &= m - 1u;
            const bool two = m != 0u; const int e1 = two ? __builtin_ctz(m) : e0; if (two) m &= m - 1u;
            const bf16* y0 = yb + ((size_t)e0 * EROWS + __shfl(myslot, e0)) * 2048; const bf16* y1 = yb + ((size_t)e1 * EROWS + __shfl(myslot, e1)) * 2048;
            u32x2 w0[8], w1[8];
#pragma unroll
            for (int j = 0; j < 8; ++j) w0[j] = *(const u32x2*)(y0 + 4 * (lane + 64 * j));
            if (two) {
#pragma unroll
                for (int j = 0; j < 8; ++j) w1[j] = *(const u32x2*)(y1 + 4 * (lane + 64 * j)); }
#pragma unroll
            for (int j = 0; j < 8; ++j) { acc[j].x += bflo(w0[j].x); acc[j].y += bfhi(w0[j].x); acc[j].z += bflo(w0[j].y); acc[j].w += bfhi(w0[j].y); }
            if (two) {
#pragma unroll
                for (int j = 0; j < 8; ++j) { acc[j].x += bflo(w1[j].x); acc[j].y += bfhi(w1[j].x); acc[j].z += bflo(w1[j].y); acc[j].w += bfhi(w1[j].y); } }
        }
#pragma unroll
        for (int j = 0; j < 8; ++j) a[j] = a[j] + *(const LAS f32x4*)(mvv + 4 * (lane + 64 * j)) * acc[j];
        if (l == 0) {
            store_row_bf16(x1 + (size_t)row * 2048, a, lane);
            norm_mod_row_lds(a, mvv + 2048, mvv + 4096, lane);
            store_row_bf16(hb + (size_t)row * 2048, a, lane);
        } else {
#pragma unroll
            for (int j = 0; j < 8; ++j) *(f32x4*)(out + (size_t)row * 2048 + 4 * (lane + 64 * j)) = a[j];
        }
    }
    __syncthreads();
}
}
#define XB_TMO      128
#define XB_XCNT(j)  (256  + 64 * (j))
#define XB_XSUB(j)  (1280 + 64 * (j))
#define XB_XGEN(j)  (2304 + 64 * (j))
#define XB_TOP      3328
#define XB_TOPGEN   3392
#define XCD_BAR_WORDS 3456
#define XB_SPIN_CAP (1u << 22)

__device__ __forceinline__ unsigned xb_ld(unsigned* p)              { return __hip_atomic_load(p, __ATOMIC_RELAXED, __HIP_MEMORY_SCOPE_AGENT); }
__device__ __forceinline__ unsigned xb_add(unsigned* p, unsigned v) { return __hip_atomic_fetch_add(p, v, __ATOMIC_RELAXED, __HIP_MEMORY_SCOPE_AGENT); }
__device__ __forceinline__ unsigned xb_xcc_id() { return (unsigned)__builtin_amdgcn_s_getreg((3 << 11) | 20) & 0xFu; }
#define XB_SPIN(cond, bar) do { unsigned _sp = 0; while (cond) { __builtin_amdgcn_s_sleep(1); \
    if ((++_sp & 255u) == 0u) { if (xb_ld(&(bar)[XB_TMO])) break; if (_sp > XB_SPIN_CAP) { atomicAdd(&(bar)[XB_TMO], 1u); break; } } } } while (0)

struct XcdBarrier { unsigned* bar; unsigned x; volatile LAS unsigned* st; };

__device__ __forceinline__ XcdBarrier xcd_barrier_post(unsigned* bar, volatile LAS unsigned* st) {
    XcdBarrier b; b.bar = bar; b.x = xb_xcc_id(); b.st = st;
    if (threadIdx.x == 0) (void)xb_add(&bar[XB_XCNT(b.x)], 1u);
    return b;
}
__device__ __forceinline__ void xcd_barrier_complete(unsigned* bar, unsigned x, unsigned& nloc, unsigned& nx) {
    const unsigned G = gridDim.x * gridDim.y * gridDim.z;
    unsigned sum, cnt, mine, sp = 0u;
    for (;;) {
        sum = 0u; cnt = 0u; mine = 0u;
#pragma unroll
        for (unsigned j = 0; j < 16; ++j) { const unsigned c = xb_ld(&bar[XB_XCNT(j)]); sum += c; cnt += (c > 0u) ? 1u : 0u; mine = (j == x) ? c : mine; }
        if (sum == G) break;
        __builtin_amdgcn_s_sleep(1);
        if ((++sp & 255u) == 0u) { if (xb_ld(&bar[XB_TMO])) break; if (sp > XB_SPIN_CAP) { atomicAdd(&bar[XB_TMO], 1u); break; } }
    }
    nloc = mine > 0u ? mine : 1u; nx = cnt > 0u ? cnt : 1u;
}
__device__ __forceinline__ void xcd_barrier(const XcdBarrier& b) {
    asm volatile("s_waitcnt vmcnt(0)" ::: "memory");
    __syncthreads();
    if (threadIdx.x == 0) {
        unsigned* bar = b.bar;
        __builtin_amdgcn_s_waitcnt(0);
        unsigned nloc = b.st[0], nx = b.st[1];
        if (nloc == 0u) { xcd_barrier_complete(bar, b.x, nloc, nx); b.st[0] = nloc; b.st[1] = nx; }
        const unsigned old = xb_add(&bar[XB_XSUB(b.x)], 1u);
        const unsigned gen = old / nloc;
        if (old + 1u == (gen + 1u) * nloc) {
            __builtin_amdgcn_fence(__ATOMIC_RELEASE, "agent");
            asm volatile("s_waitcnt vmcnt(0)" ::: "memory");
            const unsigned og = xb_add(&bar[XB_TOP], 1u);
            const unsigned tg = og / nx;
            if (og + 1u == (tg + 1u) * nx) xb_add(&bar[XB_TOPGEN], 1u);
            else XB_SPIN(xb_ld(&bar[XB_TOPGEN]) == tg, bar);
            __builtin_amdgcn_fence(__ATOMIC_ACQUIRE, "agent");
            xb_add(&bar[XB_XGEN(b.x)], 1u);
            asm volatile("s_waitcnt vmcnt(0)" ::: "memory");
        } else {
            XB_SPIN(xb_ld(&bar[XB_XGEN(b.x)]) == gen, bar);
            __builtin_amdgcn_fence(__ATOMIC_ACQUIRE, "agent");
            asm volatile("s_waitcnt vmcnt(0)" ::: "memory");
        }
    }
    __syncthreads();
}

#ifndef MK_PER_PHASE
#define MK_PER_PHASE 0
#endif
constexpr int NPHASE = 25;
constexpr int LDS_BYTES = 148480;
constexpr int MISC_OFF = 147456 + 64;

struct Args { thin::In in; float* out; unsigned char* ws; int ph_lo, ph_hi; };
#define CAS __attribute__((address_space(4)))
typedef const CAS Args* ArgsP;
__device__ __forceinline__ ArgsP opaque(ArgsP p) { asm volatile("" : "+s"(p)); return p; }
__device__ __forceinline__ thin::In load_in(ArgsP A) { thin::In r;
    r.x = A->in.x; r.c = A->in.c; r.ctx = A->in.ctx; r.c_ctx = A->in.c_ctx; r.ada_w = A->in.ada_w; r.ada_b = A->in.ada_b; r.norm_mix = A->in.norm_mix; r.norm_ffn = A->in.norm_ffn;
    r.mla_w_in = A->in.mla_w_in; r.mla_q_a_gain = A->in.mla_q_a_gain; r.mla_kv_a_gain = A->in.mla_kv_a_gain; r.mla_w_qb = A->in.mla_w_qb; r.mla_w_kvb = A->in.mla_w_kvb;
    r.mla_q_gain = A->in.mla_q_gain; r.mla_k_gain = A->in.mla_k_gain; r.mla_w_o = A->in.mla_w_o; r.na_w_qkv = A->in.na_w_qkv; r.na_q_gain = A->in.na_q_gain; r.na_k_gain = A->in.na_k_gain;
    r.na_rpb = A->in.na_rpb; r.na_w_o = A->in.na_w_o; r.router_w = A->in.router_w; r.moe_w_gate = A->in.moe_w_gate; r.moe_w_up = A->in.moe_w_up; r.moe_w_down = A->in.moe_w_down; return r; }

__global__ void __launch_bounds__(512, 2) fwd_kernel(Args args) {
    extern __shared__ __attribute__((aligned(16))) unsigned char lds_raw[];
    LAS unsigned char* lds = (LAS unsigned char*)lds_raw;
    const int tid = threadIdx.x, G = gridDim.x, bid = blockIdx.x;
    ArgsP ap = (ArgsP)__builtin_amdgcn_kernarg_segment_ptr();
    volatile LAS unsigned* MISC = (volatile LAS unsigned*)(lds + MISC_OFF);
    if (tid < 32) MISC[tid] = 0u;
    __syncthreads();
    XcdBarrier bar; bar.bar = (unsigned*)(ap->ws + WS_CTL) + CW_BAR; bar.x = 0; bar.st = MISC + 8;
    if (!MK_PER_PHASE) bar = xcd_barrier_post((unsigned*)(ap->ws + WS_CTL) + CW_BAR, MISC + 8);
    const int lo = ap->ph_lo, hi = ap->ph_hi;
#ifndef DBG_ONLY
#define DBG_ONLY -1
#endif
#ifndef DBG_MASK
#define DBG_MASK 0xFFFFFFFFu
#endif
#ifndef REPMASK
#define REPMASK 0u
#endif
#define RP(k) for (int rep_ = 0; rep_ < 1 + (int)((REPMASK >> (k)) & 1u); ++rep_)
#define EN(k) ((DBG_ONLY < 0 || DBG_ONLY == (k)) && ((DBG_MASK >> (k)) & 1u))
#define IN(k) ({ int lo_ = lo, hi_ = hi; asm volatile("" : "+s"(lo_), "+s"(hi_)); (lo_ <= (k) && (k) < hi_); })
#define SEAM(k) do { if (IN(k) && IN((k) + 1)) xcd_barrier(bar); else __syncthreads(); } while (0)
#define PH_ARGS() ArgsP A_ = opaque(ap); const thin::In in = load_in(A_); unsigned char* const ws = A_->ws; (void)in; (void)ws

    if (EN(0) && IN(0)) { PH_ARGS(); RP(0) thin::phase_prologue(in, ws, lds, G, bid); } SEAM(0);
    if (EN(2) && IN(2)) { PH_ARGS(); RP(2) thin::phase_norm_in(in, ws, lds, G, bid); } SEAM(2);
    if (EN(3) && IN(3)) { PH_ARGS(); RP(3) {
        pg8::Gemm g{(const bf16*)(ws + WS_HB), (const bf16*)(ws + WS_WIN_T), NTOK, WIN_NP, 2048}; pg8::StaticOrder S; S.init(NTOK, WIN_NP, G, bid);
        pg8::EpiWin E{(bf16*)(ws + WS_AB), (float*)(ws + WS_PS), (float*)(ws + WS_KPER), in.mla_k_gain, (const float*)(ws + WS_MODP)};
        pg8::gemm_phase<pg8::EpiWin, pg8::StaticOrder, true, true>(lds, g, S, E);
    } thin::late_work(in, ws, lds, G, 3, 0); } SEAM(3);
    if (EN(5) && IN(5)) { PH_ARGS(); RP(5) {
        { pg8::Gemm g{(const bf16*)(ws + WS_AB), (const bf16*)(ws + WS_WQB_T), NTOK, 3072, 512, WIN_NP}; pg8::StaticOrder S; S.init(NTOK, 3072, G, bid);
          pg8::EpiBf16P E{(bf16*)(ws + WS_QRAW), 3072};
          pg8::gemm_phase<pg8::EpiBf16P, pg8::StaticOrder, true, true>(lds, g, S, E); }
        __syncthreads();
        { pg8::Gemm g{(const bf16*)(ws + WS_AB) + 512, (const bf16*)(ws + WS_WKVB_T), NTOK, 4096, 512, WIN_NP}; pg8::StaticOrder S; S.init(NTOK, 4096, G, (bid + 28) % G);
          pg8::EpiKv E{(bf16*)(ws + WS_KVRAW), in.mla_k_gain, (const float*)(ws + WS_KPER), (const float*)(ws + WS_PS), (LAS float*)(lds + 131072), ws + WS_KPE};
          pg8::gemm_phase<pg8::EpiKv, pg8::StaticOrder, true, true>(lds, g, S, E); }
    } thin::late_work(in, ws, lds, G, 5, 0); } SEAM(5);
    if (EN(7) && IN(7)) { PH_ARGS(); RP(7) {
        const unsigned char* q8 = ws + WS_QRAW; const unsigned char* k8 = ws + WS_KVRAW; const unsigned char* vt = ws + WS_KPE; bf16* ob = (bf16*)(ws + WS_OB);
        const int nun = (G == 256) ? 5 : 0;
        for (int i = 0; i < nun; ++i) {
            const int x = bid & 7, rr = bid >> 3;
            int h, qb; bool isctx = false;
            if (i < 4) { h = 2 * x + (i >> 1); qb = rr * 2 + (i & 1); }
            else { if (rr >= 2) break; h = 2 * x + rr; qb = 0; isctx = true; }
            __syncthreads();
            if (!isctx) att::mla_unit(q8 + (size_t)(qb * 256) * 6144 + h * 384, k8 + h * 512, vt + (size_t)h * (NTOK / 64) * 8192, ob + (size_t)(qb * 256) * 2048 + h * 128, NTOK, (LAS char*)lds, in.mla_q_gain, (const float*)(ws + WS_MODP), (const float*)(ws + WS_PS), qb * 256, true);
            else att::mla_unit(q8 + (size_t)NL * 6144 + h * 384, k8 + (size_t)NL * 8192 + h * 512, vt + ((size_t)h * (NTOK / 64) + NL / 64) * 8192, ob + (size_t)NL * 2048 + h * 128, NC, (LAS char*)lds, in.mla_q_gain, (const float*)(ws + WS_MODP), (const float*)(ws + WS_PS), NL, false);
        }
        if (G != 256)
        for (int u = bid; u < 1040; u += G) {
            __syncthreads();
            if (u < 1024) { const int h = u >> 6, qb = u & 63;
                att::mla_unit(q8 + (size_t)(qb * 256) * 6144 + h * 384, k8 + h * 512, vt + (size_t)h * (NTOK / 64) * 8192, ob + (size_t)(qb * 256) * 2048 + h * 128, NTOK, (LAS char*)lds, in.mla_q_gain, (const float*)(ws + WS_MODP), (const float*)(ws + WS_PS), qb * 256, true);
            } else { const int h = u - 1024;
                att::mla_unit(q8 + (size_t)NL * 6144 + h * 384, k8 + (size_t)NL * 8192 + h * 512, vt + ((size_t)h * (NTOK / 64) + NL / 64) * 8192, ob + (size_t)NL * 2048 + h * 128, NC, (LAS char*)lds, in.mla_q_gain, (const float*)(ws + WS_MODP), (const float*)(ws + WS_PS), NL, false); }
        }
    } thin::late_work(in, ws, lds, G, 7, 0); } SEAM(7);
    if (EN(8) && IN(8)) { PH_ARGS(); RP(8) {
        pg8::Gemm g{(const bf16*)(ws + WS_OB), (const bf16*)(ws + WS_WO0_T), NTOK, 2048, 2048}; pg8::StaticOrder S; S.init(NTOK, 2048, G, bid);
        pg8::EpiResB<false> E{(bf16*)(ws + WS_X1), in.x, in.ctx, thin::modv(ws, 0, 0, 2), thin::modv(ws, 0, 1, 2)};
        pg8::gemm_phase<pg8::EpiResB<false>, pg8::StaticOrder, true, true>(lds, g, S, E);
    } thin::late_work(in, ws, lds, G, 8, 0); } SEAM(8);
#define MOE_PHASES(L, PB, PC) \
    if (EN(9) && IN(PB + 0)) { PH_ARGS(); RP(9) thin::phase_router(in, ws, lds, G, bid, L, L ? NL : NTOK); } SEAM(PB + 0); \
    if (EN(10) && IN(PB + 1)) { PH_ARGS(); RP(10) thin::phase_topk(ws, lds, G, bid, L ? 16 : 32); thin::late_work(in, ws, lds, G, PB + 1, 0); thin::late_work(in, ws, lds, G, -1, L ? thin::LIM_GU1 : thin::LIM_MOE0); } SEAM(PB + 1); \
    if (EN(12) && IN(PB + 3)) { PH_ARGS(); RP(12) { \
        pg8::Gemm g{(const bf16*)(ws + WS_HB), (const bf16*)(ws + WS_WGU_T) + (size_t)L * WGU_L, NE * EROWS, NE * 2816, 2048}; \
        pg8::GroupedOrder S; S.init(L ? 8 : 9, 11, G, bid); \
        pg8::EpiSwiGLU E{(bf16*)(ws + WS_HID)}; \
        pg8::gemm_phase_gather<pg8::EpiSwiGLU, pg8::GroupedOrder, true, true>(lds, g, (const int*)(ws + WS_IDX), S, E);     \
    } thin::late_work(in, ws, lds, G, PB + 3, 0); if (L == 1) thin::late_work(in, ws, lds, G, -1, thin::LIM_ALL); } SEAM(PB + 3);     \
    if (EN(13) && IN(PB + 4)) { PH_ARGS(); RP(13) { \
        pg8::Gemm g{(const bf16*)(ws + WS_HID), (const bf16*)(ws + WS_WD_T) + (size_t)L * WD_L, NE * EROWS, NE * 2048, FF}; \
        pg8::GroupedOrder S; S.init(L ? 8 : 9, 8, G, bid); \
        pg8::EpiDown E{(bf16*)(ws + WS_YB), (const float*)(ws + WS_GATE)}; \
        pg8::gemm_phase<pg8::EpiDown, pg8::GroupedOrder, true, true>(lds, g, S, E); \
    } if (L == 0) thin::late_work(in, ws, lds, G, PB + 4, 0); } SEAM(PB + 4); \
    if (EN(14) && IN(PC)) { PH_ARGS(); RP(14) thin::phase_combine(in, ws, lds, A_->out, G, bid, L, L ? NL : NTOK); if (L == 0) thin::late_work(in, ws, lds, G, -1, thin::LIM_NA); }

    MOE_PHASES(0, 9, 14)
    SEAM(14);
    if (EN(15) && IN(15)) { PH_ARGS(); RP(15) {
        pg8::Gemm g{(const bf16*)(ws + WS_HB), (const bf16*)(ws + WS_WQKV_T), NTOK, 6144, 2048}; pg8::StaticOrder S; S.init(NTOK, 6144, G, bid);
        pg8::EpiQkvNorm E{(bf16*)(ws + WS_QKV1), in.na_q_gain, in.na_k_gain, (LAS float*)(lds + 131072)};
        pg8::gemm_phase<pg8::EpiQkvNorm, pg8::StaticOrder, true, true>(lds, g, S, E);
    } thin::late_work(in, ws, lds, G, 15, 0); } SEAM(15);
    if (EN(17) && IN(17)) { PH_ARGS(); RP(17) {
        for (int u = bid; u < 1024; u += G) { const int h = u >> 6, rb = u & 63;
            __syncthreads();
            att::na_unit((const bf16*)(ws + WS_QKV1), h, rb, in.na_rpb + h * 465, (bf16*)(ws + WS_OB), (LAS char*)lds); }
    } thin::late_work(in, ws, lds, G, 17, 0); } SEAM(17);
    if (EN(18) && IN(18)) { PH_ARGS(); RP(18) {
        pg8::Gemm g{(const bf16*)(ws + WS_OB), (const bf16*)(ws + WS_WO1_T), NL, 2048, 2048}; pg8::StaticOrder S; S.init(NL, 2048, G, bid);
        pg8::EpiResB<true> E{(bf16*)(ws + WS_X1), ws + WS_X1, ws + WS_X1, thin::modv(ws, 1, 0, 2), thin::modv(ws, 1, 0, 2)};
        pg8::gemm_phase<pg8::EpiResB<true>, pg8::StaticOrder, true, true>(lds, g, S, E);
    } thin::late_work(in, ws, lds, G, 18, 0); } SEAM(18);
    MOE_PHASES(1, 19, 24)
#undef MOE_PHASES
#undef IN
#undef SEAM
}

extern "C" void kernel_launch(void* const* d_in, const int* in_sizes, int n_in, void* d_out, int out_size, void* d_ws, size_t ws_size, hipStream_t stream) {
    static int grid = 0;
    if (grid == 0) {
        if (n_in != 25 || in_sizes[0] != NL * DM || out_size != NL * DM || ws_size < WS_END) {
            fprintf(stderr, "kernel_launch: unexpected problem: n_in %d in0 %d out %d ws %zu (need %zu)\n", n_in, n_in > 0 ? in_sizes[0] : -1, out_size, ws_size, (size_t)WS_END); grid = -1; return; }
        int dev = 0, cus = 0, per_cu = 0;
        if (hipGetDevice(&dev) != hipSuccess || hipDeviceGetAttribute(&cus, hipDeviceAttributeMultiprocessorCount, dev) != hipSuccess) { grid = -1; return; }
        if (hipFuncSetAttribute((const void*)fwd_kernel, hipFuncAttributeMaxDynamicSharedMemorySize, LDS_BYTES) != hipSuccess) { fprintf(stderr, "kernel_launch: hipFuncSetAttribute failed\n"); grid = -1; return; }
        if (hipOccupancyMaxActiveBlocksPerMultiprocessor(&per_cu, (const void*)fwd_kernel, 512, LDS_BYTES) != hipSuccess || per_cu < 1)
            fprintf(stderr, "kernel_launch: note: occupancy query reports %d workgroups per CU\n", per_cu);
        (void)hipGetLastError();
        grid = cus;
    }
    if (grid < 0) return;
    if (hipMemsetAsync((char*)d_ws + WS_CTL, 0, CTL_ZERO_BYTES, stream) != hipSuccess) { fprintf(stderr, "kernel_launch: memset failed\n"); return; }
    Args a{};
    const float** ip = (const float**)&a.in;
    for (int i = 0; i < 25; ++i) ip[i] = (const float*)d_in[i];
    a.out = (float*)d_out; a.ws = (unsigned char*)d_ws;
#if MK_PER_PHASE
    for (int p = 0; p < NPHASE; ++p) { a.ph_lo = p; a.ph_hi = p + 1;
        hipLaunchKernelGGL(fwd_kernel, dim3(grid), dim3(512), LDS_BYTES, stream, a); }
#else
    a.ph_lo = 0; a.ph_hi = NPHASE;
    hipLaunchKernelGGL(fwd_kernel, dim3(grid), dim3(512), LDS_BYTES, stream, a);
#endif
    const hipError_t le = hipPeekAtLastError();
    if (le != hipSuccess) fprintf(stderr, "kernel_launch: launch failed: %s\n", hipGetErrorName(le));
}
```
